# Optimizing an MI355X kernel written in HIP

```python
import math
import jax, jax.numpy as jnp
from jax import lax
import numpy as np

D_MODEL = 1024
BATCH = 32
SEQ = 256
DEPTH = 2
DEC_BATCH = 4
DEC_SEQ = 4096
PAST_LEN = 256

GRID_W = 64
HEAD_DIM = 64
A_HEADS = 8
A_KV_HEADS = 2
A_GROUP = A_HEADS // A_KV_HEADS
B_HEADS = 4
WINDOW = 128
BLOCK = 128
N_BAND = -(-WINDOW // BLOCK)
ROPE_BASE = 10000.0
ATT_SIZES = [A_HEADS * HEAD_DIM, A_KV_HEADS * HEAD_DIM, A_KV_HEADS * HEAD_DIM,
             B_HEADS * 2 * HEAD_DIM, B_HEADS * 2 * HEAD_DIM, B_HEADS * 2 * HEAD_DIM]
ATT_IN = sum(ATT_SIZES)
ATT_OUT = A_HEADS * HEAD_DIM + B_HEADS * 2 * HEAD_DIM
D_RNN = 1280
RNN_BLOCKS = 10
RNN_BW = D_RNN // RNN_BLOCKS
CONV_W = 4
CONV_LEFT = (CONV_W - 1) // 2
RGLRU_C = 8.0
D_FF = 4 * D_MODEL
N_ATT = (DEPTH + 1) // 2
N_REC = DEPTH // 2
EPS = 1e-6
SCALE = HEAD_DIM ** -0.5
NEG = -1e30

kernel_name = 'hybrid_diffusion_prefix_step'

F32 = jnp.float32


def rmsnorm(x, g):
    xf = x.astype(F32)
    y = xf * lax.rsqrt(jnp.mean(xf * xf, axis=-1, keepdims=True) + EPS)
    return (y * g.astype(F32)).astype(x.dtype)


def ada_mod(cvec, w, b):
    m = jax.nn.silu(cvec) @ w + b
    return jnp.split(m[:, None, :], 6, axis=-1)


def modulate(h, shift, scale):
    return h * (1.0 + scale) + shift


def axial_rope_tables(n_tokens):
    rows = n_tokens // GRID_W
    r, cl = jnp.meshgrid(jnp.arange(rows, dtype=F32), jnp.arange(GRID_W, dtype=F32), indexing='ij')
    quarter = HEAD_DIM // 4
    inv = ROPE_BASE ** (-jnp.arange(quarter, dtype=F32) / quarter)
    ang = jnp.stack([r.reshape(-1)[:, None] * inv, cl.reshape(-1)[:, None] * inv], axis=1)
    return jnp.cos(ang)[:, None], jnp.sin(ang)[:, None]


def apply_rope(x, cos, sin):
    B, T, H, _ = x.shape
    xf = x.astype(F32).reshape(B, T, H, 2, 2, HEAD_DIM // 4)
    x1, x2 = xf[..., 0, :], xf[..., 1, :]
    out = jnp.stack([x1 * cos - x2 * sin, x1 * sin + x2 * cos], axis=-2)
    return out.reshape(B, T, H, HEAD_DIM).astype(x.dtype)


def rope_pairs(x, cos, sin):
    B, T, H, E = x.shape
    return apply_rope(x.reshape(B, T, 2 * H, HEAD_DIM), cos, sin).reshape(B, T, H, E)


def att_project(h, w_in):
    B, T, _ = h.shape
    idx = np.cumsum(ATT_SIZES)[:-1].tolist()
    qa, ka, va, qb, kb, vb = jnp.split(h @ w_in, idx, axis=-1)
    return (qa.reshape(B, T, A_HEADS, HEAD_DIM), ka.reshape(B, T, A_KV_HEADS, HEAD_DIM),
            va.reshape(B, T, A_KV_HEADS, HEAD_DIM), qb.reshape(B, T, B_HEADS, 2 * HEAD_DIM),
            kb.reshape(B, T, B_HEADS, 2 * HEAD_DIM), vb.reshape(B, T, B_HEADS, 2 * HEAD_DIM))


def sink_attention_dense(q, k, v, sink):
    B, Q, H, d = q.shape
    nq = Q // BLOCK
    qb = jnp.moveaxis(q.reshape(B, nq, BLOCK, A_KV_HEADS, A_GROUP, d), 1, 0)
    sink_l = sink.reshape(A_KV_HEADS, A_GROUP).astype(F32)

    def one(qi):
        s = jnp.einsum('bqkgd,bskd->bkgqs', qi, k).astype(F32) * SCALE
        sk = jnp.broadcast_to(sink_l[None, :, :, None, None], s.shape[:-1] + (1,))
        p = jax.nn.softmax(jnp.concatenate([s, sk], axis=-1), axis=-1)[..., :-1]
        return jnp.einsum('bkgqs,bskd->bqkgd', p.astype(v.dtype), v)

    o = lax.map(one, qb)
    return jnp.moveaxis(o, 0, 1).reshape(B, Q, H, d)


def banded_sink_attention(q, k, v, kc, vc, sink):
    B, T, H, d = q.shape
    nb = T // BLOCK
    L = kc.shape[1]
    qb = q.reshape(B, nb, BLOCK, A_KV_HEADS, A_GROUP, d)

    def band(t):
        tp = jnp.pad(t, ((0, 0), (N_BAND * BLOCK, N_BAND * BLOCK), (0, 0), (0, 0)))
        tp = tp.reshape(B, nb + 2 * N_BAND, BLOCK, A_KV_HEADS, d)
        return jnp.concatenate([tp[:, j:j + nb] for j in range(2 * N_BAND + 1)], axis=2)

    kb, vb = band(k), band(v)
    S = (2 * N_BAND + 1) * BLOCK
    start = jnp.arange(nb)[:, None] * BLOCK
    qpos = start + jnp.arange(BLOCK)[None]
    kpos = start + jnp.arange(S)[None] - N_BAND * BLOCK
    mask = ((jnp.abs(qpos[:, :, None] - kpos[:, None, :]) <= WINDOW)
            & (kpos[:, None, :] >= 0) & (kpos[:, None, :] < T))
    s_band = jnp.einsum('bnqkgd,bnskd->bnkgqs', qb, kb).astype(F32) * SCALE
    s_band = jnp.where(mask[None, :, None, None], s_band, NEG)
    s_ctx = jnp.einsum('bnqkgd,bskd->bnkgqs', qb, kc).astype(F32) * SCALE
    sk = jnp.broadcast_to(sink.reshape(A_KV_HEADS, A_GROUP).astype(F32)[None, None, :, :, None, None],
                          s_ctx.shape[:-1] + (1,))
    p = jax.nn.softmax(jnp.concatenate([s_ctx, s_band, sk], axis=-1), axis=-1)
    p_ctx = p[..., :L].astype(v.dtype)
    p_band = p[..., L:L + S].astype(v.dtype)
    o = (jnp.einsum('bnkgqs,bskd->bnqkgd', p_ctx, vc)
         + jnp.einsum('bnkgqs,bnskd->bnqkgd', p_band, vb))
    return o.reshape(B, T, H, d)


def diff_lambda(lam_qk, lambda_init):
    lq = lam_qk.astype(F32)
    return jnp.exp(jnp.sum(lq[0] * lq[1])) - jnp.exp(jnp.sum(lq[2] * lq[3])) + lambda_init


def diff_attention(q, k, v, lam):
    B, Q, H, E = q.shape
    d = E // 2
    k1, k2 = k[..., :d], k[..., d:]
    nq = Q // BLOCK
    qb = jnp.moveaxis(q.reshape(B, nq, BLOCK, H, E), 1, 0)

    def one(qi):
        s1 = jnp.einsum('bqhd,bshd->bhqs', qi[..., :d], k1).astype(F32) * SCALE
        s2 = jnp.einsum('bqhd,bshd->bhqs', qi[..., d:], k2).astype(F32) * SCALE
        w = jax.nn.softmax(s1, axis=-1) - lam * jax.nn.softmax(s2, axis=-1)
        return jnp.einsum('bhqs,bshe->bqhe', w.astype(v.dtype), v)

    o = lax.map(one, qb)
    return jnp.moveaxis(o, 0, 1).reshape(B, Q, H, E)


def att_merge(oa, ob, subln, lambda_init, w_out):
    B, T = oa.shape[:2]
    ob = rmsnorm(ob, subln) * (1.0 - lambda_init)
    return jnp.concatenate([oa.reshape(B, T, -1), ob.reshape(B, T, -1)], axis=-1) @ w_out


def att_mixer_context(h, w_in, w_out, sink, lam_qk, subln, lambda_init):
    qa, ka, va, qb, kb, vb = att_project(h, w_in)
    oa = sink_attention_dense(qa, ka, va, sink)
    ob = diff_attention(qb, kb, vb, diff_lambda(lam_qk, lambda_init))
    return att_merge(oa, ob, subln, lambda_init, w_out), (ka, va, kb, vb)


def att_mixer_latent(h, ck_a, cv_a, ck_b, cv_b, w_in, w_out, sink, lam_qk, subln, lambda_init):
    cos, sin = axial_rope_tables(h.shape[1])
    qa, ka, va, qb, kb, vb = att_project(h, w_in)
    qa, ka = apply_rope(qa, cos, sin), apply_rope(ka, cos, sin)
    qb, kb = rope_pairs(qb, cos, sin), rope_pairs(kb, cos, sin)
    oa = banded_sink_attention(qa, ka, va, ck_a.astype(ka.dtype), cv_a.astype(va.dtype), sink)
    k_all = jnp.concatenate([ck_b.astype(kb.dtype), kb], axis=1)
    v_all = jnp.concatenate([cv_b.astype(vb.dtype), vb], axis=1)
    ob = diff_attention(qb, k_all, v_all, diff_lambda(lam_qk, lambda_init))
    return att_merge(oa, ob, subln, lambda_init, w_out)


def centred_dwconv(x, w, b):
    T = x.shape[1]
    xp = jnp.pad(x, ((0, 0), (CONV_LEFT, CONV_W - 1 - CONV_LEFT), (0, 0)))
    y = b + xp[:, 0:T] * w[0]
    for j in range(1, CONV_W):
        y = y + xp[:, j:j + T] * w[j]
    return y


def block_diag(x, w, b):
    B, T, _ = x.shape
    return jnp.einsum('btnc,ncd->btnd', x.reshape(B, T, RNN_BLOCKS, RNN_BW), w).reshape(B, T, D_RNN) + b


def rglru_scan(x, w_a, b_a, w_x, b_x, lam, h0, reverse):
    r = jax.nn.sigmoid(block_diag(x, w_a, b_a).astype(F32))
    i = jax.nn.sigmoid(block_diag(x, w_x, b_x).astype(F32))
    log_a = -RGLRU_C * r * jax.nn.softplus(-lam.astype(F32))
    a = jnp.exp(log_a)
    u = jnp.sqrt(-jnp.expm1(2.0 * log_a)) * (i * x.astype(F32))

    def step(hc, au):
        hc = au[0] * hc + au[1]
        return hc, hc

    hT, hs = lax.scan(step, h0.astype(F32), (jnp.moveaxis(a, 1, 0), jnp.moveaxis(u, 1, 0)), reverse=reverse)
    return jnp.moveaxis(hs, 0, 1), hT


def rec_mixer(h, h0_f, h0_b, w_in, conv_w, conv_b, w_a, b_a, w_x, b_x, lam, w_out):
    gate, xr = jnp.split(h @ w_in, 2, axis=-1)
    xr = centred_dwconv(xr, conv_w, conv_b)
    hf, sf = rglru_scan(xr, w_a[0], b_a[0], w_x[0], b_x[0], lam[0], h0_f, False)
    hb, sb = rglru_scan(xr, w_a[1], b_a[1], w_x[1], b_x[1], lam[1], h0_b, True)
    y = (hf + hb).astype(h.dtype) * jax.nn.gelu(gate)
    return y @ w_out, sf, sb


def sq_relu_mlp(h, w1, w2):
    return jnp.square(jax.nn.relu(h @ w1)) @ w2


def setup_inputs(seed: int = 0) -> dict:
    key = jax.random.key(seed)
    ks = jax.random.split(key, 32)

    def nrm(k, shape, scale=1.0):
        return jax.random.normal(k, shape, F32) * scale

    a0 = jax.random.uniform(ks[29], (N_REC, 2, D_RNN), F32, minval=0.9, maxval=0.999)
    a1 = a0 ** (1.0 / RGLRU_C)
    return {
        'x_prompt': nrm(ks[0], (BATCH, SEQ, D_MODEL)),
        'x_sample': nrm(ks[1], (DEC_BATCH, DEC_SEQ, D_MODEL)),
        'cache_a_k': nrm(ks[2], (DEC_BATCH, N_ATT, PAST_LEN, A_KV_HEADS, HEAD_DIM)),
        'cache_a_v': nrm(ks[3], (DEC_BATCH, N_ATT, PAST_LEN, A_KV_HEADS, HEAD_DIM)),
        'cache_b_k': nrm(ks[4], (DEC_BATCH, N_ATT, PAST_LEN, B_HEADS, 2 * HEAD_DIM)),
        'cache_b_v': nrm(ks[5], (DEC_BATCH, N_ATT, PAST_LEN, B_HEADS, 2 * HEAD_DIM)),
        'state_fwd': nrm(ks[6], (DEC_BATCH, N_REC, D_RNN), 0.5),
        'state_bwd': nrm(ks[7], (DEC_BATCH, N_REC, D_RNN), 0.5),
        'c': nrm(ks[8], (DEC_BATCH, D_MODEL)),
        'c_ctx': nrm(ks[9], (D_MODEL,)),
        'norm1': 1.0 + nrm(ks[10], (DEPTH, D_MODEL), 0.02),
        'norm2': 1.0 + nrm(ks[11], (DEPTH, D_MODEL), 0.02),
        'w_ada': nrm(ks[12], (DEPTH, D_MODEL, 6 * D_MODEL), 0.5 * D_MODEL ** -0.5),
        'b_ada': nrm(ks[13], (DEPTH, 6 * D_MODEL), 0.02),
        'w_mlp1': nrm(ks[14], (DEPTH, D_MODEL, D_FF), D_MODEL ** -0.5),
        'w_mlp2': nrm(ks[15], (DEPTH, D_FF, D_MODEL), D_FF ** -0.5),
        'att_w_in': nrm(ks[16], (N_ATT, D_MODEL, ATT_IN), D_MODEL ** -0.5),
        'att_w_out': nrm(ks[17], (N_ATT, ATT_OUT, D_MODEL), ATT_OUT ** -0.5),
        'att_sink': nrm(ks[18], (N_ATT, A_HEADS), 0.5),
        'att_lam_qk': nrm(ks[19], (N_ATT, 4, HEAD_DIM), 0.1),
        'att_subln': 1.0 + nrm(ks[20], (N_ATT, 2 * HEAD_DIM), 0.02),
        'rec_w_in': nrm(ks[21], (N_REC, D_MODEL, 2 * D_RNN), D_MODEL ** -0.5),
        'rec_conv_w': nrm(ks[22], (N_REC, CONV_W, D_RNN), CONV_W ** -0.5),
        'rec_conv_b': nrm(ks[23], (N_REC, D_RNN), 0.02),
        'rec_w_a': nrm(ks[24], (N_REC, 2, RNN_BLOCKS, RNN_BW, RNN_BW), RNN_BW ** -0.5),
        'rec_b_a': nrm(ks[25], (N_REC, 2, D_RNN), 0.02),
        'rec_w_x': nrm(ks[26], (N_REC, 2, RNN_BLOCKS, RNN_BW, RNN_BW), RNN_BW ** -0.5),
        'rec_b_x': nrm(ks[27], (N_REC, 2, D_RNN), 0.02),
        'rec_lam': jnp.log(a1) - jnp.log1p(-a1),
        'rec_w_out': nrm(ks[28], (N_REC, D_RNN, D_MODEL), D_RNN ** -0.5),
        'final_norm': 1.0 + nrm(ks[30], (D_MODEL,), 0.02),
    }


def reference(x_prompt, x_sample, cache_a_k, cache_a_v, cache_b_k, cache_b_v, state_fwd, state_bwd,
              c, c_ctx, norm1, norm2, w_ada, b_ada, w_mlp1, w_mlp2, att_w_in, att_w_out, att_sink,
              att_lam_qk, att_subln, rec_w_in, rec_conv_w, rec_conv_b, rec_w_a, rec_b_a, rec_w_x,
              rec_b_x, rec_lam, rec_w_out, final_norm):
    xp, xs = x_prompt, x_sample
    new_ak, new_av, new_bk, new_bv, new_sf, new_sb = [], [], [], [], [], []
    for layer in range(DEPTH):
        j = layer // 2
        mp = ada_mod(c_ctx[None], w_ada[layer], b_ada[layer])
        ms = ada_mod(c, w_ada[layer], b_ada[layer])
        hp = modulate(rmsnorm(xp, norm1[layer]), mp[0], mp[1])
        hs = modulate(rmsnorm(xs, norm1[layer]), ms[0], ms[1])
        if layer % 2 == 0:
            lam_init = 0.8 - 0.6 * math.exp(-0.3 * layer)
            op, (ka, va, kb, vb) = att_mixer_context(hp, att_w_in[j], att_w_out[j], att_sink[j],
                                                     att_lam_qk[j], att_subln[j], lam_init)
            os_ = att_mixer_latent(hs, cache_a_k[:, j], cache_a_v[:, j], cache_b_k[:, j], cache_b_v[:, j],
                                   att_w_in[j], att_w_out[j], att_sink[j], att_lam_qk[j], att_subln[j],
                                   lam_init)
            new_ak.append(ka)
            new_av.append(va)
            new_bk.append(kb)
            new_bv.append(vb)
        else:
            zeros = jnp.zeros((xp.shape[0], D_RNN), F32)
            op, sf, sb = rec_mixer(hp, zeros, zeros, rec_w_in[j], rec_conv_w[j], rec_conv_b[j], rec_w_a[j],
                                   rec_b_a[j], rec_w_x[j], rec_b_x[j], rec_lam[j], rec_w_out[j])
            os_, _, _ = rec_mixer(hs, state_fwd[:, j], state_bwd[:, j], rec_w_in[j], rec_conv_w[j],
                                  rec_conv_b[j], rec_w_a[j], rec_b_a[j], rec_w_x[j], rec_b_x[j], rec_lam[j],
                                  rec_w_out[j])
            new_sf.append(sf)
            new_sb.append(sb)
        xp = xp + mp[2] * op
        xs = xs + ms[2] * os_
        hp = modulate(rmsnorm(xp, norm2[layer]), mp[3], mp[4])
        hs = modulate(rmsnorm(xs, norm2[layer]), ms[3], ms[4])
        xp = xp + mp[5] * sq_relu_mlp(hp, w_mlp1[layer], w_mlp2[layer])
        xs = xs + ms[5] * sq_relu_mlp(hs, w_mlp1[layer], w_mlp2[layer])
    y_prompt = rmsnorm(xp, final_norm)
    y_sample = rmsnorm(xs, final_norm)
    new_a_k = jnp.stack(new_ak, axis=1)
    new_a_v = jnp.stack(new_av, axis=1)
    new_b_k = jnp.stack(new_bk, axis=1)
    new_b_v = jnp.stack(new_bv, axis=1)
    new_state_fwd = jnp.stack(new_sf, axis=1)
    new_state_bwd = jnp.stack(new_sb, axis=1)
    return (y_prompt, y_sample, new_a_k, new_a_v, new_b_k, new_b_v, new_state_fwd, new_state_bwd)
```

```cpp
#include <hip/hip_runtime.h>
#include <cstdio>
#include <cstdint>
#include <cmath>
namespace pg8 {
#define PG8_LAS __attribute__((address_space(3)))
typedef unsigned short bf16_t;
typedef short bf16x8 __attribute__((ext_vector_type(8)));
typedef float f32x4 __attribute__((ext_vector_type(4)));
typedef unsigned u32x4 __attribute__((ext_vector_type(4)));
constexpr int BM = 256, BK = 64, HALF = 128, HTB = HALF * BK * 2  , STAGE_BYTES = 8 * HTB, NXCD = 8, WGM = 8;

__host__ __device__ __forceinline__ int lds_byte(int r, int c) { const int st = (r >> 4) * 2 + (c >> 5), rr = r & 15, cc = c & 31, ob = rr * 64 + cc * 2; return st * 1024 + (ob ^ (((ob >> 9) & 1) << 5)); }
__host__ __device__ __forceinline__ void stage_rc(int b, int& R, int& C) { const int st = b / 1024, sb = b % 1024, swz = sb ^ (((sb >> 9) & 1) << 5); R = (st >> 1) * 16 + swz / 64; C = (st & 1) * 32 + (swz % 64) / 2; }
__host__ __device__ __forceinline__ int perm32(int rho) { const int n = rho >> 4, i = rho & 15; return 8 * (i >> 2) + 4 * n + (i & 3); }

struct Unit { int pm, pn; };
struct Gemm { const bf16_t* A; const bf16_t* Bt; int M, N, K; };

struct StaticOrder {
    int nM, nN, nwg, G, c;
    __host__ __device__ void init(int M, int N, int G_, int c_, int bmr = BM) { nM = M / bmr; nN = N / BM; nwg = nM * nN; G = G_; c = c_; }
    __host__ __device__ bool next(int i, Unit& u) const {
        const long L = (long)i * G + c; if (L >= nwg) return false;
        int wgid = (int)L; { const int q = nwg / NXCD, r = nwg % NXCD, xcd = wgid % NXCD, off = wgid / NXCD; wgid = (xcd < r ? xcd * (q + 1) : r * (q + 1) + (xcd - r) * q) + off; }
        const int nig = WGM * nN, gid = wgid / nig, fm = gid * WGM, gsz = (nM - fm) < WGM ? (nM - fm) : WGM;
        u.pm = fm + ((wgid % nig) % gsz); u.pn = (wgid % nig) / gsz; return true;
    }
    __device__ __forceinline__ void a_ready(const Unit&) const {}
    __device__ __forceinline__ void done(const Unit&) const {}
};

__device__ __forceinline__ unsigned cvt_pk_bf16(float lo, float hi) { unsigned r; asm volatile("v_cvt_pk_bf16_f32 %0, %1, %2" : "=v"(r) : "v"(lo), "v"(hi)); return r; }
typedef float f32x2 __attribute__((ext_vector_type(2)));
typedef unsigned u32x2 __attribute__((ext_vector_type(2)));
constexpr int T_CTX = 8192, QKV_LD = 2304;
struct EpiInProj {
    static constexpr bool PERM = true, AFTER_DRAIN = false;
    bf16_t* QKV; float* out; const f32x2* rope;
    template <int MR> __device__ __forceinline__ void operator()(const f32x4 (&acc)[2][2][MR][2], const Unit& u, int wr, int wc, int fr, int fq) const {
        constexpr int HRr = MR * 32, BMR = 2 * HRr, WRO = HRr / 2;
        const bool hi_half = fq >= 2;
#pragma unroll
        for (int bj = 0; bj < 2; ++bj) {
            const int colbase = u.pn * BM + bj * HALF + wc * 32;
            const bool rope_col = (colbase < 640 || (colbase >= 768 && colbase < 1792));
            long ooff = -1; int ow = 0, cs = 0;
            if (colbase >= 512 && colbase < 640) { ooff = 25165824; ow = 128; cs = 512; }
            else if (colbase >= 640 && colbase < 768) { ooff = 26214400; ow = 128; cs = 640; }
            else if (colbase >= 1280 && colbase < 1792) { ooff = 27262976; ow = 512; cs = 1280; }
            else if (colbase >= 1792) { ooff = 31457280; ow = 512; cs = 1792; }
#pragma unroll
            for (int ai = 0; ai < 2; ++ai)
#pragma unroll
                for (int m = 0; m < MR; ++m) {
                    const int rowg = u.pm * BMR + ai * HRr + wr * WRO + m * 16;
                    const bool lat = rowg >= T_CTX;
                    const int row = rowg + fr;
                    f32x4 v[2] = {acc[ai][bj][m][0], acc[ai][bj][m][1]};
                    if (rope_col && lat) {
                        const int t = (row - T_CTX) & 4095;
                        const int pos = (wc & 1) ? (t & 63) : (t >> 6);
                        const f32x4* rp = (const f32x4*)(rope + pos * 16 + 8 * (fq & 1));
#pragma unroll
                        for (int n = 0; n < 2; ++n) {
                            const f32x4 c01 = rp[2 * n], c23 = rp[2 * n + 1];
                            const float cs_[4] = {c01[0], c01[2], c23[0], c23[2]}, sn_[4] = {c01[1], c01[3], c23[1], c23[3]};
#pragma unroll
                            for (int e = 0; e < 4; ++e) {
                                const float p = __shfl_xor(v[n][e], 32);
                                v[n][e] = hi_half ? (p * sn_[e] + v[n][e] * cs_[e]) : (v[n][e] * cs_[e] - p * sn_[e]);
                            }
                        }
                    }
                    bf16_t* qp = QKV + (size_t)row * QKV_LD + colbase + 8 * fq;
                    u32x4 w; w.x = cvt_pk_bf16(v[0][0], v[0][1]); w.y = cvt_pk_bf16(v[0][2], v[0][3]); w.z = cvt_pk_bf16(v[1][0], v[1][1]); w.w = cvt_pk_bf16(v[1][2], v[1][3]);
                    *(u32x4*)qp = w;
                    if (ooff >= 0 && !lat) { float* op = out + ooff + (size_t)row * ow + (colbase - cs) + 8 * fq; *(f32x4*)op = v[0]; *(f32x4*)(op + 4) = v[1]; }
                }
        }
    }
};
constexpr int X_SPLIT = 16384;
template <bool IN_F32>
struct EpiRes {
    static constexpr bool PERM = true, AFTER_DRAIN = false;
    const float* xin_ctx; const float* xin_lat; bf16_t* XA; bf16_t* XB; const float* gate; int row0;
    template <int MR> __device__ __forceinline__ void operator()(const f32x4 (&acc)[2][2][MR][2], const Unit& u, int wr, int wc, int fr, int fq) const {
        constexpr int HRr = MR * 32, BMR = 2 * HRr, WRO = HRr / 2;
        const int rowt = row0 + u.pm * BMR;
#pragma unroll
        for (int ai = 0; ai < 2; ++ai)
#pragma unroll
            for (int m = 0; m < MR; ++m) {
                const int rowg = rowt + ai * HRr + wr * WRO + m * 16;
                const int midx = rowg < T_CTX ? 4 : ((rowg - T_CTX) >> 12);
                const float* g = gate + (size_t)midx * 6144;
                bf16_t* xr = (rowg < X_SPLIT ? XA + (size_t)rowg * 1024 : XB + (size_t)(rowg - X_SPLIT) * 1024) + (size_t)fr * 1024;
                const float* xf = (rowg < T_CTX ? xin_ctx : xin_lat - (size_t)T_CTX * 1024) + (size_t)(rowg + fr) * 1024;
#pragma unroll
                for (int bj = 0; bj < 2; ++bj) {
                    const int col = u.pn * BM + bj * HALF + wc * 32 + 8 * fq;
                    const f32x4 gv0 = *(const f32x4*)(g + col), gv1 = *(const f32x4*)(g + col + 4);
                    f32x4 x0, x1;
                    if (IN_F32) { x0 = *(const f32x4*)(xf + col); x1 = *(const f32x4*)(xf + col + 4); }
                    else { const u32x4 w = *(const u32x4*)(xr + col);
                        x0[0] = __builtin_bit_cast(float, w.x << 16); x0[1] = __builtin_bit_cast(float, w.x & 0xffff0000u); x0[2] = __builtin_bit_cast(float, w.y << 16); x0[3] = __builtin_bit_cast(float, w.y & 0xffff0000u);
                        x1[0] = __builtin_bit_cast(float, w.z << 16); x1[1] = __builtin_bit_cast(float, w.z & 0xffff0000u); x1[2] = __builtin_bit_cast(float, w.w << 16); x1[3] = __builtin_bit_cast(float, w.w & 0xffff0000u); }
                    x0 = x0 + gv0 * acc[ai][bj][m][0]; x1 = x1 + gv1 * acc[ai][bj][m][1];
                    u32x4 o; o.x = cvt_pk_bf16(x0[0], x0[1]); o.y = cvt_pk_bf16(x0[2], x0[3]); o.z = cvt_pk_bf16(x1[0], x1[1]); o.w = cvt_pk_bf16(x1[2], x1[3]);
                    *(u32x4*)(xr + col) = o;
                }
            }
    }
};
#define HID_WRITE_THROUGH 1
struct EpiSqRelu {
    static constexpr bool PERM = true, AFTER_DRAIN = false;
    bf16_t* O; int ldc;
    template <int MR> __device__ __forceinline__ void operator()(const f32x4 (&acc)[2][2][MR][2], const Unit& u, int wr, int wc, int fr, int fq) const {
        constexpr int HRr = MR * 32, BMR = 2 * HRr, WRO = HRr / 2;
#ifdef HID_WRITE_THROUGH
        const __amdgpu_buffer_rsrc_t rsrc = __builtin_amdgcn_make_buffer_rsrc((void*)O, 0, 0x7fffffff, 0x00020000);
#endif
#pragma unroll
        for (int ai = 0; ai < 2; ++ai)
#pragma unroll
            for (int m = 0; m < MR; ++m) {
                const size_t eoff = (size_t)(u.pm * BMR + ai * HRr + wr * WRO + m * 16 + fr) * ldc + u.pn * BM + wc * 32 + 8 * fq;
                bf16_t* rowp = O + eoff;
#pragma unroll
                for (int bj = 0; bj < 2; ++bj) {
                    f32x4 v0 = acc[ai][bj][m][0], v1 = acc[ai][bj][m][1];
#pragma unroll
                    for (int e = 0; e < 4; ++e) { const float a = fmaxf(v0[e], 0.f), b = fmaxf(v1[e], 0.f); v0[e] = a * a; v1[e] = b * b; }
                    u32x4 w; w.x = cvt_pk_bf16(v0[0], v0[1]); w.y = cvt_pk_bf16(v0[2], v0[3]); w.z = cvt_pk_bf16(v1[0], v1[1]); w.w = cvt_pk_bf16(v1[2], v1[3]);
#ifdef HID_WRITE_THROUGH
                    __builtin_amdgcn_raw_buffer_store_b128(w, rsrc, (unsigned)((eoff + bj * HALF) * 2), 0, 16);
#else
                    *(u32x4*)(rowp + bj * HALF) = w;
#endif
                }
            }
    }
};
__device__ __forceinline__ float gelu_tanh(float x) {
    const float u2 = 1.5957691216057308f * (x + 0.044715f * x * x * x);
    return x * __builtin_amdgcn_rcpf(1.0f + __builtin_amdgcn_exp2f(-1.4426950408889634f * u2));
}
struct EpiRecIn {
    static constexpr bool PERM = true, AFTER_DRAIN = false;
    bf16_t* GG; bf16_t* XR; bf16_t* HALO;
    template <int MR> __device__ __forceinline__ void operator()(const f32x4 (&acc)[2][2][MR][2], const Unit& u, int wr, int wc, int fr, int fq) const {
        constexpr int HRr = MR * 32, BMR = 2 * HRr, WRO = HRr / 2;
        const bool isg = u.pn < 5;
        bf16_t* base = isg ? GG : XR; const int colt = (isg ? u.pn : u.pn - 5) * BM;
#pragma unroll
        for (int ai = 0; ai < 2; ++ai)
#pragma unroll
            for (int m = 0; m < MR; ++m) {
                const int row = u.pm * BMR + ai * HRr + wr * WRO + m * 16 + fr;
                bf16_t* rowp = base + (size_t)row * 1280 + colt + wc * 32 + 8 * fq;
                const int rl = row & 63; const bool halo = !isg && (rl == 63 || rl <= 1);
                bf16_t* hp = HALO + ((size_t)(row >> 6) * 3 + (rl == 63 ? 0 : rl + 1)) * 1280 + colt + wc * 32 + 8 * fq;
#pragma unroll
                for (int bj = 0; bj < 2; ++bj) {
                    f32x4 v0 = acc[ai][bj][m][0], v1 = acc[ai][bj][m][1];
                    if (isg) {
#pragma unroll
                        for (int e = 0; e < 4; ++e) { v0[e] = gelu_tanh(v0[e]); v1[e] = gelu_tanh(v1[e]); }
                    }
                    u32x4 w; w.x = cvt_pk_bf16(v0[0], v0[1]); w.y = cvt_pk_bf16(v0[2], v0[3]); w.z = cvt_pk_bf16(v1[0], v1[1]); w.w = cvt_pk_bf16(v1[2], v1[3]);
                    *(u32x4*)(rowp + bj * HALF) = w;
                    if (halo) *(u32x4*)(hp + bj * HALF) = w;
                }
            }
    }
};
template <class Epi, class Sched, bool ALIGN_EPI = false, bool SP2 = false, int HR = 128>
__device__ __forceinline__ void gemm_phase(PG8_LAS unsigned char* lds, const Gemm g, const Sched& S, const Epi& E) {
    int tid_ = threadIdx.x; asm volatile("" : "+v"(tid_));
    const int tid = tid_, wid = __builtin_amdgcn_readfirstlane(tid >> 6), lane = tid & 63, wr = wid >> 2, wc = wid & 3, fr = lane & 15, fq = lane >> 4;
    constexpr int MR = HR / 32;
    const int K = g.K, nt = K / BK;
    unsigned voffA[2], voffB[2];
#pragma unroll
    for (int i = 0; i < 2; ++i) { int R, C; stage_rc(tid * 16 + i * 8192, R, C); const int Rb = Epi::PERM ? ((R & ~31) + perm32(R & 31)) : R;
        voffA[i] = (unsigned)(R * K + C) * 2u; voffB[i] = (unsigned)(Rb * K + C) * 2u; }
    const size_t kstep = (size_t)(BK * 2);
    const size_t hstep = (size_t)HALF * K * 2;
    const size_t tstep = 2 * hstep;
    const size_t hstepA = (size_t)HR * K * 2, tstepA = 2 * hstepA;
    const unsigned ldsw = (unsigned)wid * 1024u;
    const int aoff = lds_byte(wr * (HR / 2) + fr, fq * 8), boff = lds_byte(wc * 32 + fr, fq * 8);
#define PG8_SA(b, h) (((b) * 2 + (h)) * HTB)
#define PG8_SB(b, h) ((4 + (b) * 2 + (h)) * HTB)
#define PG8_STAGE(bufoff, gbase, voff) do { _Pragma("unroll") for (int _i = 0; _i < 2; ++_i) \
        __builtin_amdgcn_global_load_lds((const unsigned*)((const char*)(gbase) + (voff)[_i]), (PG8_LAS unsigned*)(lds + (bufoff) + ldsw + _i * 8192), 16, 0, 0); } while (0)
#define PG8_LDA(dst, b, h) do { _Pragma("unroll") for (int m = 0; m < MR; ++m) _Pragma("unroll") for (int k = 0; k < 2; ++k) dst[m][k] = *(const PG8_LAS bf16x8*)(lds + PG8_SA(b, h) + aoff + m * 2048 + k * 1024); } while (0)
#define PG8_LDB(dst, b, h) do { _Pragma("unroll") for (int n = 0; n < 2; ++n) _Pragma("unroll") for (int k = 0; k < 2; ++k) dst[n][k] = *(const PG8_LAS bf16x8*)(lds + PG8_SB(b, h) + boff + n * 2048 + k * 1024); } while (0)
#define PG8_MMA(ai, bj, At, Bt) do { __builtin_amdgcn_s_setprio(1); _Pragma("unroll") for (int m = 0; m < MR; ++m) _Pragma("unroll") for (int n = 0; n < 2; ++n) _Pragma("unroll") for (int k = 0; k < 2; ++k) \
        acc[ai][bj][m][n] = __builtin_amdgcn_mfma_f32_16x16x32_bf16(Bt[n][k], At[m][k], acc[ai][bj][m][n], 0, 0, 0); __builtin_amdgcn_s_setprio(0); } while (0)
#define PG8_WAIT_V(n) asm volatile("s_waitcnt vmcnt(" #n ")" ::: "memory")
#define PG8_WAIT_L(n) asm volatile("s_waitcnt lgkmcnt(" #n ")" ::: "memory")
#define PG8_BAR __builtin_amdgcn_s_barrier()
#define PG8_SCHED __builtin_amdgcn_sched_barrier(0)
    Unit cur, nxt; int ui = 0;
    if (!S.next(0, cur)) return;
    f32x4 acc[2][2][MR][2];
#pragma unroll
    for (int a = 0; a < 2; ++a)
#pragma unroll
        for (int b = 0; b < 2; ++b)
#pragma unroll
            for (int m = 0; m < MR; ++m)
#pragma unroll
                for (int n = 0; n < 2; ++n) acc[a][b][m][n] = (f32x4){0.f, 0.f, 0.f, 0.f};
    bf16x8 At[MR][2], B0[2][2], B1[2][2];
    const char* cA = (const char*)g.A + (size_t)cur.pm * tstepA; const char* cB = (const char*)g.Bt + (size_t)cur.pn * tstep;
    S.a_ready(cur);
    if constexpr (SP2) {
        PG8_STAGE(PG8_SB(0, 0), cB, voffB); PG8_STAGE(PG8_SB(0, 1), cB + hstep, voffB); PG8_STAGE(PG8_SA(0, 0), cA, voffA); PG8_STAGE(PG8_SA(0, 1), cA + hstepA, voffA);
        if (wr == 1) PG8_BAR;
        PG8_WAIT_V(2); PG8_BAR;
        PG8_STAGE(PG8_SB(1, 0), cB + kstep, voffB); PG8_STAGE(PG8_SA(1, 0), cA + kstep, voffA); PG8_STAGE(PG8_SB(1, 1), cB + hstep + kstep, voffB);
        PG8_WAIT_V(6); PG8_BAR;
    } else {
        PG8_STAGE(PG8_SB(0, 0), cB, voffB); PG8_STAGE(PG8_SA(0, 0), cA, voffA); PG8_STAGE(PG8_SB(0, 1), cB + hstep, voffB); PG8_STAGE(PG8_SA(0, 1), cA + hstepA, voffA);
        if (wr == 1) PG8_BAR;
        PG8_WAIT_V(4); PG8_BAR;
        PG8_STAGE(PG8_SB(1, 0), cB + kstep, voffB); PG8_STAGE(PG8_SA(1, 0), cA + kstep, voffA); PG8_STAGE(PG8_SB(1, 1), cB + hstep + kstep, voffB);
        PG8_WAIT_V(6); PG8_BAR;
    }
    for (;;) {
        const bool has_next = S.next(ui + 1, nxt);
        const char* nA = has_next ? (const char*)g.A + (size_t)nxt.pm * tstepA : cA; const char* nB = has_next ? (const char*)g.Bt + (size_t)nxt.pn * tstep : cB;
        for (int t = 0; t < nt; t += 2) {
            const bool last = (t == nt - 2);
            const char* a1 = cA + (size_t)(t + 1) * kstep;
            const char* a2 = last ? nA : cA + (size_t)(t + 2) * kstep; const char* b2 = last ? nB : cB + (size_t)(t + 2) * kstep;
            const char* a3 = a2 + kstep; const char* b3 = b2 + kstep;
            if (last && has_next) S.a_ready(nxt);
            if constexpr (SP2) {
            PG8_LDB(B0, 0, 0); PG8_LDB(B1, 0, 1); PG8_SCHED; PG8_LDA(At, 0, 0); PG8_STAGE(PG8_SA(1, 1), a1 + hstepA, voffA);
            PG8_WAIT_V(8); PG8_WAIT_L(0); PG8_BAR; PG8_MMA(0, 0, At, B0); PG8_MMA(0, 1, At, B1); PG8_BAR; PG8_SCHED;
            PG8_LDA(At, 0, 1); PG8_STAGE(PG8_SB(0, 0), b2, voffB); PG8_STAGE(PG8_SB(0, 1), b2 + hstep, voffB); PG8_STAGE(PG8_SA(0, 0), a2, voffA);
            PG8_WAIT_V(8); PG8_WAIT_L(0); PG8_BAR; PG8_MMA(1, 0, At, B0); PG8_MMA(1, 1, At, B1); PG8_BAR; PG8_SCHED;
            PG8_LDB(B0, 1, 0); PG8_LDB(B1, 1, 1); PG8_SCHED; PG8_LDA(At, 1, 0); PG8_STAGE(PG8_SA(0, 1), a2 + hstepA, voffA);
            PG8_WAIT_V(8); PG8_WAIT_L(0); PG8_BAR; PG8_MMA(0, 0, At, B0); PG8_MMA(0, 1, At, B1); PG8_BAR; PG8_SCHED;
            PG8_LDA(At, 1, 1); PG8_STAGE(PG8_SB(1, 0), b3, voffB); PG8_STAGE(PG8_SB(1, 1), b3 + hstep, voffB); PG8_STAGE(PG8_SA(1, 0), a3, voffA);
            PG8_WAIT_V(8); PG8_WAIT_L(0); PG8_BAR; PG8_MMA(1, 0, At, B0); PG8_MMA(1, 1, At, B1); PG8_BAR; PG8_SCHED;
            } else {
            PG8_LDB(B0, 0, 0); PG8_SCHED; PG8_LDA(At, 0, 0); PG8_STAGE(PG8_SA(1, 1), a1 + hstepA, voffA);
            PG8_WAIT_L(8); PG8_BAR; PG8_WAIT_L(0); PG8_MMA(0, 0, At, B0); PG8_BAR; PG8_SCHED;
            PG8_LDB(B1, 0, 1); PG8_STAGE(PG8_SB(0, 0), b2, voffB);
            PG8_BAR; PG8_WAIT_L(0); PG8_MMA(0, 1, At, B1); PG8_BAR;
            PG8_LDA(At, 0, 1); PG8_STAGE(PG8_SA(0, 0), a2, voffA);
            PG8_BAR; PG8_WAIT_L(0); PG8_MMA(1, 0, At, B0); PG8_BAR; PG8_SCHED;
            PG8_STAGE(PG8_SB(0, 1), b2 + hstep, voffB);
            PG8_WAIT_V(6); PG8_BAR; PG8_MMA(1, 1, At, B1); PG8_BAR;
            PG8_LDB(B0, 1, 0); PG8_SCHED; PG8_LDA(At, 1, 0); PG8_STAGE(PG8_SA(0, 1), a2 + hstepA, voffA);
            PG8_WAIT_L(8); PG8_BAR; PG8_WAIT_L(0); PG8_MMA(0, 0, At, B0); PG8_BAR; PG8_SCHED;
            PG8_LDB(B1, 1, 1); PG8_STAGE(PG8_SB(1, 0), b3, voffB);
            PG8_BAR; PG8_WAIT_L(0); PG8_MMA(0, 1, At, B1); PG8_BAR;
            PG8_LDA(At, 1, 1); PG8_STAGE(PG8_SA(1, 0), a3, voffA);
            PG8_BAR; PG8_WAIT_L(0); PG8_MMA(1, 0, At, B0); PG8_BAR; PG8_SCHED;
            PG8_STAGE(PG8_SB(1, 1), b3 + hstep, voffB);
            PG8_WAIT_V(6); PG8_BAR; PG8_MMA(1, 1, At, B1); PG8_BAR;
            }
        }
        if constexpr (ALIGN_EPI) { if (wr == 0) PG8_BAR; }
        if constexpr (!Epi::AFTER_DRAIN) { E.template operator()<MR>(acc, cur, wr, wc, fr, fq); S.done(cur); }
        if (!has_next) break;
#pragma unroll
        for (int a = 0; a < 2; ++a)
#pragma unroll
            for (int b = 0; b < 2; ++b)
#pragma unroll
                for (int m = 0; m < MR; ++m)
#pragma unroll
                    for (int n = 0; n < 2; ++n) acc[a][b][m][n] = (f32x4){0.f, 0.f, 0.f, 0.f};
        cur = nxt; cA = nA; cB = nB; ++ui;
        if constexpr (ALIGN_EPI) { if (wr == 1) PG8_BAR; }
    }
    PG8_WAIT_V(0);
    if constexpr (!ALIGN_EPI) { if (wr == 0) PG8_BAR; }
    PG8_BAR;
    if constexpr (Epi::AFTER_DRAIN) { E.fused(acc, cur, wr, wc, fr, fq, lds, wid, lane); S.done(cur); }
#undef PG8_SA
#undef PG8_SB
#undef PG8_STAGE
#undef PG8_LDA
#undef PG8_LDB
#undef PG8_MMA
#undef PG8_WAIT_V
#undef PG8_WAIT_L
#undef PG8_BAR
#undef PG8_SCHED
}
}
constexpr int NWAVES = 8, NTHREADS = 512;
constexpr int DM = 1024, T_CTX = 8192, T_LAT = 16384, T_ALL = 24576, LAT_SEQ = 4096, CTX_SEQ = 256;
constexpr int QKV_LD = 2304, DFF = 4096, DRNN = 1280;
constexpr int QA_OFF = 0, KA_OFF = 512, VA_OFF = 640, QB_OFF = 768, KB_OFF = 1280, VB_OFF = 1792;
constexpr float EPSN = 1e-6f;
constexpr float SM_C = 0.125f * 1.4426950408889634f;
constexpr long OUT_AK = 25165824, OUT_AV = 26214400, OUT_BK = 27262976, OUT_BV = 31457280, OUT_SF = 35651584, OUT_SB = 35692544;
constexpr size_t MiB = 1u << 20;
constexpr size_t WS_CTL = 0, CTL_ZERO_BYTES = 64 * 1024;
constexpr size_t WS_MOD = 1 * MiB;
constexpr size_t WS_ROPE = 1 * MiB + 256 * 1024;
constexpr size_t WS_LAM = WS_ROPE + 16 * 1024;
constexpr size_t WS_CAK = 2 * MiB, WS_CAV = WS_CAK + 256 * 1024, WS_CBK = WS_CAV + 256 * 1024, WS_CBV = WS_CBK + 1 * MiB;
constexpr size_t WS_WIN = 5 * MiB;
constexpr size_t WS_WOUT = 10 * MiB;
constexpr size_t WS_W1 = 12 * MiB;
constexpr size_t WS_W2 = 28 * MiB;
constexpr size_t WS_WRIN = 44 * MiB;
constexpr size_t WS_WROUT = 49 * MiB;
constexpr size_t WS_WG = 52 * MiB;
constexpr size_t WS_SUM = 54 * MiB;
constexpr size_t WS_H = 56 * MiB;
constexpr size_t WS_BIG = 104 * MiB;
constexpr size_t WS_END = 256 * MiB;
static_assert(WS_BIG + (size_t)T_ALL * QKV_LD * 2 <= WS_END && WS_BIG + (size_t)(T_ALL / 2) * DFF * 2 <= WS_END && WS_BIG + (size_t)T_ALL * DRNN * 4 <= WS_END, "ws map");
constexpr int LDS_BYTES = 160 * 1024;
constexpr int MISC_OFF = 152 * 1024;

#define GAS __attribute__((address_space(1)))
#define LAS __attribute__((address_space(3)))
typedef unsigned short bf16;
typedef unsigned v4u __attribute__((ext_vector_type(4)));
typedef unsigned v2u __attribute__((ext_vector_type(2)));
typedef float f32x4 __attribute__((ext_vector_type(4)));
typedef float f32x2 __attribute__((ext_vector_type(2)));
typedef float f32x16 __attribute__((ext_vector_type(16)));
typedef short bf16x8 __attribute__((ext_vector_type(8)));
typedef short s16x4 __attribute__((ext_vector_type(4)));
typedef GAS unsigned gu32;
#define RLX_AGENT __ATOMIC_RELAXED, __HIP_MEMORY_SCOPE_AGENT
__device__ __forceinline__ unsigned f2bf(float f) { unsigned u = __builtin_bit_cast(unsigned, f); return (u + 0x7fffu + ((u >> 16) & 1u)) >> 16; }
__device__ __forceinline__ unsigned pk2(float lo, float hi) { return f2bf(lo) | (f2bf(hi) << 16); }
__device__ __forceinline__ float bf2f(unsigned short b) { return __builtin_bit_cast(float, (unsigned)b << 16); }
__device__ __forceinline__ float bflo(unsigned w) { return __builtin_bit_cast(float, w << 16); }
__device__ __forceinline__ float bfhi(unsigned w) { return __builtin_bit_cast(float, w & 0xffff0000u); }

#define XB_TMO      128
#define XB_XCNT(j)  (256  + 64 * (j))
#define XB_XSUB(j)  (1280 + 64 * (j))
#define XB_XGEN(j)  (2304 + 64 * (j))
#define XB_TOP      3328
#define XB_TOPGEN   3392
#define XCD_BAR_WORDS 3456
#define XB_SPIN_CAP (1u << 18)
__device__ __forceinline__ unsigned xb_ld(unsigned* p)              { return __hip_atomic_load(p, __ATOMIC_RELAXED, __HIP_MEMORY_SCOPE_AGENT); }
__device__ __forceinline__ unsigned xb_add(unsigned* p, unsigned v) { return __hip_atomic_fetch_add(p, v, __ATOMIC_RELAXED, __HIP_MEMORY_SCOPE_AGENT); }
__device__ __forceinline__ unsigned xb_xcc_id() { return (unsigned)__builtin_amdgcn_s_getreg((3 << 11) | 20) & 0xFu; }
#define XB_SPIN(cond, bar) do { unsigned _sp = 0; while (cond) { __builtin_amdgcn_s_sleep(1); \
    if ((++_sp & 255u) == 0u) { if (xb_ld(&(bar)[XB_TMO])) break; if (_sp > XB_SPIN_CAP) { atomicAdd(&(bar)[XB_TMO], 1u); break; } } } } while (0)
struct XcdBarrier { unsigned* bar; unsigned x; volatile LAS unsigned* st; };
__device__ __forceinline__ XcdBarrier xcd_barrier_post(unsigned* bar, volatile LAS unsigned* st) {
    XcdBarrier b; b.bar = bar; b.x = xb_xcc_id(); b.st = st;
    if (threadIdx.x == 0) (void)xb_add(&bar[XB_XCNT(b.x)], 1u);
    return b;
}
__device__ __forceinline__ void xcd_barrier_complete(unsigned* bar, unsigned x, unsigned& nloc, unsigned& nx) {
    const unsigned G = gridDim.x * gridDim.y * gridDim.z;
    unsigned sum, cnt, mine, sp = 0u;
    for (;;) {
        sum = 0u; cnt = 0u; mine = 0u;
#pragma unroll
        for (unsigned j = 0; j < 16; ++j) { const unsigned c = xb_ld(&bar[XB_XCNT(j)]); sum += c; cnt += (c > 0u) ? 1u : 0u; mine = (j == x) ? c : mine; }
        if (sum == G) break;
        __builtin_amdgcn_s_sleep(1);
        if ((++sp & 255u) == 0u) { if (xb_ld(&bar[XB_TMO])) break; if (sp > XB_SPIN_CAP) { atomicAdd(&bar[XB_TMO], 1u); break; } }
    }
    nloc = mine > 0u ? mine : 1u; nx = cnt > 0u ? cnt : 1u;
}
__device__ __forceinline__ void xcd_barrier(const XcdBarrier& b) {
    asm volatile("s_waitcnt vmcnt(0)" ::: "memory");
    __syncthreads();
    if (threadIdx.x == 0) {
        unsigned* bar = b.bar;
        __builtin_amdgcn_s_waitcnt(0);
        unsigned nloc = b.st[0], nx = b.st[1];
        if (nloc == 0u) { xcd_barrier_complete(bar, b.x, nloc, nx); b.st[0] = nloc; b.st[1] = nx; }
        const unsigned old = xb_add(&bar[XB_XSUB(b.x)], 1u);
        const unsigned gen = old / nloc;
        if (old + 1u == (gen + 1u) * nloc) {
            __builtin_amdgcn_fence(__ATOMIC_RELEASE, "agent");
            asm volatile("s_waitcnt vmcnt(0)" ::: "memory");
            const unsigned og = xb_add(&bar[XB_TOP], 1u);
            const unsigned tg = og / nx;
            if (og + 1u == (tg + 1u) * nx) xb_add(&bar[XB_TOPGEN], 1u);
            else XB_SPIN(xb_ld(&bar[XB_TOPGEN]) == tg, bar);
            __builtin_amdgcn_fence(__ATOMIC_ACQUIRE, "agent");
            xb_add(&bar[XB_XGEN(b.x)], 1u);
            asm volatile("s_waitcnt vmcnt(0)" ::: "memory");
        } else {
            XB_SPIN(xb_ld(&bar[XB_XGEN(b.x)]) == gen, bar);
            __builtin_amdgcn_fence(__ATOMIC_ACQUIRE, "agent");
            asm volatile("s_waitcnt vmcnt(0)" ::: "memory");
        }
    }
    __syncthreads();
}

struct Args { const float* in[31]; float* out; unsigned char* ws; int ph_lo, ph_hi; int use_bar, pad; };
struct Frame {
    LAS unsigned char* lds;
    int tid, lane, wave, vcu, G;
    const float* const* in; float* out; unsigned char* ws;
};
#define WSP(T, off) ((T*)(F.ws + (off)))
__device__ __forceinline__ Frame fresh(const Frame& F) { Frame P = F; int t = threadIdx.x; asm volatile("" : "+v"(t)); P.tid = t; P.lane = t & 63; P.wave = __builtin_amdgcn_readfirstlane(t >> 6); return P; }
enum { IN_XP = 0, IN_XS, IN_CAK, IN_CAV, IN_CBK, IN_CBV, IN_SF, IN_SB, IN_C, IN_CCTX, IN_NORM1, IN_NORM2, IN_WADA, IN_BADA, IN_WMLP1, IN_WMLP2, IN_AWIN, IN_AWOUT, IN_SINK, IN_LAMQK, IN_SUBLN,
       IN_RWIN, IN_RCONVW, IN_RCONVB, IN_RWA, IN_RBA, IN_RWX, IN_RBX, IN_RLAM, IN_RWOUT, IN_FNORM };

__device__ __forceinline__ float wave_sum(float v) {
#pragma unroll
    for (int o = 1; o < 64; o <<= 1) v += __shfl_xor(v, o);
    return v;
}

__device__ __forceinline__ void p0_transpose_item(const float* W, int K, int N, bf16* WT, LAS float* scr, int item, int lane) {
    const int nblk = N / 32, kb = item / nblk, nb = item % nblk, k0 = 64 * kb, n0 = 32 * nb;
#pragma unroll 8
    for (int i = 0; i < 32; ++i) { const int kk = 2 * i + (lane >> 5); scr[kk * 33 + (lane & 31)] = W[(size_t)(k0 + kk) * N + n0 + (lane & 31)]; }
    asm volatile("s_waitcnt lgkmcnt(0)" ::: "memory");
    const int c = lane & 7;
#pragma unroll
    for (int j = 0; j < 4; ++j) { const int n = (lane >> 3) + 8 * j; const LAS float* s = scr + (8 * c) * 33 + n;
        v4u o; o.x = pk2(s[0 * 33], s[1 * 33]); o.y = pk2(s[2 * 33], s[3 * 33]); o.z = pk2(s[4 * 33], s[5 * 33]); o.w = pk2(s[6 * 33], s[7 * 33]);
        *(GAS v4u*)(WT + (size_t)(n0 + n) * K + k0 + 8 * c) = o; }
    asm volatile("s_waitcnt lgkmcnt(0)" ::: "memory");
}
__device__ __forceinline__ void p0_prologue(Frame& F) {
    const float* const* in = F.in;
    {
        LAS float* SC = (LAS float*)(F.lds);
        LAS float* RED = (LAS float*)(F.lds + 20480);
        for (int i = F.tid; i < 5 * 1024; i += NTHREADS) { const int v = i >> 10, k = i & 1023; const float c = v < 4 ? in[IN_C][v * 1024 + k] : in[IN_CCTX][k]; SC[i] = c / (1.0f + __expf(-c)); }
        __syncthreads();
        float* MOD = WSP(float, WS_MOD);
        for (int u = blockIdx.x; u < 384; u += F.G) {
            const int l = u / 192, n0 = (u % 192) * 32;
            const float* W = in[IN_WADA] + (size_t)l * 1024 * 6144 + n0 + (F.lane & 31);
            float a[5] = {0.f, 0.f, 0.f, 0.f, 0.f};
            const int kb = F.wave * 128 + (F.lane >> 5);
#pragma unroll 8
            for (int kk = 0; kk < 64; ++kk) { const int k = kb + 2 * kk; const float w = W[(size_t)k * 6144];
#pragma unroll
                for (int v = 0; v < 5; ++v) a[v] += SC[v * 1024 + k] * w; }
#pragma unroll
            for (int v = 0; v < 5; ++v) { a[v] += __shfl_xor(a[v], 32); if (F.lane < 32) RED[(F.wave * 5 + v) * 32 + F.lane] = a[v]; }
            __syncthreads();
            if (F.tid < 160) { const int v = F.tid >> 5, c = F.tid & 31; float s = in[IN_BADA][l * 6144 + n0 + c];
#pragma unroll
                for (int w = 0; w < 8; ++w) s += RED[(w * 5 + v) * 32 + c];
                MOD[((size_t)l * 5 + v) * 6144 + n0 + c] = s; }
            __syncthreads();
        }
    }
    {
        LAS float* scr = (LAS float*)(F.lds + 32768 + F.wave * 8704);
        const int gw = F.vcu * NWAVES + F.wave, NGW = F.G * NWAVES;
        constexpr int I_IN = 16 * 72, I_OUT = 16 * 32;
        for (int it = gw; it < I_IN + I_OUT; it += NGW) {
            if (it < I_IN) p0_transpose_item(in[IN_AWIN], 1024, 2304, WSP(bf16, WS_WIN), scr, it, F.lane);
            else p0_transpose_item(in[IN_AWOUT], 1024, 1024, WSP(bf16, WS_WOUT), scr, it - I_IN, F.lane);
        }
    }
    {
        const int gt = F.vcu * NTHREADS + F.tid, NGT = F.G * NTHREADS;
        for (int i = gt; i < 4 * 256 * 128 / 4; i += NGT) {
            const f32x4 a = ((const f32x4*)in[IN_CAK])[i], b = ((const f32x4*)in[IN_CAV])[i];
            v2u o; o.x = pk2(a[0], a[1]); o.y = pk2(a[2], a[3]); WSP(v2u, WS_CAK)[i] = o; o.x = pk2(b[0], b[1]); o.y = pk2(b[2], b[3]); WSP(v2u, WS_CAV)[i] = o; }
        for (int i = gt; i < 4 * 256 * 512 / 4; i += NGT) {
            const f32x4 a = ((const f32x4*)in[IN_CBK])[i], b = ((const f32x4*)in[IN_CBV])[i];
            v2u o; o.x = pk2(a[0], a[1]); o.y = pk2(a[2], a[3]); WSP(v2u, WS_CBK)[i] = o; o.x = pk2(b[0], b[1]); o.y = pk2(b[2], b[3]); WSP(v2u, WS_CBV)[i] = o; }
        if (gt < 1024) { const int pos = gt >> 4, i = gt & 15; const double ang = (double)pos * pow(10000.0, -(double)i / 16.0);
            WSP(f32x2, WS_ROPE)[gt] = (f32x2){(float)cos(ang), (float)sin(ang)}; }
        if (gt == 0) { const float* lq = in[IN_LAMQK]; float s1 = 0.f, s2 = 0.f; for (int i = 0; i < 64; ++i) { s1 += lq[i] * lq[64 + i]; s2 += lq[128 + i] * lq[192 + i]; }
            WSP(float, WS_LAM)[0] = __expf(s1) - __expf(s2) + 0.2f; }
    }
}

__device__ __forceinline__ void p_deferred_transposes(Frame& F, int iw, int nw) {
    const float* const* in = F.in;
    LAS float* scr = (LAS float*)(F.lds + 32768 + F.wave * 8704);
    const int gw = iw * NWAVES + F.wave, NGW = nw * NWAVES;
    constexpr int I_M1 = 16 * 128, I_M2 = 64 * 32, I_RIN = 16 * 80, I_ROUT = 20 * 32, I_G = 8;
    constexpr int NITEMS = 2 * I_M1 + 2 * I_M2 + I_RIN + I_ROUT + 40 * I_G;
    for (int it = gw; it < NITEMS; it += NGW) {
        int r = it;
        if (r < 2 * I_M1) { const int l = r / I_M1; p0_transpose_item(in[IN_WMLP1] + (size_t)l * 1024 * 4096, 1024, 4096, WSP(bf16, WS_W1) + (size_t)l * 4096 * 1024, scr, r % I_M1, F.lane); continue; } r -= 2 * I_M1;
        if (r < 2 * I_M2) { const int l = r / I_M2; p0_transpose_item(in[IN_WMLP2] + (size_t)l * 4096 * 1024, 4096, 1024, WSP(bf16, WS_W2) + (size_t)l * 1024 * 4096, scr, r % I_M2, F.lane); continue; } r -= 2 * I_M2;
        if (r < I_RIN) { p0_transpose_item(in[IN_RWIN], 1024, 2560, WSP(bf16, WS_WRIN), scr, r, F.lane); continue; } r -= I_RIN;
        if (r < I_ROUT) { p0_transpose_item(in[IN_RWOUT], 1280, 1024, WSP(bf16, WS_WROUT), scr, r, F.lane); continue; } r -= I_ROUT;
        { const int mtx = r / I_G, gate = mtx / 20, db = mtx % 20;
          p0_transpose_item(in[gate ? IN_RWX : IN_RWA] + (size_t)db * 16384, 128, 128, WSP(bf16, WS_WG) + (size_t)(gate * 20 + db) * 16384, scr, r % I_G, F.lane); }
    }
}

__device__ __forceinline__ void norm_mod_pass(Frame& F, const float* x_ctx, const float* x_lat, const float* g, const float* mod  , int shift_off, int scale_off, bf16* H) {
    const int gw = F.vcu * NWAVES + F.wave, NGW = F.G * NWAVES;
    for (int m = gw; m < T_ALL; m += NGW) {
        const float* xr = m < T_CTX ? x_ctx + (size_t)m * DM : x_lat + (size_t)(m - T_CTX) * DM;
        const int midx = m < T_CTX ? 4 : ((m - T_CTX) >> 12);
        const float* mv = mod + (size_t)midx * 6144;
        f32x4 v[4]; float s = 0.f;
#pragma unroll
        for (int j = 0; j < 4; ++j) { v[j] = ((const f32x4*)xr)[F.lane + 64 * j]; s += (v[j][0] * v[j][0] + v[j][1] * v[j][1]) + (v[j][2] * v[j][2] + v[j][3] * v[j][3]); }
        const float rstd = 1.0f / sqrtf(wave_sum(s) * (1.0f / DM) + EPSN);
#pragma unroll
        for (int j = 0; j < 4; ++j) {
            const int c = 4 * (F.lane + 64 * j);
            const f32x4 gg = *(const f32x4*)(g + c), sc = *(const f32x4*)(mv + scale_off + c), sh = *(const f32x4*)(mv + shift_off + c);
            f32x4 o = (v[j] * rstd) * gg; o = o * (sc + 1.0f) + sh;
            v2u w; w.x = pk2(o[0], o[1]); w.y = pk2(o[2], o[3]);
            *(v2u*)(H + (size_t)m * DM + c) = w;
        }
    }
}
constexpr int X_SPLIT = 16384;
__device__ __forceinline__ const bf16* xrow_bf(const bf16* XA, const bf16* XB, int m) { return m < X_SPLIT ? XA + (size_t)m * DM : XB + (size_t)(m - X_SPLIT) * DM; }
__device__ __forceinline__ void unpack16(const v4u a, const v4u b, float (&v)[16]) {
    const unsigned w[8] = {a.x, a.y, a.z, a.w, b.x, b.y, b.z, b.w};
#pragma unroll
    for (int e = 0; e < 8; ++e) { v[2 * e] = bflo(w[e]); v[2 * e + 1] = bfhi(w[e]); }
}
__device__ __forceinline__ void norm_mod_pass_bf(Frame& F, const bf16* XA, const bf16* XB, const float* g, const float* mod  , int shift_off, int scale_off, bf16* H) {
    const int gw = F.vcu * NWAVES + F.wave, NGW = F.G * NWAVES;
    for (int m = gw; m < T_ALL; m += NGW) {
        const v4u* xp = (const v4u*)(xrow_bf(XA, XB, m) + F.lane * 8);
        const int midx = m < T_CTX ? 4 : ((m - T_CTX) >> 12);
        const float* mv = mod + (size_t)midx * 6144;
        float v[16]; unpack16(xp[0], xp[64], v);
        float s = 0.f;
#pragma unroll
        for (int e = 0; e < 16; ++e) s += v[e] * v[e];
        const float rstd = 1.0f / sqrtf(wave_sum(s) * (1.0f / DM) + EPSN);
        unsigned ow[8];
#pragma unroll
        for (int q = 0; q < 4; ++q) {
            const int c = 8 * F.lane + (q >> 1) * 512 + (q & 1) * 4;
            const f32x4 gg = *(const f32x4*)(g + c), sc = *(const f32x4*)(mv + scale_off + c), sh = *(const f32x4*)(mv + shift_off + c);
            const float o0 = (v[4 * q] * rstd) * gg[0] * (sc[0] + 1.0f) + sh[0], o1 = (v[4 * q + 1] * rstd) * gg[1] * (sc[1] + 1.0f) + sh[1];
            const float o2 = (v[4 * q + 2] * rstd) * gg[2] * (sc[2] + 1.0f) + sh[2], o3 = (v[4 * q + 3] * rstd) * gg[3] * (sc[3] + 1.0f) + sh[3];
            ow[2 * q] = pk2(o0, o1); ow[2 * q + 1] = pk2(o2, o3);
        }
        v4u* hp = (v4u*)(H + (size_t)m * DM + 8 * F.lane);
        v4u a, b2; a.x = ow[0]; a.y = ow[1]; a.z = ow[2]; a.w = ow[3]; b2.x = ow[4]; b2.y = ow[5]; b2.z = ow[6]; b2.w = ow[7];
        hp[0] = a; hp[64] = b2;
    }
}
__device__ __forceinline__ void final_norm_pass(Frame& F, const bf16* XA, const bf16* XB, float* Y, const float* g, int m_lo, int m_hi) {
    const int gw = F.vcu * NWAVES + F.wave, NGW = F.G * NWAVES;
    for (int m = m_lo + gw; m < m_hi; m += NGW) {
        const v4u* xp = (const v4u*)(xrow_bf(XA, XB, m) + F.lane * 8);
        float v[16]; unpack16(xp[0], xp[64], v);
        float s = 0.f;
#pragma unroll
        for (int e = 0; e < 16; ++e) s += v[e] * v[e];
        const float rstd = 1.0f / sqrtf(wave_sum(s) * (1.0f / DM) + EPSN);
#pragma unroll
        for (int q = 0; q < 4; ++q) { const int c = 8 * F.lane + (q >> 1) * 512 + (q & 1) * 4; const f32x4 gg = *(const f32x4*)(g + c);
            f32x4 o; o[0] = v[4 * q] * rstd * gg[0]; o[1] = v[4 * q + 1] * rstd * gg[1]; o[2] = v[4 * q + 2] * rstd * gg[2]; o[3] = v[4 * q + 3] * rstd * gg[3];
            *(f32x4*)(Y + (size_t)m * DM + c) = o; }
    }
}

constexpr int AT_K0 = 0, AT_K1 = 9216;
constexpr int AT_V0 = 18432, AT_V1 = 38912;
constexpr int AT_WS = 59392;
constexpr int AT_O1 = 61440;
static_assert(AT_O1 + 65536 <= MISC_OFF, "attention LDS map");
__device__ __forceinline__ int crow(int r, int hi) { return (r & 3) + 8 * (r >> 2) + 4 * hi; }
__device__ __forceinline__ unsigned cvtpk_s(float lo, float hi) { typedef __bf16 bf16x2_t __attribute__((ext_vector_type(2))); f32x2 v = {lo, hi}; bf16x2_t b = __builtin_convertvector(v, bf16x2_t); return __builtin_bit_cast(unsigned, b); }
__device__ __forceinline__ s16x4 vtr(const LAS unsigned char* p) { typedef short v4i16_t __attribute__((ext_vector_type(4))); return __builtin_bit_cast(s16x4, __builtin_amdgcn_ds_read_tr16_b64_v4i16((LAS v4i16_t*)p)); }

struct AttnSrc {
    const bf16* K0; const bf16* V0; int ld0, n0;
    const bf16* K1; const bf16* V1; int ld1, t_lo, t_hi;
};
template <int DV, bool WINDOW>
__device__ __forceinline__ void attn_pass(Frame& F, const bf16* Q, int ldq, const AttnSrc& S, int qpos0, float m_init, float l_init, f32x16 (&o)[DV / 32], float& m_out, float& l_out) {
    constexpr int RSV = DV == 128 ? 320 : 192, NVL = DV / 64;
    LAS unsigned char* lds = F.lds;
    const int tid = F.tid, lane = F.lane, wid = F.wave, r32 = lane & 31, hi = lane >> 5;
    LAS float* wsf = (LAS float*)(lds + AT_WS) + wid * 64;
    bf16x8 qr[4];
    { const bf16* qp = Q + (size_t)(wid * 32 + r32) * ldq + hi * 8;
#pragma unroll
      for (int d0 = 0; d0 < 4; ++d0) qr[d0] = *(const bf16x8*)(qp + d0 * 16); }
#pragma unroll
    for (int d = 0; d < DV / 32; ++d) o[d] = f32x16{};
    float m = m_init, l = l_init;
    const int nt = S.n0 + (S.t_hi - S.t_lo);
    v4u kreg, vreg[NVL];
    const int krow = tid >> 3, kch = tid & 7;
#define AT_ISSUE(it_) do { const int it__ = (it_); const bf16* Kp; const bf16* Vp; int ld; \
        if (it__ < S.n0) { Kp = S.K0 + (size_t)(it__ * 64) * S.ld0; Vp = S.V0 + (size_t)(it__ * 64) * S.ld0; ld = S.ld0; } \
        else { const int t = S.t_lo + it__ - S.n0; Kp = S.K1 + (size_t)(t * 64) * S.ld1; Vp = S.V1 + (size_t)(t * 64) * S.ld1; ld = S.ld1; } \
        kreg = *(const v4u*)(Kp + (size_t)krow * ld + kch * 8); \
        if (DV == 128) { _Pragma("unroll") for (int i = 0; i < NVL; ++i) { const int idx = tid + 512 * i; vreg[i] = *(const v4u*)(Vp + (size_t)(idx >> 4) * ld + (idx & 15) * 8); } } \
        else vreg[0] = *(const v4u*)(Vp + (size_t)krow * ld + kch * 8); } while (0)
#define AT_COMMIT(buf_) do { const int kb_ = (buf_) ? AT_K1 : AT_K0, vb_ = (buf_) ? AT_V1 : AT_V0; \
        *(LAS v4u*)(lds + kb_ + krow * 144 + kch * 16) = kreg; \
        if (DV == 128) { _Pragma("unroll") for (int i = 0; i < NVL; ++i) { const int idx = tid + 512 * i; *(LAS v4u*)(lds + vb_ + (idx >> 4) * RSV + (idx & 15) * 16) = vreg[i]; } } \
        else *(LAS v4u*)(lds + vb_ + krow * RSV + kch * 16) = vreg[0]; } while (0)
    const int koff = r32 * 144 + hi * 16;
    const int voff = (4 * hi + ((lane & 15) >> 2)) * RSV + ((lane >> 4) & 1) * 32 + (lane & 3) * 8;
    const int qw0 = qpos0 + 32 * wid;
    __syncthreads();
    AT_ISSUE(0); AT_COMMIT(0);
    if (nt > 1) AT_ISSUE(1);
#pragma unroll 1
    for (int it = 0; it < nt; ++it) {
        __syncthreads();
        const LAS unsigned char* kbase = lds + ((it & 1) ? AT_K1 : AT_K0) + koff;
        const LAS unsigned char* vbase = lds + ((it & 1) ? AT_V1 : AT_V0) + voff;
        bool skip = false, need_mask = false;
        int kp0 = 0;
        if (WINDOW && it >= S.n0) {
            kp0 = (S.t_lo + it - S.n0) * 64;
            skip = (kp0 + 63 < qw0 - 128 || kp0 > qw0 + 31 + 128);
            need_mask = !(kp0 >= qw0 + 31 - 128 && kp0 + 63 <= qw0 + 128);
        }
        if (!skip) {
            f32x16 p0 = f32x16{}, p1 = f32x16{};
            __builtin_amdgcn_s_setprio(1);
#pragma unroll
            for (int d0 = 0; d0 < 4; ++d0) {
                const bf16x8 k0 = *(const LAS bf16x8*)(kbase + d0 * 32);
                const bf16x8 k1 = *(const LAS bf16x8*)(kbase + 32 * 144 + d0 * 32);
                p0 = __builtin_amdgcn_mfma_f32_32x32x16_bf16(k0, qr[d0], p0, 0, 0, 0);
                p1 = __builtin_amdgcn_mfma_f32_32x32x16_bf16(k1, qr[d0], p1, 0, 0, 0);
            }
            __builtin_amdgcn_s_setprio(0);
            if (WINDOW && need_mask) {
                const int q = qw0 + r32;
#pragma unroll
                for (int r = 0; r < 16; ++r) { const int kv = kp0 + crow(r, hi); int d0 = q - kv; d0 = d0 < 0 ? -d0 : d0; int d1 = q - kv - 32; d1 = d1 < 0 ? -d1 : d1;
                    if (d0 > 128) p0[r] = -1e30f; if (d1 > 128) p1[r] = -1e30f; }
            }
            float rm = fmaxf(p0[0], p1[0]);
#pragma unroll
            for (int r = 1; r < 16; ++r) rm = fmaxf(fmaxf(rm, p0[r]), p1[r]);
            rm = fmaxf(rm, __shfl_xor(rm, 32));
            const float m_new = fmaxf(m, rm);
            if (__any(m_new > m)) {
                const float alpha = __builtin_amdgcn_exp2f((m - m_new) * SM_C);
                l *= alpha;
                if (hi == 0) wsf[r32] = alpha;
                asm volatile("s_waitcnt lgkmcnt(0)" ::: "memory");
#pragma unroll
                for (int r = 0; r < 16; ++r) { const float a = wsf[crow(r, hi)];
#pragma unroll
                    for (int d = 0; d < DV / 32; ++d) o[d][r] *= a; }
                m = m_new;
            }
            const float mc = -m * SM_C;
            float ps = 0.f;
            bf16x8 pa[4];
#define AT_ECHUNK(P_, B_, c_) do { v4u w_; \
                _Pragma("unroll") for (int j = 0; j < 4; ++j) { const float e0 = __builtin_amdgcn_exp2f(__builtin_fmaf(P_[(B_) + 2 * j], SM_C, mc)), e1 = __builtin_amdgcn_exp2f(__builtin_fmaf(P_[(B_) + 2 * j + 1], SM_C, mc)); \
                    ps += e0 + e1; w_[j] = cvtpk_s(e0, e1); } \
                pa[c_] = __builtin_bit_cast(bf16x8, w_); } while (0)
#define AT_PVSTEP(s_) do { _Pragma("unroll") for (int d = 0; d < DV / 32; ++d) { \
                const s16x4 lo = vtr(vbase + (16 * (s_)) * RSV + d * 64); const s16x4 hh = vtr(vbase + (16 * (s_) + 8) * RSV + d * 64); \
                const bf16x8 vf = (bf16x8){lo[0], lo[1], lo[2], lo[3], hh[0], hh[1], hh[2], hh[3]}; \
                o[d] = __builtin_amdgcn_mfma_f32_32x32x16_bf16(pa[s_], vf, o[d], 0, 0, 0); } } while (0)
            AT_ECHUNK(p0, 0, 0);
            AT_ECHUNK(p0, 8, 1); AT_PVSTEP(0);
            AT_ECHUNK(p1, 0, 2); AT_PVSTEP(1);
            AT_ECHUNK(p1, 8, 3); AT_PVSTEP(2);
            AT_PVSTEP(3);
            l += ps;
#undef AT_ECHUNK
#undef AT_PVSTEP
        }
        if (it + 1 < nt) { AT_COMMIT((it + 1) & 1); if (it + 2 < nt) AT_ISSUE(it + 2); }
    }
#undef AT_ISSUE
#undef AT_COMMIT
    m_out = m; l_out = l;
}
__device__ __forceinline__ void row_recip(Frame& F, float l, float (&rli)[16]) {
    LAS float* wsf = (LAS float*)(F.lds + AT_WS) + F.wave * 64;
    const int r32 = F.lane & 31, hi = F.lane >> 5;
    l += __shfl_xor(l, 32);
    asm volatile("s_waitcnt lgkmcnt(0)" ::: "memory");
    if (hi == 0) wsf[r32] = 1.0f / l;
    asm volatile("s_waitcnt lgkmcnt(0)" ::: "memory");
#pragma unroll
    for (int r = 0; r < 16; ++r) rli[r] = wsf[crow(r, hi)];
    asm volatile("s_waitcnt lgkmcnt(0)" ::: "memory");
}
template <bool WINDOW>
__device__ __forceinline__ void attn_a_unit(Frame& F, const bf16* QKV, size_t row0, int h, const AttnSrc& S, int qpos0, float sink, bf16* OM) {
    f32x16 o[2]; float m, l;
    attn_pass<64, WINDOW>(F, QKV + row0 * QKV_LD + QA_OFF + h * 64, QKV_LD, S, qpos0, sink * 8.0f, (F.lane >> 5) == 0 ? 1.0f : 0.0f, o, m, l);
    float rli[16]; row_recip(F, l, rli);
    const int r32 = F.lane & 31, hi = F.lane >> 5;
    bf16* op = OM + (row0 + F.wave * 32) * DM + h * 64 + r32;
#pragma unroll
    for (int r = 0; r < 16; ++r)
#pragma unroll
        for (int d = 0; d < 2; ++d) op[(size_t)crow(r, hi) * DM + d * 32] = (bf16)f2bf(o[d][r] * rli[r]);
}
__device__ __forceinline__ void attn_b_unit(Frame& F, const bf16* QKV, size_t row0, int h, AttnSrc S, float lam, const float* subln, bf16* OM) {
    f32x16 o[4]; float m, l; float rli[16];
    const bf16* K0 = S.K0; const bf16* K1 = S.K1;
    const int r32 = F.lane & 31, hi = F.lane >> 5;
    LAS unsigned* o1s = (LAS unsigned*)(F.lds + AT_O1) + F.wave * 2048 + F.lane;
    attn_pass<128, false>(F, QKV + row0 * QKV_LD + QB_OFF + h * 128, QKV_LD, S, 0, -1e30f, 0.f, o, m, l);
    row_recip(F, l, rli);
#pragma unroll
    for (int d = 0; d < 4; ++d)
#pragma unroll
        for (int r = 0; r < 8; ++r) o1s[(d * 8 + r) * 64] = cvtpk_s(o[d][2 * r] * rli[2 * r], o[d][2 * r + 1] * rli[2 * r + 1]);
    S.K0 = K0 + 64; S.K1 = K1 + 64;
    attn_pass<128, false>(F, QKV + row0 * QKV_LD + QB_OFF + h * 128 + 64, QKV_LD, S, 0, -1e30f, 0.f, o, m, l);
    row_recip(F, l, rli);
    float ss[16];
#pragma unroll
    for (int r = 0; r < 16; ++r) { float s = 0.f;
#pragma unroll
        for (int d = 0; d < 4; ++d) { const unsigned w = o1s[(d * 8 + (r >> 1)) * 64]; const float o1 = (r & 1) ? bfhi(w) : bflo(w); const float v = o1 - lam * (o[d][r] * rli[r]); o[d][r] = v; s += v * v; }
        ss[r] = s; }
#pragma unroll
    for (int r = 0; r < 16; ++r) { float s = ss[r];
#pragma unroll
        for (int x = 1; x < 32; x <<= 1) s += __shfl_xor(s, x);
        ss[r] = 0.8f / sqrtf(s * (1.0f / 128.0f) + EPSN); }
    float gs[4];
#pragma unroll
    for (int d = 0; d < 4; ++d) gs[d] = subln[d * 32 + r32];
    bf16* op = OM + (row0 + F.wave * 32) * DM + 512 + h * 128 + r32;
#pragma unroll
    for (int r = 0; r < 16; ++r)
#pragma unroll
        for (int d = 0; d < 4; ++d) op[(size_t)crow(r, hi) * DM + d * 32] = (bf16)f2bf(o[d][r] * ss[r] * gs[d]);
}
__device__ __forceinline__ void attention_phase(Frame& F) {
    const bf16* QKV = WSP(bf16, WS_BIG); bf16* OM = WSP(bf16, WS_H);
    const float lam = WSP(float, WS_LAM)[0];
    const float* sinkp = F.in[IN_SINK]; const float* subln = F.in[IN_SUBLN];
    for (int u = F.vcu; u < 256; u += F.G) {
        const int b = u >> 6, h = (u >> 4) & 3, qb = u & 15;
        const size_t seq0 = T_CTX + (size_t)b * LAT_SEQ;
        AttnSrc S; S.K0 = WSP(bf16, WS_CBK) + (size_t)b * 256 * 512 + h * 128; S.V0 = WSP(bf16, WS_CBV) + (size_t)b * 256 * 512 + h * 128; S.ld0 = 512; S.n0 = 4;
        S.K1 = QKV + seq0 * QKV_LD + KB_OFF + h * 128; S.V1 = QKV + seq0 * QKV_LD + VB_OFF + h * 128; S.ld1 = QKV_LD; S.t_lo = 0; S.t_hi = 64;
        attn_b_unit(F, QKV, seq0 + qb * 256, h, S, lam, subln, OM);
    }
    for (int u = F.vcu; u < 512; u += F.G) {
        const int b = u >> 7, h = (u >> 4) & 7, qb = u & 15, kvh = h >> 2;
        const size_t seq0 = T_CTX + (size_t)b * LAT_SEQ;
        AttnSrc S; S.K0 = WSP(bf16, WS_CAK) + (size_t)b * 256 * 128 + kvh * 64; S.V0 = WSP(bf16, WS_CAV) + (size_t)b * 256 * 128 + kvh * 64; S.ld0 = 128; S.n0 = 4;
        S.K1 = QKV + seq0 * QKV_LD + KA_OFF + kvh * 64; S.V1 = QKV + seq0 * QKV_LD + VA_OFF + kvh * 64; S.ld1 = QKV_LD;
        S.t_lo = 4 * qb - 2 < 0 ? 0 : 4 * qb - 2; S.t_hi = 4 * qb + 6 > 64 ? 64 : 4 * qb + 6;
        attn_a_unit<true>(F, QKV, seq0 + qb * 256, h, S, qb * 256, sinkp[h], OM);
    }
    for (int u = F.vcu; u < 256; u += F.G) {
        const int b = u >> 3, h = u & 7, kvh = h >> 2;
        const size_t seq0 = (size_t)b * CTX_SEQ;
        AttnSrc S; S.K0 = nullptr; S.V0 = nullptr; S.ld0 = 0; S.n0 = 0;
        S.K1 = QKV + seq0 * QKV_LD + KA_OFF + kvh * 64; S.V1 = QKV + seq0 * QKV_LD + VA_OFF + kvh * 64; S.ld1 = QKV_LD; S.t_lo = 0; S.t_hi = 4;
        attn_a_unit<false>(F, QKV, seq0, h, S, 0, sinkp[h], OM);
    }
    for (int u = F.vcu; u < 128; u += F.G) {
        const int b = u >> 2, h = u & 3;
        const size_t seq0 = (size_t)b * CTX_SEQ;
        AttnSrc S; S.K0 = nullptr; S.V0 = nullptr; S.ld0 = 0; S.n0 = 0;
        S.K1 = QKV + seq0 * QKV_LD + KB_OFF + h * 128; S.V1 = QKV + seq0 * QKV_LD + VB_OFF + h * 128; S.ld1 = QKV_LD; S.t_lo = 0; S.t_hi = 4;
        attn_b_unit(F, QKV, seq0, h, S, lam, subln, OM);
    }
}

constexpr int SC_XC = 0;
constexpr int SC_AUF = 17408;
constexpr int SC_AUB = 17408 + 65536;
constexpr int SC_CW = 17408 + 131072;
static_assert(SC_CW + 2560 <= MISC_OFF, "scan LDS map");
#ifndef DUP_EPI
#define DUP_EPI 1
#endif
#ifndef DUP_SCAN
#define DUP_SCAN 1
#endif
#ifndef DUP_CONV
#define DUP_CONV 1
#endif
constexpr int SCAN_UNITS = 3840;
__device__ __forceinline__ void scan_pass(Frame& F) {
    LAS unsigned char* lds = F.lds;
    const int tid = F.tid, lane = F.lane, wid = F.wave, r32 = lane & 31, hi = lane >> 5;
    bf16* XR = WSP(bf16, WS_BIG) + (size_t)T_ALL * DRNN; bf16* GG = WSP(bf16, WS_BIG); bf16* ABG = (bf16*)F.out;
    const bf16* HALO = WSP(bf16, WS_BIG + 136 * MiB);
    f32x2* SUM = WSP(f32x2, WS_H);
    const int wdir = wid >> 2, cb = wid & 3, chl = cb * 32 + r32;
    const int tk = tid >> 3, cg = tid & 7;
    LAS float* CW = (LAS float*)(lds + SC_CW);
    const int per = (SCAN_UNITS + F.G - 1) / F.G, u_lo = F.vcu * per, u_hi = (u_lo + per) < SCAN_UNITS ? (u_lo + per) : SCAN_UNITS;
    int n_cur = -1;
    v4u xr[8];
    bf16x8 wa[8], wx[8]; float ba = 0.f, bx = 0.f, sp8 = 0.f;
#define SC_DECODE(u_) const int n = (u_) / 384, cidx = (u_) % 384; const bool isctx = cidx < 128; const int b = isctx ? (cidx >> 2) : ((cidx - 128) >> 6); const int c = isctx ? (cidx & 3) : ((cidx - 128) & 63); \
        const size_t seq0 = isctx ? (size_t)b * CTX_SEQ : (size_t)T_CTX + (size_t)b * LAT_SEQ; const int seq_len = isctx ? CTX_SEQ : LAT_SEQ, t0 = c * 64;
#define SC_LOADX(u_) do { SC_DECODE(u_) (void)b; (void)seq_len; \
        _Pragma("unroll") for (int j = 0; j < 4; ++j) { const int tl = tk - 1 + j; \
            const bf16* src = tl < 0 ? HALO + (size_t)((cidx > 0 ? cidx - 1 : 0) * 3 + 0) * DRNN : (tl >= 64 ? HALO + (size_t)((cidx < 383 ? cidx + 1 : 383) * 3 + 1 + (tl - 64)) * DRNN : XR + (seq0 + t0 + tl) * DRNN); \
            const v4u* p = (const v4u*)(src + n * 128 + cg * 8); xr[2 * j] = p[0]; xr[2 * j + 1] = p[8]; } } while (0)
    if (u_lo < u_hi) SC_LOADX(u_lo);
#pragma unroll 1
    for (int u = u_lo; u < u_hi; ++u) {
        SC_DECODE(u)
        (void)b;
        if (n != n_cur) {
            __syncthreads();
            for (int i = tid; i < 640; i += NTHREADS) CW[i] = i < 512 ? F.in[IN_RCONVW][(i >> 7) * DRNN + n * 128 + (i & 127)] : F.in[IN_RCONVB][n * 128 + (i & 127)];
            n_cur = n;
            { const bf16* wap = WSP(bf16, WS_WG) + (size_t)((0 * 2 + wdir) * 10 + n) * 16384 + (size_t)chl * 128 + hi * 8;
              const bf16* wxp = WSP(bf16, WS_WG) + (size_t)((1 * 2 + wdir) * 10 + n) * 16384 + (size_t)chl * 128 + hi * 8;
#pragma unroll
              for (int ks = 0; ks < 8; ++ks) { wa[ks] = *(const bf16x8*)(wap + ks * 16); wx[ks] = *(const bf16x8*)(wxp + ks * 16); } }
            ba = F.in[IN_RBA][wdir * DRNN + n * 128 + chl] * -1.4426950408889634f; bx = F.in[IN_RBX][wdir * DRNN + n * 128 + chl] * -1.4426950408889634f;
            { const float lamv = F.in[IN_RLAM][wdir * DRNN + n * 128 + chl]; sp8 = -8.0f * (lamv > 20.f ? __expf(-lamv) : log1pf(__expf(-lamv))); }
            __syncthreads();
        }
        { float a[16];
#pragma unroll
          for (int e = 0; e < 16; ++e) a[e] = CW[512 + (e >> 3) * 64 + cg * 8 + (e & 7)];
#pragma unroll
          for (int j = 0; j < 4; ++j) { const int t = t0 + tk - 1 + j; const float msk = (t >= 0 && t < seq_len) ? 1.0f : 0.0f;
              const unsigned w[8] = {xr[2 * j].x, xr[2 * j].y, xr[2 * j].z, xr[2 * j].w, xr[2 * j + 1].x, xr[2 * j + 1].y, xr[2 * j + 1].z, xr[2 * j + 1].w};
#pragma unroll
              for (int e = 0; e < 8; ++e) { const int c0 = (e >> 2) * 64 + cg * 8 + 2 * (e & 3); a[2 * e] += (CW[j * 128 + c0] * msk) * bflo(w[e]); a[2 * e + 1] += (CW[j * 128 + c0 + 1] * msk) * bfhi(w[e]); } }
          v4u o0, o1; o0.x = pk2(a[0], a[1]); o0.y = pk2(a[2], a[3]); o0.z = pk2(a[4], a[5]); o0.w = pk2(a[6], a[7]); o1.x = pk2(a[8], a[9]); o1.y = pk2(a[10], a[11]); o1.z = pk2(a[12], a[13]); o1.w = pk2(a[14], a[15]);
          LAS v4u* xp = (LAS v4u*)(lds + SC_XC + tk * 272 + cg * 16); xp[0] = o0; xp[8] = o1; }
        __syncthreads();
        if (u + 1 < u_hi) SC_LOADX(u + 1);
        { LAS f32x2* AU = (LAS f32x2*)(lds + (wdir ? SC_AUB : SC_AUF));
#pragma unroll
          for (int rb = 0; rb < 2; ++rb) {
            f32x16 ra = f32x16{}, ia = f32x16{};
            { const LAS unsigned char* ap = lds + SC_XC + (rb * 32 + r32) * 272 + hi * 16;
#pragma unroll
              for (int ks = 0; ks < 8; ++ks) { const bf16x8 af = *(const LAS bf16x8*)(ap + ks * 32);
                  ra = __builtin_amdgcn_mfma_f32_32x32x16_bf16(af, wa[ks], ra, 0, 0, 0);
                  ia = __builtin_amdgcn_mfma_f32_32x32x16_bf16(af, wx[ks], ia, 0, 0, 0); } }
#pragma unroll
            for (int r = 0; r < 16; ++r) {
                const int row = rb * 32 + crow(r, hi);
                const float rr = __builtin_amdgcn_rcpf(1.0f + __builtin_amdgcn_exp2f(ra[r] * -1.4426950408889634f + ba));
                const float ii = __builtin_amdgcn_rcpf(1.0f + __builtin_amdgcn_exp2f(ia[r] * -1.4426950408889634f + bx));
                const float x = sp8 * rr;
                const float em = -x * (1.0f + x * (0.5f + x * (0.16666667f + x * (0.041666668f + x * 0.0083333338f))));
                const float av = 1.0f - em;
                const float om = __builtin_fmaf(em, av, em);
                const float xv = bf2f(*(const LAS unsigned short*)(lds + SC_XC + row * 272 + chl * 2));
                AU[row * 128 + chl] = (f32x2){av, __builtin_amdgcn_sqrtf(om) * ii * xv};
            }
          } }
        __syncthreads();
        if (tid >= 256) {
            const int sch = tid & 127, sd = (tid >> 7) & 1;
            LAS f32x2* AU = (LAS f32x2*)(lds + (sd ? SC_AUB : SC_AUF)) + sch;
            float h = 0.f, pprod = 1.0f;
#pragma unroll 1
            for (int s0 = 0; s0 < 64; s0 += 8) {
                f32x2 au[8];
#pragma unroll
                for (int j = 0; j < 8; ++j) { const int row = sd == 0 ? s0 + j : 63 - s0 - j; au[j] = AU[row * 128]; }
#pragma unroll
                for (int j = 0; j < 8; ++j) { const int row = sd == 0 ? s0 + j : 63 - s0 - j; h = au[j].x * h + au[j].y; pprod *= au[j].x; AU[row * 128] = (f32x2){h, pprod}; }
            }
            SUM[(size_t)cidx * 2 * DRNN + sd * DRNN + n * 128 + sch] = (f32x2){pprod, h};
        }
        __syncthreads();
        {
            const LAS f32x4* hfp = (const LAS f32x4*)(lds + SC_AUF) + lane; const LAS f32x4* hbp = (const LAS f32x4*)(lds + SC_AUB) + lane;
            const size_t eoff = (seq0 + t0 + wid * 8) * DRNN + n * 128;
            unsigned* gp = (unsigned*)(GG + eoff) + lane; unsigned* fp = (unsigned*)(XR + eoff) + lane; unsigned* bp = (unsigned*)(ABG + eoff) + lane;
            unsigned gw[8];
#pragma unroll
            for (int i = 0; i < 8; ++i) gw[i] = gp[(size_t)i * (DRNN / 2)];
#pragma unroll
            for (int i = 0; i < 8; ++i) {
                const f32x4 hf = hfp[(wid * 8 + i) * 64], hb = hbp[(wid * 8 + i) * 64];
                const float g0 = bflo(gw[i]), g1 = bfhi(gw[i]);
                gp[(size_t)i * (DRNN / 2)] = pk2((hf[0] + hb[0]) * g0, (hf[2] + hb[2]) * g1);
                fp[(size_t)i * (DRNN / 2)] = pk2(hf[1] * g0, hf[3] * g1);
                bp[(size_t)i * (DRNN / 2)] = pk2(hb[1] * g0, hb[3] * g1);
            }
        }
        __syncthreads();
    }
#undef SC_DECODE
#undef SC_LOADX
}
__device__ __forceinline__ void scan_correct_phase(Frame& F) {
    bf16* GG = WSP(bf16, WS_BIG); const bf16* XR = WSP(bf16, WS_BIG) + (size_t)T_ALL * DRNN; const bf16* ABG = (const bf16*)F.out;
    const float* CAR = WSP(float, WS_H + 8 * MiB);
    const int gt = F.vcu * NTHREADS + F.tid, NGT = F.G * NTHREADS;
    for (int i = gt; i < T_ALL * (DRNN / 8); i += NGT) {
        const int row = i / (DRNN / 8), c8 = (i % (DRNN / 8)) * 8;
        const size_t off = (size_t)row * DRNN + c8;
        const v4u yl = *(const v4u*)(GG + off), af = *(const v4u*)(XR + off), ab = *(const v4u*)(ABG + off);
        const float* cf = CAR + (size_t)(row >> 6) * 2 * DRNN + c8; const float* cbp = cf + DRNN;
        const f32x4 f0 = *(const f32x4*)cf, f1 = *(const f32x4*)(cf + 4), b0 = *(const f32x4*)cbp, b1 = *(const f32x4*)(cbp + 4);
        const unsigned wy[4] = {yl.x, yl.y, yl.z, yl.w}, wf[4] = {af.x, af.y, af.z, af.w}, wb[4] = {ab.x, ab.y, ab.z, ab.w};
        const float cfv[8] = {f0[0], f0[1], f0[2], f0[3], f1[0], f1[1], f1[2], f1[3]}, cbv[8] = {b0[0], b0[1], b0[2], b0[3], b1[0], b1[1], b1[2], b1[3]};
        unsigned o[4];
#pragma unroll
        for (int e = 0; e < 4; ++e) o[e] = pk2(bflo(wy[e]) + bflo(wf[e]) * cfv[2 * e] + bflo(wb[e]) * cbv[2 * e], bfhi(wy[e]) + bfhi(wf[e]) * cfv[2 * e + 1] + bfhi(wb[e]) * cbv[2 * e + 1]);
        v4u ov; ov.x = o[0]; ov.y = o[1]; ov.z = o[2]; ov.w = o[3];
        *(v4u*)(GG + off) = ov;
    }
}

__device__ __forceinline__ void scan_carry_phase(Frame& F) {
    const f32x2* SUM = WSP(f32x2, WS_H); float* CAR = WSP(float, WS_H + 8 * MiB);
    const int gt = F.vcu * NTHREADS + F.tid, NGT = F.G * NTHREADS;
    for (int i = gt; i < 10240 + 81920; i += NGT) {
        const bool lat = i < 10240; const int j = lat ? i : i - 10240;
        const int ch = j % DRNN, sd = (j / DRNN) & 1, b = j / (2 * DRNN);
        const int nch = lat ? 64 : 4, cfirst = lat ? 128 + b * 64 : b * 4;
        float h = lat ? F.in[sd ? IN_SB : IN_SF][b * DRNN + ch] : 0.f;
        const f32x2* sp = SUM + (size_t)cfirst * 2 * DRNN + sd * DRNN + ch; float* cp = CAR + (size_t)cfirst * 2 * DRNN + sd * DRNN + ch;
        for (int k0 = 0; k0 < nch; k0 += 4) {
            f32x2 s[4];
#pragma unroll
            for (int q = 0; q < 4; ++q) { const int c = sd == 0 ? k0 + q : nch - 1 - k0 - q; s[q] = sp[(size_t)c * 2 * DRNN]; }
#pragma unroll
            for (int q = 0; q < 4; ++q) { const int c = sd == 0 ? k0 + q : nch - 1 - k0 - q; cp[(size_t)c * 2 * DRNN] = h; h = s[q].x * h + s[q].y; }
        }
        if (!lat) F.out[(sd ? OUT_SB : OUT_SF) + b * DRNN + ch] = h;
    }
}

constexpr int N_PHASES = 23;
__global__ void __launch_bounds__(NTHREADS, 2) fwd_kernel(Args args) {
    extern __shared__ __attribute__((aligned(16))) unsigned char lds_raw[];
    Frame F;
    F.lds = (LAS unsigned char*)lds_raw;
    F.tid = threadIdx.x; F.lane = F.tid & 63; F.wave = __builtin_amdgcn_readfirstlane(F.tid >> 6);
    F.G = gridDim.x; { const int bx = blockIdx.x; F.vcu = (F.G % 8 == 0) ? (bx % 8) * (F.G / 8) + bx / 8 : bx; }
    F.in = args.in; F.out = args.out; F.ws = args.ws;
    volatile LAS unsigned* MISC = (volatile LAS unsigned*)(F.lds + MISC_OFF);
    if (F.tid < 32) MISC[F.tid] = 0u;
    __syncthreads();
    XcdBarrier bar; bar.bar = (unsigned*)(args.ws + WS_CTL) + 1024; bar.x = 0; bar.st = nullptr;
    if (args.use_bar) bar = xcd_barrier_post((unsigned*)(args.ws + WS_CTL) + 1024, MISC + 8);
    const int lo = args.ph_lo, hi = args.ph_hi;
#ifndef PHMASK
#define PHMASK 0x7fffff
#endif
#ifndef REP_PHASE
#define REP_PHASE -1
#endif
#ifndef REP_N
#define REP_N 1
#endif
#define IN(k) (((PHMASK >> (k)) & 1) && lo <= (k) && (k) < hi)
#define REPS(k) for (int rep_ = 0; rep_ < (((k) == REP_PHASE) ? REP_N : 1); ++rep_)
#define SEAM(k) do { if (IN(k) && IN((k) + 1)) xcd_barrier(bar); } while (0)
    bf16* XA = (bf16*)((unsigned char*)F.out + 64 * MiB);
    bf16* XB = WSP(bf16, WS_BIG + 120 * MiB);
    const float* MOD = WSP(float, WS_MOD);
    bf16* H = WSP(bf16, WS_H);
    PG8_LAS unsigned char* ring = (PG8_LAS unsigned char*)lds_raw;

    if (IN(0)) REPS(0) { Frame P = fresh(F); p0_prologue(P); } SEAM(0);
    if (IN(1)) REPS(1) { Frame P = fresh(F); norm_mod_pass(P, F.in[IN_XP], F.in[IN_XS], F.in[IN_NORM1], MOD, 0, 1024, H); } SEAM(1);
    if (IN(2)) REPS(2) {
        pg8::Gemm g{H, WSP(bf16, WS_WIN), T_ALL, QKV_LD, DM}; pg8::StaticOrder S; S.init(T_ALL, QKV_LD, F.G, (int)blockIdx.x);
        pg8::EpiInProj E{WSP(bf16, WS_BIG), F.out, WSP(pg8::f32x2, WS_ROPE)};
        pg8::gemm_phase<pg8::EpiInProj, pg8::StaticOrder, true, true>(ring, g, S, E);
        { const int nfull = (T_ALL / 256) * (QKV_LD / 256) % F.G; Frame P = fresh(F);
          if (nfull == 0) p_deferred_transposes(P, (int)blockIdx.x, F.G); else if ((int)blockIdx.x >= nfull) p_deferred_transposes(P, (int)blockIdx.x - nfull, F.G - nfull); }
    } SEAM(2);
    if (IN(3)) REPS(3) { Frame P = fresh(F); attention_phase(P); } SEAM(3);
    if (IN(4)) REPS(4) {
        pg8::Gemm g{H, WSP(bf16, WS_WOUT), T_ALL, DM, DM}; pg8::StaticOrder S; S.init(T_ALL, DM, F.G, (int)blockIdx.x, 192);
        pg8::EpiRes<true> E{F.in[IN_XP], F.in[IN_XS], XA, XB, MOD + 2048, 0};
        pg8::gemm_phase<pg8::EpiRes<true>, pg8::StaticOrder, true, true, 96>(ring, g, S, E);
    } SEAM(4);
#pragma unroll 1
    for (int layer = 0; layer < 2; ++layer) {
        const int pb = layer == 0 ? 5 : 16;
        const float* MODL = MOD + (size_t)layer * 5 * 6144;
        if (IN(pb)) REPS(pb) { Frame P = fresh(F); norm_mod_pass_bf(P, XA, XB, F.in[IN_NORM2] + layer * DM, MODL, 3072, 4096, H); } SEAM(pb);
#pragma unroll 1
        for (int half = 0; half < 2; ++half) {
            const int row0 = half * (T_ALL / 2);
            if (IN(pb + 1 + 2 * half)) REPS(pb + 1 + 2 * half) {
                pg8::Gemm g{H + (size_t)row0 * DM, WSP(bf16, WS_W1) + (size_t)layer * DFF * DM, T_ALL / 2, DFF, DM}; pg8::StaticOrder S; S.init(T_ALL / 2, DFF, F.G, (int)blockIdx.x);
                pg8::EpiSqRelu E{WSP(bf16, WS_BIG), DFF};
                pg8::gemm_phase<pg8::EpiSqRelu, pg8::StaticOrder, true, true>(ring, g, S, E);
            } SEAM(pb + 1 + 2 * half);
            if (IN(pb + 2 + 2 * half)) REPS(pb + 2 + 2 * half) {
                pg8::Gemm g{WSP(bf16, WS_BIG), WSP(bf16, WS_W2) + (size_t)layer * DM * DFF, T_ALL / 2, DM, DFF}; pg8::StaticOrder S; S.init(T_ALL / 2, DM, F.G, (int)blockIdx.x, 192);
                pg8::EpiRes<false> E{nullptr, nullptr, XA, XB, MODL + 5120, row0};
                pg8::gemm_phase<pg8::EpiRes<false>, pg8::StaticOrder, true, true, 96>(ring, g, S, E);
            } SEAM(pb + 2 + 2 * half);
        }
        if (layer == 0) {
            const float* MOD1 = MOD + 5 * 6144;
            if (IN(10)) REPS(10) { Frame P = fresh(F); norm_mod_pass_bf(P, XA, XB, F.in[IN_NORM1] + DM, MOD1, 0, 1024, H); } SEAM(10);
            if (IN(11)) REPS(11) {
                pg8::Gemm g{H, WSP(bf16, WS_WRIN), T_ALL, 2 * DRNN, DM}; pg8::StaticOrder S; S.init(T_ALL, 2 * DRNN, F.G, (int)blockIdx.x);
                pg8::EpiRecIn E{WSP(bf16, WS_BIG), WSP(bf16, WS_BIG) + (size_t)T_ALL * DRNN, WSP(bf16, WS_BIG + 136 * MiB)};
                pg8::gemm_phase<pg8::EpiRecIn, pg8::StaticOrder, true, true>(ring, g, S, E);
            } SEAM(11);
            if (IN(12)) REPS(12) { Frame P = fresh(F); scan_pass(P); } SEAM(12);
            if (IN(13)) REPS(13) { Frame P = fresh(F); scan_carry_phase(P); } SEAM(13);
            if (IN(14)) REPS(14) { Frame P = fresh(F); scan_correct_phase(P); } SEAM(14);
            if (IN(15)) REPS(15) {
                pg8::Gemm g{WSP(bf16, WS_BIG), WSP(bf16, WS_WROUT), T_ALL, DM, DRNN}; pg8::StaticOrder S; S.init(T_ALL, DM, F.G, (int)blockIdx.x, 192);
                pg8::EpiRes<false> E{nullptr, nullptr, XA, XB, MOD1 + 2048, 0};
                pg8::gemm_phase<pg8::EpiRes<false>, pg8::StaticOrder, true, true, 96>(ring, g, S, E);
            } SEAM(15);
        }
    }
    if (IN(21)) REPS(21) { Frame P = fresh(F); final_norm_pass(P, XA, XB, F.out, F.in[IN_FNORM], 0, X_SPLIT); } SEAM(21);
    if (IN(22)) REPS(22) { Frame P = fresh(F); final_norm_pass(P, XA, XB, F.out, F.in[IN_FNORM], X_SPLIT, T_ALL); }
#undef IN
#undef SEAM
}

#ifndef MK_ONE_LAUNCH
#define MK_ONE_LAUNCH 1
#endif
extern "C" void kernel_launch(void* const* d_in, const int* in_sizes, int n_in, void* d_out, int out_size, void* d_ws, size_t ws_size, hipStream_t stream) {
    static int grid = 0;
    if (grid == 0) {
        if (n_in != 31 || ws_size < WS_END) { fprintf(stderr, "kernel_launch: unexpected n_in %d / ws_size %zu\n", n_in, ws_size); grid = -1; return; }
        int dev = 0, cus = 0, per_cu = 0;
        if (hipGetDevice(&dev) != hipSuccess || hipDeviceGetAttribute(&cus, hipDeviceAttributeMultiprocessorCount, dev) != hipSuccess) { grid = -1; return; }
        if (hipFuncSetAttribute((const void*)fwd_kernel, hipFuncAttributeMaxDynamicSharedMemorySize, LDS_BYTES) != hipSuccess) { fprintf(stderr, "kernel_launch: hipFuncSetAttribute failed\n"); grid = -1; return; }
        if (hipOccupancyMaxActiveBlocksPerMultiprocessor(&per_cu, (const void*)fwd_kernel, NTHREADS, LDS_BYTES) != hipSuccess || per_cu < 1) { fprintf(stderr, "kernel_launch: occupancy query says %d\n", per_cu); (void)hipGetLastError(); grid = -1; return; }
        grid = cus;
    }
    if (grid < 0) return;
    (void)hipMemsetAsync((char*)d_ws + WS_CTL, 0, CTL_ZERO_BYTES, stream);
    Args a{};
    for (int i = 0; i < 31; ++i) a.in[i] = (const float*)d_in[i];
    a.out = (float*)d_out; a.ws = (unsigned char*)d_ws;
#if MK_ONE_LAUNCH
    a.ph_lo = 0; a.ph_hi = N_PHASES; a.use_bar = 1;
    hipLaunchKernelGGL(fwd_kernel, dim3(grid), dim3(NTHREADS), LDS_BYTES, stream, a);
#else
    for (int p = 0; p < N_PHASES; ++p) { a.ph_lo = p; a.ph_hi = p + 1; a.use_bar = 0; hipLaunchKernelGGL(fwd_kernel, dim3(grid), dim3(NTHREADS), LDS_BYTES, stream, a); }
#endif
}
```

```cpp
#include <hip/hip_runtime.h>
#include <cstdio>
#include <cstdint>
#include <cmath>
namespace pg8 {
#define PG8_LAS __attribute__((address_space(3)))
typedef unsigned short bf16_t;
typedef short bf16x8 __attribute__((ext_vector_type(8)));
typedef float f32x4 __attribute__((ext_vector_type(4)));
typedef unsigned u32x4 __attribute__((ext_vector_type(4)));
constexpr int BM = 256, BK = 64, HALF = 128, HTB = HALF * BK * 2  , STAGE_BYTES = 8 * HTB, NXCD = 8, WGM = 8;

__host__ __device__ __forceinline__ int lds_byte(int r, int c) { const int st = (r >> 4) * 2 + (c >> 5), rr = r & 15, cc = c & 31, ob = rr * 64 + cc * 2; return st * 1024 + (ob ^ (((ob >> 9) & 1) << 5)); }
__host__ __device__ __forceinline__ void stage_rc(int b, int& R, int& C) { const int st = b / 1024, sb = b % 1024, swz = sb ^ (((sb >> 9) & 1) << 5); R = (st >> 1) * 16 + swz / 64; C = (st & 1) * 32 + (swz % 64) / 2; }
__host__ __device__ __forceinline__ int perm32(int rho) { const int n = rho >> 4, i = rho & 15; return 8 * (i >> 2) + 4 * n + (i & 3); }

struct Unit { int pm, pn; };
struct Gemm { const bf16_t* A; const bf16_t* Bt; int M, N, K; };

struct StaticOrder {
    int nM, nN, nwg, G, c;
    __host__ __device__ void init(int M, int N, int G_, int c_, int bmr = BM) { nM = M / bmr; nN = N / BM; nwg = nM * nN; G = G_; c = c_; }
    __host__ __device__ bool next(int i, Unit& u) const {
        const long L = (long)i * G + c; if (L >= nwg) return false;
        int wgid = (int)L; { const int q = nwg / NXCD, r = nwg % NXCD, xcd = wgid % NXCD, off = wgid / NXCD; wgid = (xcd < r ? xcd * (q + 1) : r * (q + 1) + (xcd - r) * q) + off; }
        const int nig = WGM * nN, gid = wgid / nig, fm = gid * WGM, gsz = (nM - fm) < WGM ? (nM - fm) : WGM;
        u.pm = fm + ((wgid % nig) % gsz); u.pn = (wgid % nig) / gsz; return true;
    }
    __device__ __forceinline__ void a_ready(const Unit&) const {}
    __device__ __forceinline__ void done(const Unit&) const {}
};

__device__ __forceinline__ unsigned cvt_pk_bf16(float lo, float hi) { unsigned r; asm volatile("v_cvt_pk_bf16_f32 %0, %1, %2" : "=v"(r) : "v"(lo), "v"(hi)); return r; }
typedef float f32x2 __attribute__((ext_vector_type(2)));
typedef unsigned u32x2 __attribute__((ext_vector_type(2)));
constexpr int T_CTX = 8192, QKV_LD = 2304;
constexpr float QSCALE = 0.125f * 1.4426950408889634f;
struct EpiInProj {
    static constexpr bool PERM = true, AFTER_DRAIN = false;
    bf16_t* QKV; float* out; const f32x2* rope;
    template <int MR> __device__ __forceinline__ void operator()(const f32x4 (&acc)[2][2][MR][2], const Unit& u, int wr, int wc, int fr, int fq) const {
        constexpr int HRr = MR * 32, BMR = 2 * HRr, WRO = HRr / 2;
        const bool hi_half = fq >= 2;
#pragma unroll
        for (int bj = 0; bj < 2; ++bj) {
            const int colbase = u.pn * BM + bj * HALF + wc * 32;
            const bool rope_col = (colbase < 640 || (colbase >= 768 && colbase < 1792));
            const bool q_col = (colbase < 512 || (colbase >= 768 && colbase < 1280));
            long ooff = -1; int ow = 0, cs = 0;
            if (colbase >= 512 && colbase < 640) { ooff = 25165824; ow = 128; cs = 512; }
            else if (colbase >= 640 && colbase < 768) { ooff = 26214400; ow = 128; cs = 640; }
            else if (colbase >= 1280 && colbase < 1792) { ooff = 27262976; ow = 512; cs = 1280; }
            else if (colbase >= 1792) { ooff = 31457280; ow = 512; cs = 1792; }
#pragma unroll
            for (int ai = 0; ai < 2; ++ai)
#pragma unroll
                for (int m = 0; m < MR; ++m) {
                    const int rowg = u.pm * BMR + ai * HRr + wr * WRO + m * 16;
                    const bool lat = rowg >= T_CTX;
                    const int row = rowg + fr;
                    f32x4 v[2] = {acc[ai][bj][m][0], acc[ai][bj][m][1]};
                    if (rope_col && lat) {
                        const int t = (row - T_CTX) & 4095;
                        const int pos = (wc & 1) ? (t & 63) : (t >> 6);
                        const f32x4* rp = (const f32x4*)(rope + pos * 16 + 8 * (fq & 1));
#pragma unroll
                        for (int n = 0; n < 2; ++n) {
                            const f32x4 c01 = rp[2 * n], c23 = rp[2 * n + 1];
                            const float cs_[4] = {c01[0], c01[2], c23[0], c23[2]}, sn_[4] = {c01[1], c01[3], c23[1], c23[3]};
#pragma unroll
                            for (int e = 0; e < 4; ++e) {
                                const float p = __shfl_xor(v[n][e], 32);
                                v[n][e] = hi_half ? (p * sn_[e] + v[n][e] * cs_[e]) : (v[n][e] * cs_[e] - p * sn_[e]);
                            }
                        }
                    }
                    if (q_col) { v[0] = v[0] * QSCALE; v[1] = v[1] * QSCALE; }
                    bf16_t* qp = QKV + (size_t)row * QKV_LD + colbase + 8 * fq;
                    u32x4 w; w.x = cvt_pk_bf16(v[0][0], v[0][1]); w.y = cvt_pk_bf16(v[0][2], v[0][3]); w.z = cvt_pk_bf16(v[1][0], v[1][1]); w.w = cvt_pk_bf16(v[1][2], v[1][3]);
                    *(u32x4*)qp = w;
                    if (ooff >= 0 && !lat) { float* op = out + ooff + (size_t)row * ow + (colbase - cs) + 8 * fq; *(f32x4*)op = v[0]; *(f32x4*)(op + 4) = v[1]; }
                }
        }
    }
};
constexpr int X_SPLIT = 16384;
template <bool IN_F32>
struct EpiRes {
    static constexpr bool PERM = true, AFTER_DRAIN = false;
    const float* xin_ctx; const float* xin_lat; bf16_t* XA; bf16_t* XB; const float* gate; int row0;
    template <int MR> __device__ __forceinline__ void operator()(const f32x4 (&acc)[2][2][MR][2], const Unit& u, int wr, int wc, int fr, int fq) const {
        constexpr int HRr = MR * 32, BMR = 2 * HRr, WRO = HRr / 2;
        const int rowt = row0 + u.pm * BMR;
#pragma unroll
        for (int ai = 0; ai < 2; ++ai)
#pragma unroll
            for (int m = 0; m < MR; ++m) {
                const int rowg = rowt + ai * HRr + wr * WRO + m * 16;
                const int midx = rowg < T_CTX ? 4 : ((rowg - T_CTX) >> 12);
                const float* g = gate + (size_t)midx * 6144;
                bf16_t* xr = (rowg < X_SPLIT ? XA + (size_t)rowg * 1024 : XB + (size_t)(rowg - X_SPLIT) * 1024) + (size_t)fr * 1024;
                const float* xf = (rowg < T_CTX ? xin_ctx : xin_lat - (size_t)T_CTX * 1024) + (size_t)(rowg + fr) * 1024;
#pragma unroll
                for (int bj = 0; bj < 2; ++bj) {
                    const int col = u.pn * BM + bj * HALF + wc * 32 + 8 * fq;
                    const f32x4 gv0 = *(const f32x4*)(g + col), gv1 = *(const f32x4*)(g + col + 4);
                    f32x4 x0, x1;
                    if (IN_F32) { x0 = *(const f32x4*)(xf + col); x1 = *(const f32x4*)(xf + col + 4); }
                    else { const u32x4 w = *(const u32x4*)(xr + col);
                        x0[0] = __builtin_bit_cast(float, w.x << 16); x0[1] = __builtin_bit_cast(float, w.x & 0xffff0000u); x0[2] = __builtin_bit_cast(float, w.y << 16); x0[3] = __builtin_bit_cast(float, w.y & 0xffff0000u);
                        x1[0] = __builtin_bit_cast(float, w.z << 16); x1[1] = __builtin_bit_cast(float, w.z & 0xffff0000u); x1[2] = __builtin_bit_cast(float, w.w << 16); x1[3] = __builtin_bit_cast(float, w.w & 0xffff0000u); }
                    x0 = x0 + gv0 * acc[ai][bj][m][0]; x1 = x1 + gv1 * acc[ai][bj][m][1];
                    u32x4 o; o.x = cvt_pk_bf16(x0[0], x0[1]); o.y = cvt_pk_bf16(x0[2], x0[3]); o.z = cvt_pk_bf16(x1[0], x1[1]); o.w = cvt_pk_bf16(x1[2], x1[3]);
                    *(u32x4*)(xr + col) = o;
                }
            }
    }
};
struct EpiSqRelu {
    static constexpr bool PERM = true, AFTER_DRAIN = false;
    bf16_t* O; int ldc;
    template <int MR> __device__ __forceinline__ void operator()(const f32x4 (&acc)[2][2][MR][2], const Unit& u, int wr, int wc, int fr, int fq) const {
        constexpr int HRr = MR * 32, BMR = 2 * HRr, WRO = HRr / 2;
#pragma unroll
        for (int ai = 0; ai < 2; ++ai)
#pragma unroll
            for (int m = 0; m < MR; ++m) {
                bf16_t* rowp = O + (size_t)(u.pm * BMR + ai * HRr + wr * WRO + m * 16 + fr) * ldc + u.pn * BM + wc * 32 + 8 * fq;
#pragma unroll
                for (int bj = 0; bj < 2; ++bj) {
                    f32x4 v0 = acc[ai][bj][m][0], v1 = acc[ai][bj][m][1];
#pragma unroll
                    for (int e = 0; e < 4; ++e) { const float a = fmaxf(v0[e], 0.f), b = fmaxf(v1[e], 0.f); v0[e] = a * a; v1[e] = b * b; }
                    u32x4 w; w.x = cvt_pk_bf16(v0[0], v0[1]); w.y = cvt_pk_bf16(v0[2], v0[3]); w.z = cvt_pk_bf16(v1[0], v1[1]); w.w = cvt_pk_bf16(v1[2], v1[3]);
                    *(u32x4*)(rowp + bj * HALF) = w;
                }
            }
    }
};
__device__ __forceinline__ float gelu_tanh(float x) {
    const float u2 = 1.5957691216057308f * (x + 0.044715f * x * x * x);
    return x * __builtin_amdgcn_rcpf(1.0f + __builtin_amdgcn_exp2f(-1.4426950408889634f * u2));
}
struct EpiRecIn {
    static constexpr bool PERM = true, AFTER_DRAIN = false;
    bf16_t* GG; bf16_t* XR; bf16_t* HALO;
    template <int MR> __device__ __forceinline__ void operator()(const f32x4 (&acc)[2][2][MR][2], const Unit& u, int wr, int wc, int fr, int fq) const {
        constexpr int HRr = MR * 32, BMR = 2 * HRr, WRO = HRr / 2;
        const bool isg = u.pn < 5;
        bf16_t* base = isg ? GG : XR; const int colt = (isg ? u.pn : u.pn - 5) * BM;
#pragma unroll
        for (int ai = 0; ai < 2; ++ai)
#pragma unroll
            for (int m = 0; m < MR; ++m) {
                const int row = u.pm * BMR + ai * HRr + wr * WRO + m * 16 + fr;
                bf16_t* rowp = base + (size_t)row * 1280 + colt + wc * 32 + 8 * fq;
                const int rl = row & 63; const bool halo = !isg && (rl == 63 || rl <= 1);
                bf16_t* hp = HALO + ((size_t)(row >> 6) * 3 + (rl == 63 ? 0 : rl + 1)) * 1280 + colt + wc * 32 + 8 * fq;
#pragma unroll
                for (int bj = 0; bj < 2; ++bj) {
                    f32x4 v0 = acc[ai][bj][m][0], v1 = acc[ai][bj][m][1];
                    if (isg) {
#pragma unroll
                        for (int e = 0; e < 4; ++e) { v0[e] = gelu_tanh(v0[e]); v1[e] = gelu_tanh(v1[e]); }
                    }
                    u32x4 w; w.x = cvt_pk_bf16(v0[0], v0[1]); w.y = cvt_pk_bf16(v0[2], v0[3]); w.z = cvt_pk_bf16(v1[0], v1[1]); w.w = cvt_pk_bf16(v1[2], v1[3]);
                    *(u32x4*)(rowp + bj * HALF) = w;
                    if (halo) *(u32x4*)(hp + bj * HALF) = w;
                }
            }
    }
};
template <class Epi, class Sched, bool ALIGN_EPI = false, bool SP2 = false, int HR = 128>
__device__ __forceinline__ void gemm_phase(PG8_LAS unsigned char* lds, const Gemm g, const Sched& S, const Epi& E) {
    int tid_ = threadIdx.x; asm volatile("" : "+v"(tid_));
    const int tid = tid_, wid = __builtin_amdgcn_readfirstlane(tid >> 6), lane = tid & 63, wr = wid >> 2, wc = wid & 3, fr = lane & 15, fq = lane >> 4;
    constexpr int MR = HR / 32;
    const int K = g.K, nt = K / BK;
    unsigned voffA[2], voffB[2];
#pragma unroll
    for (int i = 0; i < 2; ++i) { int R, C; stage_rc(tid * 16 + i * 8192, R, C); const int Rb = Epi::PERM ? ((R & ~31) + perm32(R & 31)) : R;
        voffA[i] = (unsigned)(R * K + C) * 2u; voffB[i] = (unsigned)(Rb * K + C) * 2u; }
    const size_t kstep = (size_t)(BK * 2);
    const size_t hstep = (size_t)HALF * K * 2;
    const size_t tstep = 2 * hstep;
    const size_t hstepA = (size_t)HR * K * 2, tstepA = 2 * hstepA;
    const unsigned ldsw = (unsigned)wid * 1024u;
    const int aoff = lds_byte(wr * (HR / 2) + fr, fq * 8), boff = lds_byte(wc * 32 + fr, fq * 8);
#define PG8_SA(b, h) (((b) * 2 + (h)) * HTB)
#define PG8_SB(b, h) ((4 + (b) * 2 + (h)) * HTB)
#define PG8_STAGE(bufoff, gbase, voff) do { _Pragma("unroll") for (int _i = 0; _i < 2; ++_i) \
        __builtin_amdgcn_global_load_lds((const unsigned*)((const char*)(gbase) + (voff)[_i]), (PG8_LAS unsigned*)(lds + (bufoff) + ldsw + _i * 8192), 16, 0, 0); } while (0)
#define PG8_LDA(dst, b, h) do { _Pragma("unroll") for (int m = 0; m < MR; ++m) _Pragma("unroll") for (int k = 0; k < 2; ++k) dst[m][k] = *(const PG8_LAS bf16x8*)(lds + PG8_SA(b, h) + aoff + m * 2048 + k * 1024); } while (0)
#define PG8_LDB(dst, b, h) do { _Pragma("unroll") for (int n = 0; n < 2; ++n) _Pragma("unroll") for (int k = 0; k < 2; ++k) dst[n][k] = *(const PG8_LAS bf16x8*)(lds + PG8_SB(b, h) + boff + n * 2048 + k * 1024); } while (0)
#define PG8_MMA(ai, bj, At, Bt) do { __builtin_amdgcn_s_setprio(1); _Pragma("unroll") for (int m = 0; m < MR; ++m) _Pragma("unroll") for (int n = 0; n < 2; ++n) _Pragma("unroll") for (int k = 0; k < 2; ++k) \
        acc[ai][bj][m][n] = __builtin_amdgcn_mfma_f32_16x16x32_bf16(Bt[n][k], At[m][k], acc[ai][bj][m][n], 0, 0, 0); __builtin_amdgcn_s_setprio(0); } while (0)
#define PG8_WAIT_V(n) asm volatile("s_waitcnt vmcnt(" #n ")" ::: "memory")
#define PG8_WAIT_L(n) asm volatile("s_waitcnt lgkmcnt(" #n ")" ::: "memory")
#define PG8_BAR __builtin_amdgcn_s_barrier()
#define PG8_SCHED __builtin_amdgcn_sched_barrier(0)
    Unit cur, nxt; int ui = 0;
    if (!S.next(0, cur)) return;
    f32x4 acc[2][2][MR][2];
#pragma unroll
    for (int a = 0; a < 2; ++a)
#pragma unroll
        for (int b = 0; b < 2; ++b)
#pragma unroll
            for (int m = 0; m < MR; ++m)
#pragma unroll
                for (int n = 0; n < 2; ++n) acc[a][b][m][n] = (f32x4){0.f, 0.f, 0.f, 0.f};
    bf16x8 At[MR][2], B0[2][2], B1[2][2];
    const char* cA = (const char*)g.A + (size_t)cur.pm * tstepA; const char* cB = (const char*)g.Bt + (size_t)cur.pn * tstep;
    S.a_ready(cur);
    if constexpr (SP2) {
        PG8_STAGE(PG8_SB(0, 0), cB, voffB); PG8_STAGE(PG8_SB(0, 1), cB + hstep, voffB); PG8_STAGE(PG8_SA(0, 0), cA, voffA); PG8_STAGE(PG8_SA(0, 1), cA + hstepA, voffA);
        if (wr == 1) PG8_BAR;
        PG8_WAIT_V(2); PG8_BAR;
        PG8_STAGE(PG8_SB(1, 0), cB + kstep, voffB); PG8_STAGE(PG8_SA(1, 0), cA + kstep, voffA); PG8_STAGE(PG8_SB(1, 1), cB + hstep + kstep, voffB);
        PG8_WAIT_V(6); PG8_BAR;
    } else {
        PG8_STAGE(PG8_SB(0, 0), cB, voffB); PG8_STAGE(PG8_SA(0, 0), cA, voffA); PG8_STAGE(PG8_SB(0, 1), cB + hstep, voffB); PG8_STAGE(PG8_SA(0, 1), cA + hstepA, voffA);
        if (wr == 1) PG8_BAR;
        PG8_WAIT_V(4); PG8_BAR;
        PG8_STAGE(PG8_SB(1, 0), cB + kstep, voffB); PG8_STAGE(PG8_SA(1, 0), cA + kstep, voffA); PG8_STAGE(PG8_SB(1, 1), cB + hstep + kstep, voffB);
        PG8_WAIT_V(6); PG8_BAR;
    }
    for (;;) {
        const bool has_next = S.next(ui + 1, nxt);
        const char* nA = has_next ? (const char*)g.A + (size_t)nxt.pm * tstepA : cA; const char* nB = has_next ? (const char*)g.Bt + (size_t)nxt.pn * tstep : cB;
        for (int t = 0; t < nt; t += 2) {
            const bool last = (t == nt - 2);
            const char* a1 = cA + (size_t)(t + 1) * kstep;
            const char* a2 = last ? nA : cA + (size_t)(t + 2) * kstep; const char* b2 = last ? nB : cB + (size_t)(t + 2) * kstep;
            const char* a3 = a2 + kstep; const char* b3 = b2 + kstep;
            if (last && has_next) S.a_ready(nxt);
            if constexpr (SP2) {
            PG8_LDB(B0, 0, 0); PG8_LDB(B1, 0, 1); PG8_SCHED; PG8_LDA(At, 0, 0); PG8_STAGE(PG8_SA(1, 1), a1 + hstepA, voffA);
            PG8_WAIT_V(8); PG8_WAIT_L(0); PG8_BAR; PG8_MMA(0, 0, At, B0); PG8_MMA(0, 1, At, B1); PG8_BAR; PG8_SCHED;
            PG8_LDA(At, 0, 1); PG8_STAGE(PG8_SB(0, 0), b2, voffB); PG8_STAGE(PG8_SB(0, 1), b2 + hstep, voffB); PG8_STAGE(PG8_SA(0, 0), a2, voffA);
            PG8_WAIT_V(8); PG8_WAIT_L(0); PG8_BAR; PG8_MMA(1, 0, At, B0); PG8_MMA(1, 1, At, B1); PG8_BAR; PG8_SCHED;
            PG8_LDB(B0, 1, 0); PG8_LDB(B1, 1, 1); PG8_SCHED; PG8_LDA(At, 1, 0); PG8_STAGE(PG8_SA(0, 1), a2 + hstepA, voffA);
            PG8_WAIT_V(8); PG8_WAIT_L(0); PG8_BAR; PG8_MMA(0, 0, At, B0); PG8_MMA(0, 1, At, B1); PG8_BAR; PG8_SCHED;
            PG8_LDA(At, 1, 1); PG8_STAGE(PG8_SB(1, 0), b3, voffB); PG8_STAGE(PG8_SB(1, 1), b3 + hstep, voffB); PG8_STAGE(PG8_SA(1, 0), a3, voffA);
            PG8_WAIT_V(8); PG8_WAIT_L(0); PG8_BAR; PG8_MMA(1, 0, At, B0); PG8_MMA(1, 1, At, B1); PG8_BAR; PG8_SCHED;
            } else {
            PG8_LDB(B0, 0, 0); PG8_SCHED; PG8_LDA(At, 0, 0); PG8_STAGE(PG8_SA(1, 1), a1 + hstepA, voffA);
            PG8_WAIT_L(8); PG8_BAR; PG8_WAIT_L(0); PG8_MMA(0, 0, At, B0); PG8_BAR; PG8_SCHED;
            PG8_LDB(B1, 0, 1); PG8_STAGE(PG8_SB(0, 0), b2, voffB);
            PG8_BAR; PG8_WAIT_L(0); PG8_MMA(0, 1, At, B1); PG8_BAR;
            PG8_LDA(At, 0, 1); PG8_STAGE(PG8_SA(0, 0), a2, voffA);
            PG8_BAR; PG8_WAIT_L(0); PG8_MMA(1, 0, At, B0); PG8_BAR; PG8_SCHED;
            PG8_STAGE(PG8_SB(0, 1), b2 + hstep, voffB);
            PG8_WAIT_V(6); PG8_BAR; PG8_MMA(1, 1, At, B1); PG8_BAR;
            PG8_LDB(B0, 1, 0); PG8_SCHED; PG8_LDA(At, 1, 0); PG8_STAGE(PG8_SA(0, 1), a2 + hstepA, voffA);
            PG8_WAIT_L(8); PG8_BAR; PG8_WAIT_L(0); PG8_MMA(0, 0, At, B0); PG8_BAR; PG8_SCHED;
            PG8_LDB(B1, 1, 1); PG8_STAGE(PG8_SB(1, 0), b3, voffB);
            PG8_BAR; PG8_WAIT_L(0); PG8_MMA(0, 1, At, B1); PG8_BAR;
            PG8_LDA(At, 1, 1); PG8_STAGE(PG8_SA(1, 0), a3, voffA);
            PG8_BAR; PG8_WAIT_L(0); PG8_MMA(1, 0, At, B0); PG8_BAR; PG8_SCHED;
            PG8_STAGE(PG8_SB(1, 1), b3 + hstep, voffB);
            PG8_WAIT_V(6); PG8_BAR; PG8_MMA(1, 1, At, B1); PG8_BAR;
            }
        }
        if constexpr (ALIGN_EPI) { if (wr == 0) PG8_BAR; }
        if constexpr (!Epi::AFTER_DRAIN) { E.template operator()<MR>(acc, cur, wr, wc, fr, fq); S.done(cur); }
        if (!has_next) break;
#pragma unroll
        for (int a = 0; a < 2; ++a)
#pragma unroll
            for (int b = 0; b < 2; ++b)
#pragma unroll
                for (int m = 0; m < MR; ++m)
#pragma unroll
                    for (int n = 0; n < 2; ++n) acc[a][b][m][n] = (f32x4){0.f, 0.f, 0.f, 0.f};
        cur = nxt; cA = nA; cB = nB; ++ui;
        if constexpr (ALIGN_EPI) { if (wr == 1) PG8_BAR; }
    }
    PG8_WAIT_V(0);
    if constexpr (!ALIGN_EPI) { if (wr == 0) PG8_BAR; }
    PG8_BAR;
    if constexpr (Epi::AFTER_DRAIN) { E.fused(acc, cur, wr, wc, fr, fq, lds, wid, lane); S.done(cur); }
#undef PG8_SA
#undef PG8_SB
#undef PG8_STAGE
#undef PG8_LDA
#undef PG8_LDB
#undef PG8_MMA
#undef PG8_WAIT_V
#undef PG8_WAIT_L
#undef PG8_BAR
#undef PG8_SCHED
}
}
constexpr int NWAVES = 8, NTHREADS = 512;
constexpr int DM = 1024, T_CTX = 8192, T_LAT = 16384, T_ALL = 24576, LAT_SEQ = 4096, CTX_SEQ = 256;
constexpr int QKV_LD = 2304, DFF = 4096, DRNN = 1280;
constexpr int QA_OFF = 0, KA_OFF = 512, VA_OFF = 640, QB_OFF = 768, KB_OFF = 1280, VB_OFF = 1792;
constexpr float EPSN = 1e-6f;
constexpr float SM_C = 0.125f * 1.4426950408889634f;
constexpr long OUT_AK = 25165824, OUT_AV = 26214400, OUT_BK = 27262976, OUT_BV = 31457280, OUT_SF = 35651584, OUT_SB = 35692544;
constexpr size_t MiB = 1u << 20;
constexpr size_t WS_CTL = 0, CTL_ZERO_BYTES = 64 * 1024;
constexpr size_t WS_MOD = 1 * MiB;
constexpr size_t WS_ROPE = 1 * MiB + 256 * 1024;
constexpr size_t WS_LAM = WS_ROPE + 16 * 1024;
constexpr size_t WS_CAK = 2 * MiB, WS_CAV = WS_CAK + 256 * 1024, WS_CBK = WS_CAV + 256 * 1024, WS_CBV = WS_CBK + 1 * MiB;
constexpr size_t WS_WIN = 5 * MiB;
constexpr size_t WS_WOUT = 10 * MiB;
constexpr size_t WS_W1 = 12 * MiB;
constexpr size_t WS_W2 = 28 * MiB;
constexpr size_t WS_WRIN = 44 * MiB;
constexpr size_t WS_WROUT = 49 * MiB;
constexpr size_t WS_WG = 52 * MiB;
constexpr size_t WS_SUM = 54 * MiB;
constexpr size_t WS_H = 56 * MiB;
constexpr size_t WS_BIG = 104 * MiB;
constexpr size_t WS_END = 256 * MiB;
static_assert(WS_BIG + (size_t)T_ALL * QKV_LD * 2 <= WS_END && WS_BIG + (size_t)(T_ALL / 2) * DFF * 2 <= WS_END && WS_BIG + (size_t)T_ALL * DRNN * 4 <= WS_END, "ws map");
constexpr int LDS_BYTES = 160 * 1024;
constexpr int MISC_OFF = 152 * 1024;

#define GAS __attribute__((address_space(1)))
#define LAS __attribute__((address_space(3)))
typedef unsigned short bf16;
typedef unsigned v4u __attribute__((ext_vector_type(4)));
typedef unsigned v2u __attribute__((ext_vector_type(2)));
typedef float f32x4 __attribute__((ext_vector_type(4)));
typedef float f32x2 __attribute__((ext_vector_type(2)));
typedef float f32x16 __attribute__((ext_vector_type(16)));
typedef short bf16x8 __attribute__((ext_vector_type(8)));
typedef short s16x4 __attribute__((ext_vector_type(4)));
typedef GAS unsigned gu32;
#define RLX_AGENT __ATOMIC_RELAXED, __HIP_MEMORY_SCOPE_AGENT
__device__ __forceinline__ unsigned f2bf(float f) { unsigned u = __builtin_bit_cast(unsigned, f); return (u + 0x7fffu + ((u >> 16) & 1u)) >> 16; }
__device__ __forceinline__ unsigned pk2(float lo, float hi) { return f2bf(lo) | (f2bf(hi) << 16); }
__device__ __forceinline__ float bf2f(unsigned short b) { return __builtin_bit_cast(float, (unsigned)b << 16); }
__device__ __forceinline__ float bflo(unsigned w) { return __builtin_bit_cast(float, w << 16); }
__device__ __forceinline__ float bfhi(unsigned w) { return __builtin_bit_cast(float, w & 0xffff0000u); }

#define XB_TMO      128
#define XB_XCNT(j)  (256  + 64 * (j))
#define XB_XSUB(j)  (1280 + 64 * (j))
#define XB_XGEN(j)  (2304 + 64 * (j))
#define XB_TOP      3328
#define XB_TOPGEN   3392
#define XCD_BAR_WORDS 3456
#define XB_SPIN_CAP (1u << 18)
__device__ __forceinline__ unsigned xb_ld(unsigned* p)              { return __hip_atomic_load(p, __ATOMIC_RELAXED, __HIP_MEMORY_SCOPE_AGENT); }
__device__ __forceinline__ unsigned xb_add(unsigned* p, unsigned v) { return __hip_atomic_fetch_add(p, v, __ATOMIC_RELAXED, __HIP_MEMORY_SCOPE_AGENT); }
__device__ __forceinline__ unsigned xb_xcc_id() { return (unsigned)__builtin_amdgcn_s_getreg((3 << 11) | 20) & 0xFu; }
#define XB_SPIN(cond, bar) do { unsigned _sp = 0; while (cond) { __builtin_amdgcn_s_sleep(1); \
    if ((++_sp & 255u) == 0u) { if (xb_ld(&(bar)[XB_TMO])) break; if (_sp > XB_SPIN_CAP) { atomicAdd(&(bar)[XB_TMO], 1u); break; } } } } while (0)
struct XcdBarrier { unsigned* bar; unsigned x; volatile LAS unsigned* st; };
__device__ __forceinline__ XcdBarrier xcd_barrier_post(unsigned* bar, volatile LAS unsigned* st) {
    XcdBarrier b; b.bar = bar; b.x = xb_xcc_id(); b.st = st;
    if (threadIdx.x == 0) (void)xb_add(&bar[XB_XCNT(b.x)], 1u);
    return b;
}
__device__ __forceinline__ void xcd_barrier_complete(unsigned* bar, unsigned x, unsigned& nloc, unsigned& nx) {
    const unsigned G = gridDim.x * gridDim.y * gridDim.z;
    unsigned sum, cnt, mine, sp = 0u;
    for (;;) {
        sum = 0u; cnt = 0u; mine = 0u;
#pragma unroll
        for (unsigned j = 0; j < 16; ++j) { const unsigned c = xb_ld(&bar[XB_XCNT(j)]); sum += c; cnt += (c > 0u) ? 1u : 0u; mine = (j == x) ? c : mine; }
        if (sum == G) break;
        __builtin_amdgcn_s_sleep(1);
        if ((++sp & 255u) == 0u) { if (xb_ld(&bar[XB_TMO])) break; if (sp > XB_SPIN_CAP) { atomicAdd(&bar[XB_TMO], 1u); break; } }
    }
    nloc = mine > 0u ? mine : 1u; nx = cnt > 0u ? cnt : 1u;
}
__device__ __forceinline__ void xcd_barrier(const XcdBarrier& b) {
    asm volatile("s_waitcnt vmcnt(0)" ::: "memory");
    __syncthreads();
    if (threadIdx.x == 0) {
        unsigned* bar = b.bar;
        __builtin_amdgcn_s_waitcnt(0);
        unsigned nloc = b.st[0], nx = b.st[1];
        if (nloc == 0u) { xcd_barrier_complete(bar, b.x, nloc, nx); b.st[0] = nloc; b.st[1] = nx; }
        const unsigned old = xb_add(&bar[XB_XSUB(b.x)], 1u);
        const unsigned gen = old / nloc;
        if (old + 1u == (gen + 1u) * nloc) {
            __builtin_amdgcn_fence(__ATOMIC_RELEASE, "agent");
            asm volatile("s_waitcnt vmcnt(0)" ::: "memory");
            const unsigned og = xb_add(&bar[XB_TOP], 1u);
            const unsigned tg = og / nx;
            if (og + 1u == (tg + 1u) * nx) xb_add(&bar[XB_TOPGEN], 1u);
            else XB_SPIN(xb_ld(&bar[XB_TOPGEN]) == tg, bar);
            __builtin_amdgcn_fence(__ATOMIC_ACQUIRE, "agent");
            xb_add(&bar[XB_XGEN(b.x)], 1u);
            asm volatile("s_waitcnt vmcnt(0)" ::: "memory");
        } else {
            XB_SPIN(xb_ld(&bar[XB_XGEN(b.x)]) == gen, bar);
            __builtin_amdgcn_fence(__ATOMIC_ACQUIRE, "agent");
            asm volatile("s_waitcnt vmcnt(0)" ::: "memory");
        }
    }
    __syncthreads();
}

struct Args { const float* in[31]; float* out; unsigned char* ws; int ph_lo, ph_hi; int use_bar, pad; };
struct Frame {
    LAS unsigned char* lds;
    int tid, lane, wave, vcu, G;
    const float* const* in; float* out; unsigned char* ws;
};
#define WSP(T, off) ((T*)(F.ws + (off)))
__device__ __forceinline__ Frame fresh(const Frame& F) { Frame P = F; int t = threadIdx.x; asm volatile("" : "+v"(t)); P.tid = t; P.lane = t & 63; P.wave = __builtin_amdgcn_readfirstlane(t >> 6); return P; }
enum { IN_XP = 0, IN_XS, IN_CAK, IN_CAV, IN_CBK, IN_CBV, IN_SF, IN_SB, IN_C, IN_CCTX, IN_NORM1, IN_NORM2, IN_WADA, IN_BADA, IN_WMLP1, IN_WMLP2, IN_AWIN, IN_AWOUT, IN_SINK, IN_LAMQK, IN_SUBLN,
       IN_RWIN, IN_RCONVW, IN_RCONVB, IN_RWA, IN_RBA, IN_RWX, IN_RBX, IN_RLAM, IN_RWOUT, IN_FNORM };

__device__ __forceinline__ float wave_sum(float v) {
#pragma unroll
    for (int o = 1; o < 64; o <<= 1) v += __shfl_xor(v, o);
    return v;
}

__device__ __forceinline__ void p0_transpose_item(const float* W, int K, int N, bf16* WT, LAS float* scr, int item, int lane) {
    const int nblk = N / 32, kb = item / nblk, nb = item % nblk, k0 = 64 * kb, n0 = 32 * nb;
#pragma unroll 8
    for (int i = 0; i < 32; ++i) { const int kk = 2 * i + (lane >> 5); scr[kk * 33 + (lane & 31)] = W[(size_t)(k0 + kk) * N + n0 + (lane & 31)]; }
    asm volatile("s_waitcnt lgkmcnt(0)" ::: "memory");
    const int c = lane & 7;
#pragma unroll
    for (int j = 0; j < 4; ++j) { const int n = (lane >> 3) + 8 * j; const LAS float* s = scr + (8 * c) * 33 + n;
        v4u o; o.x = pk2(s[0 * 33], s[1 * 33]); o.y = pk2(s[2 * 33], s[3 * 33]); o.z = pk2(s[4 * 33], s[5 * 33]); o.w = pk2(s[6 * 33], s[7 * 33]);
        *(GAS v4u*)(WT + (size_t)(n0 + n) * K + k0 + 8 * c) = o; }
    asm volatile("s_waitcnt lgkmcnt(0)" ::: "memory");
}
__device__ __forceinline__ void p0_prologue(Frame& F) {
    const float* const* in = F.in;
    {
        LAS float* SC = (LAS float*)(F.lds);
        LAS float* RED = (LAS float*)(F.lds + 20480);
        for (int i = F.tid; i < 5 * 1024; i += NTHREADS) { const int v = i >> 10, k = i & 1023; const float c = v < 4 ? in[IN_C][v * 1024 + k] : in[IN_CCTX][k]; SC[i] = c / (1.0f + __expf(-c)); }
        __syncthreads();
        float* MOD = WSP(float, WS_MOD);
        for (int u = blockIdx.x; u < 384; u += F.G) {
            const int l = u / 192, n0 = (u % 192) * 32;
            const float* W = in[IN_WADA] + (size_t)l * 1024 * 6144 + n0 + (F.lane & 31);
            float a[5] = {0.f, 0.f, 0.f, 0.f, 0.f};
            const int kb = F.wave * 128 + (F.lane >> 5);
#pragma unroll 8
            for (int kk = 0; kk < 64; ++kk) { const int k = kb + 2 * kk; const float w = W[(size_t)k * 6144];
#pragma unroll
                for (int v = 0; v < 5; ++v) a[v] += SC[v * 1024 + k] * w; }
#pragma unroll
            for (int v = 0; v < 5; ++v) { a[v] += __shfl_xor(a[v], 32); if (F.lane < 32) RED[(F.wave * 5 + v) * 32 + F.lane] = a[v]; }
            __syncthreads();
            if (F.tid < 160) { const int v = F.tid >> 5, c = F.tid & 31; float s = in[IN_BADA][l * 6144 + n0 + c];
#pragma unroll
                for (int w = 0; w < 8; ++w) s += RED[(w * 5 + v) * 32 + c];
                MOD[((size_t)l * 5 + v) * 6144 + n0 + c] = s; }
            __syncthreads();
        }
    }
    {
        LAS float* scr = (LAS float*)(F.lds + 32768 + F.wave * 8704);
        const int gw = F.vcu * NWAVES + F.wave, NGW = F.G * NWAVES;
        constexpr int I_IN = 16 * 72, I_OUT = 16 * 32;
        for (int it = gw; it < I_IN + I_OUT; it += NGW) {
            if (it < I_IN) p0_transpose_item(in[IN_AWIN], 1024, 2304, WSP(bf16, WS_WIN), scr, it, F.lane);
            else p0_transpose_item(in[IN_AWOUT], 1024, 1024, WSP(bf16, WS_WOUT), scr, it - I_IN, F.lane);
        }
    }
    {
        const int gt = F.vcu * NTHREADS + F.tid, NGT = F.G * NTHREADS;
        for (int i = gt; i < 4 * 256 * 128 / 4; i += NGT) {
            const f32x4 a = ((const f32x4*)in[IN_CAK])[i], b = ((const f32x4*)in[IN_CAV])[i];
            v2u o; o.x = pk2(a[0], a[1]); o.y = pk2(a[2], a[3]); WSP(v2u, WS_CAK)[i] = o; o.x = pk2(b[0], b[1]); o.y = pk2(b[2], b[3]); WSP(v2u, WS_CAV)[i] = o; }
        for (int i = gt; i < 4 * 256 * 512 / 4; i += NGT) {
            const f32x4 a = ((const f32x4*)in[IN_CBK])[i], b = ((const f32x4*)in[IN_CBV])[i];
            v2u o; o.x = pk2(a[0], a[1]); o.y = pk2(a[2], a[3]); WSP(v2u, WS_CBK)[i] = o; o.x = pk2(b[0], b[1]); o.y = pk2(b[2], b[3]); WSP(v2u, WS_CBV)[i] = o; }
        if (gt < 1024) { const int pos = gt >> 4, i = gt & 15; const double ang = (double)pos * pow(10000.0, -(double)i / 16.0);
            WSP(f32x2, WS_ROPE)[gt] = (f32x2){(float)cos(ang), (float)sin(ang)}; }
        if (gt == 0) { const float* lq = in[IN_LAMQK]; float s1 = 0.f, s2 = 0.f; for (int i = 0; i < 64; ++i) { s1 += lq[i] * lq[64 + i]; s2 += lq[128 + i] * lq[192 + i]; }
            WSP(float, WS_LAM)[0] = __expf(s1) - __expf(s2) + 0.2f; }
    }
}

__device__ __forceinline__ void p_deferred_transposes(Frame& F, int iw, int nw) {
    const float* const* in = F.in;
    LAS float* scr = (LAS float*)(F.lds + 32768 + F.wave * 8704);
    const int gw = iw * NWAVES + F.wave, NGW = nw * NWAVES;
    constexpr int I_M1 = 16 * 128, I_M2 = 64 * 32, I_RIN = 16 * 80, I_ROUT = 20 * 32, I_G = 8;
    constexpr int NITEMS = 2 * I_M1 + 2 * I_M2 + I_RIN + I_ROUT + 40 * I_G;
    for (int it = gw; it < NITEMS; it += NGW) {
        int r = it;
        if (r < 2 * I_M1) { const int l = r / I_M1; p0_transpose_item(in[IN_WMLP1] + (size_t)l * 1024 * 4096, 1024, 4096, WSP(bf16, WS_W1) + (size_t)l * 4096 * 1024, scr, r % I_M1, F.lane); continue; } r -= 2 * I_M1;
        if (r < 2 * I_M2) { const int l = r / I_M2; p0_transpose_item(in[IN_WMLP2] + (size_t)l * 4096 * 1024, 4096, 1024, WSP(bf16, WS_W2) + (size_t)l * 1024 * 4096, scr, r % I_M2, F.lane); continue; } r -= 2 * I_M2;
        if (r < I_RIN) { p0_transpose_item(in[IN_RWIN], 1024, 2560, WSP(bf16, WS_WRIN), scr, r, F.lane); continue; } r -= I_RIN;
        if (r < I_ROUT) { p0_transpose_item(in[IN_RWOUT], 1280, 1024, WSP(bf16, WS_WROUT), scr, r, F.lane); continue; } r -= I_ROUT;
        { const int mtx = r / I_G, gate = mtx / 20, db = mtx % 20;
          p0_transpose_item(in[gate ? IN_RWX : IN_RWA] + (size_t)db * 16384, 128, 128, WSP(bf16, WS_WG) + (size_t)(gate * 20 + db) * 16384, scr, r % I_G, F.lane); }
    }
}

__device__ __forceinline__ void norm_mod_pass(Frame& F, const float* x_ctx, const float* x_lat, const float* g, const float* mod  , int shift_off, int scale_off, bf16* H) {
    const int gw = F.vcu * NWAVES + F.wave, NGW = F.G * NWAVES;
    for (int m = gw; m < T_ALL; m += NGW) {
        const float* xr = m < T_CTX ? x_ctx + (size_t)m * DM : x_lat + (size_t)(m - T_CTX) * DM;
        const int midx = m < T_CTX ? 4 : ((m - T_CTX) >> 12);
        const float* mv = mod + (size_t)midx * 6144;
        f32x4 v[4]; float s = 0.f;
#pragma unroll
        for (int j = 0; j < 4; ++j) { v[j] = ((const f32x4*)xr)[F.lane + 64 * j]; s += (v[j][0] * v[j][0] + v[j][1] * v[j][1]) + (v[j][2] * v[j][2] + v[j][3] * v[j][3]); }
        const float rstd = 1.0f / sqrtf(wave_sum(s) * (1.0f / DM) + EPSN);
#pragma unroll
        for (int j = 0; j < 4; ++j) {
            const int c = 4 * (F.lane + 64 * j);
            const f32x4 gg = *(const f32x4*)(g + c), sc = *(const f32x4*)(mv + scale_off + c), sh = *(const f32x4*)(mv + shift_off + c);
            f32x4 o = (v[j] * rstd) * gg; o = o * (sc + 1.0f) + sh;
            v2u w; w.x = pk2(o[0], o[1]); w.y = pk2(o[2], o[3]);
            *(v2u*)(H + (size_t)m * DM + c) = w;
        }
    }
}
constexpr int X_SPLIT = 16384;
__device__ __forceinline__ const bf16* xrow_bf(const bf16* XA, const bf16* XB, int m) { return m < X_SPLIT ? XA + (size_t)m * DM : XB + (size_t)(m - X_SPLIT) * DM; }
__device__ __forceinline__ void unpack16(const v4u a, const v4u b, float (&v)[16]) {
    const unsigned w[8] = {a.x, a.y, a.z, a.w, b.x, b.y, b.z, b.w};
#pragma unroll
    for (int e = 0; e < 8; ++e) { v[2 * e] = bflo(w[e]); v[2 * e + 1] = bfhi(w[e]); }
}
__device__ __forceinline__ void norm_mod_pass_bf(Frame& F, const bf16* XA, const bf16* XB, const float* g, const float* mod  , int shift_off, int scale_off, bf16* H) {
    const int gw = F.vcu * NWAVES + F.wave, NGW = F.G * NWAVES;
    for (int m = gw; m < T_ALL; m += NGW) {
        const v4u* xp = (const v4u*)(xrow_bf(XA, XB, m) + F.lane * 8);
        const int midx = m < T_CTX ? 4 : ((m - T_CTX) >> 12);
        const float* mv = mod + (size_t)midx * 6144;
        float v[16]; unpack16(xp[0], xp[64], v);
        float s = 0.f;
#pragma unroll
        for (int e = 0; e < 16; ++e) s += v[e] * v[e];
        const float rstd = 1.0f / sqrtf(wave_sum(s) * (1.0f / DM) + EPSN);
        unsigned ow[8];
#pragma unroll
        for (int q = 0; q < 4; ++q) {
            const int c = 8 * F.lane + (q >> 1) * 512 + (q & 1) * 4;
            const f32x4 gg = *(const f32x4*)(g + c), sc = *(const f32x4*)(mv + scale_off + c), sh = *(const f32x4*)(mv + shift_off + c);
            const float o0 = (v[4 * q] * rstd) * gg[0] * (sc[0] + 1.0f) + sh[0], o1 = (v[4 * q + 1] * rstd) * gg[1] * (sc[1] + 1.0f) + sh[1];
            const float o2 = (v[4 * q + 2] * rstd) * gg[2] * (sc[2] + 1.0f) + sh[2], o3 = (v[4 * q + 3] * rstd) * gg[3] * (sc[3] + 1.0f) + sh[3];
            ow[2 * q] = pk2(o0, o1); ow[2 * q + 1] = pk2(o2, o3);
        }
        v4u* hp = (v4u*)(H + (size_t)m * DM + 8 * F.lane);
        v4u a, b2; a.x = ow[0]; a.y = ow[1]; a.z = ow[2]; a.w = ow[3]; b2.x = ow[4]; b2.y = ow[5]; b2.z = ow[6]; b2.w = ow[7];
        hp[0] = a; hp[64] = b2;
    }
}
__device__ __forceinline__ void final_norm_pass(Frame& F, const bf16* XA, const bf16* XB, float* Y, const float* g, int m_lo, int m_hi) {
    const int gw = F.vcu * NWAVES + F.wave, NGW = F.G * NWAVES;
    for (int m = m_lo + gw; m < m_hi; m += NGW) {
        const v4u* xp = (const v4u*)(xrow_bf(XA, XB, m) + F.lane * 8);
        float v[16]; unpack16(xp[0], xp[64], v);
        float s = 0.f;
#pragma unroll
        for (int e = 0; e < 16; ++e) s += v[e] * v[e];
        const float rstd = 1.0f / sqrtf(wave_sum(s) * (1.0f / DM) + EPSN);
#pragma unroll
        for (int q = 0; q < 4; ++q) { const int c = 8 * F.lane + (q >> 1) * 512 + (q & 1) * 4; const f32x4 gg = *(const f32x4*)(g + c);
            f32x4 o; o[0] = v[4 * q] * rstd * gg[0]; o[1] = v[4 * q + 1] * rstd * gg[1]; o[2] = v[4 * q + 2] * rstd * gg[2]; o[3] = v[4 * q + 3] * rstd * gg[3];
            *(f32x4*)(Y + (size_t)m * DM + c) = o; }
    }
}

constexpr float ATT_THR = 8.0f;
constexpr int AT_K0 = 0, AT_K1 = 9216;
constexpr int AT_V0 = 18432, AT_V1 = 38912;
constexpr int AT_WS = 59392;
constexpr int AT_O1 = 61440;
static_assert(AT_O1 + 65536 <= MISC_OFF, "attention LDS map");
__device__ __forceinline__ int crow(int r, int hi) { return (r & 3) + 8 * (r >> 2) + 4 * hi; }
__device__ __forceinline__ unsigned cvtpk_s(float lo, float hi) { typedef __bf16 bf16x2_t __attribute__((ext_vector_type(2))); f32x2 v = {lo, hi}; bf16x2_t b = __builtin_convertvector(v, bf16x2_t); return __builtin_bit_cast(unsigned, b); }
__device__ __forceinline__ s16x4 vtr(const LAS unsigned char* p) { typedef short v4i16_t __attribute__((ext_vector_type(4))); return __builtin_bit_cast(s16x4, __builtin_amdgcn_ds_read_tr16_b64_v4i16((LAS v4i16_t*)p)); }

struct AttnSrc {
    const bf16* K0; const bf16* V0; int ld0, n0;
    const bf16* K1; const bf16* V1; int ld1, t_lo, t_hi;
};
template <int DV, bool WINDOW>
__device__ __forceinline__ void attn_pass(Frame& F, const bf16* Q, int ldq, const AttnSrc& S, int qpos0, float m_init, float l_init, bool start_exact, f32x16 (&o)[DV / 32], float& m_out, float& l_out) {
    constexpr int RSV = DV == 128 ? 320 : 192, NVL = DV / 64;
    LAS unsigned char* lds = F.lds;
    const int tid = F.tid, lane = F.lane, wid = F.wave, r32 = lane & 31, hi = lane >> 5;
    LAS float* wsf = (LAS float*)(lds + AT_WS) + wid * 64;
    bf16x8 qr[4];
    { const bf16* qp = Q + (size_t)(wid * 32 + r32) * ldq + hi * 8;
#pragma unroll
      for (int d0 = 0; d0 < 4; ++d0) qr[d0] = *(const bf16x8*)(qp + d0 * 16); }
#pragma unroll
    for (int d = 0; d < DV / 32; ++d) o[d] = f32x16{};
    float m = m_init, l = l_init;
    f32x16 negm;
#pragma unroll
    for (int r = 0; r < 16; ++r) negm[r] = -m_init;
    const int nt = S.n0 + (S.t_hi - S.t_lo);
    v4u kreg, vreg[NVL];
    const int krow = tid >> 3, kch = tid & 7;
#define AT_ISSUE(it_) do { const int it__ = (it_); const bf16* Kp; const bf16* Vp; int ld; \
        if (it__ < S.n0) { Kp = S.K0 + (size_t)(it__ * 64) * S.ld0; Vp = S.V0 + (size_t)(it__ * 64) * S.ld0; ld = S.ld0; } \
        else { const int t = S.t_lo + it__ - S.n0; Kp = S.K1 + (size_t)(t * 64) * S.ld1; Vp = S.V1 + (size_t)(t * 64) * S.ld1; ld = S.ld1; } \
        kreg = *(const v4u*)(Kp + (size_t)krow * ld + kch * 8); \
        if (DV == 128) { _Pragma("unroll") for (int i = 0; i < NVL; ++i) { const int idx = tid + 512 * i; vreg[i] = *(const v4u*)(Vp + (size_t)(idx >> 4) * ld + (idx & 15) * 8); } } \
        else vreg[0] = *(const v4u*)(Vp + (size_t)krow * ld + kch * 8); } while (0)
#define AT_COMMIT(buf_) do { const int kb_ = (buf_) ? AT_K1 : AT_K0, vb_ = (buf_) ? AT_V1 : AT_V0; \
        *(LAS v4u*)(lds + kb_ + krow * 144 + kch * 16) = kreg; \
        if (DV == 128) { _Pragma("unroll") for (int i = 0; i < NVL; ++i) { const int idx = tid + 512 * i; *(LAS v4u*)(lds + vb_ + (idx >> 4) * RSV + (idx & 15) * 16) = vreg[i]; } } \
        else *(LAS v4u*)(lds + vb_ + krow * RSV + kch * 16) = vreg[0]; } while (0)
    const int koff = r32 * 144 + hi * 16;
    const int voff = (4 * hi + ((lane & 15) >> 2)) * RSV + ((lane >> 4) & 1) * 32 + (lane & 3) * 8;
    const int qw0 = qpos0 + 32 * wid;
    __syncthreads();
    AT_ISSUE(0); AT_COMMIT(0);
    if (nt > 1) AT_ISSUE(1);
#pragma unroll 1
    for (int it = 0; it < nt; ++it) {
        __syncthreads();
        const LAS unsigned char* kbase = lds + ((it & 1) ? AT_K1 : AT_K0) + koff;
        const LAS unsigned char* vbase = lds + ((it & 1) ? AT_V1 : AT_V0) + voff;
        bool skip = false, need_mask = false;
        int kp0 = 0;
        if (WINDOW && it >= S.n0) {
            kp0 = (S.t_lo + it - S.n0) * 64;
            skip = (kp0 + 63 < qw0 - 128 || kp0 > qw0 + 31 + 128);
            need_mask = !(kp0 >= qw0 + 31 - 128 && kp0 + 63 <= qw0 + 128);
        }
        if (!skip) {
            f32x16 p0, p1;
            __builtin_amdgcn_s_setprio(1);
#pragma unroll
            for (int d0 = 0; d0 < 4; ++d0) {
                const bf16x8 k0 = *(const LAS bf16x8*)(kbase + d0 * 32);
                const bf16x8 k1 = *(const LAS bf16x8*)(kbase + 32 * 144 + d0 * 32);
                if (d0 == 0) { p0 = __builtin_amdgcn_mfma_f32_32x32x16_bf16(k0, qr[0], negm, 0, 0, 0); p1 = __builtin_amdgcn_mfma_f32_32x32x16_bf16(k1, qr[0], negm, 0, 0, 0); }
                else { p0 = __builtin_amdgcn_mfma_f32_32x32x16_bf16(k0, qr[d0], p0, 0, 0, 0); p1 = __builtin_amdgcn_mfma_f32_32x32x16_bf16(k1, qr[d0], p1, 0, 0, 0); }
            }
            __builtin_amdgcn_s_setprio(0);
            if (WINDOW && need_mask) {
                const int q = qw0 + r32;
#pragma unroll
                for (int r = 0; r < 16; ++r) { const int kv = kp0 + crow(r, hi); int d0 = q - kv; d0 = d0 < 0 ? -d0 : d0; int d1 = q - kv - 32; d1 = d1 < 0 ? -d1 : d1;
                    if (d0 > 128) p0[r] = -1e30f; if (d1 > 128) p1[r] = -1e30f; }
            }
            float rm = fmaxf(p0[0], p1[0]);
#pragma unroll
            for (int r = 1; r < 16; ++r) rm = fmaxf(fmaxf(rm, p0[r]), p1[r]);
            rm = fmaxf(rm, __shfl_xor(rm, 32));
            const bool exact = start_exact && it == 0;
            if (exact || __any(rm > ATT_THR)) {
                const float dl = exact ? rm : fmaxf(rm, 0.f);
                m += dl;
#pragma unroll
                for (int r = 0; r < 16; ++r) { p0[r] -= dl; p1[r] -= dl; negm[r] = -m; }
                const float alpha = exact ? 1.0f : __builtin_amdgcn_exp2f(-dl);
                l *= alpha;
                if (hi == 0) wsf[r32] = alpha;
                asm volatile("s_waitcnt lgkmcnt(0)" ::: "memory");
#pragma unroll
                for (int r = 0; r < 16; ++r) { const float a = wsf[crow(r, hi)];
#pragma unroll
                    for (int d = 0; d < DV / 32; ++d) o[d][r] *= a; }
            }
            float ps = 0.f;
            bf16x8 pa[4];
#define AT_ECHUNK(P_, B_, c_) do { v4u w_; \
                _Pragma("unroll") for (int j = 0; j < 4; ++j) { const float e0 = __builtin_amdgcn_exp2f(P_[(B_) + 2 * j]), e1 = __builtin_amdgcn_exp2f(P_[(B_) + 2 * j + 1]); \
                    ps += e0 + e1; w_[j] = cvtpk_s(e0, e1); } \
                pa[c_] = __builtin_bit_cast(bf16x8, w_); } while (0)
#define AT_PVSTEP(s_) do { _Pragma("unroll") for (int d = 0; d < DV / 32; ++d) { \
                const s16x4 lo = vtr(vbase + (16 * (s_)) * RSV + d * 64); const s16x4 hh = vtr(vbase + (16 * (s_) + 8) * RSV + d * 64); \
                const bf16x8 vf = (bf16x8){lo[0], lo[1], lo[2], lo[3], hh[0], hh[1], hh[2], hh[3]}; \
                o[d] = __builtin_amdgcn_mfma_f32_32x32x16_bf16(pa[s_], vf, o[d], 0, 0, 0); } } while (0)
            AT_ECHUNK(p0, 0, 0);
            AT_ECHUNK(p0, 8, 1); AT_PVSTEP(0);
            AT_ECHUNK(p1, 0, 2); AT_PVSTEP(1);
            AT_ECHUNK(p1, 8, 3); AT_PVSTEP(2);
            AT_PVSTEP(3);
            l += ps;
#undef AT_ECHUNK
#undef AT_PVSTEP
        }
        if (it + 1 < nt) { AT_COMMIT((it + 1) & 1); if (it + 2 < nt) AT_ISSUE(it + 2); }
    }
#undef AT_ISSUE
#undef AT_COMMIT
    m_out = m; l_out = l;
}
__device__ __forceinline__ void row_recip(Frame& F, float l, float (&rli)[16]) {
    LAS float* wsf = (LAS float*)(F.lds + AT_WS) + F.wave * 64;
    const int r32 = F.lane & 31, hi = F.lane >> 5;
    l += __shfl_xor(l, 32);
    asm volatile("s_waitcnt lgkmcnt(0)" ::: "memory");
    if (hi == 0) wsf[r32] = 1.0f / l;
    asm volatile("s_waitcnt lgkmcnt(0)" ::: "memory");
#pragma unroll
    for (int r = 0; r < 16; ++r) rli[r] = wsf[crow(r, hi)];
    asm volatile("s_waitcnt lgkmcnt(0)" ::: "memory");
}
template <bool WINDOW>
__device__ __forceinline__ void attn_a_unit(Frame& F, const bf16* QKV, size_t row0, int h, const AttnSrc& S, int qpos0, float sink, bf16* OM) {
    f32x16 o[2]; float m, l;
    attn_pass<64, WINDOW>(F, QKV + row0 * QKV_LD + QA_OFF + h * 64, QKV_LD, S, qpos0, sink * 1.4426950408889634f, (F.lane >> 5) == 0 ? 1.0f : 0.0f, false, o, m, l);
    float rli[16]; row_recip(F, l, rli);
    const int r32 = F.lane & 31, hi = F.lane >> 5;
    bf16* op = OM + (row0 + F.wave * 32) * DM + h * 64 + r32;
#pragma unroll
    for (int r = 0; r < 16; ++r)
#pragma unroll
        for (int d = 0; d < 2; ++d) op[(size_t)crow(r, hi) * DM + d * 32] = (bf16)f2bf(o[d][r] * rli[r]);
}
__device__ __forceinline__ void attn_b_unit(Frame& F, const bf16* QKV, size_t row0, int h, AttnSrc S, float lam, const float* subln, bf16* OM) {
    f32x16 o[4]; float m, l; float rli[16];
    const bf16* K0 = S.K0; const bf16* K1 = S.K1;
    const int r32 = F.lane & 31, hi = F.lane >> 5;
    LAS unsigned* o1s = (LAS unsigned*)(F.lds + AT_O1) + F.wave * 2048 + F.lane;
    attn_pass<128, false>(F, QKV + row0 * QKV_LD + QB_OFF + h * 128, QKV_LD, S, 0, 0.f, 0.f, true, o, m, l);
    row_recip(F, l, rli);
#pragma unroll
    for (int d = 0; d < 4; ++d)
#pragma unroll
        for (int r = 0; r < 8; ++r) o1s[(d * 8 + r) * 64] = cvtpk_s(o[d][2 * r] * rli[2 * r], o[d][2 * r + 1] * rli[2 * r + 1]);
    S.K0 = K0 + 64; S.K1 = K1 + 64;
    attn_pass<128, false>(F, QKV + row0 * QKV_LD + QB_OFF + h * 128 + 64, QKV_LD, S, 0, 0.f, 0.f, true, o, m, l);
    row_recip(F, l, rli);
    float ss[16];
#pragma unroll
    for (int r = 0; r < 16; ++r) { float s = 0.f;
#pragma unroll
        for (int d = 0; d < 4; ++d) { const unsigned w = o1s[(d * 8 + (r >> 1)) * 64]; const float o1 = (r & 1) ? bfhi(w) : bflo(w); const float v = o1 - lam * (o[d][r] * rli[r]); o[d][r] = v; s += v * v; }
        ss[r] = s; }
#pragma unroll
    for (int r = 0; r < 16; ++r) { float s = ss[r];
#pragma unroll
        for (int x = 1; x < 32; x <<= 1) s += __shfl_xor(s, x);
        ss[r] = 0.8f / sqrtf(s * (1.0f / 128.0f) + EPSN); }
    float gs[4];
#pragma unroll
    for (int d = 0; d < 4; ++d) gs[d] = subln[d * 32 + r32];
    bf16* op = OM + (row0 + F.wave * 32) * DM + 512 + h * 128 + r32;
#pragma unroll
    for (int r = 0; r < 16; ++r)
#pragma unroll
        for (int d = 0; d < 4; ++d) op[(size_t)crow(r, hi) * DM + d * 32] = (bf16)f2bf(o[d][r] * ss[r] * gs[d]);
}
__device__ __forceinline__ void attention_phase(Frame& F) {
    const bf16* QKV = WSP(bf16, WS_BIG); bf16* OM = WSP(bf16, WS_H);
    const float lam = WSP(float, WS_LAM)[0];
    const float* sinkp = F.in[IN_SINK]; const float* subln = F.in[IN_SUBLN];
    for (int u = F.vcu; u < 256; u += F.G) {
        const int b = u >> 6, h = (u >> 4) & 3, qb = u & 15;
        const size_t seq0 = T_CTX + (size_t)b * LAT_SEQ;
        AttnSrc S; S.K0 = WSP(bf16, WS_CBK) + (size_t)b * 256 * 512 + h * 128; S.V0 = WSP(bf16, WS_CBV) + (size_t)b * 256 * 512 + h * 128; S.ld0 = 512; S.n0 = 4;
        S.K1 = QKV + seq0 * QKV_LD + KB_OFF + h * 128; S.V1 = QKV + seq0 * QKV_LD + VB_OFF + h * 128; S.ld1 = QKV_LD; S.t_lo = 0; S.t_hi = 64;
        attn_b_unit(F, QKV, seq0 + qb * 256, h, S, lam, subln, OM);
    }
    for (int u = F.vcu; u < 512; u += F.G) {
        const int b = u >> 7, h = (u >> 4) & 7, qb = u & 15, kvh = h >> 2;
        const size_t seq0 = T_CTX + (size_t)b * LAT_SEQ;
        AttnSrc S; S.K0 = WSP(bf16, WS_CAK) + (size_t)b * 256 * 128 + kvh * 64; S.V0 = WSP(bf16, WS_CAV) + (size_t)b * 256 * 128 + kvh * 64; S.ld0 = 128; S.n0 = 4;
        S.K1 = QKV + seq0 * QKV_LD + KA_OFF + kvh * 64; S.V1 = QKV + seq0 * QKV_LD + VA_OFF + kvh * 64; S.ld1 = QKV_LD;
        S.t_lo = 4 * qb - 2 < 0 ? 0 : 4 * qb - 2; S.t_hi = 4 * qb + 6 > 64 ? 64 : 4 * qb + 6;
        attn_a_unit<true>(F, QKV, seq0 + qb * 256, h, S, qb * 256, sinkp[h], OM);
    }
    for (int u = F.vcu; u < 256; u += F.G) {
        const int b = u >> 3, h = u & 7, kvh = h >> 2;
        const size_t seq0 = (size_t)b * CTX_SEQ;
        AttnSrc S; S.K0 = nullptr; S.V0 = nullptr; S.ld0 = 0; S.n0 = 0;
        S.K1 = QKV + seq0 * QKV_LD + KA_OFF + kvh * 64; S.V1 = QKV + seq0 * QKV_LD + VA_OFF + kvh * 64; S.ld1 = QKV_LD; S.t_lo = 0; S.t_hi = 4;
        attn_a_unit<false>(F, QKV, seq0, h, S, 0, sinkp[h], OM);
    }
    for (int u = F.vcu; u < 128; u += F.G) {
        const int b = u >> 2, h = u & 3;
        const size_t seq0 = (size_t)b * CTX_SEQ;
        AttnSrc S; S.K0 = nullptr; S.V0 = nullptr; S.ld0 = 0; S.n0 = 0;
        S.K1 = QKV + seq0 * QKV_LD + KB_OFF + h * 128; S.V1 = QKV + seq0 * QKV_LD + VB_OFF + h * 128; S.ld1 = QKV_LD; S.t_lo = 0; S.t_hi = 4;
        attn_b_unit(F, QKV, seq0, h, S, lam, subln, OM);
    }
}

constexpr int SC_XC = 0;
constexpr int SC_AUF = 17408;
constexpr int SC_AUB = 17408 + 65536;
constexpr int SC_CW = 17408 + 131072;
static_assert(SC_CW + 2560 <= MISC_OFF, "scan LDS map");
#ifndef DUP_EPI
#define DUP_EPI 1
#endif
#ifndef DUP_SCAN
#define DUP_SCAN 1
#endif
#ifndef DUP_CONV
#define DUP_CONV 1
#endif
constexpr int SCAN_UNITS = 3840;
__device__ __forceinline__ void scan_pass(Frame& F) {
    LAS unsigned char* lds = F.lds;
    const int tid = F.tid, lane = F.lane, wid = F.wave, r32 = lane & 31, hi = lane >> 5;
    bf16* XR = WSP(bf16, WS_BIG) + (size_t)T_ALL * DRNN; bf16* GG = WSP(bf16, WS_BIG); bf16* ABG = (bf16*)F.out;
    const bf16* HALO = WSP(bf16, WS_BIG + 136 * MiB);
    f32x2* SUM = WSP(f32x2, WS_H);
    const int wdir = wid >> 2, cb = wid & 3, chl = cb * 32 + r32;
    const int tk = tid >> 3, cg = tid & 7;
    LAS float* CW = (LAS float*)(lds + SC_CW);
    const int per = (SCAN_UNITS + F.G - 1) / F.G, u_lo = F.vcu * per, u_hi = (u_lo + per) < SCAN_UNITS ? (u_lo + per) : SCAN_UNITS;
    int n_cur = -1;
    v4u xr[8];
    bf16x8 wa[8], wx[8]; float ba = 0.f, bx = 0.f, sp8 = 0.f;
#define SC_DECODE(u_) const int n = (u_) / 384, cidx = (u_) % 384; const bool isctx = cidx < 128; const int b = isctx ? (cidx >> 2) : ((cidx - 128) >> 6); const int c = isctx ? (cidx & 3) : ((cidx - 128) & 63); \
        const size_t seq0 = isctx ? (size_t)b * CTX_SEQ : (size_t)T_CTX + (size_t)b * LAT_SEQ; const int seq_len = isctx ? CTX_SEQ : LAT_SEQ, t0 = c * 64;
#define SC_LOADX(u_) do { SC_DECODE(u_) (void)b; (void)seq_len; \
        _Pragma("unroll") for (int j = 0; j < 4; ++j) { const int tl = tk - 1 + j; \
            const bf16* src = tl < 0 ? HALO + (size_t)((cidx > 0 ? cidx - 1 : 0) * 3 + 0) * DRNN : (tl >= 64 ? HALO + (size_t)((cidx < 383 ? cidx + 1 : 383) * 3 + 1 + (tl - 64)) * DRNN : XR + (seq0 + t0 + tl) * DRNN); \
            const v4u* p = (const v4u*)(src + n * 128 + cg * 8); xr[2 * j] = p[0]; xr[2 * j + 1] = p[8]; } } while (0)
    if (u_lo < u_hi) SC_LOADX(u_lo);
#pragma unroll 1
    for (int u = u_lo; u < u_hi; ++u) {
        SC_DECODE(u)
        (void)b;
        if (n != n_cur) {
            __syncthreads();
            for (int i = tid; i < 640; i += NTHREADS) CW[i] = i < 512 ? F.in[IN_RCONVW][(i >> 7) * DRNN + n * 128 + (i & 127)] : F.in[IN_RCONVB][n * 128 + (i & 127)];
            n_cur = n;
            { const bf16* wap = WSP(bf16, WS_WG) + (size_t)((0 * 2 + wdir) * 10 + n) * 16384 + (size_t)chl * 128 + hi * 8;
              const bf16* wxp = WSP(bf16, WS_WG) + (size_t)((1 * 2 + wdir) * 10 + n) * 16384 + (size_t)chl * 128 + hi * 8;
#pragma unroll
              for (int ks = 0; ks < 8; ++ks) { wa[ks] = *(const bf16x8*)(wap + ks * 16); wx[ks] = *(const bf16x8*)(wxp + ks * 16); } }
            ba = F.in[IN_RBA][wdir * DRNN + n * 128 + chl] * -1.4426950408889634f; bx = F.in[IN_RBX][wdir * DRNN + n * 128 + chl] * -1.4426950408889634f;
            { const float lamv = F.in[IN_RLAM][wdir * DRNN + n * 128 + chl]; sp8 = -8.0f * (lamv > 20.f ? __expf(-lamv) : log1pf(__expf(-lamv))); }
            __syncthreads();
        }
        { float a[16];
#pragma unroll
          for (int e = 0; e < 16; ++e) a[e] = CW[512 + (e >> 3) * 64 + cg * 8 + (e & 7)];
#pragma unroll
          for (int j = 0; j < 4; ++j) { const int t = t0 + tk - 1 + j; const float msk = (t >= 0 && t < seq_len) ? 1.0f : 0.0f;
              const unsigned w[8] = {xr[2 * j].x, xr[2 * j].y, xr[2 * j].z, xr[2 * j].w, xr[2 * j + 1].x, xr[2 * j + 1].y, xr[2 * j + 1].z, xr[2 * j + 1].w};
#pragma unroll
              for (int e = 0; e < 8; ++e) { const int c0 = (e >> 2) * 64 + cg * 8 + 2 * (e & 3); a[2 * e] += (CW[j * 128 + c0] * msk) * bflo(w[e]); a[2 * e + 1] += (CW[j * 128 + c0 + 1] * msk) * bfhi(w[e]); } }
          v4u o0, o1; o0.x = pk2(a[0], a[1]); o0.y = pk2(a[2], a[3]); o0.z = pk2(a[4], a[5]); o0.w = pk2(a[6], a[7]); o1.x = pk2(a[8], a[9]); o1.y = pk2(a[10], a[11]); o1.z = pk2(a[12], a[13]); o1.w = pk2(a[14], a[15]);
          LAS v4u* xp = (LAS v4u*)(lds + SC_XC + tk * 272 + cg * 16); xp[0] = o0; xp[8] = o1; }
        __syncthreads();
        if (u + 1 < u_hi) SC_LOADX(u + 1);
        { LAS f32x2* AU = (LAS f32x2*)(lds + (wdir ? SC_AUB : SC_AUF));
#pragma unroll 1
          for (int rb = 0; rb < 2; ++rb) {
            f32x16 ra = f32x16{}, ia = f32x16{};
            { const LAS unsigned char* ap = lds + SC_XC + (rb * 32 + r32) * 272 + hi * 16;
#pragma unroll
              for (int ks = 0; ks < 8; ++ks) { const bf16x8 af = *(const LAS bf16x8*)(ap + ks * 32);
                  ra = __builtin_amdgcn_mfma_f32_32x32x16_bf16(af, wa[ks], ra, 0, 0, 0);
                  ia = __builtin_amdgcn_mfma_f32_32x32x16_bf16(af, wx[ks], ia, 0, 0, 0); } }
#pragma unroll
            for (int r = 0; r < 16; ++r) {
                const int row = rb * 32 + crow(r, hi);
                const float rr = __builtin_amdgcn_rcpf(1.0f + __builtin_amdgcn_exp2f(ra[r] * -1.4426950408889634f + ba));
                const float ii = __builtin_amdgcn_rcpf(1.0f + __builtin_amdgcn_exp2f(ia[r] * -1.4426950408889634f + bx));
                const float x = sp8 * rr;
                const float em = -x * (1.0f + x * (0.5f + x * (0.16666667f + x * (0.041666668f + x * 0.0083333338f))));
                const float av = 1.0f - em;
                const float om = __builtin_fmaf(em, av, em);
                const float xv = bf2f(*(const LAS unsigned short*)(lds + SC_XC + row * 272 + chl * 2));
                AU[row * 128 + chl] = (f32x2){av, __builtin_amdgcn_sqrtf(om) * ii * xv};
            }
          } }
        __syncthreads();
        if (tid >= 256) {
            const int sch = tid & 127, sd = (tid >> 7) & 1;
            LAS f32x2* AU = (LAS f32x2*)(lds + (sd ? SC_AUB : SC_AUF)) + sch;
            float h = 0.f, pprod = 1.0f;
#pragma unroll 1
            for (int s0 = 0; s0 < 64; s0 += 8) {
                f32x2 au[8];
#pragma unroll
                for (int j = 0; j < 8; ++j) { const int row = sd == 0 ? s0 + j : 63 - s0 - j; au[j] = AU[row * 128]; }
#pragma unroll
                for (int j = 0; j < 8; ++j) { const int row = sd == 0 ? s0 + j : 63 - s0 - j; h = au[j].x * h + au[j].y; pprod *= au[j].x; AU[row * 128] = (f32x2){h, pprod}; }
            }
            SUM[(size_t)cidx * 2 * DRNN + sd * DRNN + n * 128 + sch] = (f32x2){pprod, h};
        }
        __syncthreads();
        {
            const LAS f32x4* hfp = (const LAS f32x4*)(lds + SC_AUF) + lane; const LAS f32x4* hbp = (const LAS f32x4*)(lds + SC_AUB) + lane;
            const size_t eoff = (seq0 + t0 + wid * 8) * DRNN + n * 128;
            unsigned* gp = (unsigned*)(GG + eoff) + lane; unsigned* fp = (unsigned*)(XR + eoff) + lane; unsigned* bp = (unsigned*)(ABG + eoff) + lane;
            unsigned gw[8];
#pragma unroll
            for (int i = 0; i < 8; ++i) gw[i] = gp[(size_t)i * (DRNN / 2)];
#pragma unroll
            for (int i = 0; i < 8; ++i) {
                const f32x4 hf = hfp[(wid * 8 + i) * 64], hb = hbp[(wid * 8 + i) * 64];
                const float g0 = bflo(gw[i]), g1 = bfhi(gw[i]);
                gp[(size_t)i * (DRNN / 2)] = pk2((hf[0] + hb[0]) * g0, (hf[2] + hb[2]) * g1);
                fp[(size_t)i * (DRNN / 2)] = pk2(hf[1] * g0, hf[3] * g1);
                bp[(size_t)i * (DRNN / 2)] = pk2(hb[1] * g0, hb[3] * g1);
            }
        }
        __syncthreads();
    }
#undef SC_DECODE
#undef SC_LOADX
}
__device__ __forceinline__ void scan_correct_phase(Frame& F) {
    bf16* GG = WSP(bf16, WS_BIG); const bf16* XR = WSP(bf16, WS_BIG) + (size_t)T_ALL * DRNN; const bf16* ABG = (const bf16*)F.out;
    const float* CAR = WSP(float, WS_H + 8 * MiB);
    const int gt = F.vcu * NTHREADS + F.tid, NGT = F.G * NTHREADS;
    for (int i = gt; i < T_ALL * (DRNN / 8); i += NGT) {
        const int row = i / (DRNN / 8), c8 = (i % (DRNN / 8)) * 8;
        const size_t off = (size_t)row * DRNN + c8;
        const v4u yl = *(const v4u*)(GG + off), af = *(const v4u*)(XR + off), ab = *(const v4u*)(ABG + off);
        const float* cf = CAR + (size_t)(row >> 6) * 2 * DRNN + c8; const float* cbp = cf + DRNN;
        const f32x4 f0 = *(const f32x4*)cf, f1 = *(const f32x4*)(cf + 4), b0 = *(const f32x4*)cbp, b1 = *(const f32x4*)(cbp + 4);
        const unsigned wy[4] = {yl.x, yl.y, yl.z, yl.w}, wf[4] = {af.x, af.y, af.z, af.w}, wb[4] = {ab.x, ab.y, ab.z, ab.w};
        const float cfv[8] = {f0[0], f0[1], f0[2], f0[3], f1[0], f1[1], f1[2], f1[3]}, cbv[8] = {b0[0], b0[1], b0[2], b0[3], b1[0], b1[1], b1[2], b1[3]};
        unsigned o[4];
#pragma unroll
        for (int e = 0; e < 4; ++e) o[e] = pk2(bflo(wy[e]) + bflo(wf[e]) * cfv[2 * e] + bflo(wb[e]) * cbv[2 * e], bfhi(wy[e]) + bfhi(wf[e]) * cfv[2 * e + 1] + bfhi(wb[e]) * cbv[2 * e + 1]);
        v4u ov; ov.x = o[0]; ov.y = o[1]; ov.z = o[2]; ov.w = o[3];
        *(v4u*)(GG + off) = ov;
    }
}

__device__ __forceinline__ void scan_carry_phase(Frame& F) {
    const f32x2* SUM = WSP(f32x2, WS_H); float* CAR = WSP(float, WS_H + 8 * MiB);
    const int gt = F.vcu * NTHREADS + F.tid, NGT = F.G * NTHREADS;
    for (int i = gt; i < 10240 + 81920; i += NGT) {
        const bool lat = i < 10240; const int j = lat ? i : i - 10240;
        const int ch = j % DRNN, sd = (j / DRNN) & 1, b = j / (2 * DRNN);
        const int nch = lat ? 64 : 4, cfirst = lat ? 128 + b * 64 : b * 4;
        float h = lat ? F.in[sd ? IN_SB : IN_SF][b * DRNN + ch] : 0.f;
        const f32x2* sp = SUM + (size_t)cfirst * 2 * DRNN + sd * DRNN + ch; float* cp = CAR + (size_t)cfirst * 2 * DRNN + sd * DRNN + ch;
        for (int k0 = 0; k0 < nch; k0 += 4) {
            f32x2 s[4];
#pragma unroll
            for (int q = 0; q < 4; ++q) { const int c = sd == 0 ? k0 + q : nch - 1 - k0 - q; s[q] = sp[(size_t)c * 2 * DRNN]; }
#pragma unroll
            for (int q = 0; q < 4; ++q) { const int c = sd == 0 ? k0 + q : nch - 1 - k0 - q; cp[(size_t)c * 2 * DRNN] = h; h = s[q].x * h + s[q].y; }
        }
        if (!lat) F.out[(sd ? OUT_SB : OUT_SF) + b * DRNN + ch] = h;
    }
}

constexpr int N_PHASES = 23;
__global__ void __launch_bounds__(NTHREADS, 2) fwd_kernel(Args args) {
    extern __shared__ __attribute__((aligned(16))) unsigned char lds_raw[];
    Frame F;
    F.lds = (LAS unsigned char*)lds_raw;
    F.tid = threadIdx.x; F.lane = F.tid & 63; F.wave = __builtin_amdgcn_readfirstlane(F.tid >> 6);
    F.G = gridDim.x; { const int bx = blockIdx.x; F.vcu = (F.G % 8 == 0) ? (bx % 8) * (F.G / 8) + bx / 8 : bx; }
    F.in = args.in; F.out = args.out; F.ws = args.ws;
    volatile LAS unsigned* MISC = (volatile LAS unsigned*)(F.lds + MISC_OFF);
    if (F.tid < 32) MISC[F.tid] = 0u;
    __syncthreads();
    XcdBarrier bar; bar.bar = (unsigned*)(args.ws + WS_CTL) + 1024; bar.x = 0; bar.st = nullptr;
    if (args.use_bar) bar = xcd_barrier_post((unsigned*)(args.ws + WS_CTL) + 1024, MISC + 8);
    const int lo = args.ph_lo, hi = args.ph_hi;
#ifndef PHMASK
#define PHMASK 0x7fffff
#endif
#ifndef REP_PHASE
#define REP_PHASE -1
#endif
#ifndef REP_N
#define REP_N 1
#endif
#define IN(k) (((PHMASK >> (k)) & 1) && lo <= (k) && (k) < hi)
#define REPS(k) for (int rep_ = 0; rep_ < (((k) == REP_PHASE) ? REP_N : 1); ++rep_)
#define SEAM(k) do { if (IN(k) && IN((k) + 1)) xcd_barrier(bar); } while (0)
    bf16* XA = (bf16*)((unsigned char*)F.out + 64 * MiB);
    bf16* XB = WSP(bf16, WS_BIG + 120 * MiB);
    const float* MOD = WSP(float, WS_MOD);
    bf16* H = WSP(bf16, WS_H);
    PG8_LAS unsigned char* ring = (PG8_LAS unsigned char*)lds_raw;

    if (IN(0)) REPS(0) { Frame P = fresh(F); p0_prologue(P); } SEAM(0);
    if (IN(1)) REPS(1) { Frame P = fresh(F); norm_mod_pass(P, F.in[IN_XP], F.in[IN_XS], F.in[IN_NORM1], MOD, 0, 1024, H); } SEAM(1);
    if (IN(2)) REPS(2) {
        pg8::Gemm g{H, WSP(bf16, WS_WIN), T_ALL, QKV_LD, DM}; pg8::StaticOrder S; S.init(T_ALL, QKV_LD, F.G, (int)blockIdx.x);
        pg8::EpiInProj E{WSP(bf16, WS_BIG), F.out, WSP(pg8::f32x2, WS_ROPE)};
        pg8::gemm_phase<pg8::EpiInProj, pg8::StaticOrder, true, true>(ring, g, S, E);
        { const int nfull = (T_ALL / 256) * (QKV_LD / 256) % F.G; Frame P = fresh(F);
          if (nfull == 0) p_deferred_transposes(P, (int)blockIdx.x, F.G); else if ((int)blockIdx.x >= nfull) p_deferred_transposes(P, (int)blockIdx.x - nfull, F.G - nfull); }
    } SEAM(2);
    if (IN(3)) REPS(3) { Frame P = fresh(F); attention_phase(P); } SEAM(3);
    if (IN(4)) REPS(4) {
        pg8::Gemm g{H, WSP(bf16, WS_WOUT), T_ALL, DM, DM}; pg8::StaticOrder S; S.init(T_ALL, DM, F.G, (int)blockIdx.x, 192);
        pg8::EpiRes<true> E{F.in[IN_XP], F.in[IN_XS], XA, XB, MOD + 2048, 0};
        pg8::gemm_phase<pg8::EpiRes<true>, pg8::StaticOrder, true, true, 96>(ring, g, S, E);
    } SEAM(4);
#pragma unroll 1
    for (int layer = 0; layer < 2; ++layer) {
        const int pb = layer == 0 ? 5 : 16;
        const float* MODL = MOD + (size_t)layer * 5 * 6144;
        if (IN(pb)) REPS(pb) { Frame P = fresh(F); norm_mod_pass_bf(P, XA, XB, F.in[IN_NORM2] + layer * DM, MODL, 3072, 4096, H); } SEAM(pb);
#pragma unroll 1
        for (int half = 0; half < 2; ++half) {
            const int row0 = half * (T_ALL / 2);
            if (IN(pb + 1 + 2 * half)) REPS(pb + 1 + 2 * half) {
                pg8::Gemm g{H + (size_t)row0 * DM, WSP(bf16, WS_W1) + (size_t)layer * DFF * DM, T_ALL / 2, DFF, DM}; pg8::StaticOrder S; S.init(T_ALL / 2, DFF, F.G, (int)blockIdx.x);
                pg8::EpiSqRelu E{WSP(bf16, WS_BIG), DFF};
                pg8::gemm_phase<pg8::EpiSqRelu, pg8::StaticOrder, true, true>(ring, g, S, E);
            } SEAM(pb + 1 + 2 * half);
            if (IN(pb + 2 + 2 * half)) REPS(pb + 2 + 2 * half) {
                pg8::Gemm g{WSP(bf16, WS_BIG), WSP(bf16, WS_W2) + (size_t)layer * DM * DFF, T_ALL / 2, DM, DFF}; pg8::StaticOrder S; S.init(T_ALL / 2, DM, F.G, (int)blockIdx.x, 192);
                pg8::EpiRes<false> E{nullptr, nullptr, XA, XB, MODL + 5120, row0};
                pg8::gemm_phase<pg8::EpiRes<false>, pg8::StaticOrder, true, true, 96>(ring, g, S, E);
            } SEAM(pb + 2 + 2 * half);
        }
        if (layer == 0) {
            const float* MOD1 = MOD + 5 * 6144;
            if (IN(10)) REPS(10) { Frame P = fresh(F); norm_mod_pass_bf(P, XA, XB, F.in[IN_NORM1] + DM, MOD1, 0, 1024, H); } SEAM(10);
            if (IN(11)) REPS(11) {
                pg8::Gemm g{H, WSP(bf16, WS_WRIN), T_ALL, 2 * DRNN, DM}; pg8::StaticOrder S; S.init(T_ALL, 2 * DRNN, F.G, (int)blockIdx.x);
                pg8::EpiRecIn E{WSP(bf16, WS_BIG), WSP(bf16, WS_BIG) + (size_t)T_ALL * DRNN, WSP(bf16, WS_BIG + 136 * MiB)};
                pg8::gemm_phase<pg8::EpiRecIn, pg8::StaticOrder, true, true>(ring, g, S, E);
            } SEAM(11);
            if (IN(12)) REPS(12) { Frame P = fresh(F); scan_pass(P); } SEAM(12);
            if (IN(13)) REPS(13) { Frame P = fresh(F); scan_carry_phase(P); } SEAM(13);
            if (IN(14)) REPS(14) { Frame P = fresh(F); scan_correct_phase(P); } SEAM(14);
            if (IN(15)) REPS(15) {
                pg8::Gemm g{WSP(bf16, WS_BIG), WSP(bf16, WS_WROUT), T_ALL, DM, DRNN}; pg8::StaticOrder S; S.init(T_ALL, DM, F.G, (int)blockIdx.x, 192);
                pg8::EpiRes<false> E{nullptr, nullptr, XA, XB, MOD1 + 2048, 0};
                pg8::gemm_phase<pg8::EpiRes<false>, pg8::StaticOrder, true, true, 96>(ring, g, S, E);
            } SEAM(15);
        }
    }
    if (IN(21)) REPS(21) { Frame P = fresh(F); final_norm_pass(P, XA, XB, F.out, F.in[IN_FNORM], 0, X_SPLIT); } SEAM(21);
    if (IN(22)) REPS(22) { Frame P = fresh(F); final_norm_pass(P, XA, XB, F.out, F.in[IN_FNORM], X_SPLIT, T_ALL); }
#undef IN
#undef SEAM
}

#ifndef MK_ONE_LAUNCH
#define MK_ONE_LAUNCH 1
#endif
extern "C" void kernel_launch(void* const* d_in, const int* in_sizes, int n_in, void* d_out, int out_size, void* d_ws, size_t ws_size, hipStream_t stream) {
    static int grid = 0;
    if (grid == 0) {
        if (n_in != 31 || ws_size < WS_END) { fprintf(stderr, "kernel_launch: unexpected n_in %d / ws_size %zu\n", n_in, ws_size); grid = -1; return; }
        int dev = 0, cus = 0, per_cu = 0;
        if (hipGetDevice(&dev) != hipSuccess || hipDeviceGetAttribute(&cus, hipDeviceAttributeMultiprocessorCount, dev) != hipSuccess) { grid = -1; return; }
        if (hipFuncSetAttribute((const void*)fwd_kernel, hipFuncAttributeMaxDynamicSharedMemorySize, LDS_BYTES) != hipSuccess) { fprintf(stderr, "kernel_launch: hipFuncSetAttribute failed\n"); grid = -1; return; }
        if (hipOccupancyMaxActiveBlocksPerMultiprocessor(&per_cu, (const void*)fwd_kernel, NTHREADS, LDS_BYTES) != hipSuccess || per_cu < 1) { fprintf(stderr, "kernel_launch: occupancy query says %d\n", per_cu); (void)hipGetLastError(); grid = -1; return; }
        grid = cus;
    }
    if (grid < 0) return;
    (void)hipMemsetAsync((char*)d_ws + WS_CTL, 0, CTL_ZERO_BYTES, stream);
    Args a{};
    for (int i = 0; i < 31; ++i) a.in[i] = (const float*)d_in[i];
    a.out = (float*)d_out; a.ws = (unsigned char*)d_ws;
#if MK_ONE_LAUNCH
    a.ph_lo = 0; a.ph_hi = N_PHASES; a.use_bar = 1;
    hipLaunchKernelGGL(fwd_kernel, dim3(grid), dim3(NTHREADS), LDS_BYTES, stream, a);
#else
    for (int p = 0; p < N_PHASES; ++p) { a.ph_lo = p; a.ph_hi = p + 1; a.use_bar = 0; hipLaunchKernelGGL(fwd_kernel, dim3(grid), dim3(NTHREADS), LDS_BYTES, stream, a); }
#endif
}
```

```cpp
#include <hip/hip_runtime.h>
#include <cstdio>
#include <cstdint>
#include <cmath>
namespace pg8 {
#define PG8_LAS __attribute__((address_space(3)))
typedef unsigned short bf16_t;
typedef short bf16x8 __attribute__((ext_vector_type(8)));
typedef float f32x4 __attribute__((ext_vector_type(4)));
typedef unsigned u32x4 __attribute__((ext_vector_type(4)));
constexpr int BM = 256, BK = 64, HALF = 128, HTB = HALF * BK * 2  , STAGE_BYTES = 8 * HTB, NXCD = 8, WGM = 8;

__host__ __device__ __forceinline__ int lds_byte(int r, int c) { const int st = (r >> 4) * 2 + (c >> 5), rr = r & 15, cc = c & 31, ob = rr * 64 + cc * 2; return st * 1024 + (ob ^ (((ob >> 9) & 1) << 5)); }
__host__ __device__ __forceinline__ void stage_rc(int b, int& R, int& C) { const int st = b / 1024, sb = b % 1024, swz = sb ^ (((sb >> 9) & 1) << 5); R = (st >> 1) * 16 + swz / 64; C = (st & 1) * 32 + (swz % 64) / 2; }
__host__ __device__ __forceinline__ int perm32(int rho) { const int n = rho >> 4, i = rho & 15; return 8 * (i >> 2) + 4 * n + (i & 3); }

struct Unit { int pm, pn; };
struct Gemm { const bf16_t* A; const bf16_t* Bt; int M, N, K; };

struct StaticOrder {
    int nM, nN, nwg, G, c;
    __host__ __device__ void init(int M, int N, int G_, int c_, int bmr = BM) { nM = M / bmr; nN = N / BM; nwg = nM * nN; G = G_; c = c_; }
    __host__ __device__ bool next(int i, Unit& u) const {
        const long L = (long)i * G + c; if (L >= nwg) return false;
        int wgid = (int)L; { const int q = nwg / NXCD, r = nwg % NXCD, xcd = wgid % NXCD, off = wgid / NXCD; wgid = (xcd < r ? xcd * (q + 1) : r * (q + 1) + (xcd - r) * q) + off; }
        const int nig = WGM * nN, gid = wgid / nig, fm = gid * WGM, gsz = (nM - fm) < WGM ? (nM - fm) : WGM;
        u.pm = fm + ((wgid % nig) % gsz); u.pn = (wgid % nig) / gsz; return true;
    }
    __device__ __forceinline__ void a_ready(const Unit&) const {}
    __device__ __forceinline__ void done(const Unit&) const {}
};

__device__ __forceinline__ unsigned cvt_pk_bf16(float lo, float hi) { unsigned r; asm volatile("v_cvt_pk_bf16_f32 %0, %1, %2" : "=v"(r) : "v"(lo), "v"(hi)); return r; }
typedef float f32x2 __attribute__((ext_vector_type(2)));
typedef unsigned u32x2 __attribute__((ext_vector_type(2)));
constexpr int T_CTX = 8192, QKV_LD = 2304;
constexpr float QSCALE = 0.125f * 1.4426950408889634f;
struct EpiInProj {
    static constexpr bool PERM = true, AFTER_DRAIN = false;
    bf16_t* QKV; float* out; const f32x2* rope;
    template <int MR> __device__ __forceinline__ void operator()(const f32x4 (&acc)[2][2][MR][2], const Unit& u, int wr, int wc, int fr, int fq) const {
        constexpr int HRr = MR * 32, BMR = 2 * HRr, WRO = HRr / 2;
        const bool hi_half = fq >= 2;
#pragma unroll
        for (int bj = 0; bj < 2; ++bj) {
            const int colbase = u.pn * BM + bj * HALF + wc * 32;
            const bool rope_col = (colbase < 640 || (colbase >= 768 && colbase < 1792));
            const bool q_col = (colbase < 512 || (colbase >= 768 && colbase < 1280));
            long ooff = -1; int ow = 0, cs = 0;
            if (colbase >= 512 && colbase < 640) { ooff = 25165824; ow = 128; cs = 512; }
            else if (colbase >= 640 && colbase < 768) { ooff = 26214400; ow = 128; cs = 640; }
            else if (colbase >= 1280 && colbase < 1792) { ooff = 27262976; ow = 512; cs = 1280; }
            else if (colbase >= 1792) { ooff = 31457280; ow = 512; cs = 1792; }
#pragma unroll
            for (int ai = 0; ai < 2; ++ai)
#pragma unroll
                for (int m = 0; m < MR; ++m) {
                    const int rowg = u.pm * BMR + ai * HRr + wr * WRO + m * 16;
                    const bool lat = rowg >= T_CTX;
                    const int row = rowg + fr;
                    f32x4 v[2] = {acc[ai][bj][m][0], acc[ai][bj][m][1]};
                    if (rope_col && lat) {
                        const int t = (row - T_CTX) & 4095;
                        const int pos = (wc & 1) ? (t & 63) : (t >> 6);
                        const f32x4* rp = (const f32x4*)(rope + pos * 16 + 8 * (fq & 1));
#pragma unroll
                        for (int n = 0; n < 2; ++n) {
                            const f32x4 c01 = rp[2 * n], c23 = rp[2 * n + 1];
                            const float cs_[4] = {c01[0], c01[2], c23[0], c23[2]}, sn_[4] = {c01[1], c01[3], c23[1], c23[3]};
#pragma unroll
                            for (int e = 0; e < 4; ++e) {
                                const float p = __shfl_xor(v[n][e], 32);
                                v[n][e] = hi_half ? (p * sn_[e] + v[n][e] * cs_[e]) : (v[n][e] * cs_[e] - p * sn_[e]);
                            }
                        }
                    }
                    if (q_col) { v[0] = v[0] * QSCALE; v[1] = v[1] * QSCALE; }
                    bf16_t* qp = QKV + (size_t)row * QKV_LD + colbase + 8 * fq;
                    u32x4 w; w.x = cvt_pk_bf16(v[0][0], v[0][1]); w.y = cvt_pk_bf16(v[0][2], v[0][3]); w.z = cvt_pk_bf16(v[1][0], v[1][1]); w.w = cvt_pk_bf16(v[1][2], v[1][3]);
                    *(u32x4*)qp = w;
                    if (ooff >= 0 && !lat) { float* op = out + ooff + (size_t)row * ow + (colbase - cs) + 8 * fq; *(f32x4*)op = v[0]; *(f32x4*)(op + 4) = v[1]; }
                }
        }
    }
};
constexpr int X_SPLIT = 16384;
template <bool IN_F32>
struct EpiRes {
    static constexpr bool PERM = true, AFTER_DRAIN = false;
    const float* xin_ctx; const float* xin_lat; bf16_t* XA; bf16_t* XB; const float* gate; int row0;
    template <int MR> __device__ __forceinline__ void operator()(const f32x4 (&acc)[2][2][MR][2], const Unit& u, int wr, int wc, int fr, int fq) const {
        constexpr int HRr = MR * 32, BMR = 2 * HRr, WRO = HRr / 2;
        const int rowt = row0 + u.pm * BMR;
#pragma unroll
        for (int ai = 0; ai < 2; ++ai)
#pragma unroll
            for (int m = 0; m < MR; ++m) {
                const int rowg = rowt + ai * HRr + wr * WRO + m * 16;
                const int midx = rowg < T_CTX ? 4 : ((rowg - T_CTX) >> 12);
                const float* g = gate + (size_t)midx * 6144;
                bf16_t* xr = (rowg < X_SPLIT ? XA + (size_t)rowg * 1024 : XB + (size_t)(rowg - X_SPLIT) * 1024) + (size_t)fr * 1024;
                const float* xf = (rowg < T_CTX ? xin_ctx : xin_lat - (size_t)T_CTX * 1024) + (size_t)(rowg + fr) * 1024;
#pragma unroll
                for (int bj = 0; bj < 2; ++bj) {
                    const int col = u.pn * BM + bj * HALF + wc * 32 + 8 * fq;
                    const f32x4 gv0 = *(const f32x4*)(g + col), gv1 = *(const f32x4*)(g + col + 4);
                    f32x4 x0, x1;
                    if (IN_F32) { x0 = *(const f32x4*)(xf + col); x1 = *(const f32x4*)(xf + col + 4); }
                    else { const u32x4 w = *(const u32x4*)(xr + col);
                        x0[0] = __builtin_bit_cast(float, w.x << 16); x0[1] = __builtin_bit_cast(float, w.x & 0xffff0000u); x0[2] = __builtin_bit_cast(float, w.y << 16); x0[3] = __builtin_bit_cast(float, w.y & 0xffff0000u);
                        x1[0] = __builtin_bit_cast(float, w.z << 16); x1[1] = __builtin_bit_cast(float, w.z & 0xffff0000u); x1[2] = __builtin_bit_cast(float, w.w << 16); x1[3] = __builtin_bit_cast(float, w.w & 0xffff0000u); }
                    x0 = x0 + gv0 * acc[ai][bj][m][0]; x1 = x1 + gv1 * acc[ai][bj][m][1];
                    u32x4 o; o.x = cvt_pk_bf16(x0[0], x0[1]); o.y = cvt_pk_bf16(x0[2], x0[3]); o.z = cvt_pk_bf16(x1[0], x1[1]); o.w = cvt_pk_bf16(x1[2], x1[3]);
                    *(u32x4*)(xr + col) = o;
                }
            }
    }
};
struct EpiSqRelu {
    static constexpr bool PERM = true, AFTER_DRAIN = false;
    bf16_t* O; int ldc;
    template <int MR> __device__ __forceinline__ void operator()(const f32x4 (&acc)[2][2][MR][2], const Unit& u, int wr, int wc, int fr, int fq) const {
        constexpr int HRr = MR * 32, BMR = 2 * HRr, WRO = HRr / 2;
#pragma unroll
        for (int ai = 0; ai < 2; ++ai)
#pragma unroll
            for (int m = 0; m < MR; ++m) {
                bf16_t* rowp = O + (size_t)(u.pm * BMR + ai * HRr + wr * WRO + m * 16 + fr) * ldc + u.pn * BM + wc * 32 + 8 * fq;
#pragma unroll
                for (int bj = 0; bj < 2; ++bj) {
                    f32x4 v0 = acc[ai][bj][m][0], v1 = acc[ai][bj][m][1];
#pragma unroll
                    for (int e = 0; e < 4; ++e) { const float a = fmaxf(v0[e], 0.f), b = fmaxf(v1[e], 0.f); v0[e] = a * a; v1[e] = b * b; }
                    u32x4 w; w.x = cvt_pk_bf16(v0[0], v0[1]); w.y = cvt_pk_bf16(v0[2], v0[3]); w.z = cvt_pk_bf16(v1[0], v1[1]); w.w = cvt_pk_bf16(v1[2], v1[3]);
                    *(u32x4*)(rowp + bj * HALF) = w;
                }
            }
    }
};
__device__ __forceinline__ float gelu_tanh(float x) {
    const float u2 = 1.5957691216057308f * (x + 0.044715f * x * x * x);
    return x * __builtin_amdgcn_rcpf(1.0f + __builtin_amdgcn_exp2f(-1.4426950408889634f * u2));
}
struct EpiRecIn {
    static constexpr bool PERM = true, AFTER_DRAIN = false;
    bf16_t* GG; bf16_t* XR; bf16_t* HALO;
    template <int MR> __device__ __forceinline__ void operator()(const f32x4 (&acc)[2][2][MR][2], const Unit& u, int wr, int wc, int fr, int fq) const {
        constexpr int HRr = MR * 32, BMR = 2 * HRr, WRO = HRr / 2;
        const bool isg = u.pn < 5;
        bf16_t* base = isg ? GG : XR; const int colt = (isg ? u.pn : u.pn - 5) * BM;
#pragma unroll
        for (int ai = 0; ai < 2; ++ai)
#pragma unroll
            for (int m = 0; m < MR; ++m) {
                const int row = u.pm * BMR + ai * HRr + wr * WRO + m * 16 + fr;
                bf16_t* rowp = base + (size_t)row * 1280 + colt + wc * 32 + 8 * fq;
                const int rl = row & 63; const bool halo = !isg && (rl == 63 || rl <= 1);
                bf16_t* hp = HALO + ((size_t)(row >> 6) * 3 + (rl == 63 ? 0 : rl + 1)) * 1280 + colt + wc * 32 + 8 * fq;
#pragma unroll
                for (int bj = 0; bj < 2; ++bj) {
                    f32x4 v0 = acc[ai][bj][m][0], v1 = acc[ai][bj][m][1];
                    if (isg) {
#pragma unroll
                        for (int e = 0; e < 4; ++e) { v0[e] = gelu_tanh(v0[e]); v1[e] = gelu_tanh(v1[e]); }
                    }
                    u32x4 w; w.x = cvt_pk_bf16(v0[0], v0[1]); w.y = cvt_pk_bf16(v0[2], v0[3]); w.z = cvt_pk_bf16(v1[0], v1[1]); w.w = cvt_pk_bf16(v1[2], v1[3]);
                    *(u32x4*)(rowp + bj * HALF) = w;
                    if (halo) *(u32x4*)(hp + bj * HALF) = w;
                }
            }
    }
};
template <class Epi, class Sched, bool ALIGN_EPI = false, bool SP2 = false, int HR = 128>
__device__ __forceinline__ void gemm_phase(PG8_LAS unsigned char* lds, const Gemm g, const Sched& S, const Epi& E) {
    int tid_ = threadIdx.x; asm volatile("" : "+v"(tid_));
    const int tid = tid_, wid = __builtin_amdgcn_readfirstlane(tid >> 6), lane = tid & 63, wr = wid >> 2, wc = wid & 3, fr = lane & 15, fq = lane >> 4;
    constexpr int MR = HR / 32;
    const int K = g.K, nt = K / BK;
    unsigned voffA[2], voffB[2];
#pragma unroll
    for (int i = 0; i < 2; ++i) { int R, C; stage_rc(tid * 16 + i * 8192, R, C); const int Rb = Epi::PERM ? ((R & ~31) + perm32(R & 31)) : R;
        voffA[i] = (unsigned)(R * K + C) * 2u; voffB[i] = (unsigned)(Rb * K + C) * 2u; }
    const size_t kstep = (size_t)(BK * 2);
    const size_t hstep = (size_t)HALF * K * 2;
    const size_t tstep = 2 * hstep;
    const size_t hstepA = (size_t)HR * K * 2, tstepA = 2 * hstepA;
    const unsigned ldsw = (unsigned)wid * 1024u;
    const int aoff = lds_byte(wr * (HR / 2) + fr, fq * 8), boff = lds_byte(wc * 32 + fr, fq * 8);
#define PG8_SA(b, h) (((b) * 2 + (h)) * HTB)
#define PG8_SB(b, h) ((4 + (b) * 2 + (h)) * HTB)
#define PG8_STAGE(bufoff, gbase, voff) do { _Pragma("unroll") for (int _i = 0; _i < 2; ++_i) \
        __builtin_amdgcn_global_load_lds((const unsigned*)((const char*)(gbase) + (voff)[_i]), (PG8_LAS unsigned*)(lds + (bufoff) + ldsw + _i * 8192), 16, 0, 0); } while (0)
#define PG8_LDA(dst, b, h) do { _Pragma("unroll") for (int m = 0; m < MR; ++m) _Pragma("unroll") for (int k = 0; k < 2; ++k) dst[m][k] = *(const PG8_LAS bf16x8*)(lds + PG8_SA(b, h) + aoff + m * 2048 + k * 1024); } while (0)
#define PG8_LDB(dst, b, h) do { _Pragma("unroll") for (int n = 0; n < 2; ++n) _Pragma("unroll") for (int k = 0; k < 2; ++k) dst[n][k] = *(const PG8_LAS bf16x8*)(lds + PG8_SB(b, h) + boff + n * 2048 + k * 1024); } while (0)
#define PG8_MMA(ai, bj, At, Bt) do { __builtin_amdgcn_s_setprio(1); _Pragma("unroll") for (int m = 0; m < MR; ++m) _Pragma("unroll") for (int n = 0; n < 2; ++n) _Pragma("unroll") for (int k = 0; k < 2; ++k) \
        acc[ai][bj][m][n] = __builtin_amdgcn_mfma_f32_16x16x32_bf16(Bt[n][k], At[m][k], acc[ai][bj][m][n], 0, 0, 0); __builtin_amdgcn_s_setprio(0); } while (0)
#define PG8_WAIT_V(n) asm volatile("s_waitcnt vmcnt(" #n ")" ::: "memory")
#define PG8_WAIT_L(n) asm volatile("s_waitcnt lgkmcnt(" #n ")" ::: "memory")
#define PG8_BAR __builtin_amdgcn_s_barrier()
#define PG8_SCHED __builtin_amdgcn_sched_barrier(0)
    Unit cur, nxt; int ui = 0;
    if (!S.next(0, cur)) return;
    f32x4 acc[2][2][MR][2];
#pragma unroll
    for (int a = 0; a < 2; ++a)
#pragma unroll
        for (int b = 0; b < 2; ++b)
#pragma unroll
            for (int m = 0; m < MR; ++m)
#pragma unroll
                for (int n = 0; n < 2; ++n) acc[a][b][m][n] = (f32x4){0.f, 0.f, 0.f, 0.f};
    bf16x8 At[MR][2], B0[2][2], B1[2][2];
    const char* cA = (const char*)g.A + (size_t)cur.pm * tstepA; const char* cB = (const char*)g.Bt + (size_t)cur.pn * tstep;
    S.a_ready(cur);
    if constexpr (SP2) {
        PG8_STAGE(PG8_SB(0, 0), cB, voffB); PG8_STAGE(PG8_SB(0, 1), cB + hstep, voffB); PG8_STAGE(PG8_SA(0, 0), cA, voffA); PG8_STAGE(PG8_SA(0, 1), cA + hstepA, voffA);
        if (wr == 1) PG8_BAR;
        PG8_WAIT_V(2); PG8_BAR;
        PG8_STAGE(PG8_SB(1, 0), cB + kstep, voffB); PG8_STAGE(PG8_SA(1, 0), cA + kstep, voffA); PG8_STAGE(PG8_SB(1, 1), cB + hstep + kstep, voffB);
        PG8_WAIT_V(6); PG8_BAR;
    } else {
        PG8_STAGE(PG8_SB(0, 0), cB, voffB); PG8_STAGE(PG8_SA(0, 0), cA, voffA); PG8_STAGE(PG8_SB(0, 1), cB + hstep, voffB); PG8_STAGE(PG8_SA(0, 1), cA + hstepA, voffA);
        if (wr == 1) PG8_BAR;
        PG8_WAIT_V(4); PG8_BAR;
        PG8_STAGE(PG8_SB(1, 0), cB + kstep, voffB); PG8_STAGE(PG8_SA(1, 0), cA + kstep, voffA); PG8_STAGE(PG8_SB(1, 1), cB + hstep + kstep, voffB);
        PG8_WAIT_V(6); PG8_BAR;
    }
    for (;;) {
        const bool has_next = S.next(ui + 1, nxt);
        const char* nA = has_next ? (const char*)g.A + (size_t)nxt.pm * tstepA : cA; const char* nB = has_next ? (const char*)g.Bt + (size_t)nxt.pn * tstep : cB;
        for (int t = 0; t < nt; t += 2) {
            const bool last = (t == nt - 2);
            const char* a1 = cA + (size_t)(t + 1) * kstep;
            const char* a2 = last ? nA : cA + (size_t)(t + 2) * kstep; const char* b2 = last ? nB : cB + (size_t)(t + 2) * kstep;
            const char* a3 = a2 + kstep; const char* b3 = b2 + kstep;
            if (last && has_next) S.a_ready(nxt);
            if constexpr (SP2) {
            PG8_LDB(B0, 0, 0); PG8_LDB(B1, 0, 1); PG8_SCHED; PG8_LDA(At, 0, 0); PG8_STAGE(PG8_SA(1, 1), a1 + hstepA, voffA);
            PG8_WAIT_V(8); PG8_WAIT_L(0); PG8_BAR; PG8_MMA(0, 0, At, B0); PG8_MMA(0, 1, At, B1); PG8_BAR; PG8_SCHED;
            PG8_LDA(At, 0, 1); PG8_STAGE(PG8_SB(0, 0), b2, voffB); PG8_STAGE(PG8_SB(0, 1), b2 + hstep, voffB); PG8_STAGE(PG8_SA(0, 0), a2, voffA);
            PG8_WAIT_V(8); PG8_WAIT_L(0); PG8_BAR; PG8_MMA(1, 0, At, B0); PG8_MMA(1, 1, At, B1); PG8_BAR; PG8_SCHED;
            PG8_LDB(B0, 1, 0); PG8_LDB(B1, 1, 1); PG8_SCHED; PG8_LDA(At, 1, 0); PG8_STAGE(PG8_SA(0, 1), a2 + hstepA, voffA);
            PG8_WAIT_V(8); PG8_WAIT_L(0); PG8_BAR; PG8_MMA(0, 0, At, B0); PG8_MMA(0, 1, At, B1); PG8_BAR; PG8_SCHED;
            PG8_LDA(At, 1, 1); PG8_STAGE(PG8_SB(1, 0), b3, voffB); PG8_STAGE(PG8_SB(1, 1), b3 + hstep, voffB); PG8_STAGE(PG8_SA(1, 0), a3, voffA);
            PG8_WAIT_V(8); PG8_WAIT_L(0); PG8_BAR; PG8_MMA(1, 0, At, B0); PG8_MMA(1, 1, At, B1); PG8_BAR; PG8_SCHED;
            } else {
            PG8_LDB(B0, 0, 0); PG8_SCHED; PG8_LDA(At, 0, 0); PG8_STAGE(PG8_SA(1, 1), a1 + hstepA, voffA);
            PG8_WAIT_L(8); PG8_BAR; PG8_WAIT_L(0); PG8_MMA(0, 0, At, B0); PG8_BAR; PG8_SCHED;
            PG8_LDB(B1, 0, 1); PG8_STAGE(PG8_SB(0, 0), b2, voffB);
            PG8_BAR; PG8_WAIT_L(0); PG8_MMA(0, 1, At, B1); PG8_BAR;
            PG8_LDA(At, 0, 1); PG8_STAGE(PG8_SA(0, 0), a2, voffA);
            PG8_BAR; PG8_WAIT_L(0); PG8_MMA(1, 0, At, B0); PG8_BAR; PG8_SCHED;
            PG8_STAGE(PG8_SB(0, 1), b2 + hstep, voffB);
            PG8_WAIT_V(6); PG8_BAR; PG8_MMA(1, 1, At, B1); PG8_BAR;
            PG8_LDB(B0, 1, 0); PG8_SCHED; PG8_LDA(At, 1, 0); PG8_STAGE(PG8_SA(0, 1), a2 + hstepA, voffA);
            PG8_WAIT_L(8); PG8_BAR; PG8_WAIT_L(0); PG8_MMA(0, 0, At, B0); PG8_BAR; PG8_SCHED;
            PG8_LDB(B1, 1, 1); PG8_STAGE(PG8_SB(1, 0), b3, voffB);
            PG8_BAR; PG8_WAIT_L(0); PG8_MMA(0, 1, At, B1); PG8_BAR;
            PG8_LDA(At, 1, 1); PG8_STAGE(PG8_SA(1, 0), a3, voffA);
            PG8_BAR; PG8_WAIT_L(0); PG8_MMA(1, 0, At, B0); PG8_BAR; PG8_SCHED;
            PG8_STAGE(PG8_SB(1, 1), b3 + hstep, voffB);
            PG8_WAIT_V(6); PG8_BAR; PG8_MMA(1, 1, At, B1); PG8_BAR;
            }
        }
        if constexpr (ALIGN_EPI) { if (wr == 0) PG8_BAR; }
        if constexpr (!Epi::AFTER_DRAIN) { E.template operator()<MR>(acc, cur, wr, wc, fr, fq); S.done(cur); }
        if (!has_next) break;
#pragma unroll
        for (int a = 0; a < 2; ++a)
#pragma unroll
            for (int b = 0; b < 2; ++b)
#pragma unroll
                for (int m = 0; m < MR; ++m)
#pragma unroll
                    for (int n = 0; n < 2; ++n) acc[a][b][m][n] = (f32x4){0.f, 0.f, 0.f, 0.f};
        cur = nxt; cA = nA; cB = nB; ++ui;
        if constexpr (ALIGN_EPI) { if (wr == 1) PG8_BAR; }
    }
    PG8_WAIT_V(0);
    if constexpr (!ALIGN_EPI) { if (wr == 0) PG8_BAR; }
    PG8_BAR;
    if constexpr (Epi::AFTER_DRAIN) { E.fused(acc, cur, wr, wc, fr, fq, lds, wid, lane); S.done(cur); }
#undef PG8_SA
#undef PG8_SB
#undef PG8_STAGE
#undef PG8_LDA
#undef PG8_LDB
#undef PG8_MMA
#undef PG8_WAIT_V
#undef PG8_WAIT_L
#undef PG8_BAR
#undef PG8_SCHED
}
}
constexpr int NWAVES = 8, NTHREADS = 512;
constexpr int DM = 1024, T_CTX = 8192, T_LAT = 16384, T_ALL = 24576, LAT_SEQ = 4096, CTX_SEQ = 256;
constexpr int QKV_LD = 2304, DFF = 4096, DRNN = 1280;
constexpr int QA_OFF = 0, KA_OFF = 512, VA_OFF = 640, QB_OFF = 768, KB_OFF = 1280, VB_OFF = 1792;
constexpr float EPSN = 1e-6f;
constexpr float SM_C = 0.125f * 1.4426950408889634f;
constexpr long OUT_AK = 25165824, OUT_AV = 26214400, OUT_BK = 27262976, OUT_BV = 31457280, OUT_SF = 35651584, OUT_SB = 35692544;
constexpr size_t MiB = 1u << 20;
constexpr size_t WS_CTL = 0, CTL_ZERO_BYTES = 64 * 1024;
constexpr size_t WS_MOD = 1 * MiB;
constexpr size_t WS_ROPE = 1 * MiB + 256 * 1024;
constexpr size_t WS_LAM = WS_ROPE + 16 * 1024;
constexpr size_t WS_CAK = 2 * MiB, WS_CAV = WS_CAK + 256 * 1024, WS_CBK = WS_CAV + 256 * 1024, WS_CBV = WS_CBK + 1 * MiB;
constexpr size_t WS_WIN = 5 * MiB;
constexpr size_t WS_WOUT = 10 * MiB;
constexpr size_t WS_W1 = 12 * MiB;
constexpr size_t WS_W2 = 28 * MiB;
constexpr size_t WS_WRIN = 44 * MiB;
constexpr size_t WS_WROUT = 49 * MiB;
constexpr size_t WS_WG = 52 * MiB;
constexpr size_t WS_SUM = 54 * MiB;
constexpr size_t WS_H = 56 * MiB;
constexpr size_t WS_BIG = 104 * MiB;
constexpr size_t WS_END = 256 * MiB;
static_assert(WS_BIG + (size_t)T_ALL * QKV_LD * 2 <= WS_END && WS_BIG + (size_t)(T_ALL / 2) * DFF * 2 <= WS_END && WS_BIG + (size_t)T_ALL * DRNN * 4 <= WS_END, "ws map");
constexpr int LDS_BYTES = 160 * 1024;
constexpr int MISC_OFF = 152 * 1024;

#define GAS __attribute__((address_space(1)))
#define LAS __attribute__((address_space(3)))
typedef unsigned short bf16;
typedef unsigned v4u __attribute__((ext_vector_type(4)));
typedef unsigned v2u __attribute__((ext_vector_type(2)));
typedef float f32x4 __attribute__((ext_vector_type(4)));
typedef float f32x2 __attribute__((ext_vector_type(2)));
typedef float f32x16 __attribute__((ext_vector_type(16)));
typedef short bf16x8 __attribute__((ext_vector_type(8)));
typedef short s16x4 __attribute__((ext_vector_type(4)));
typedef GAS unsigned gu32;
#define RLX_AGENT __ATOMIC_RELAXED, __HIP_MEMORY_SCOPE_AGENT
__device__ __forceinline__ unsigned f2bf(float f) { unsigned u = __builtin_bit_cast(unsigned, f); return (u + 0x7fffu + ((u >> 16) & 1u)) >> 16; }
__device__ __forceinline__ unsigned pk2(float lo, float hi) { return f2bf(lo) | (f2bf(hi) << 16); }
__device__ __forceinline__ float bf2f(unsigned short b) { return __builtin_bit_cast(float, (unsigned)b << 16); }
__device__ __forceinline__ float bflo(unsigned w) { return __builtin_bit_cast(float, w << 16); }
__device__ __forceinline__ float bfhi(unsigned w) { return __builtin_bit_cast(float, w & 0xffff0000u); }

#define XB_TMO      128
#define XB_XCNT(j)  (256  + 64 * (j))
#define XB_XSUB(j)  (1280 + 64 * (j))
#define XB_XGEN(j)  (2304 + 64 * (j))
#define XB_TOP      3328
#define XB_TOPGEN   3392
#define XCD_BAR_WORDS 3456
#define XB_SPIN_CAP (1u << 18)
__device__ __forceinline__ unsigned xb_ld(unsigned* p)              { return __hip_atomic_load(p, __ATOMIC_RELAXED, __HIP_MEMORY_SCOPE_AGENT); }
__device__ __forceinline__ unsigned xb_add(unsigned* p, unsigned v) { return __hip_atomic_fetch_add(p, v, __ATOMIC_RELAXED, __HIP_MEMORY_SCOPE_AGENT); }
__device__ __forceinline__ unsigned xb_xcc_id() { return (unsigned)__builtin_amdgcn_s_getreg((3 << 11) | 20) & 0xFu; }
#define XB_SPIN(cond, bar) do { unsigned _sp = 0; while (cond) { __builtin_amdgcn_s_sleep(1); \
    if ((++_sp & 255u) == 0u) { if (xb_ld(&(bar)[XB_TMO])) break; if (_sp > XB_SPIN_CAP) { atomicAdd(&(bar)[XB_TMO], 1u); break; } } } } while (0)
struct XcdBarrier { unsigned* bar; unsigned x; volatile LAS unsigned* st; };
__device__ __forceinline__ XcdBarrier xcd_barrier_post(unsigned* bar, volatile LAS unsigned* st) {
    XcdBarrier b; b.bar = bar; b.x = xb_xcc_id(); b.st = st;
    if (threadIdx.x == 0) (void)xb_add(&bar[XB_XCNT(b.x)], 1u);
    return b;
}
__device__ __forceinline__ void xcd_barrier_complete(unsigned* bar, unsigned x, unsigned& nloc, unsigned& nx) {
    const unsigned G = gridDim.x * gridDim.y * gridDim.z;
    unsigned sum, cnt, mine, sp = 0u;
    for (;;) {
        sum = 0u; cnt = 0u; mine = 0u;
#pragma unroll
        for (unsigned j = 0; j < 16; ++j) { const unsigned c = xb_ld(&bar[XB_XCNT(j)]); sum += c; cnt += (c > 0u) ? 1u : 0u; mine = (j == x) ? c : mine; }
        if (sum == G) break;
        __builtin_amdgcn_s_sleep(1);
        if ((++sp & 255u) == 0u) { if (xb_ld(&bar[XB_TMO])) break; if (sp > XB_SPIN_CAP) { atomicAdd(&bar[XB_TMO], 1u); break; } }
    }
    nloc = mine > 0u ? mine : 1u; nx = cnt > 0u ? cnt : 1u;
}
__device__ __forceinline__ void xcd_barrier(const XcdBarrier& b) {
    asm volatile("s_waitcnt vmcnt(0)" ::: "memory");
    __syncthreads();
    if (threadIdx.x == 0) {
        unsigned* bar = b.bar;
        __builtin_amdgcn_s_waitcnt(0);
        unsigned nloc = b.st[0], nx = b.st[1];
        if (nloc == 0u) { xcd_barrier_complete(bar, b.x, nloc, nx); b.st[0] = nloc; b.st[1] = nx; }
        const unsigned old = xb_add(&bar[XB_XSUB(b.x)], 1u);
        const unsigned gen = old / nloc;
        if (old + 1u == (gen + 1u) * nloc) {
            __builtin_amdgcn_fence(__ATOMIC_RELEASE, "agent");
            asm volatile("s_waitcnt vmcnt(0)" ::: "memory");
            const unsigned og = xb_add(&bar[XB_TOP], 1u);
            const unsigned tg = og / nx;
            if (og + 1u == (tg + 1u) * nx) xb_add(&bar[XB_TOPGEN], 1u);
            else XB_SPIN(xb_ld(&bar[XB_TOPGEN]) == tg, bar);
            __builtin_amdgcn_fence(__ATOMIC_ACQUIRE, "agent");
            xb_add(&bar[XB_XGEN(b.x)], 1u);
            asm volatile("s_waitcnt vmcnt(0)" ::: "memory");
        } else {
            XB_SPIN(xb_ld(&bar[XB_XGEN(b.x)]) == gen, bar);
            __builtin_amdgcn_fence(__ATOMIC_ACQUIRE, "agent");
            asm volatile("s_waitcnt vmcnt(0)" ::: "memory");
        }
    }
    __syncthreads();
}

struct Args { const float* in[31]; float* out; unsigned char* ws; int ph_lo, ph_hi; int use_bar, pad; };
struct Frame {
    LAS unsigned char* lds;
    int tid, lane, wave, vcu, G;
    const float* const* in; float* out; unsigned char* ws;
};
#define WSP(T, off) ((T*)(F.ws + (off)))
__device__ __forceinline__ Frame fresh(const Frame& F) { Frame P = F; int t = threadIdx.x; asm volatile("" : "+v"(t)); P.tid = t; P.lane = t & 63; P.wave = __builtin_amdgcn_readfirstlane(t >> 6); return P; }
enum { IN_XP = 0, IN_XS, IN_CAK, IN_CAV, IN_CBK, IN_CBV, IN_SF, IN_SB, IN_C, IN_CCTX, IN_NORM1, IN_NORM2, IN_WADA, IN_BADA, IN_WMLP1, IN_WMLP2, IN_AWIN, IN_AWOUT, IN_SINK, IN_LAMQK, IN_SUBLN,
       IN_RWIN, IN_RCONVW, IN_RCONVB, IN_RWA, IN_RBA, IN_RWX, IN_RBX, IN_RLAM, IN_RWOUT, IN_FNORM };

__device__ __forceinline__ float wave_sum(float v) {
#pragma unroll
    for (int o = 1; o < 64; o <<= 1) v += __shfl_xor(v, o);
    return v;
}

__device__ __forceinline__ void p0_transpose_item(const float* W, int K, int N, bf16* WT, LAS float* scr, int item, int lane) {
    const int nblk = N / 32, kb = item / nblk, nb = item % nblk, k0 = 64 * kb, n0 = 32 * nb;
#pragma unroll 8
    for (int i = 0; i < 32; ++i) { const int kk = 2 * i + (lane >> 5); scr[kk * 33 + (lane & 31)] = W[(size_t)(k0 + kk) * N + n0 + (lane & 31)]; }
    asm volatile("s_waitcnt lgkmcnt(0)" ::: "memory");
    const int c = lane & 7;
#pragma unroll
    for (int j = 0; j < 4; ++j) { const int n = (lane >> 3) + 8 * j; const LAS float* s = scr + (8 * c) * 33 + n;
        v4u o; o.x = pk2(s[0 * 33], s[1 * 33]); o.y = pk2(s[2 * 33], s[3 * 33]); o.z = pk2(s[4 * 33], s[5 * 33]); o.w = pk2(s[6 * 33], s[7 * 33]);
        *(GAS v4u*)(WT + (size_t)(n0 + n) * K + k0 + 8 * c) = o; }
    asm volatile("s_waitcnt lgkmcnt(0)" ::: "memory");
}
__device__ __forceinline__ void p0_prologue(Frame& F) {
    const float* const* in = F.in;
    {
        LAS float* SC = (LAS float*)(F.lds);
        LAS float* RED = (LAS float*)(F.lds + 20480);
        for (int i = F.tid; i < 5 * 1024; i += NTHREADS) { const int v = i >> 10, k = i & 1023; const float c = v < 4 ? in[IN_C][v * 1024 + k] : in[IN_CCTX][k]; SC[i] = c / (1.0f + __expf(-c)); }
        __syncthreads();
        float* MOD = WSP(float, WS_MOD);
        for (int u = blockIdx.x; u < 384; u += F.G) {
            const int l = u / 192, n0 = (u % 192) * 32;
            const float* W = in[IN_WADA] + (size_t)l * 1024 * 6144 + n0 + (F.lane & 31);
            float a[5] = {0.f, 0.f, 0.f, 0.f, 0.f};
            const int kb = F.wave * 128 + (F.lane >> 5);
#pragma unroll 8
            for (int kk = 0; kk < 64; ++kk) { const int k = kb + 2 * kk; const float w = W[(size_t)k * 6144];
#pragma unroll
                for (int v = 0; v < 5; ++v) a[v] += SC[v * 1024 + k] * w; }
#pragma unroll
            for (int v = 0; v < 5; ++v) { a[v] += __shfl_xor(a[v], 32); if (F.lane < 32) RED[(F.wave * 5 + v) * 32 + F.lane] = a[v]; }
            __syncthreads();
            if (F.tid < 160) { const int v = F.tid >> 5, c = F.tid & 31; float s = in[IN_BADA][l * 6144 + n0 + c];
#pragma unroll
                for (int w = 0; w < 8; ++w) s += RED[(w * 5 + v) * 32 + c];
                MOD[((size_t)l * 5 + v) * 6144 + n0 + c] = s; }
            __syncthreads();
        }
    }
    {
        LAS float* scr = (LAS float*)(F.lds + 32768 + F.wave * 8704);
        const int gw = F.vcu * NWAVES + F.wave, NGW = F.G * NWAVES;
        constexpr int I_IN = 16 * 72, I_OUT = 16 * 32;
        for (int it = gw; it < I_IN + I_OUT; it += NGW) {
            if (it < I_IN) p0_transpose_item(in[IN_AWIN], 1024, 2304, WSP(bf16, WS_WIN), scr, it, F.lane);
            else p0_transpose_item(in[IN_AWOUT], 1024, 1024, WSP(bf16, WS_WOUT), scr, it - I_IN, F.lane);
        }
    }
    {
        const int gt = F.vcu * NTHREADS + F.tid, NGT = F.G * NTHREADS;
        for (int i = gt; i < 4 * 256 * 128 / 4; i += NGT) {
            const f32x4 a = ((const f32x4*)in[IN_CAK])[i], b = ((const f32x4*)in[IN_CAV])[i];
            v2u o; o.x = pk2(a[0], a[1]); o.y = pk2(a[2], a[3]); WSP(v2u, WS_CAK)[i] = o; o.x = pk2(b[0], b[1]); o.y = pk2(b[2], b[3]); WSP(v2u, WS_CAV)[i] = o; }
        for (int i = gt; i < 4 * 256 * 512 / 4; i += NGT) {
            const f32x4 a = ((const f32x4*)in[IN_CBK])[i], b = ((const f32x4*)in[IN_CBV])[i];
            v2u o; o.x = pk2(a[0], a[1]); o.y = pk2(a[2], a[3]); WSP(v2u, WS_CBK)[i] = o; o.x = pk2(b[0], b[1]); o.y = pk2(b[2], b[3]); WSP(v2u, WS_CBV)[i] = o; }
        if (gt < 1024) { const int pos = gt >> 4, i = gt & 15; const double ang = (double)pos * pow(10000.0, -(double)i / 16.0);
            WSP(f32x2, WS_ROPE)[gt] = (f32x2){(float)cos(ang), (float)sin(ang)}; }
        if (gt == 0) { const float* lq = in[IN_LAMQK]; float s1 = 0.f, s2 = 0.f; for (int i = 0; i < 64; ++i) { s1 += lq[i] * lq[64 + i]; s2 += lq[128 + i] * lq[192 + i]; }
            WSP(float, WS_LAM)[0] = __expf(s1) - __expf(s2) + 0.2f; }
    }
}

__device__ __forceinline__ void p_deferred_transposes(Frame& F, int iw, int nw) {
    const float* const* in = F.in;
    LAS float* scr = (LAS float*)(F.lds + 32768 + F.wave * 8704);
    const int gw = iw * NWAVES + F.wave, NGW = nw * NWAVES;
    constexpr int I_M1 = 16 * 128, I_M2 = 64 * 32, I_RIN = 16 * 80, I_ROUT = 20 * 32, I_G = 8;
    constexpr int NITEMS = 2 * I_M1 + 2 * I_M2 + I_RIN + I_ROUT + 40 * I_G;
    for (int it = gw; it < NITEMS; it += NGW) {
        int r = it;
        if (r < 2 * I_M1) { const int l = r / I_M1; p0_transpose_item(in[IN_WMLP1] + (size_t)l * 1024 * 4096, 1024, 4096, WSP(bf16, WS_W1) + (size_t)l * 4096 * 1024, scr, r % I_M1, F.lane); continue; } r -= 2 * I_M1;
        if (r < 2 * I_M2) { const int l = r / I_M2; p0_transpose_item(in[IN_WMLP2] + (size_t)l * 4096 * 1024, 4096, 1024, WSP(bf16, WS_W2) + (size_t)l * 1024 * 4096, scr, r % I_M2, F.lane); continue; } r -= 2 * I_M2;
        if (r < I_RIN) { p0_transpose_item(in[IN_RWIN], 1024, 2560, WSP(bf16, WS_WRIN), scr, r, F.lane); continue; } r -= I_RIN;
        if (r < I_ROUT) { p0_transpose_item(in[IN_RWOUT], 1280, 1024, WSP(bf16, WS_WROUT), scr, r, F.lane); continue; } r -= I_ROUT;
        { const int mtx = r / I_G, gate = mtx / 20, db = mtx % 20;
          p0_transpose_item(in[gate ? IN_RWX : IN_RWA] + (size_t)db * 16384, 128, 128, WSP(bf16, WS_WG) + (size_t)(gate * 20 + db) * 16384, scr, r % I_G, F.lane); }
    }
}

__device__ __forceinline__ void norm_mod_pass(Frame& F, const float* x_ctx, const float* x_lat, const float* g, const float* mod  , int shift_off, int scale_off, bf16* H) {
    const int gw = F.vcu * NWAVES + F.wave, NGW = F.G * NWAVES;
    for (int m = gw; m < T_ALL; m += NGW) {
        const float* xr = m < T_CTX ? x_ctx + (size_t)m * DM : x_lat + (size_t)(m - T_CTX) * DM;
        const int midx = m < T_CTX ? 4 : ((m - T_CTX) >> 12);
        const float* mv = mod + (size_t)midx * 6144;
        f32x4 v[4]; float s = 0.f;
#pragma unroll
        for (int j = 0; j < 4; ++j) { v[j] = ((const f32x4*)xr)[F.lane + 64 * j]; s += (v[j][0] * v[j][0] + v[j][1] * v[j][1]) + (v[j][2] * v[j][2] + v[j][3] * v[j][3]); }
        const float rstd = 1.0f / sqrtf(wave_sum(s) * (1.0f / DM) + EPSN);
#pragma unroll
        for (int j = 0; j < 4; ++j) {
            const int c = 4 * (F.lane + 64 * j);
            const f32x4 gg = *(const f32x4*)(g + c), sc = *(const f32x4*)(mv + scale_off + c), sh = *(const f32x4*)(mv + shift_off + c);
            f32x4 o = (v[j] * rstd) * gg; o = o * (sc + 1.0f) + sh;
            v2u w; w.x = pk2(o[0], o[1]); w.y = pk2(o[2], o[3]);
            *(v2u*)(H + (size_t)m * DM + c) = w;
        }
    }
}
constexpr int X_SPLIT = 16384;
__device__ __forceinline__ const bf16* xrow_bf(const bf16* XA, const bf16* XB, int m) { return m < X_SPLIT ? XA + (size_t)m * DM : XB + (size_t)(m - X_SPLIT) * DM; }
__device__ __forceinline__ void unpack16(const v4u a, const v4u b, float (&v)[16]) {
    const unsigned w[8] = {a.x, a.y, a.z, a.w, b.x, b.y, b.z, b.w};
#pragma unroll
    for (int e = 0; e < 8; ++e) { v[2 * e] = bflo(w[e]); v[2 * e + 1] = bfhi(w[e]); }
}
__device__ __forceinline__ void norm_mod_pass_bf(Frame& F, const bf16* XA, const bf16* XB, const float* g, const float* mod  , int shift_off, int scale_off, bf16* H) {
    const int gw = F.vcu * NWAVES + F.wave, NGW = F.G * NWAVES;
    for (int m = gw; m < T_ALL; m += NGW) {
        const v4u* xp = (const v4u*)(xrow_bf(XA, XB, m) + F.lane * 8);
        const int midx = m < T_CTX ? 4 : ((m - T_CTX) >> 12);
        const float* mv = mod + (size_t)midx * 6144;
        float v[16]; unpack16(xp[0], xp[64], v);
        float s = 0.f;
#pragma unroll
        for (int e = 0; e < 16; ++e) s += v[e] * v[e];
        const float rstd = 1.0f / sqrtf(wave_sum(s) * (1.0f / DM) + EPSN);
        unsigned ow[8];
#pragma unroll
        for (int q = 0; q < 4; ++q) {
            const int c = 8 * F.lane + (q >> 1) * 512 + (q & 1) * 4;
            const f32x4 gg = *(const f32x4*)(g + c), sc = *(const f32x4*)(mv + scale_off + c), sh = *(const f32x4*)(mv + shift_off + c);
            const float o0 = (v[4 * q] * rstd) * gg[0] * (sc[0] + 1.0f) + sh[0], o1 = (v[4 * q + 1] * rstd) * gg[1] * (sc[1] + 1.0f) + sh[1];
            const float o2 = (v[4 * q + 2] * rstd) * gg[2] * (sc[2] + 1.0f) + sh[2], o3 = (v[4 * q + 3] * rstd) * gg[3] * (sc[3] + 1.0f) + sh[3];
            ow[2 * q] = pk2(o0, o1); ow[2 * q + 1] = pk2(o2, o3);
        }
        v4u* hp = (v4u*)(H + (size_t)m * DM + 8 * F.lane);
        v4u a, b2; a.x = ow[0]; a.y = ow[1]; a.z = ow[2]; a.w = ow[3]; b2.x = ow[4]; b2.y = ow[5]; b2.z = ow[6]; b2.w = ow[7];
        hp[0] = a; hp[64] = b2;
    }
}
__device__ __forceinline__ void final_norm_pass(Frame& F, const bf16* XA, const bf16* XB, float* Y, const float* g, int m_lo, int m_hi) {
    const int gw = F.vcu * NWAVES + F.wave, NGW = F.G * NWAVES;
    for (int m = m_lo + gw; m < m_hi; m += NGW) {
        const v4u* xp = (const v4u*)(xrow_bf(XA, XB, m) + F.lane * 8);
        float v[16]; unpack16(xp[0], xp[64], v);
        float s = 0.f;
#pragma unroll
        for (int e = 0; e < 16; ++e) s += v[e] * v[e];
        const float rstd = 1.0f / sqrtf(wave_sum(s) * (1.0f / DM) + EPSN);
#pragma unroll
        for (int q = 0; q < 4; ++q) { const int c = 8 * F.lane + (q >> 1) * 512 + (q & 1) * 4; const f32x4 gg = *(const f32x4*)(g + c);
            f32x4 o; o[0] = v[4 * q] * rstd * gg[0]; o[1] = v[4 * q + 1] * rstd * gg[1]; o[2] = v[4 * q + 2] * rstd * gg[2]; o[3] = v[4 * q + 3] * rstd * gg[3];
            *(f32x4*)(Y + (size_t)m * DM + c) = o; }
    }
}

constexpr float ATT_THR = 8.0f;
constexpr int AT_K0 = 0, AT_K1 = 9216;
constexpr int AT_V0 = 18432, AT_V1 = 38912;
constexpr int AT_WS = 59392;
constexpr int AT_O1 = 61440;
static_assert(AT_O1 + 65536 <= MISC_OFF, "attention LDS map");
__device__ __forceinline__ int crow(int r, int hi) { return (r & 3) + 8 * (r >> 2) + 4 * hi; }
__device__ __forceinline__ unsigned cvtpk_s(float lo, float hi) { typedef __bf16 bf16x2_t __attribute__((ext_vector_type(2))); f32x2 v = {lo, hi}; bf16x2_t b = __builtin_convertvector(v, bf16x2_t); return __builtin_bit_cast(unsigned, b); }
__device__ __forceinline__ s16x4 vtr(const LAS unsigned char* p) { typedef short v4i16_t __attribute__((ext_vector_type(4))); return __builtin_bit_cast(s16x4, __builtin_amdgcn_ds_read_tr16_b64_v4i16((LAS v4i16_t*)p)); }

struct AttnSrc {
    const bf16* K0; const bf16* V0; int ld0, n0;
    const bf16* K1; const bf16* V1; int ld1, t_lo, t_hi;
};
template <int DV, bool WINDOW>
__device__ __forceinline__ void attn_pass(Frame& F, const bf16* Q, int ldq, const AttnSrc& S, int qpos0, float m_init, float l_init, bool start_exact, f32x16 (&o)[DV / 32], float& m_out, float& l_out) {
    constexpr int RSV = DV == 128 ? 320 : 192, NVL = DV / 64;
    LAS unsigned char* lds = F.lds;
    const int tid = F.tid, lane = F.lane, wid = F.wave, r32 = lane & 31, hi = lane >> 5;
    LAS float* wsf = (LAS float*)(lds + AT_WS) + wid * 64;
    bf16x8 qr[4];
    { const bf16* qp = Q + (size_t)(wid * 32 + r32) * ldq + hi * 8;
#pragma unroll
      for (int d0 = 0; d0 < 4; ++d0) qr[d0] = *(const bf16x8*)(qp + d0 * 16); }
#pragma unroll
    for (int d = 0; d < DV / 32; ++d) o[d] = f32x16{};
    float m = m_init, l = l_init;
    f32x16 negm;
#pragma unroll
    for (int r = 0; r < 16; ++r) negm[r] = -m_init;
    const int nt = S.n0 + (S.t_hi - S.t_lo);
    v4u kreg, vreg[NVL];
    const int krow = tid >> 3, kch = tid & 7;
#define AT_ISSUE(it_) do { const int it__ = (it_); const bf16* Kp; const bf16* Vp; int ld; \
        if (it__ < S.n0) { Kp = S.K0 + (size_t)(it__ * 64) * S.ld0; Vp = S.V0 + (size_t)(it__ * 64) * S.ld0; ld = S.ld0; } \
        else { const int t = S.t_lo + it__ - S.n0; Kp = S.K1 + (size_t)(t * 64) * S.ld1; Vp = S.V1 + (size_t)(t * 64) * S.ld1; ld = S.ld1; } \
        kreg = *(const v4u*)(Kp + (size_t)krow * ld + kch * 8); \
        if (DV == 128) { _Pragma("unroll") for (int i = 0; i < NVL; ++i) { const int idx = tid + 512 * i; vreg[i] = *(const v4u*)(Vp + (size_t)(idx >> 4) * ld + (idx & 15) * 8); } } \
        else vreg[0] = *(const v4u*)(Vp + (size_t)krow * ld + kch * 8); } while (0)
#define AT_COMMIT(buf_) do { const int kb_ = (buf_) ? AT_K1 : AT_K0, vb_ = (buf_) ? AT_V1 : AT_V0; \
        *(LAS v4u*)(lds + kb_ + krow * 144 + kch * 16) = kreg; \
        if (DV == 128) { _Pragma("unroll") for (int i = 0; i < NVL; ++i) { const int idx = tid + 512 * i; *(LAS v4u*)(lds + vb_ + (idx >> 4) * RSV + (idx & 15) * 16) = vreg[i]; } } \
        else *(LAS v4u*)(lds + vb_ + krow * RSV + kch * 16) = vreg[0]; } while (0)
    const int koff = r32 * 144 + hi * 16;
    const int voff = (4 * hi + ((lane & 15) >> 2)) * RSV + ((lane >> 4) & 1) * 32 + (lane & 3) * 8;
    const int qw0 = qpos0 + 32 * wid;
    __syncthreads();
    AT_ISSUE(0); AT_COMMIT(0);
    if (nt > 1) AT_ISSUE(1);
#pragma unroll 1
    for (int it = 0; it < nt; ++it) {
        __syncthreads();
        const LAS unsigned char* kbase = lds + ((it & 1) ? AT_K1 : AT_K0) + koff;
        const LAS unsigned char* vbase = lds + ((it & 1) ? AT_V1 : AT_V0) + voff;
        bool skip = false, need_mask = false;
        int kp0 = 0;
        if (WINDOW && it >= S.n0) {
            kp0 = (S.t_lo + it - S.n0) * 64;
            skip = (kp0 + 63 < qw0 - 128 || kp0 > qw0 + 31 + 128);
            need_mask = !(kp0 >= qw0 + 31 - 128 && kp0 + 63 <= qw0 + 128);
        }
        if (!skip) {
            f32x16 p0, p1;
            __builtin_amdgcn_s_setprio(1);
#pragma unroll
            for (int d0 = 0; d0 < 4; ++d0) {
                const bf16x8 k0 = *(const LAS bf16x8*)(kbase + d0 * 32);
                const bf16x8 k1 = *(const LAS bf16x8*)(kbase + 32 * 144 + d0 * 32);
                if (d0 == 0) { p0 = __builtin_amdgcn_mfma_f32_32x32x16_bf16(k0, qr[0], negm, 0, 0, 0); p1 = __builtin_amdgcn_mfma_f32_32x32x16_bf16(k1, qr[0], negm, 0, 0, 0); }
                else { p0 = __builtin_amdgcn_mfma_f32_32x32x16_bf16(k0, qr[d0], p0, 0, 0, 0); p1 = __builtin_amdgcn_mfma_f32_32x32x16_bf16(k1, qr[d0], p1, 0, 0, 0); }
            }
            __builtin_amdgcn_s_setprio(0);
            if (WINDOW && need_mask) {
                const int q = qw0 + r32;
#pragma unroll
                for (int r = 0; r < 16; ++r) { const int kv = kp0 + crow(r, hi); int d0 = q - kv; d0 = d0 < 0 ? -d0 : d0; int d1 = q - kv - 32; d1 = d1 < 0 ? -d1 : d1;
                    if (d0 > 128) p0[r] = -1e30f; if (d1 > 128) p1[r] = -1e30f; }
            }
            float rm = fmaxf(p0[0], p1[0]);
#pragma unroll
            for (int r = 1; r < 16; ++r) rm = fmaxf(fmaxf(rm, p0[r]), p1[r]);
            const bool exact = start_exact && it == 0;
            if (exact || __any(rm > ATT_THR)) {
                rm = fmaxf(rm, __shfl_xor(rm, 32));
                const float dl = exact ? rm : fmaxf(rm, 0.f);
                m += dl;
#pragma unroll
                for (int r = 0; r < 16; ++r) { p0[r] -= dl; p1[r] -= dl; negm[r] = -m; }
                const float alpha = exact ? 1.0f : __builtin_amdgcn_exp2f(-dl);
                l *= alpha;
                if (hi == 0) wsf[r32] = alpha;
                asm volatile("s_waitcnt lgkmcnt(0)" ::: "memory");
#pragma unroll
                for (int r = 0; r < 16; ++r) { const float a = wsf[crow(r, hi)];
#pragma unroll
                    for (int d = 0; d < DV / 32; ++d) o[d][r] *= a; }
            }
            float ps = 0.f;
            bf16x8 pa[4];
#define AT_ECHUNK(P_, B_, c_) do { v4u w_; \
                _Pragma("unroll") for (int j = 0; j < 4; ++j) { const float e0 = __builtin_amdgcn_exp2f(P_[(B_) + 2 * j]), e1 = __builtin_amdgcn_exp2f(P_[(B_) + 2 * j + 1]); \
                    ps += e0 + e1; w_[j] = cvtpk_s(e0, e1); } \
                pa[c_] = __builtin_bit_cast(bf16x8, w_); } while (0)
#define AT_PVSTEP(s_) do { _Pragma("unroll") for (int d = 0; d < DV / 32; ++d) { \
                const s16x4 lo = vtr(vbase + (16 * (s_)) * RSV + d * 64); const s16x4 hh = vtr(vbase + (16 * (s_) + 8) * RSV + d * 64); \
                const bf16x8 vf = (bf16x8){lo[0], lo[1], lo[2], lo[3], hh[0], hh[1], hh[2], hh[3]}; \
                o[d] = __builtin_amdgcn_mfma_f32_32x32x16_bf16(pa[s_], vf, o[d], 0, 0, 0); } } while (0)
            AT_ECHUNK(p0, 0, 0);
            AT_ECHUNK(p0, 8, 1); AT_PVSTEP(0);
            AT_ECHUNK(p1, 0, 2); AT_PVSTEP(1);
            AT_ECHUNK(p1, 8, 3); AT_PVSTEP(2);
            AT_PVSTEP(3);
            l += ps;
#undef AT_ECHUNK
#undef AT_PVSTEP
        }
        if (it + 1 < nt) { AT_COMMIT((it + 1) & 1); if (it + 2 < nt) AT_ISSUE(it + 2); }
    }
#undef AT_ISSUE
#undef AT_COMMIT
    m_out = m; l_out = l;
}
__device__ __forceinline__ void row_recip(Frame& F, float l, float (&rli)[16]) {
    LAS float* wsf = (LAS float*)(F.lds + AT_WS) + F.wave * 64;
    const int r32 = F.lane & 31, hi = F.lane >> 5;
    l += __shfl_xor(l, 32);
    asm volatile("s_waitcnt lgkmcnt(0)" ::: "memory");
    if (hi == 0) wsf[r32] = 1.0f / l;
    asm volatile("s_waitcnt lgkmcnt(0)" ::: "memory");
#pragma unroll
    for (int r = 0; r < 16; ++r) rli[r] = wsf[crow(r, hi)];
    asm volatile("s_waitcnt lgkmcnt(0)" ::: "memory");
}
template <bool WINDOW>
__device__ __forceinline__ void attn_a_unit(Frame& F, const bf16* QKV, size_t row0, int h, const AttnSrc& S, int qpos0, float sink, bf16* OM) {
    f32x16 o[2]; float m, l;
    attn_pass<64, WINDOW>(F, QKV + row0 * QKV_LD + QA_OFF + h * 64, QKV_LD, S, qpos0, sink * 1.4426950408889634f, (F.lane >> 5) == 0 ? 1.0f : 0.0f, false, o, m, l);
    float rli[16]; row_recip(F, l, rli);
    const int r32 = F.lane & 31, hi = F.lane >> 5;
    bf16* op = OM + (row0 + F.wave * 32) * DM + h * 64 + r32;
#pragma unroll
    for (int r = 0; r < 16; ++r)
#pragma unroll
        for (int d = 0; d < 2; ++d) op[(size_t)crow(r, hi) * DM + d * 32] = (bf16)f2bf(o[d][r] * rli[r]);
}
__device__ __forceinline__ void attn_b_unit(Frame& F, const bf16* QKV, size_t row0, int h, AttnSrc S, float lam, const float* subln, bf16* OM) {
    f32x16 o[4]; float m, l; float rli[16];
    const bf16* K0 = S.K0; const bf16* K1 = S.K1;
    const int r32 = F.lane & 31, hi = F.lane >> 5;
    LAS unsigned* o1s = (LAS unsigned*)(F.lds + AT_O1) + F.wave * 2048 + F.lane;
    attn_pass<128, false>(F, QKV + row0 * QKV_LD + QB_OFF + h * 128, QKV_LD, S, 0, 0.f, 0.f, true, o, m, l);
    row_recip(F, l, rli);
#pragma unroll
    for (int d = 0; d < 4; ++d)
#pragma unroll
        for (int r = 0; r < 8; ++r) o1s[(d * 8 + r) * 64] = cvtpk_s(o[d][2 * r] * rli[2 * r], o[d][2 * r + 1] * rli[2 * r + 1]);
    S.K0 = K0 + 64; S.K1 = K1 + 64;
    attn_pass<128, false>(F, QKV + row0 * QKV_LD + QB_OFF + h * 128 + 64, QKV_LD, S, 0, 0.f, 0.f, true, o, m, l);
    row_recip(F, l, rli);
    float ss[16];
#pragma unroll
    for (int r = 0; r < 16; ++r) { float s = 0.f;
#pragma unroll
        for (int d = 0; d < 4; ++d) { const unsigned w = o1s[(d * 8 + (r >> 1)) * 64]; const float o1 = (r & 1) ? bfhi(w) : bflo(w); const float v = o1 - lam * (o[d][r] * rli[r]); o[d][r] = v; s += v * v; }
        ss[r] = s; }
#pragma unroll
    for (int r = 0; r < 16; ++r) { float s = ss[r];
#pragma unroll
        for (int x = 1; x < 32; x <<= 1) s += __shfl_xor(s, x);
        ss[r] = 0.8f / sqrtf(s * (1.0f / 128.0f) + EPSN); }
    float gs[4];
#pragma unroll
    for (int d = 0; d < 4; ++d) gs[d] = subln[d * 32 + r32];
    bf16* op = OM + (row0 + F.wave * 32) * DM + 512 + h * 128 + r32;
#pragma unroll
    for (int r = 0; r < 16; ++r)
#pragma unroll
        for (int d = 0; d < 4; ++d) op[(size_t)crow(r, hi) * DM + d * 32] = (bf16)f2bf(o[d][r] * ss[r] * gs[d]);
}
__device__ __forceinline__ void attention_phase(Frame& F) {
    const bf16* QKV = WSP(bf16, WS_BIG); bf16* OM = WSP(bf16, WS_H);
    const float lam = WSP(float, WS_LAM)[0];
    const float* sinkp = F.in[IN_SINK]; const float* subln = F.in[IN_SUBLN];
    for (int u = F.vcu; u < 256; u += F.G) {
        const int b = u >> 6, h = (u >> 4) & 3, qb = u & 15;
        const size_t seq0 = T_CTX + (size_t)b * LAT_SEQ;
        AttnSrc S; S.K0 = WSP(bf16, WS_CBK) + (size_t)b * 256 * 512 + h * 128; S.V0 = WSP(bf16, WS_CBV) + (size_t)b * 256 * 512 + h * 128; S.ld0 = 512; S.n0 = 4;
        S.K1 = QKV + seq0 * QKV_LD + KB_OFF + h * 128; S.V1 = QKV + seq0 * QKV_LD + VB_OFF + h * 128; S.ld1 = QKV_LD; S.t_lo = 0; S.t_hi = 64;
        attn_b_unit(F, QKV, seq0 + qb * 256, h, S, lam, subln, OM);
    }
    for (int u = F.vcu; u < 512; u += F.G) {
        const int b = u >> 7, h = (u >> 4) & 7, qb = u & 15, kvh = h >> 2;
        const size_t seq0 = T_CTX + (size_t)b * LAT_SEQ;
        AttnSrc S; S.K0 = WSP(bf16, WS_CAK) + (size_t)b * 256 * 128 + kvh * 64; S.V0 = WSP(bf16, WS_CAV) + (size_t)b * 256 * 128 + kvh * 64; S.ld0 = 128; S.n0 = 4;
        S.K1 = QKV + seq0 * QKV_LD + KA_OFF + kvh * 64; S.V1 = QKV + seq0 * QKV_LD + VA_OFF + kvh * 64; S.ld1 = QKV_LD;
        S.t_lo = 4 * qb - 2 < 0 ? 0 : 4 * qb - 2; S.t_hi = 4 * qb + 6 > 64 ? 64 : 4 * qb + 6;
        attn_a_unit<true>(F, QKV, seq0 + qb * 256, h, S, qb * 256, sinkp[h], OM);
    }
    for (int u = F.vcu; u < 256; u += F.G) {
        const int b = u >> 3, h = u & 7, kvh = h >> 2;
        const size_t seq0 = (size_t)b * CTX_SEQ;
        AttnSrc S; S.K0 = nullptr; S.V0 = nullptr; S.ld0 = 0; S.n0 = 0;
        S.K1 = QKV + seq0 * QKV_LD + KA_OFF + kvh * 64; S.V1 = QKV + seq0 * QKV_LD + VA_OFF + kvh * 64; S.ld1 = QKV_LD; S.t_lo = 0; S.t_hi = 4;
        attn_a_unit<false>(F, QKV, seq0, h, S, 0, sinkp[h], OM);
    }
    for (int u = F.vcu; u < 128; u += F.G) {
        const int b = u >> 2, h = u & 3;
        const size_t seq0 = (size_t)b * CTX_SEQ;
        AttnSrc S; S.K0 = nullptr; S.V0 = nullptr; S.ld0 = 0; S.n0 = 0;
        S.K1 = QKV + seq0 * QKV_LD + KB_OFF + h * 128; S.V1 = QKV + seq0 * QKV_LD + VB_OFF + h * 128; S.ld1 = QKV_LD; S.t_lo = 0; S.t_hi = 4;
        attn_b_unit(F, QKV, seq0, h, S, lam, subln, OM);
    }
}

constexpr int SC_XC = 0;
constexpr int SC_AUF = 17408;
constexpr int SC_AUB = 17408 + 65536;
constexpr int SC_CW = 17408 + 131072;
static_assert(SC_CW + 2560 <= MISC_OFF, "scan LDS map");
#ifndef DUP_EPI
#define DUP_EPI 1
#endif
#ifndef DUP_SCAN
#define DUP_SCAN 1
#endif
#ifndef DUP_CONV
#define DUP_CONV 1
#endif
constexpr int SCAN_UNITS = 3840;
__device__ __forceinline__ void scan_pass(Frame& F) {
    LAS unsigned char* lds = F.lds;
    const int tid = F.tid, lane = F.lane, wid = F.wave, r32 = lane & 31, hi = lane >> 5;
    bf16* XR = WSP(bf16, WS_BIG) + (size_t)T_ALL * DRNN; bf16* GG = WSP(bf16, WS_BIG); bf16* ABG = (bf16*)F.out;
    const bf16* HALO = WSP(bf16, WS_BIG + 136 * MiB);
    f32x2* SUM = WSP(f32x2, WS_H);
    const int wdir = wid >> 2, cb = wid & 3, chl = cb * 32 + r32;
    const int tk = tid >> 3, cg = tid & 7;
    LAS float* CW = (LAS float*)(lds + SC_CW);
    const int per = (SCAN_UNITS + F.G - 1) / F.G, u_lo = F.vcu * per, u_hi = (u_lo + per) < SCAN_UNITS ? (u_lo + per) : SCAN_UNITS;
    int n_cur = -1;
    v4u xr[8];
    bf16x8 wa[8], wx[8]; float ba = 0.f, bx = 0.f, sp8 = 0.f;
#define SC_DECODE(u_) const int n = (u_) / 384, cidx = (u_) % 384; const bool isctx = cidx < 128; const int b = isctx ? (cidx >> 2) : ((cidx - 128) >> 6); const int c = isctx ? (cidx & 3) : ((cidx - 128) & 63); \
        const size_t seq0 = isctx ? (size_t)b * CTX_SEQ : (size_t)T_CTX + (size_t)b * LAT_SEQ; const int seq_len = isctx ? CTX_SEQ : LAT_SEQ, t0 = c * 64;
#define SC_LOADX(u_) do { SC_DECODE(u_) (void)b; (void)seq_len; \
        _Pragma("unroll") for (int j = 0; j < 4; ++j) { const int tl = tk - 1 + j; \
            const bf16* src = tl < 0 ? HALO + (size_t)((cidx > 0 ? cidx - 1 : 0) * 3 + 0) * DRNN : (tl >= 64 ? HALO + (size_t)((cidx < 383 ? cidx + 1 : 383) * 3 + 1 + (tl - 64)) * DRNN : XR + (seq0 + t0 + tl) * DRNN); \
            const v4u* p = (const v4u*)(src + n * 128 + cg * 8); xr[2 * j] = p[0]; xr[2 * j + 1] = p[8]; } } while (0)
    if (u_lo < u_hi) SC_LOADX(u_lo);
#pragma unroll 1
    for (int u = u_lo; u < u_hi; ++u) {
        SC_DECODE(u)
        (void)b;
        if (n != n_cur) {
            __syncthreads();
            for (int i = tid; i < 640; i += NTHREADS) CW[i] = i < 512 ? F.in[IN_RCONVW][(i >> 7) * DRNN + n * 128 + (i & 127)] : F.in[IN_RCONVB][n * 128 + (i & 127)];
            n_cur = n;
            { const bf16* wap = WSP(bf16, WS_WG) + (size_t)((0 * 2 + wdir) * 10 + n) * 16384 + (size_t)chl * 128 + hi * 8;
              const bf16* wxp = WSP(bf16, WS_WG) + (size_t)((1 * 2 + wdir) * 10 + n) * 16384 + (size_t)chl * 128 + hi * 8;
#pragma unroll
              for (int ks = 0; ks < 8; ++ks) { wa[ks] = *(const bf16x8*)(wap + ks * 16); wx[ks] = *(const bf16x8*)(wxp + ks * 16); } }
            ba = F.in[IN_RBA][wdir * DRNN + n * 128 + chl] * -1.4426950408889634f; bx = F.in[IN_RBX][wdir * DRNN + n * 128 + chl] * -1.4426950408889634f;
            { const float lamv = F.in[IN_RLAM][wdir * DRNN + n * 128 + chl]; sp8 = -8.0f * (lamv > 20.f ? __expf(-lamv) : log1pf(__expf(-lamv))); }
            __syncthreads();
        }
        { float a[16];
#pragma unroll
          for (int e = 0; e < 16; ++e) a[e] = CW[512 + (e >> 3) * 64 + cg * 8 + (e & 7)];
#pragma unroll
          for (int j = 0; j < 4; ++j) { const int t = t0 + tk - 1 + j; const float msk = (t >= 0 && t < seq_len) ? 1.0f : 0.0f;
              const unsigned w[8] = {xr[2 * j].x, xr[2 * j].y, xr[2 * j].z, xr[2 * j].w, xr[2 * j + 1].x, xr[2 * j + 1].y, xr[2 * j + 1].z, xr[2 * j + 1].w};
#pragma unroll
              for (int e = 0; e < 8; ++e) { const int c0 = (e >> 2) * 64 + cg * 8 + 2 * (e & 3); a[2 * e] += (CW[j * 128 + c0] * msk) * bflo(w[e]); a[2 * e + 1] += (CW[j * 128 + c0 + 1] * msk) * bfhi(w[e]); } }
          v4u o0, o1; o0.x = pk2(a[0], a[1]); o0.y = pk2(a[2], a[3]); o0.z = pk2(a[4], a[5]); o0.w = pk2(a[6], a[7]); o1.x = pk2(a[8], a[9]); o1.y = pk2(a[10], a[11]); o1.z = pk2(a[12], a[13]); o1.w = pk2(a[14], a[15]);
          LAS v4u* xp = (LAS v4u*)(lds + SC_XC + tk * 272 + cg * 16); xp[0] = o0; xp[8] = o1; }
        __syncthreads();
        if (u + 1 < u_hi) SC_LOADX(u + 1);
        { LAS f32x2* AU = (LAS f32x2*)(lds + (wdir ? SC_AUB : SC_AUF));
#pragma unroll 1
          for (int rb = 0; rb < 2; ++rb) {
            f32x16 ra = f32x16{}, ia = f32x16{};
            { const LAS unsigned char* ap = lds + SC_XC + (rb * 32 + r32) * 272 + hi * 16;
#pragma unroll
              for (int ks = 0; ks < 8; ++ks) { const bf16x8 af = *(const LAS bf16x8*)(ap + ks * 32);
                  ra = __builtin_amdgcn_mfma_f32_32x32x16_bf16(af, wa[ks], ra, 0, 0, 0);
                  ia = __builtin_amdgcn_mfma_f32_32x32x16_bf16(af, wx[ks], ia, 0, 0, 0); } }
#pragma unroll
            for (int r = 0; r < 16; ++r) {
                const int row = rb * 32 + crow(r, hi);
                const float rr = __builtin_amdgcn_rcpf(1.0f + __builtin_amdgcn_exp2f(ra[r] * -1.4426950408889634f + ba));
                const float ii = __builtin_amdgcn_rcpf(1.0f + __builtin_amdgcn_exp2f(ia[r] * -1.4426950408889634f + bx));
                const float x = sp8 * rr;
                const float em = -x * (1.0f + x * (0.5f + x * (0.16666667f + x * (0.041666668f + x * 0.0083333338f))));
                const float av = 1.0f - em;
                const float om = __builtin_fmaf(em, av, em);
                const float xv = bf2f(*(const LAS unsigned short*)(lds + SC_XC + row * 272 + chl * 2));
                AU[row * 128 + chl] = (f32x2){av, __builtin_amdgcn_sqrtf(om) * ii * xv};
            }
          } }
        __syncthreads();
        if (tid >= 256) {
            const int sch = tid & 127, sd = (tid >> 7) & 1;
            LAS f32x2* AU = (LAS f32x2*)(lds + (sd ? SC_AUB : SC_AUF)) + sch;
            float h = 0.f, pprod = 1.0f;
            f32x2 auA[8], auB[8];
#define SC_LD(dst, s0_) do { _Pragma("unroll") for (int j = 0; j < 8; ++j) { const int row = sd == 0 ? (s0_) + j : 63 - (s0_) - j; dst[j] = AU[row * 128]; } } while (0)
#define SC_RUN(src, s0_) do { _Pragma("unroll") for (int j = 0; j < 8; ++j) { const int row = sd == 0 ? (s0_) + j : 63 - (s0_) - j; h = src[j].x * h + src[j].y; pprod *= src[j].x; AU[row * 128] = (f32x2){h, pprod}; } } while (0)
            SC_LD(auA, 0);
#pragma unroll 1
            for (int s0 = 0; s0 < 64; s0 += 16) {
                SC_LD(auB, s0 + 8);
                SC_RUN(auA, s0);
                if (s0 + 16 < 64) SC_LD(auA, s0 + 16);
                SC_RUN(auB, s0 + 8);
            }
#undef SC_LD
#undef SC_RUN
            SUM[(size_t)cidx * 2 * DRNN + sd * DRNN + n * 128 + sch] = (f32x2){pprod, h};
        }
        __syncthreads();
        {
            const LAS f32x4* hfp = (const LAS f32x4*)(lds + SC_AUF) + lane; const LAS f32x4* hbp = (const LAS f32x4*)(lds + SC_AUB) + lane;
            const size_t eoff = (seq0 + t0 + wid * 8) * DRNN + n * 128;
            unsigned* gp = (unsigned*)(GG + eoff) + lane; unsigned* fp = (unsigned*)(XR + eoff) + lane; unsigned* bp = (unsigned*)(ABG + eoff) + lane;
            unsigned gw[8];
#pragma unroll
            for (int i = 0; i < 8; ++i) gw[i] = gp[(size_t)i * (DRNN / 2)];
#pragma unroll
            for (int i = 0; i < 8; ++i) {
                const f32x4 hf = hfp[(wid * 8 + i) * 64], hb = hbp[(wid * 8 + i) * 64];
                const float g0 = bflo(gw[i]), g1 = bfhi(gw[i]);
                gp[(size_t)i * (DRNN / 2)] = pk2((hf[0] + hb[0]) * g0, (hf[2] + hb[2]) * g1);
                fp[(size_t)i * (DRNN / 2)] = pk2(hf[1] * g0, hf[3] * g1);
                bp[(size_t)i * (DRNN / 2)] = pk2(hb[1] * g0, hb[3] * g1);
            }
        }
        __syncthreads();
    }
#undef SC_DECODE
#undef SC_LOADX
}
__device__ __forceinline__ void scan_correct_phase(Frame& F) {
    bf16* GG = WSP(bf16, WS_BIG); const bf16* XR = WSP(bf16, WS_BIG) + (size_t)T_ALL * DRNN; const bf16* ABG = (const bf16*)F.out;
    const float* CAR = WSP(float, WS_H + 8 * MiB);
    const int gt = F.vcu * NTHREADS + F.tid, NGT = F.G * NTHREADS;
    for (int i = gt; i < T_ALL * (DRNN / 8); i += NGT) {
        const int row = i / (DRNN / 8), c8 = (i % (DRNN / 8)) * 8;
        const size_t off = (size_t)row * DRNN + c8;
        const v4u yl = *(const v4u*)(GG + off), af = *(const v4u*)(XR + off), ab = *(const v4u*)(ABG + off);
        const float* cf = CAR + (size_t)(row >> 6) * 2 * DRNN + c8; const float* cbp = cf + DRNN;
        const f32x4 f0 = *(const f32x4*)cf, f1 = *(const f32x4*)(cf + 4), b0 = *(const f32x4*)cbp, b1 = *(const f32x4*)(cbp + 4);
        const unsigned wy[4] = {yl.x, yl.y, yl.z, yl.w}, wf[4] = {af.x, af.y, af.z, af.w}, wb[4] = {ab.x, ab.y, ab.z, ab.w};
        const float cfv[8] = {f0[0], f0[1], f0[2], f0[3], f1[0], f1[1], f1[2], f1[3]}, cbv[8] = {b0[0], b0[1], b0[2], b0[3], b1[0], b1[1], b1[2], b1[3]};
        unsigned o[4];
#pragma unroll
        for (int e = 0; e < 4; ++e) o[e] = pk2(bflo(wy[e]) + bflo(wf[e]) * cfv[2 * e] + bflo(wb[e]) * cbv[2 * e], bfhi(wy[e]) + bfhi(wf[e]) * cfv[2 * e + 1] + bfhi(wb[e]) * cbv[2 * e + 1]);
        v4u ov; ov.x = o[0]; ov.y = o[1]; ov.z = o[2]; ov.w = o[3];
        *(v4u*)(GG + off) = ov;
    }
}

__device__ __forceinline__ void scan_carry_phase(Frame& F) {
    const f32x2* SUM = WSP(f32x2, WS_H); float* CAR = WSP(float, WS_H + 8 * MiB);
    const int gt = F.vcu * NTHREADS + F.tid, NGT = F.G * NTHREADS;
    for (int i = gt; i < 10240 + 81920; i += NGT) {
        const bool lat = i < 10240; const int j = lat ? i : i - 10240;
        const int ch = j % DRNN, sd = (j / DRNN) & 1, b = j / (2 * DRNN);
        const int nch = lat ? 64 : 4, cfirst = lat ? 128 + b * 64 : b * 4;
        float h = lat ? F.in[sd ? IN_SB : IN_SF][b * DRNN + ch] : 0.f;
        const f32x2* sp = SUM + (size_t)cfirst * 2 * DRNN + sd * DRNN + ch; float* cp = CAR + (size_t)cfirst * 2 * DRNN + sd * DRNN + ch;
        for (int k0 = 0; k0 < nch; k0 += 4) {
            f32x2 s[4];
#pragma unroll
            for (int q = 0; q < 4; ++q) { const int c = sd == 0 ? k0 + q : nch - 1 - k0 - q; s[q] = sp[(size_t)c * 2 * DRNN]; }
#pragma unroll
            for (int q = 0; q < 4; ++q) { const int c = sd == 0 ? k0 + q : nch - 1 - k0 - q; cp[(size_t)c * 2 * DRNN] = h; h = s[q].x * h + s[q].y; }
        }
        if (!lat) F.out[(sd ? OUT_SB : OUT_SF) + b * DRNN + ch] = h;
    }
}

constexpr int N_PHASES = 23;
__global__ void __launch_bounds__(NTHREADS, 2) fwd_kernel(Args args) {
    extern __shared__ __attribute__((aligned(16))) unsigned char lds_raw[];
    Frame F;
    F.lds = (LAS unsigned char*)lds_raw;
    F.tid = threadIdx.x; F.lane = F.tid & 63; F.wave = __builtin_amdgcn_readfirstlane(F.tid >> 6);
    F.G = gridDim.x; { const int bx = blockIdx.x; F.vcu = (F.G % 8 == 0) ? (bx % 8) * (F.G / 8) + bx / 8 : bx; }
    F.in = args.in; F.out = args.out; F.ws = args.ws;
    volatile LAS unsigned* MISC = (volatile LAS unsigned*)(F.lds + MISC_OFF);
    if (F.tid < 32) MISC[F.tid] = 0u;
    __syncthreads();
    XcdBarrier bar; bar.bar = (unsigned*)(args.ws + WS_CTL) + 1024; bar.x = 0; bar.st = nullptr;
    if (args.use_bar) bar = xcd_barrier_post((unsigned*)(args.ws + WS_CTL) + 1024, MISC + 8);
    const int lo = args.ph_lo, hi = args.ph_hi;
#ifndef PHMASK
#define PHMASK 0x7fffff
#endif
#ifndef REP_PHASE
#define REP_PHASE -1
#endif
#ifndef REP_N
#define REP_N 1
#endif
#define IN(k) (((PHMASK >> (k)) & 1) && lo <= (k) && (k) < hi)
#define REPS(k) for (int rep_ = 0; rep_ < (((k) == REP_PHASE) ? REP_N : 1); ++rep_)
#define SEAM(k) do { if (IN(k) && IN((k) + 1)) xcd_barrier(bar); } while (0)
    bf16* XA = (bf16*)((unsigned char*)F.out + 64 * MiB);
    bf16* XB = WSP(bf16, WS_BIG + 120 * MiB);
    const float* MOD = WSP(float, WS_MOD);
    bf16* H = WSP(bf16, WS_H);
    PG8_LAS unsigned char* ring = (PG8_LAS unsigned char*)lds_raw;

    if (IN(0)) REPS(0) { Frame P = fresh(F); p0_prologue(P); } SEAM(0);
    if (IN(1)) REPS(1) { Frame P = fresh(F); norm_mod_pass(P, F.in[IN_XP], F.in[IN_XS], F.in[IN_NORM1], MOD, 0, 1024, H); } SEAM(1);
    if (IN(2)) REPS(2) {
        pg8::Gemm g{H, WSP(bf16, WS_WIN), T_ALL, QKV_LD, DM}; pg8::StaticOrder S; S.init(T_ALL, QKV_LD, F.G, (int)blockIdx.x);
        pg8::EpiInProj E{WSP(bf16, WS_BIG), F.out, WSP(pg8::f32x2, WS_ROPE)};
        pg8::gemm_phase<pg8::EpiInProj, pg8::StaticOrder, true, true>(ring, g, S, E);
        { const int nfull = (T_ALL / 256) * (QKV_LD / 256) % F.G; Frame P = fresh(F);
          if (nfull == 0) p_deferred_transposes(P, (int)blockIdx.x, F.G); else if ((int)blockIdx.x >= nfull) p_deferred_transposes(P, (int)blockIdx.x - nfull, F.G - nfull); }
    } SEAM(2);
    if (IN(3)) REPS(3) { Frame P = fresh(F); attention_phase(P); } SEAM(3);
    if (IN(4)) REPS(4) {
        pg8::Gemm g{H, WSP(bf16, WS_WOUT), T_ALL, DM, DM}; pg8::StaticOrder S; S.init(T_ALL, DM, F.G, (int)blockIdx.x, 192);
        pg8::EpiRes<true> E{F.in[IN_XP], F.in[IN_XS], XA, XB, MOD + 2048, 0};
        pg8::gemm_phase<pg8::EpiRes<true>, pg8::StaticOrder, true, true, 96>(ring, g, S, E);
    } SEAM(4);
#pragma unroll 1
    for (int layer = 0; layer < 2; ++layer) {
        const int pb = layer == 0 ? 5 : 16;
        const float* MODL = MOD + (size_t)layer * 5 * 6144;
        if (IN(pb)) REPS(pb) { Frame P = fresh(F); norm_mod_pass_bf(P, XA, XB, F.in[IN_NORM2] + layer * DM, MODL, 3072, 4096, H); } SEAM(pb);
#pragma unroll 1
        for (int half = 0; half < 2; ++half) {
            const int row0 = half * (T_ALL / 2);
            if (IN(pb + 1 + 2 * half)) REPS(pb + 1 + 2 * half) {
                pg8::Gemm g{H + (size_t)row0 * DM, WSP(bf16, WS_W1) + (size_t)layer * DFF * DM, T_ALL / 2, DFF, DM}; pg8::StaticOrder S; S.init(T_ALL / 2, DFF, F.G, (int)blockIdx.x);
                pg8::EpiSqRelu E{WSP(bf16, WS_BIG), DFF};
                pg8::gemm_phase<pg8::EpiSqRelu, pg8::StaticOrder, true, true>(ring, g, S, E);
            } SEAM(pb + 1 + 2 * half);
            if (IN(pb + 2 + 2 * half)) REPS(pb + 2 + 2 * half) {
                pg8::Gemm g{WSP(bf16, WS_BIG), WSP(bf16, WS_W2) + (size_t)layer * DM * DFF, T_ALL / 2, DM, DFF}; pg8::StaticOrder S; S.init(T_ALL / 2, DM, F.G, (int)blockIdx.x, 192);
                pg8::EpiRes<false> E{nullptr, nullptr, XA, XB, MODL + 5120, row0};
                pg8::gemm_phase<pg8::EpiRes<false>, pg8::StaticOrder, true, true, 96>(ring, g, S, E);
            } SEAM(pb + 2 + 2 * half);
        }
        if (layer == 0) {
            const float* MOD1 = MOD + 5 * 6144;
            if (IN(10)) REPS(10) { Frame P = fresh(F); norm_mod_pass_bf(P, XA, XB, F.in[IN_NORM1] + DM, MOD1, 0, 1024, H); } SEAM(10);
            if (IN(11)) REPS(11) {
                pg8::Gemm g{H, WSP(bf16, WS_WRIN), T_ALL, 2 * DRNN, DM}; pg8::StaticOrder S; S.init(T_ALL, 2 * DRNN, F.G, (int)blockIdx.x);
                pg8::EpiRecIn E{WSP(bf16, WS_BIG), WSP(bf16, WS_BIG) + (size_t)T_ALL * DRNN, WSP(bf16, WS_BIG + 136 * MiB)};
                pg8::gemm_phase<pg8::EpiRecIn, pg8::StaticOrder, true, true>(ring, g, S, E);
            } SEAM(11);
            if (IN(12)) REPS(12) { Frame P = fresh(F); scan_pass(P); } SEAM(12);
            if (IN(13)) REPS(13) { Frame P = fresh(F); scan_carry_phase(P); } SEAM(13);
            if (IN(14)) REPS(14) { Frame P = fresh(F); scan_correct_phase(P); } SEAM(14);
            if (IN(15)) REPS(15) {
                pg8::Gemm g{WSP(bf16, WS_BIG), WSP(bf16, WS_WROUT), T_ALL, DM, DRNN}; pg8::StaticOrder S; S.init(T_ALL, DM, F.G, (int)blockIdx.x, 192);
                pg8::EpiRes<false> E{nullptr, nullptr, XA, XB, MOD1 + 2048, 0};
                pg8::gemm_phase<pg8::EpiRes<false>, pg8::StaticOrder, true, true, 96>(ring, g, S, E);
            } SEAM(15);
        }
    }
    if (IN(21)) REPS(21) { Frame P = fresh(F); final_norm_pass(P, XA, XB, F.out, F.in[IN_FNORM], 0, X_SPLIT); } SEAM(21);
    if (IN(22)) REPS(22) { Frame P = fresh(F); final_norm_pass(P, XA, XB, F.out, F.in[IN_FNORM], X_SPLIT, T_ALL); }
#undef IN
#undef SEAM
}

#ifndef MK_ONE_LAUNCH
#define MK_ONE_LAUNCH 1
#endif
extern "C" void kernel_launch(void* const* d_in, const int* in_sizes, int n_in, void* d_out, int out_size, void* d_ws, size_t ws_size, hipStream_t stream) {
    static int grid = 0;
    if (grid == 0) {
        if (n_in != 31 || ws_size < WS_END) { fprintf(stderr, "kernel_launch: unexpected n_in %d / ws_size %zu\n", n_in, ws_size); grid = -1; return; }
        int dev = 0, cus = 0, per_cu = 0;
        if (hipGetDevice(&dev) != hipSuccess || hipDeviceGetAttribute(&cus, hipDeviceAttributeMultiprocessorCount, dev) != hipSuccess) { grid = -1; return; }
        if (hipFuncSetAttribute((const void*)fwd_kernel, hipFuncAttributeMaxDynamicSharedMemorySize, LDS_BYTES) != hipSuccess) { fprintf(stderr, "kernel_launch: hipFuncSetAttribute failed\n"); grid = -1; return; }
        if (hipOccupancyMaxActiveBlocksPerMultiprocessor(&per_cu, (const void*)fwd_kernel, NTHREADS, LDS_BYTES) != hipSuccess || per_cu < 1) { fprintf(stderr, "kernel_launch: occupancy query says %d\n", per_cu); (void)hipGetLastError(); grid = -1; return; }
        grid = cus;
    }
    if (grid < 0) return;
    (void)hipMemsetAsync((char*)d_ws + WS_CTL, 0, CTL_ZERO_BYTES, stream);
    Args a{};
    for (int i = 0; i < 31; ++i) a.in[i] = (const float*)d_in[i];
    a.out = (float*)d_out; a.ws = (unsigned char*)d_ws;
#if MK_ONE_LAUNCH
    a.ph_lo = 0; a.ph_hi = N_PHASES; a.use_bar = 1;
    hipLaunchKernelGGL(fwd_kernel, dim3(grid), dim3(NTHREADS), LDS_BYTES, stream, a);
#else
    for (int p = 0; p < N_PHASES; ++p) { a.ph_lo = p; a.ph_hi = p + 1; a.use_bar = 0; hipLaunchKernelGGL(fwd_kernel, dim3(grid), dim3(NTHREADS), LDS_BYTES, stream, a); }
#endif
}
```

```cpp
#include <hip/hip_runtime.h>
#include <cstdio>
#include <cstdint>
#include <cmath>
namespace pg8 {
#define PG8_LAS __attribute__((address_space(3)))
typedef unsigned short bf16_t;
typedef short bf16x8 __attribute__((ext_vector_type(8)));
typedef float f32x4 __attribute__((ext_vector_type(4)));
typedef unsigned u32x4 __attribute__((ext_vector_type(4)));
constexpr int BM = 256, BK = 64, HALF = 128, HTB = HALF * BK * 2  , STAGE_BYTES = 8 * HTB, NXCD = 8, WGM = 8;

__host__ __device__ __forceinline__ int lds_byte(int r, int c) { const int st = (r >> 4) * 2 + (c >> 5), rr = r & 15, cc = c & 31, ob = rr * 64 + cc * 2; return st * 1024 + (ob ^ (((ob >> 9) & 1) << 5)); }
__host__ __device__ __forceinline__ void stage_rc(int b, int& R, int& C) { const int st = b / 1024, sb = b % 1024, swz = sb ^ (((sb >> 9) & 1) << 5); R = (st >> 1) * 16 + swz / 64; C = (st & 1) * 32 + (swz % 64) / 2; }
__host__ __device__ __forceinline__ int perm32(int rho) { const int n = rho >> 4, i = rho & 15; return 8 * (i >> 2) + 4 * n + (i & 3); }

struct Unit { int pm, pn; };
struct Gemm { const bf16_t* A; const bf16_t* Bt; int M, N, K; };

struct StaticOrder {
    int nM, nN, nwg, G, c;
    __host__ __device__ void init(int M, int N, int G_, int c_, int bmr = BM) { nM = M / bmr; nN = N / BM; nwg = nM * nN; G = G_; c = c_; }
    __host__ __device__ bool next(int i, Unit& u) const {
        const long L = (long)i * G + c; if (L >= nwg) return false;
        int wgid = (int)L; { const int q = nwg / NXCD, r = nwg % NXCD, xcd = wgid % NXCD, off = wgid / NXCD; wgid = (xcd < r ? xcd * (q + 1) : r * (q + 1) + (xcd - r) * q) + off; }
        const int nig = WGM * nN, gid = wgid / nig, fm = gid * WGM, gsz = (nM - fm) < WGM ? (nM - fm) : WGM;
        u.pm = fm + ((wgid % nig) % gsz); u.pn = (wgid % nig) / gsz; return true;
    }
    __device__ __forceinline__ void a_ready(const Unit&) const {}
    __device__ __forceinline__ void done(const Unit&) const {}
};

__device__ __forceinline__ unsigned cvt_pk_bf16(float lo, float hi) { unsigned r; asm volatile("v_cvt_pk_bf16_f32 %0, %1, %2" : "=v"(r) : "v"(lo), "v"(hi)); return r; }
typedef float f32x2 __attribute__((ext_vector_type(2)));
typedef unsigned u32x2 __attribute__((ext_vector_type(2)));
constexpr int T_CTX = 8192, QKV_LD = 2304;
constexpr float QSCALE = 0.125f * 1.4426950408889634f;
struct EpiInProj {
    static constexpr bool PERM = true, AFTER_DRAIN = false;
    bf16_t* QKV; float* out; const f32x2* rope;
    template <int MR> __device__ __forceinline__ void operator()(const f32x4 (&acc)[2][2][MR][2], const Unit& u, int wr, int wc, int fr, int fq) const {
        constexpr int HRr = MR * 32, BMR = 2 * HRr, WRO = HRr / 2;
        const bool hi_half = fq >= 2;
#pragma unroll
        for (int bj = 0; bj < 2; ++bj) {
            const int colbase = u.pn * BM + bj * HALF + wc * 32;
            const bool rope_col = (colbase < 640 || (colbase >= 768 && colbase < 1792));
            const bool q_col = (colbase < 512 || (colbase >= 768 && colbase < 1280));
            long ooff = -1; int ow = 0, cs = 0;
            if (colbase >= 512 && colbase < 640) { ooff = 25165824; ow = 128; cs = 512; }
            else if (colbase >= 640 && colbase < 768) { ooff = 26214400; ow = 128; cs = 640; }
            else if (colbase >= 1280 && colbase < 1792) { ooff = 27262976; ow = 512; cs = 1280; }
            else if (colbase >= 1792) { ooff = 31457280; ow = 512; cs = 1792; }
#pragma unroll
            for (int ai = 0; ai < 2; ++ai)
#pragma unroll
                for (int m = 0; m < MR; ++m) {
                    const int rowg = u.pm * BMR + ai * HRr + wr * WRO + m * 16;
                    const bool lat = rowg >= T_CTX;
                    const int row = rowg + fr;
                    f32x4 v[2] = {acc[ai][bj][m][0], acc[ai][bj][m][1]};
                    if (rope_col && lat) {
                        const int t = (row - T_CTX) & 4095;
                        const int pos = (wc & 1) ? (t & 63) : (t >> 6);
                        const f32x4* rp = (const f32x4*)(rope + pos * 16 + 8 * (fq & 1));
#pragma unroll
                        for (int n = 0; n < 2; ++n) {
                            const f32x4 c01 = rp[2 * n], c23 = rp[2 * n + 1];
                            const float cs_[4] = {c01[0], c01[2], c23[0], c23[2]}, sn_[4] = {c01[1], c01[3], c23[1], c23[3]};
#pragma unroll
                            for (int e = 0; e < 4; ++e) {
                                const float p = __shfl_xor(v[n][e], 32);
                                v[n][e] = hi_half ? (p * sn_[e] + v[n][e] * cs_[e]) : (v[n][e] * cs_[e] - p * sn_[e]);
                            }
                        }
                    }
                    if (q_col) { v[0] = v[0] * QSCALE; v[1] = v[1] * QSCALE; }
                    bf16_t* qp = QKV + (size_t)row * QKV_LD + colbase + 8 * fq;
                    u32x4 w; w.x = cvt_pk_bf16(v[0][0], v[0][1]); w.y = cvt_pk_bf16(v[0][2], v[0][3]); w.z = cvt_pk_bf16(v[1][0], v[1][1]); w.w = cvt_pk_bf16(v[1][2], v[1][3]);
                    *(u32x4*)qp = w;
                    if (ooff >= 0 && !lat) { float* op = out + ooff + (size_t)row * ow + (colbase - cs) + 8 * fq; *(f32x4*)op = v[0]; *(f32x4*)(op + 4) = v[1]; }
                }
        }
    }
};
constexpr int X_SPLIT = 16384;
template <bool IN_F32>
struct EpiRes {
    static constexpr bool PERM = true, AFTER_DRAIN = false;
    const float* xin_ctx; const float* xin_lat; bf16_t* XA; bf16_t* XB; const float* gate; int row0;
    template <int MR> __device__ __forceinline__ void operator()(const f32x4 (&acc)[2][2][MR][2], const Unit& u, int wr, int wc, int fr, int fq) const {
        constexpr int HRr = MR * 32, BMR = 2 * HRr, WRO = HRr / 2;
        const int rowt = row0 + u.pm * BMR;
#pragma unroll
        for (int ai = 0; ai < 2; ++ai)
#pragma unroll
            for (int m = 0; m < MR; ++m) {
                const int rowg = rowt + ai * HRr + wr * WRO + m * 16;
                const int midx = rowg < T_CTX ? 4 : ((rowg - T_CTX) >> 12);
                const float* g = gate + (size_t)midx * 6144;
                bf16_t* xr = (rowg < X_SPLIT ? XA + (size_t)rowg * 1024 : XB + (size_t)(rowg - X_SPLIT) * 1024) + (size_t)fr * 1024;
                const float* xf = (rowg < T_CTX ? xin_ctx : xin_lat - (size_t)T_CTX * 1024) + (size_t)(rowg + fr) * 1024;
#pragma unroll
                for (int bj = 0; bj < 2; ++bj) {
                    const int col = u.pn * BM + bj * HALF + wc * 32 + 8 * fq;
                    const f32x4 gv0 = *(const f32x4*)(g + col), gv1 = *(const f32x4*)(g + col + 4);
                    f32x4 x0, x1;
                    if (IN_F32) { x0 = *(const f32x4*)(xf + col); x1 = *(const f32x4*)(xf + col + 4); }
                    else { const u32x4 w = *(const u32x4*)(xr + col);
                        x0[0] = __builtin_bit_cast(float, w.x << 16); x0[1] = __builtin_bit_cast(float, w.x & 0xffff0000u); x0[2] = __builtin_bit_cast(float, w.y << 16); x0[3] = __builtin_bit_cast(float, w.y & 0xffff0000u);
                        x1[0] = __builtin_bit_cast(float, w.z << 16); x1[1] = __builtin_bit_cast(float, w.z & 0xffff0000u); x1[2] = __builtin_bit_cast(float, w.w << 16); x1[3] = __builtin_bit_cast(float, w.w & 0xffff0000u); }
                    x0 = x0 + gv0 * acc[ai][bj][m][0]; x1 = x1 + gv1 * acc[ai][bj][m][1];
                    u32x4 o; o.x = cvt_pk_bf16(x0[0], x0[1]); o.y = cvt_pk_bf16(x0[2], x0[3]); o.z = cvt_pk_bf16(x1[0], x1[1]); o.w = cvt_pk_bf16(x1[2], x1[3]);
                    *(u32x4*)(xr + col) = o;
                }
            }
    }
};
struct EpiSqRelu {
    static constexpr bool PERM = true, AFTER_DRAIN = false;
    bf16_t* O; int ldc;
    template <int MR> __device__ __forceinline__ void operator()(const f32x4 (&acc)[2][2][MR][2], const Unit& u, int wr, int wc, int fr, int fq) const {
        constexpr int HRr = MR * 32, BMR = 2 * HRr, WRO = HRr / 2;
#pragma unroll
        for (int ai = 0; ai < 2; ++ai)
#pragma unroll
            for (int m = 0; m < MR; ++m) {
                bf16_t* rowp = O + (size_t)(u.pm * BMR + ai * HRr + wr * WRO + m * 16 + fr) * ldc + u.pn * BM + wc * 32 + 8 * fq;
#pragma unroll
                for (int bj = 0; bj < 2; ++bj) {
                    f32x4 v0 = acc[ai][bj][m][0], v1 = acc[ai][bj][m][1];
#pragma unroll
                    for (int e = 0; e < 4; ++e) { const float a = fmaxf(v0[e], 0.f), b = fmaxf(v1[e], 0.f); v0[e] = a * a; v1[e] = b * b; }
                    u32x4 w; w.x = cvt_pk_bf16(v0[0], v0[1]); w.y = cvt_pk_bf16(v0[2], v0[3]); w.z = cvt_pk_bf16(v1[0], v1[1]); w.w = cvt_pk_bf16(v1[2], v1[3]);
                    *(u32x4*)(rowp + bj * HALF) = w;
                }
            }
    }
};
__device__ __forceinline__ float gelu_tanh(float x) {
    const float u2 = 1.5957691216057308f * (x + 0.044715f * x * x * x);
    return x * __builtin_amdgcn_rcpf(1.0f + __builtin_amdgcn_exp2f(-1.4426950408889634f * u2));
}
struct EpiRecIn {
    static constexpr bool PERM = true, AFTER_DRAIN = false;
    bf16_t* GG; bf16_t* XR; bf16_t* HALO;
    template <int MR> __device__ __forceinline__ void operator()(const f32x4 (&acc)[2][2][MR][2], const Unit& u, int wr, int wc, int fr, int fq) const {
        constexpr int HRr = MR * 32, BMR = 2 * HRr, WRO = HRr / 2;
        const bool isg = u.pn < 5;
        bf16_t* base = isg ? GG : XR; const int colt = (isg ? u.pn : u.pn - 5) * BM;
#pragma unroll
        for (int ai = 0; ai < 2; ++ai)
#pragma unroll
            for (int m = 0; m < MR; ++m) {
                const int row = u.pm * BMR + ai * HRr + wr * WRO + m * 16 + fr;
                bf16_t* rowp = base + (size_t)row * 1280 + colt + wc * 32 + 8 * fq;
                const int rl = row & 63; const bool halo = !isg && (rl == 63 || rl <= 1);
                bf16_t* hp = HALO + ((size_t)(row >> 6) * 3 + (rl == 63 ? 0 : rl + 1)) * 1280 + colt + wc * 32 + 8 * fq;
#pragma unroll
                for (int bj = 0; bj < 2; ++bj) {
                    f32x4 v0 = acc[ai][bj][m][0], v1 = acc[ai][bj][m][1];
                    if (isg) {
#pragma unroll
                        for (int e = 0; e < 4; ++e) { v0[e] = gelu_tanh(v0[e]); v1[e] = gelu_tanh(v1[e]); }
                    }
                    u32x4 w; w.x = cvt_pk_bf16(v0[0], v0[1]); w.y = cvt_pk_bf16(v0[2], v0[3]); w.z = cvt_pk_bf16(v1[0], v1[1]); w.w = cvt_pk_bf16(v1[2], v1[3]);
                    *(u32x4*)(rowp + bj * HALF) = w;
                    if (halo) *(u32x4*)(hp + bj * HALF) = w;
                }
            }
    }
};
template <class Epi, class Sched, bool ALIGN_EPI = false, bool SP2 = false, int HR = 128>
__device__ __forceinline__ void gemm_phase(PG8_LAS unsigned char* lds, const Gemm g, const Sched& S, const Epi& E) {
    int tid_ = threadIdx.x; asm volatile("" : "+v"(tid_));
    const int tid = tid_, wid = __builtin_amdgcn_readfirstlane(tid >> 6), lane = tid & 63, wr = wid >> 2, wc = wid & 3, fr = lane & 15, fq = lane >> 4;
    constexpr int MR = HR / 32;
    const int K = g.K, nt = K / BK;
    unsigned voffA[2], voffB[2];
#pragma unroll
    for (int i = 0; i < 2; ++i) { int R, C; stage_rc(tid * 16 + i * 8192, R, C); const int Rb = Epi::PERM ? ((R & ~31) + perm32(R & 31)) : R;
        voffA[i] = (unsigned)(R * K + C) * 2u; voffB[i] = (unsigned)(Rb * K + C) * 2u; }
    const size_t kstep = (size_t)(BK * 2);
    const size_t hstep = (size_t)HALF * K * 2;
    const size_t tstep = 2 * hstep;
    const size_t hstepA = (size_t)HR * K * 2, tstepA = 2 * hstepA;
    const unsigned ldsw = (unsigned)wid * 1024u;
    const int aoff = lds_byte(wr * (HR / 2) + fr, fq * 8), boff = lds_byte(wc * 32 + fr, fq * 8);
#define PG8_SA(b, h) (((b) * 2 + (h)) * HTB)
#define PG8_SB(b, h) ((4 + (b) * 2 + (h)) * HTB)
#define PG8_STAGE(bufoff, gbase, voff) do { _Pragma("unroll") for (int _i = 0; _i < 2; ++_i) \
        __builtin_amdgcn_global_load_lds((const unsigned*)((const char*)(gbase) + (voff)[_i]), (PG8_LAS unsigned*)(lds + (bufoff) + ldsw + _i * 8192), 16, 0, 0); } while (0)
#define PG8_LDA(dst, b, h) do { _Pragma("unroll") for (int m = 0; m < MR; ++m) _Pragma("unroll") for (int k = 0; k < 2; ++k) dst[m][k] = *(const PG8_LAS bf16x8*)(lds + PG8_SA(b, h) + aoff + m * 2048 + k * 1024); } while (0)
#define PG8_LDB(dst, b, h) do { _Pragma("unroll") for (int n = 0; n < 2; ++n) _Pragma("unroll") for (int k = 0; k < 2; ++k) dst[n][k] = *(const PG8_LAS bf16x8*)(lds + PG8_SB(b, h) + boff + n * 2048 + k * 1024); } while (0)
#define PG8_MMA(ai, bj, At, Bt) do { __builtin_amdgcn_s_setprio(1); _Pragma("unroll") for (int m = 0; m < MR; ++m) _Pragma("unroll") for (int n = 0; n < 2; ++n) _Pragma("unroll") for (int k = 0; k < 2; ++k) \
        acc[ai][bj][m][n] = __builtin_amdgcn_mfma_f32_16x16x32_bf16(Bt[n][k], At[m][k], acc[ai][bj][m][n], 0, 0, 0); __builtin_amdgcn_s_setprio(0); } while (0)
#define PG8_WAIT_V(n) asm volatile("s_waitcnt vmcnt(" #n ")" ::: "memory")
#define PG8_WAIT_L(n) asm volatile("s_waitcnt lgkmcnt(" #n ")" ::: "memory")
#define PG8_BAR __builtin_amdgcn_s_barrier()
#define PG8_SCHED __builtin_amdgcn_sched_barrier(0)
    Unit cur, nxt; int ui = 0;
    if (!S.next(0, cur)) return;
    f32x4 acc[2][2][MR][2];
#pragma unroll
    for (int a = 0; a < 2; ++a)
#pragma unroll
        for (int b = 0; b < 2; ++b)
#pragma unroll
            for (int m = 0; m < MR; ++m)
#pragma unroll
                for (int n = 0; n < 2; ++n) acc[a][b][m][n] = (f32x4){0.f, 0.f, 0.f, 0.f};
    bf16x8 At[MR][2], B0[2][2], B1[2][2];
    const char* cA = (const char*)g.A + (size_t)cur.pm * tstepA; const char* cB = (const char*)g.Bt + (size_t)cur.pn * tstep;
    S.a_ready(cur);
    if constexpr (SP2) {
        PG8_STAGE(PG8_SB(0, 0), cB, voffB); PG8_STAGE(PG8_SB(0, 1), cB + hstep, voffB); PG8_STAGE(PG8_SA(0, 0), cA, voffA); PG8_STAGE(PG8_SA(0, 1), cA + hstepA, voffA);
        if (wr == 1) PG8_BAR;
        PG8_WAIT_V(2); PG8_BAR;
        PG8_STAGE(PG8_SB(1, 0), cB + kstep, voffB); PG8_STAGE(PG8_SA(1, 0), cA + kstep, voffA); PG8_STAGE(PG8_SB(1, 1), cB + hstep + kstep, voffB);
        PG8_WAIT_V(6); PG8_BAR;
    } else {
        PG8_STAGE(PG8_SB(0, 0), cB, voffB); PG8_STAGE(PG8_SA(0, 0), cA, voffA); PG8_STAGE(PG8_SB(0, 1), cB + hstep, voffB); PG8_STAGE(PG8_SA(0, 1), cA + hstepA, voffA);
        if (wr == 1) PG8_BAR;
        PG8_WAIT_V(4); PG8_BAR;
        PG8_STAGE(PG8_SB(1, 0), cB + kstep, voffB); PG8_STAGE(PG8_SA(1, 0), cA + kstep, voffA); PG8_STAGE(PG8_SB(1, 1), cB + hstep + kstep, voffB);
        PG8_WAIT_V(6); PG8_BAR;
    }
    for (;;) {
        const bool has_next = S.next(ui + 1, nxt);
        const char* nA = has_next ? (const char*)g.A + (size_t)nxt.pm * tstepA : cA; const char* nB = has_next ? (const char*)g.Bt + (size_t)nxt.pn * tstep : cB;
        for (int t = 0; t < nt; t += 2) {
            const bool last = (t == nt - 2);
            const char* a1 = cA + (size_t)(t + 1) * kstep;
            const char* a2 = last ? nA : cA + (size_t)(t + 2) * kstep; const char* b2 = last ? nB : cB + (size_t)(t + 2) * kstep;
            const char* a3 = a2 + kstep; const char* b3 = b2 + kstep;
            if (last && has_next) S.a_ready(nxt);
            if constexpr (SP2) {
            PG8_LDB(B0, 0, 0); PG8_LDB(B1, 0, 1); PG8_SCHED; PG8_LDA(At, 0, 0); PG8_STAGE(PG8_SA(1, 1), a1 + hstepA, voffA);
            PG8_WAIT_V(8); PG8_WAIT_L(0); PG8_BAR; PG8_MMA(0, 0, At, B0); PG8_MMA(0, 1, At, B1); PG8_BAR; PG8_SCHED;
            PG8_LDA(At, 0, 1); PG8_STAGE(PG8_SB(0, 0), b2, voffB); PG8_STAGE(PG8_SB(0, 1), b2 + hstep, voffB); PG8_STAGE(PG8_SA(0, 0), a2, voffA);
            PG8_WAIT_V(8); PG8_WAIT_L(0); PG8_BAR; PG8_MMA(1, 0, At, B0); PG8_MMA(1, 1, At, B1); PG8_BAR; PG8_SCHED;
            PG8_LDB(B0, 1, 0); PG8_LDB(B1, 1, 1); PG8_SCHED; PG8_LDA(At, 1, 0); PG8_STAGE(PG8_SA(0, 1), a2 + hstepA, voffA);
            PG8_WAIT_V(8); PG8_WAIT_L(0); PG8_BAR; PG8_MMA(0, 0, At, B0); PG8_MMA(0, 1, At, B1); PG8_BAR; PG8_SCHED;
            PG8_LDA(At, 1, 1); PG8_STAGE(PG8_SB(1, 0), b3, voffB); PG8_STAGE(PG8_SB(1, 1), b3 + hstep, voffB); PG8_STAGE(PG8_SA(1, 0), a3, voffA);
            PG8_WAIT_V(8); PG8_WAIT_L(0); PG8_BAR; PG8_MMA(1, 0, At, B0); PG8_MMA(1, 1, At, B1); PG8_BAR; PG8_SCHED;
            } else {
            PG8_LDB(B0, 0, 0); PG8_SCHED; PG8_LDA(At, 0, 0); PG8_STAGE(PG8_SA(1, 1), a1 + hstepA, voffA);
            PG8_WAIT_L(8); PG8_BAR; PG8_WAIT_L(0); PG8_MMA(0, 0, At, B0); PG8_BAR; PG8_SCHED;
            PG8_LDB(B1, 0, 1); PG8_STAGE(PG8_SB(0, 0), b2, voffB);
            PG8_BAR; PG8_WAIT_L(0); PG8_MMA(0, 1, At, B1); PG8_BAR;
            PG8_LDA(At, 0, 1); PG8_STAGE(PG8_SA(0, 0), a2, voffA);
            PG8_BAR; PG8_WAIT_L(0); PG8_MMA(1, 0, At, B0); PG8_BAR; PG8_SCHED;
            PG8_STAGE(PG8_SB(0, 1), b2 + hstep, voffB);
            PG8_WAIT_V(6); PG8_BAR; PG8_MMA(1, 1, At, B1); PG8_BAR;
            PG8_LDB(B0, 1, 0); PG8_SCHED; PG8_LDA(At, 1, 0); PG8_STAGE(PG8_SA(0, 1), a2 + hstepA, voffA);
            PG8_WAIT_L(8); PG8_BAR; PG8_WAIT_L(0); PG8_MMA(0, 0, At, B0); PG8_BAR; PG8_SCHED;
            PG8_LDB(B1, 1, 1); PG8_STAGE(PG8_SB(1, 0), b3, voffB);
            PG8_BAR; PG8_WAIT_L(0); PG8_MMA(0, 1, At, B1); PG8_BAR;
            PG8_LDA(At, 1, 1); PG8_STAGE(PG8_SA(1, 0), a3, voffA);
            PG8_BAR; PG8_WAIT_L(0); PG8_MMA(1, 0, At, B0); PG8_BAR; PG8_SCHED;
            PG8_STAGE(PG8_SB(1, 1), b3 + hstep, voffB);
            PG8_WAIT_V(6); PG8_BAR; PG8_MMA(1, 1, At, B1); PG8_BAR;
            }
        }
        if constexpr (ALIGN_EPI) { if (wr == 0) PG8_BAR; }
        if constexpr (!Epi::AFTER_DRAIN) { E.template operator()<MR>(acc, cur, wr, wc, fr, fq); S.done(cur); }
        if (!has_next) break;
#pragma unroll
        for (int a = 0; a < 2; ++a)
#pragma unroll
            for (int b = 0; b < 2; ++b)
#pragma unroll
                for (int m = 0; m < MR; ++m)
#pragma unroll
                    for (int n = 0; n < 2; ++n) acc[a][b][m][n] = (f32x4){0.f, 0.f, 0.f, 0.f};
        cur = nxt; cA = nA; cB = nB; ++ui;
        if constexpr (ALIGN_EPI) { if (wr == 1) PG8_BAR; }
    }
    PG8_WAIT_V(0);
    if constexpr (!ALIGN_EPI) { if (wr == 0) PG8_BAR; }
    PG8_BAR;
    if constexpr (Epi::AFTER_DRAIN) { E.fused(acc, cur, wr, wc, fr, fq, lds, wid, lane); S.done(cur); }
#undef PG8_SA
#undef PG8_SB
#undef PG8_STAGE
#undef PG8_LDA
#undef PG8_LDB
#undef PG8_MMA
#undef PG8_WAIT_V
#undef PG8_WAIT_L
#undef PG8_BAR
#undef PG8_SCHED
}
}
constexpr int NWAVES = 8, NTHREADS = 512;
constexpr int DM = 1024, T_CTX = 8192, T_LAT = 16384, T_ALL = 24576, LAT_SEQ = 4096, CTX_SEQ = 256;
constexpr int QKV_LD = 2304, DFF = 4096, DRNN = 1280;
constexpr int QA_OFF = 0, KA_OFF = 512, VA_OFF = 640, QB_OFF = 768, KB_OFF = 1280, VB_OFF = 1792;
constexpr float EPSN = 1e-6f;
constexpr float SM_C = 0.125f * 1.4426950408889634f;
constexpr long OUT_AK = 25165824, OUT_AV = 26214400, OUT_BK = 27262976, OUT_BV = 31457280, OUT_SF = 35651584, OUT_SB = 35692544;
constexpr size_t MiB = 1u << 20;
constexpr size_t WS_CTL = 0, CTL_ZERO_BYTES = 64 * 1024;
constexpr size_t WS_MOD = 1 * MiB;
constexpr size_t WS_ROPE = 1 * MiB + 256 * 1024;
constexpr size_t WS_LAM = WS_ROPE + 16 * 1024;
constexpr size_t WS_CAK = 2 * MiB, WS_CAV = WS_CAK + 256 * 1024, WS_CBK = WS_CAV + 256 * 1024, WS_CBV = WS_CBK + 1 * MiB;
constexpr size_t WS_WIN = 5 * MiB;
constexpr size_t WS_WOUT = 10 * MiB;
constexpr size_t WS_W1 = 12 * MiB;
constexpr size_t WS_W2 = 28 * MiB;
constexpr size_t WS_WRIN = 44 * MiB;
constexpr size_t WS_WROUT = 49 * MiB;
constexpr size_t WS_WG = 52 * MiB;
constexpr size_t WS_SUM = 54 * MiB;
constexpr size_t WS_H = 56 * MiB;
constexpr size_t WS_BIG = 104 * MiB;
constexpr size_t WS_END = 256 * MiB;
static_assert(WS_BIG + (size_t)T_ALL * QKV_LD * 2 <= WS_END && WS_BIG + (size_t)(T_ALL / 2) * DFF * 2 <= WS_END && WS_BIG + (size_t)T_ALL * DRNN * 4 <= WS_END, "ws map");
constexpr int LDS_BYTES = 160 * 1024;
constexpr int MISC_OFF = 152 * 1024;

#define GAS __attribute__((address_space(1)))
#define LAS __attribute__((address_space(3)))
typedef unsigned short bf16;
typedef unsigned v4u __attribute__((ext_vector_type(4)));
typedef unsigned v2u __attribute__((ext_vector_type(2)));
typedef float f32x4 __attribute__((ext_vector_type(4)));
typedef float f32x2 __attribute__((ext_vector_type(2)));
typedef float f32x16 __attribute__((ext_vector_type(16)));
typedef short bf16x8 __attribute__((ext_vector_type(8)));
typedef short s16x4 __attribute__((ext_vector_type(4)));
typedef GAS unsigned gu32;
#define RLX_AGENT __ATOMIC_RELAXED, __HIP_MEMORY_SCOPE_AGENT
__device__ __forceinline__ unsigned f2bf(float f) { unsigned u = __builtin_bit_cast(unsigned, f); return (u + 0x7fffu + ((u >> 16) & 1u)) >> 16; }
__device__ __forceinline__ unsigned pk2(float lo, float hi) { return f2bf(lo) | (f2bf(hi) << 16); }
__device__ __forceinline__ float bf2f(unsigned short b) { return __builtin_bit_cast(float, (unsigned)b << 16); }
__device__ __forceinline__ float bflo(unsigned w) { return __builtin_bit_cast(float, w << 16); }
__device__ __forceinline__ float bfhi(unsigned w) { return __builtin_bit_cast(float, w & 0xffff0000u); }

#define XB_TMO      128
#define XB_XCNT(j)  (256  + 64 * (j))
#define XB_XSUB(j)  (1280 + 64 * (j))
#define XB_XGEN(j)  (2304 + 64 * (j))
#define XB_TOP      3328
#define XB_TOPGEN   3392
#define XCD_BAR_WORDS 3456
#define XB_SPIN_CAP (1u << 18)
__device__ __forceinline__ unsigned xb_ld(unsigned* p)              { return __hip_atomic_load(p, __ATOMIC_RELAXED, __HIP_MEMORY_SCOPE_AGENT); }
__device__ __forceinline__ unsigned xb_add(unsigned* p, unsigned v) { return __hip_atomic_fetch_add(p, v, __ATOMIC_RELAXED, __HIP_MEMORY_SCOPE_AGENT); }
__device__ __forceinline__ unsigned xb_xcc_id() { return (unsigned)__builtin_amdgcn_s_getreg((3 << 11) | 20) & 0xFu; }
#define XB_SPIN(cond, bar) do { unsigned _sp = 0; while (cond) { __builtin_amdgcn_s_sleep(1); \
    if ((++_sp & 255u) == 0u) { if (xb_ld(&(bar)[XB_TMO])) break; if (_sp > XB_SPIN_CAP) { atomicAdd(&(bar)[XB_TMO], 1u); break; } } } } while (0)
struct XcdBarrier { unsigned* bar; unsigned x; volatile LAS unsigned* st; };
__device__ __forceinline__ XcdBarrier xcd_barrier_post(unsigned* bar, volatile LAS unsigned* st) {
    XcdBarrier b; b.bar = bar; b.x = xb_xcc_id(); b.st = st;
    if (threadIdx.x == 0) (void)xb_add(&bar[XB_XCNT(b.x)], 1u);
    return b;
}
__device__ __forceinline__ void xcd_barrier_complete(unsigned* bar, unsigned x, unsigned& nloc, unsigned& nx) {
    const unsigned G = gridDim.x * gridDim.y * gridDim.z;
    unsigned sum, cnt, mine, sp = 0u;
    for (;;) {
        sum = 0u; cnt = 0u; mine = 0u;
#pragma unroll
        for (unsigned j = 0; j < 16; ++j) { const unsigned c = xb_ld(&bar[XB_XCNT(j)]); sum += c; cnt += (c > 0u) ? 1u : 0u; mine = (j == x) ? c : mine; }
        if (sum == G) break;
        __builtin_amdgcn_s_sleep(1);
        if ((++sp & 255u) == 0u) { if (xb_ld(&bar[XB_TMO])) break; if (sp > XB_SPIN_CAP) { atomicAdd(&bar[XB_TMO], 1u); break; } }
    }
    nloc = mine > 0u ? mine : 1u; nx = cnt > 0u ? cnt : 1u;
}
__device__ __forceinline__ void xcd_barrier(const XcdBarrier& b) {
    asm volatile("s_waitcnt vmcnt(0)" ::: "memory");
    __syncthreads();
    if (threadIdx.x == 0) {
        unsigned* bar = b.bar;
        __builtin_amdgcn_s_waitcnt(0);
        unsigned nloc = b.st[0], nx = b.st[1];
        if (nloc == 0u) { xcd_barrier_complete(bar, b.x, nloc, nx); b.st[0] = nloc; b.st[1] = nx; }
        const unsigned old = xb_add(&bar[XB_XSUB(b.x)], 1u);
        const unsigned gen = old / nloc;
        if (old + 1u == (gen + 1u) * nloc) {
            __builtin_amdgcn_fence(__ATOMIC_RELEASE, "agent");
            asm volatile("s_waitcnt vmcnt(0)" ::: "memory");
            const unsigned og = xb_add(&bar[XB_TOP], 1u);
            const unsigned tg = og / nx;
            if (og + 1u == (tg + 1u) * nx) xb_add(&bar[XB_TOPGEN], 1u);
            else XB_SPIN(xb_ld(&bar[XB_TOPGEN]) == tg, bar);
            __builtin_amdgcn_fence(__ATOMIC_ACQUIRE, "agent");
            xb_add(&bar[XB_XGEN(b.x)], 1u);
            asm volatile("s_waitcnt vmcnt(0)" ::: "memory");
        } else {
            XB_SPIN(xb_ld(&bar[XB_XGEN(b.x)]) == gen, bar);
            __builtin_amdgcn_fence(__ATOMIC_ACQUIRE, "agent");
            asm volatile("s_waitcnt vmcnt(0)" ::: "memory");
        }
    }
    __syncthreads();
}

struct Args { const float* in[31]; float* out; unsigned char* ws; int ph_lo, ph_hi; int use_bar, pad; };
struct Frame {
    LAS unsigned char* lds;
    int tid, lane, wave, vcu, G;
    const float* const* in; float* out; unsigned char* ws;
};
#define WSP(T, off) ((T*)(F.ws + (off)))
__device__ __forceinline__ Frame fresh(const Frame& F) { Frame P = F; int t = threadIdx.x; asm volatile("" : "+v"(t)); P.tid = t; P.lane = t & 63; P.wave = __builtin_amdgcn_readfirstlane(t >> 6); return P; }
enum { IN_XP = 0, IN_XS, IN_CAK, IN_CAV, IN_CBK, IN_CBV, IN_SF, IN_SB, IN_C, IN_CCTX, IN_NORM1, IN_NORM2, IN_WADA, IN_BADA, IN_WMLP1, IN_WMLP2, IN_AWIN, IN_AWOUT, IN_SINK, IN_LAMQK, IN_SUBLN,
       IN_RWIN, IN_RCONVW, IN_RCONVB, IN_RWA, IN_RBA, IN_RWX, IN_RBX, IN_RLAM, IN_RWOUT, IN_FNORM };

__device__ __forceinline__ float wave_sum(float v) {
#pragma unroll
    for (int o = 1; o < 64; o <<= 1) v += __shfl_xor(v, o);
    return v;
}

__device__ __forceinline__ void p0_transpose_item(const float* W, int K, int N, bf16* WT, LAS float* scr, int item, int lane, float wscale = 1.0f) {
    const int nblk = N / 32, kb = item / nblk, nb = item % nblk, k0 = 64 * kb, n0 = 32 * nb;
#pragma unroll 8
    for (int i = 0; i < 32; ++i) { const int kk = 2 * i + (lane >> 5); scr[kk * 33 + (lane & 31)] = W[(size_t)(k0 + kk) * N + n0 + (lane & 31)]; }
    asm volatile("s_waitcnt lgkmcnt(0)" ::: "memory");
    const int c = lane & 7;
#pragma unroll
    for (int j = 0; j < 4; ++j) { const int n = (lane >> 3) + 8 * j; const LAS float* s = scr + (8 * c) * 33 + n;
        v4u o; o.x = pk2(s[0 * 33] * wscale, s[1 * 33] * wscale); o.y = pk2(s[2 * 33] * wscale, s[3 * 33] * wscale); o.z = pk2(s[4 * 33] * wscale, s[5 * 33] * wscale); o.w = pk2(s[6 * 33] * wscale, s[7 * 33] * wscale);
        *(GAS v4u*)(WT + (size_t)(n0 + n) * K + k0 + 8 * c) = o; }
    asm volatile("s_waitcnt lgkmcnt(0)" ::: "memory");
}
__device__ __forceinline__ void p0_prologue(Frame& F) {
    const float* const* in = F.in;
    {
        LAS float* SC = (LAS float*)(F.lds);
        LAS float* RED = (LAS float*)(F.lds + 20480);
        for (int i = F.tid; i < 5 * 1024; i += NTHREADS) { const int v = i >> 10, k = i & 1023; const float c = v < 4 ? in[IN_C][v * 1024 + k] : in[IN_CCTX][k]; SC[i] = c / (1.0f + __expf(-c)); }
        __syncthreads();
        float* MOD = WSP(float, WS_MOD);
        for (int u = blockIdx.x; u < 384; u += F.G) {
            const int l = u / 192, n0 = (u % 192) * 32;
            const float* W = in[IN_WADA] + (size_t)l * 1024 * 6144 + n0 + (F.lane & 31);
            float a[5] = {0.f, 0.f, 0.f, 0.f, 0.f};
            const int kb = F.wave * 128 + (F.lane >> 5);
#pragma unroll 8
            for (int kk = 0; kk < 64; ++kk) { const int k = kb + 2 * kk; const float w = W[(size_t)k * 6144];
#pragma unroll
                for (int v = 0; v < 5; ++v) a[v] += SC[v * 1024 + k] * w; }
#pragma unroll
            for (int v = 0; v < 5; ++v) { a[v] += __shfl_xor(a[v], 32); if (F.lane < 32) RED[(F.wave * 5 + v) * 32 + F.lane] = a[v]; }
            __syncthreads();
            if (F.tid < 160) { const int v = F.tid >> 5, c = F.tid & 31; float s = in[IN_BADA][l * 6144 + n0 + c];
#pragma unroll
                for (int w = 0; w < 8; ++w) s += RED[(w * 5 + v) * 32 + c];
                MOD[((size_t)l * 5 + v) * 6144 + n0 + c] = s; }
            __syncthreads();
        }
    }
    {
        LAS float* scr = (LAS float*)(F.lds + 32768 + F.wave * 8704);
        const int gw = F.vcu * NWAVES + F.wave, NGW = F.G * NWAVES;
        constexpr int I_IN = 16 * 72, I_OUT = 16 * 32;
        for (int it = gw; it < I_IN + I_OUT; it += NGW) {
            if (it < I_IN) p0_transpose_item(in[IN_AWIN], 1024, 2304, WSP(bf16, WS_WIN), scr, it, F.lane);
            else p0_transpose_item(in[IN_AWOUT], 1024, 1024, WSP(bf16, WS_WOUT), scr, it - I_IN, F.lane);
        }
    }
    {
        const int gt = F.vcu * NTHREADS + F.tid, NGT = F.G * NTHREADS;
        for (int i = gt; i < 4 * 256 * 128 / 4; i += NGT) {
            const f32x4 a = ((const f32x4*)in[IN_CAK])[i], b = ((const f32x4*)in[IN_CAV])[i];
            v2u o; o.x = pk2(a[0], a[1]); o.y = pk2(a[2], a[3]); WSP(v2u, WS_CAK)[i] = o; o.x = pk2(b[0], b[1]); o.y = pk2(b[2], b[3]); WSP(v2u, WS_CAV)[i] = o; }
        for (int i = gt; i < 4 * 256 * 512 / 4; i += NGT) {
            const f32x4 a = ((const f32x4*)in[IN_CBK])[i], b = ((const f32x4*)in[IN_CBV])[i];
            v2u o; o.x = pk2(a[0], a[1]); o.y = pk2(a[2], a[3]); WSP(v2u, WS_CBK)[i] = o; o.x = pk2(b[0], b[1]); o.y = pk2(b[2], b[3]); WSP(v2u, WS_CBV)[i] = o; }
        if (gt < 1024) { const int pos = gt >> 4, i = gt & 15; const double ang = (double)pos * pow(10000.0, -(double)i / 16.0);
            WSP(f32x2, WS_ROPE)[gt] = (f32x2){(float)cos(ang), (float)sin(ang)}; }
        if (gt == 0) { const float* lq = in[IN_LAMQK]; float s1 = 0.f, s2 = 0.f; for (int i = 0; i < 64; ++i) { s1 += lq[i] * lq[64 + i]; s2 += lq[128 + i] * lq[192 + i]; }
            WSP(float, WS_LAM)[0] = __expf(s1) - __expf(s2) + 0.2f; }
    }
}

__device__ __forceinline__ void p_deferred_transposes(Frame& F, int iw, int nw) {
    const float* const* in = F.in;
    LAS float* scr = (LAS float*)(F.lds + 32768 + F.wave * 8704);
    const int gw = iw * NWAVES + F.wave, NGW = nw * NWAVES;
    constexpr int I_M1 = 16 * 128, I_M2 = 64 * 32, I_RIN = 16 * 80, I_ROUT = 20 * 32, I_G = 8;
    constexpr int NITEMS = 2 * I_M1 + 2 * I_M2 + I_RIN + I_ROUT + 40 * I_G;
    for (int it = gw; it < NITEMS; it += NGW) {
        int r = it;
        if (r < 2 * I_M1) { const int l = r / I_M1; p0_transpose_item(in[IN_WMLP1] + (size_t)l * 1024 * 4096, 1024, 4096, WSP(bf16, WS_W1) + (size_t)l * 4096 * 1024, scr, r % I_M1, F.lane); continue; } r -= 2 * I_M1;
        if (r < 2 * I_M2) { const int l = r / I_M2; p0_transpose_item(in[IN_WMLP2] + (size_t)l * 4096 * 1024, 4096, 1024, WSP(bf16, WS_W2) + (size_t)l * 1024 * 4096, scr, r % I_M2, F.lane); continue; } r -= 2 * I_M2;
        if (r < I_RIN) { p0_transpose_item(in[IN_RWIN], 1024, 2560, WSP(bf16, WS_WRIN), scr, r, F.lane); continue; } r -= I_RIN;
        if (r < I_ROUT) { p0_transpose_item(in[IN_RWOUT], 1280, 1024, WSP(bf16, WS_WROUT), scr, r, F.lane); continue; } r -= I_ROUT;
        { const int mtx = r / I_G, gate = mtx / 20, db = mtx % 20;
          p0_transpose_item(in[gate ? IN_RWX : IN_RWA] + (size_t)db * 16384, 128, 128, WSP(bf16, WS_WG) + (size_t)(gate * 20 + db) * 16384, scr, r % I_G, F.lane, -1.4426950408889634f); }
    }
}

__device__ __forceinline__ void norm_mod_pass(Frame& F, const float* x_ctx, const float* x_lat, const float* g, const float* mod  , int shift_off, int scale_off, bf16* H) {
    const int gw = F.vcu * NWAVES + F.wave, NGW = F.G * NWAVES;
    for (int m = gw; m < T_ALL; m += NGW) {
        const float* xr = m < T_CTX ? x_ctx + (size_t)m * DM : x_lat + (size_t)(m - T_CTX) * DM;
        const int midx = m < T_CTX ? 4 : ((m - T_CTX) >> 12);
        const float* mv = mod + (size_t)midx * 6144;
        f32x4 v[4]; float s = 0.f;
#pragma unroll
        for (int j = 0; j < 4; ++j) { v[j] = ((const f32x4*)xr)[F.lane + 64 * j]; s += (v[j][0] * v[j][0] + v[j][1] * v[j][1]) + (v[j][2] * v[j][2] + v[j][3] * v[j][3]); }
        const float rstd = 1.0f / sqrtf(wave_sum(s) * (1.0f / DM) + EPSN);
#pragma unroll
        for (int j = 0; j < 4; ++j) {
            const int c = 4 * (F.lane + 64 * j);
            const f32x4 gg = *(const f32x4*)(g + c), sc = *(const f32x4*)(mv + scale_off + c), sh = *(const f32x4*)(mv + shift_off + c);
            f32x4 o = (v[j] * rstd) * gg; o = o * (sc + 1.0f) + sh;
            v2u w; w.x = pk2(o[0], o[1]); w.y = pk2(o[2], o[3]);
            *(v2u*)(H + (size_t)m * DM + c) = w;
        }
    }
}
constexpr int X_SPLIT = 16384;
__device__ __forceinline__ const bf16* xrow_bf(const bf16* XA, const bf16* XB, int m) { return m < X_SPLIT ? XA + (size_t)m * DM : XB + (size_t)(m - X_SPLIT) * DM; }
__device__ __forceinline__ void unpack16(const v4u a, const v4u b, float (&v)[16]) {
    const unsigned w[8] = {a.x, a.y, a.z, a.w, b.x, b.y, b.z, b.w};
#pragma unroll
    for (int e = 0; e < 8; ++e) { v[2 * e] = bflo(w[e]); v[2 * e + 1] = bfhi(w[e]); }
}
__device__ __forceinline__ void norm_mod_pass_bf(Frame& F, const bf16* XA, const bf16* XB, const float* g, const float* mod  , int shift_off, int scale_off, bf16* H) {
    const int gw = F.vcu * NWAVES + F.wave, NGW = F.G * NWAVES;
    for (int m = gw; m < T_ALL; m += NGW) {
        const v4u* xp = (const v4u*)(xrow_bf(XA, XB, m) + F.lane * 8);
        const int midx = m < T_CTX ? 4 : ((m - T_CTX) >> 12);
        const float* mv = mod + (size_t)midx * 6144;
        float v[16]; unpack16(xp[0], xp[64], v);
        float s = 0.f;
#pragma unroll
        for (int e = 0; e < 16; ++e) s += v[e] * v[e];
        const float rstd = 1.0f / sqrtf(wave_sum(s) * (1.0f / DM) + EPSN);
        unsigned ow[8];
#pragma unroll
        for (int q = 0; q < 4; ++q) {
            const int c = 8 * F.lane + (q >> 1) * 512 + (q & 1) * 4;
            const f32x4 gg = *(const f32x4*)(g + c), sc = *(const f32x4*)(mv + scale_off + c), sh = *(const f32x4*)(mv + shift_off + c);
            const float o0 = (v[4 * q] * rstd) * gg[0] * (sc[0] + 1.0f) + sh[0], o1 = (v[4 * q + 1] * rstd) * gg[1] * (sc[1] + 1.0f) + sh[1];
            const float o2 = (v[4 * q + 2] * rstd) * gg[2] * (sc[2] + 1.0f) + sh[2], o3 = (v[4 * q + 3] * rstd) * gg[3] * (sc[3] + 1.0f) + sh[3];
            ow[2 * q] = pk2(o0, o1); ow[2 * q + 1] = pk2(o2, o3);
        }
        v4u* hp = (v4u*)(H + (size_t)m * DM + 8 * F.lane);
        v4u a, b2; a.x = ow[0]; a.y = ow[1]; a.z = ow[2]; a.w = ow[3]; b2.x = ow[4]; b2.y = ow[5]; b2.z = ow[6]; b2.w = ow[7];
        hp[0] = a; hp[64] = b2;
    }
}
__device__ __forceinline__ void final_norm_pass(Frame& F, const bf16* XA, const bf16* XB, float* Y, const float* g, int m_lo, int m_hi) {
    const int gw = F.vcu * NWAVES + F.wave, NGW = F.G * NWAVES;
    for (int m = m_lo + gw; m < m_hi; m += NGW) {
        const v4u* xp = (const v4u*)(xrow_bf(XA, XB, m) + F.lane * 8);
        float v[16]; unpack16(xp[0], xp[64], v);
        float s = 0.f;
#pragma unroll
        for (int e = 0; e < 16; ++e) s += v[e] * v[e];
        const float rstd = 1.0f / sqrtf(wave_sum(s) * (1.0f / DM) + EPSN);
#pragma unroll
        for (int q = 0; q < 4; ++q) { const int c = 8 * F.lane + (q >> 1) * 512 + (q & 1) * 4; const f32x4 gg = *(const f32x4*)(g + c);
            f32x4 o; o[0] = v[4 * q] * rstd * gg[0]; o[1] = v[4 * q + 1] * rstd * gg[1]; o[2] = v[4 * q + 2] * rstd * gg[2]; o[3] = v[4 * q + 3] * rstd * gg[3];
            *(f32x4*)(Y + (size_t)m * DM + c) = o; }
    }
}

constexpr float ATT_THR = 8.0f;
constexpr int AT_K0 = 0, AT_K1 = 9216;
constexpr int AT_V0 = 18432, AT_V1 = 38912;
constexpr int AT_WS = 59392;
constexpr int AT_O1 = 61440;
static_assert(AT_O1 + 65536 <= MISC_OFF, "attention LDS map");
__device__ __forceinline__ int crow(int r, int hi) { return (r & 3) + 8 * (r >> 2) + 4 * hi; }
__device__ __forceinline__ unsigned cvtpk_s(float lo, float hi) { typedef __bf16 bf16x2_t __attribute__((ext_vector_type(2))); f32x2 v = {lo, hi}; bf16x2_t b = __builtin_convertvector(v, bf16x2_t); return __builtin_bit_cast(unsigned, b); }
__device__ __forceinline__ s16x4 vtr(const LAS unsigned char* p) { typedef short v4i16_t __attribute__((ext_vector_type(4))); return __builtin_bit_cast(s16x4, __builtin_amdgcn_ds_read_tr16_b64_v4i16((LAS v4i16_t*)p)); }

struct AttnSrc {
    const bf16* K0; const bf16* V0; int ld0, n0;
    const bf16* K1; const bf16* V1; int ld1, t_lo, t_hi;
};
template <int DV, bool WINDOW>
__device__ __forceinline__ void attn_pass(Frame& F, const bf16* Q, int ldq, const AttnSrc& S, int qpos0, float m_init, float l_init, bool start_exact, f32x16 (&o)[DV / 32], float& m_out, float& l_out) {
    constexpr int RSV = DV == 128 ? 320 : 192, NVL = DV / 64;
    LAS unsigned char* lds = F.lds;
    const int tid = F.tid, lane = F.lane, wid = F.wave, r32 = lane & 31, hi = lane >> 5;
    LAS float* wsf = (LAS float*)(lds + AT_WS) + wid * 64;
    bf16x8 qr[4];
    { const bf16* qp = Q + (size_t)(wid * 32 + r32) * ldq + hi * 8;
#pragma unroll
      for (int d0 = 0; d0 < 4; ++d0) qr[d0] = *(const bf16x8*)(qp + d0 * 16); }
#pragma unroll
    for (int d = 0; d < DV / 32; ++d) o[d] = f32x16{};
    float m = m_init, l = l_init;
    f32x16 negm;
#pragma unroll
    for (int r = 0; r < 16; ++r) negm[r] = -m_init;
    const int nt = S.n0 + (S.t_hi - S.t_lo);
    v4u kreg, vreg[NVL];
    const int krow = tid >> 3, kch = tid & 7;
#define AT_ISSUE(it_) do { const int it__ = (it_); const bf16* Kp; const bf16* Vp; int ld; \
        if (it__ < S.n0) { Kp = S.K0 + (size_t)(it__ * 64) * S.ld0; Vp = S.V0 + (size_t)(it__ * 64) * S.ld0; ld = S.ld0; } \
        else { const int t = S.t_lo + it__ - S.n0; Kp = S.K1 + (size_t)(t * 64) * S.ld1; Vp = S.V1 + (size_t)(t * 64) * S.ld1; ld = S.ld1; } \
        kreg = *(const v4u*)(Kp + (size_t)krow * ld + kch * 8); \
        if (DV == 128) { _Pragma("unroll") for (int i = 0; i < NVL; ++i) { const int idx = tid + 512 * i; vreg[i] = *(const v4u*)(Vp + (size_t)(idx >> 4) * ld + (idx & 15) * 8); } } \
        else vreg[0] = *(const v4u*)(Vp + (size_t)krow * ld + kch * 8); } while (0)
#define AT_COMMIT(buf_) do { const int kb_ = (buf_) ? AT_K1 : AT_K0, vb_ = (buf_) ? AT_V1 : AT_V0; \
        *(LAS v4u*)(lds + kb_ + krow * 144 + kch * 16) = kreg; \
        if (DV == 128) { _Pragma("unroll") for (int i = 0; i < NVL; ++i) { const int idx = tid + 512 * i; *(LAS v4u*)(lds + vb_ + (idx >> 4) * RSV + (idx & 15) * 16) = vreg[i]; } } \
        else *(LAS v4u*)(lds + vb_ + krow * RSV + kch * 16) = vreg[0]; } while (0)
    const int koff = r32 * 144 + hi * 16;
    const int voff = (4 * hi + ((lane & 15) >> 2)) * RSV + ((lane >> 4) & 1) * 32 + (lane & 3) * 8;
    const int qw0 = qpos0 + 32 * wid;
    if (wid >= 4) __builtin_amdgcn_s_setprio(1);
    __syncthreads();
    AT_ISSUE(0); AT_COMMIT(0);
    if (nt > 1) AT_ISSUE(1);
#pragma unroll 1
    for (int it = 0; it < nt; ++it) {
        __syncthreads();
        const LAS unsigned char* kbase = lds + ((it & 1) ? AT_K1 : AT_K0) + koff;
        const LAS unsigned char* vbase = lds + ((it & 1) ? AT_V1 : AT_V0) + voff;
        bool skip = false, need_mask = false;
        int kp0 = 0;
        if (WINDOW && it >= S.n0) {
            kp0 = (S.t_lo + it - S.n0) * 64;
            skip = (kp0 + 63 < qw0 - 128 || kp0 > qw0 + 31 + 128);
            need_mask = !(kp0 >= qw0 + 31 - 128 && kp0 + 63 <= qw0 + 128);
        }
        if (!skip) {
            f32x16 p0, p1;
#pragma unroll
            for (int d0 = 0; d0 < 4; ++d0) {
                const bf16x8 k0 = *(const LAS bf16x8*)(kbase + d0 * 32);
                const bf16x8 k1 = *(const LAS bf16x8*)(kbase + 32 * 144 + d0 * 32);
                if (d0 == 0) { p0 = __builtin_amdgcn_mfma_f32_32x32x16_bf16(k0, qr[0], negm, 0, 0, 0); p1 = __builtin_amdgcn_mfma_f32_32x32x16_bf16(k1, qr[0], negm, 0, 0, 0); }
                else { p0 = __builtin_amdgcn_mfma_f32_32x32x16_bf16(k0, qr[d0], p0, 0, 0, 0); p1 = __builtin_amdgcn_mfma_f32_32x32x16_bf16(k1, qr[d0], p1, 0, 0, 0); }
            }
            if (WINDOW && need_mask) {
                const int q = qw0 + r32;
#pragma unroll
                for (int r = 0; r < 16; ++r) { const int kv = kp0 + crow(r, hi); int d0 = q - kv; d0 = d0 < 0 ? -d0 : d0; int d1 = q - kv - 32; d1 = d1 < 0 ? -d1 : d1;
                    if (d0 > 128) p0[r] = -1e30f; if (d1 > 128) p1[r] = -1e30f; }
            }
            float rm = fmaxf(p0[0], p1[0]);
#pragma unroll
            for (int r = 1; r < 16; ++r) rm = fmaxf(fmaxf(rm, p0[r]), p1[r]);
            const bool exact = start_exact && it == 0;
            if (exact || __any(rm > ATT_THR)) {
                rm = fmaxf(rm, __shfl_xor(rm, 32));
                const float dl = exact ? rm : fmaxf(rm, 0.f);
                m += dl;
#pragma unroll
                for (int r = 0; r < 16; ++r) { p0[r] -= dl; p1[r] -= dl; negm[r] = -m; }
                const float alpha = exact ? 1.0f : __builtin_amdgcn_exp2f(-dl);
                l *= alpha;
                if (hi == 0) wsf[r32] = alpha;
                asm volatile("s_waitcnt lgkmcnt(0)" ::: "memory");
#pragma unroll
                for (int r = 0; r < 16; ++r) { const float a = wsf[crow(r, hi)];
#pragma unroll
                    for (int d = 0; d < DV / 32; ++d) o[d][r] *= a; }
            }
            float ps = 0.f;
            bf16x8 pa[4];
#define AT_ECHUNK(P_, B_, c_) do { v4u w_; \
                _Pragma("unroll") for (int j = 0; j < 4; ++j) { const float e0 = __builtin_amdgcn_exp2f(P_[(B_) + 2 * j]), e1 = __builtin_amdgcn_exp2f(P_[(B_) + 2 * j + 1]); \
                    ps += e0 + e1; w_[j] = cvtpk_s(e0, e1); } \
                pa[c_] = __builtin_bit_cast(bf16x8, w_); } while (0)
#define AT_PVSTEP(s_) do { _Pragma("unroll") for (int d = 0; d < DV / 32; ++d) { \
                const s16x4 lo = vtr(vbase + (16 * (s_)) * RSV + d * 64); const s16x4 hh = vtr(vbase + (16 * (s_) + 8) * RSV + d * 64); \
                const bf16x8 vf = (bf16x8){lo[0], lo[1], lo[2], lo[3], hh[0], hh[1], hh[2], hh[3]}; \
                o[d] = __builtin_amdgcn_mfma_f32_32x32x16_bf16(pa[s_], vf, o[d], 0, 0, 0); } } while (0)
            AT_ECHUNK(p0, 0, 0);
            AT_ECHUNK(p0, 8, 1); AT_PVSTEP(0);
            AT_ECHUNK(p1, 0, 2); AT_PVSTEP(1);
            AT_ECHUNK(p1, 8, 3); AT_PVSTEP(2);
            AT_PVSTEP(3);
            l += ps;
#undef AT_ECHUNK
#undef AT_PVSTEP
        }
        if (it + 1 < nt) { AT_COMMIT((it + 1) & 1); if (it + 2 < nt) AT_ISSUE(it + 2); }
    }
#undef AT_ISSUE
#undef AT_COMMIT
    __builtin_amdgcn_s_setprio(0);
    m_out = m; l_out = l;
}
__device__ __forceinline__ void row_recip(Frame& F, float l, float (&rli)[16]) {
    LAS float* wsf = (LAS float*)(F.lds + AT_WS) + F.wave * 64;
    const int r32 = F.lane & 31, hi = F.lane >> 5;
    l += __shfl_xor(l, 32);
    asm volatile("s_waitcnt lgkmcnt(0)" ::: "memory");
    if (hi == 0) wsf[r32] = 1.0f / l;
    asm volatile("s_waitcnt lgkmcnt(0)" ::: "memory");
#pragma unroll
    for (int r = 0; r < 16; ++r) rli[r] = wsf[crow(r, hi)];
    asm volatile("s_waitcnt lgkmcnt(0)" ::: "memory");
}
template <bool WINDOW>
__device__ __forceinline__ void attn_a_unit(Frame& F, const bf16* QKV, size_t row0, int h, const AttnSrc& S, int qpos0, float sink, bf16* OM) {
    f32x16 o[2]; float m, l;
    attn_pass<64, WINDOW>(F, QKV + row0 * QKV_LD + QA_OFF + h * 64, QKV_LD, S, qpos0, sink * 1.4426950408889634f, (F.lane >> 5) == 0 ? 1.0f : 0.0f, false, o, m, l);
    float rli[16]; row_recip(F, l, rli);
    const int r32 = F.lane & 31, hi = F.lane >> 5;
    bf16* op = OM + (row0 + F.wave * 32) * DM + h * 64 + r32;
#pragma unroll
    for (int r = 0; r < 16; ++r)
#pragma unroll
        for (int d = 0; d < 2; ++d) op[(size_t)crow(r, hi) * DM + d * 32] = (bf16)f2bf(o[d][r] * rli[r]);
}
__device__ __forceinline__ void attn_b_unit(Frame& F, const bf16* QKV, size_t row0, int h, AttnSrc S, float lam, const float* subln, bf16* OM) {
    f32x16 o[4]; float m, l; float rli[16];
    const bf16* K0 = S.K0; const bf16* K1 = S.K1;
    const int r32 = F.lane & 31, hi = F.lane >> 5;
    LAS unsigned* o1s = (LAS unsigned*)(F.lds + AT_O1) + F.wave * 2048 + F.lane;
    attn_pass<128, false>(F, QKV + row0 * QKV_LD + QB_OFF + h * 128, QKV_LD, S, 0, 0.f, 0.f, true, o, m, l);
    row_recip(F, l, rli);
#pragma unroll
    for (int d = 0; d < 4; ++d)
#pragma unroll
        for (int r = 0; r < 8; ++r) o1s[(d * 8 + r) * 64] = cvtpk_s(o[d][2 * r] * rli[2 * r], o[d][2 * r + 1] * rli[2 * r + 1]);
    S.K0 = K0 + 64; S.K1 = K1 + 64;
    attn_pass<128, false>(F, QKV + row0 * QKV_LD + QB_OFF + h * 128 + 64, QKV_LD, S, 0, 0.f, 0.f, true, o, m, l);
    row_recip(F, l, rli);
    float ss[16];
#pragma unroll
    for (int r = 0; r < 16; ++r) { float s = 0.f;
#pragma unroll
        for (int d = 0; d < 4; ++d) { const unsigned w = o1s[(d * 8 + (r >> 1)) * 64]; const float o1 = (r & 1) ? bfhi(w) : bflo(w); const float v = o1 - lam * (o[d][r] * rli[r]); o[d][r] = v; s += v * v; }
        ss[r] = s; }
#pragma unroll
    for (int r = 0; r < 16; ++r) { float s = ss[r];
#pragma unroll
        for (int x = 1; x < 32; x <<= 1) s += __shfl_xor(s, x);
        ss[r] = 0.8f / sqrtf(s * (1.0f / 128.0f) + EPSN); }
    float gs[4];
#pragma unroll
    for (int d = 0; d < 4; ++d) gs[d] = subln[d * 32 + r32];
    bf16* op = OM + (row0 + F.wave * 32) * DM + 512 + h * 128 + r32;
#pragma unroll
    for (int r = 0; r < 16; ++r)
#pragma unroll
        for (int d = 0; d < 4; ++d) op[(size_t)crow(r, hi) * DM + d * 32] = (bf16)f2bf(o[d][r] * ss[r] * gs[d]);
}
__device__ __forceinline__ void attention_phase(Frame& F) {
    const bf16* QKV = WSP(bf16, WS_BIG); bf16* OM = WSP(bf16, WS_H);
    const float lam = WSP(float, WS_LAM)[0];
    const float* sinkp = F.in[IN_SINK]; const float* subln = F.in[IN_SUBLN];
    for (int u = F.vcu; u < 256; u += F.G) {
        const int b = u >> 6, h = (u >> 4) & 3, qb = u & 15;
        const size_t seq0 = T_CTX + (size_t)b * LAT_SEQ;
        AttnSrc S; S.K0 = WSP(bf16, WS_CBK) + (size_t)b * 256 * 512 + h * 128; S.V0 = WSP(bf16, WS_CBV) + (size_t)b * 256 * 512 + h * 128; S.ld0 = 512; S.n0 = 4;
        S.K1 = QKV + seq0 * QKV_LD + KB_OFF + h * 128; S.V1 = QKV + seq0 * QKV_LD + VB_OFF + h * 128; S.ld1 = QKV_LD; S.t_lo = 0; S.t_hi = 64;
        attn_b_unit(F, QKV, seq0 + qb * 256, h, S, lam, subln, OM);
    }
    for (int u = F.vcu; u < 512; u += F.G) {
        const int b = u >> 7, h = (u >> 4) & 7, qb = u & 15, kvh = h >> 2;
        const size_t seq0 = T_CTX + (size_t)b * LAT_SEQ;
        AttnSrc S; S.K0 = WSP(bf16, WS_CAK) + (size_t)b * 256 * 128 + kvh * 64; S.V0 = WSP(bf16, WS_CAV) + (size_t)b * 256 * 128 + kvh * 64; S.ld0 = 128; S.n0 = 4;
        S.K1 = QKV + seq0 * QKV_LD + KA_OFF + kvh * 64; S.V1 = QKV + seq0 * QKV_LD + VA_OFF + kvh * 64; S.ld1 = QKV_LD;
        S.t_lo = 4 * qb - 2 < 0 ? 0 : 4 * qb - 2; S.t_hi = 4 * qb + 6 > 64 ? 64 : 4 * qb + 6;
        attn_a_unit<true>(F, QKV, seq0 + qb * 256, h, S, qb * 256, sinkp[h], OM);
    }
    for (int u = F.vcu; u < 256; u += F.G) {
        const int b = u >> 3, h = u & 7, kvh = h >> 2;
        const size_t seq0 = (size_t)b * CTX_SEQ;
        AttnSrc S; S.K0 = nullptr; S.V0 = nullptr; S.ld0 = 0; S.n0 = 0;
        S.K1 = QKV + seq0 * QKV_LD + KA_OFF + kvh * 64; S.V1 = QKV + seq0 * QKV_LD + VA_OFF + kvh * 64; S.ld1 = QKV_LD; S.t_lo = 0; S.t_hi = 4;
        attn_a_unit<false>(F, QKV, seq0, h, S, 0, sinkp[h], OM);
    }
    for (int u = F.vcu; u < 128; u += F.G) {
        const int b = u >> 2, h = u & 3;
        const size_t seq0 = (size_t)b * CTX_SEQ;
        AttnSrc S; S.K0 = nullptr; S.V0 = nullptr; S.ld0 = 0; S.n0 = 0;
        S.K1 = QKV + seq0 * QKV_LD + KB_OFF + h * 128; S.V1 = QKV + seq0 * QKV_LD + VB_OFF + h * 128; S.ld1 = QKV_LD; S.t_lo = 0; S.t_hi = 4;
        attn_b_unit(F, QKV, seq0, h, S, lam, subln, OM);
    }
}

constexpr int SC_XC = 0;
constexpr int SC_AUF = 17408;
constexpr int SC_AUB = 17408 + 65536;
constexpr int SC_CW = 17408 + 131072;
static_assert(SC_CW + 2560 <= MISC_OFF, "scan LDS map");
#ifndef DUP_EPI
#define DUP_EPI 1
#endif
#ifndef DUP_SCAN
#define DUP_SCAN 1
#endif
#ifndef DUP_CONV
#define DUP_CONV 1
#endif
constexpr int SCAN_UNITS = 3840;
__device__ __forceinline__ void scan_pass(Frame& F) {
    LAS unsigned char* lds = F.lds;
    const int tid = F.tid, lane = F.lane, wid = F.wave, r32 = lane & 31, hi = lane >> 5;
    bf16* XR = WSP(bf16, WS_BIG) + (size_t)T_ALL * DRNN; bf16* GG = WSP(bf16, WS_BIG); bf16* ABG = (bf16*)F.out;
    const bf16* HALO = WSP(bf16, WS_BIG + 136 * MiB);
    f32x2* SUM = WSP(f32x2, WS_H);
    const int wdir = wid >> 2, cb = wid & 3, chl = cb * 32 + r32;
    const int tk = tid >> 3, cg = tid & 7;
    LAS float* CW = (LAS float*)(lds + SC_CW);
    const int per = (SCAN_UNITS + F.G - 1) / F.G, u_lo = F.vcu * per, u_hi = (u_lo + per) < SCAN_UNITS ? (u_lo + per) : SCAN_UNITS;
    int n_cur = -1;
    v4u xr[8];
    bf16x8 wa[8], wx[8]; float ba = 0.f, bx = 0.f, sp8 = 0.f;
#define SC_DECODE(u_) const int n = (u_) / 384, cidx = (u_) % 384; const bool isctx = cidx < 128; const int b = isctx ? (cidx >> 2) : ((cidx - 128) >> 6); const int c = isctx ? (cidx & 3) : ((cidx - 128) & 63); \
        const size_t seq0 = isctx ? (size_t)b * CTX_SEQ : (size_t)T_CTX + (size_t)b * LAT_SEQ; const int seq_len = isctx ? CTX_SEQ : LAT_SEQ, t0 = c * 64;
#define SC_LOADX(u_) do { SC_DECODE(u_) (void)b; (void)seq_len; \
        _Pragma("unroll") for (int j = 0; j < 4; ++j) { const int tl = tk - 1 + j; \
            const bf16* src = tl < 0 ? HALO + (size_t)((cidx > 0 ? cidx - 1 : 0) * 3 + 0) * DRNN : (tl >= 64 ? HALO + (size_t)((cidx < 383 ? cidx + 1 : 383) * 3 + 1 + (tl - 64)) * DRNN : XR + (seq0 + t0 + tl) * DRNN); \
            const v4u* p = (const v4u*)(src + n * 128 + cg * 8); xr[2 * j] = p[0]; xr[2 * j + 1] = p[8]; } } while (0)
    if (u_lo < u_hi) SC_LOADX(u_lo);
#pragma unroll 1
    for (int u = u_lo; u < u_hi; ++u) {
        SC_DECODE(u)
        (void)b;
        if (n != n_cur) {
            __syncthreads();
            for (int i = tid; i < 640; i += NTHREADS) CW[i] = i < 512 ? F.in[IN_RCONVW][(i >> 7) * DRNN + n * 128 + (i & 127)] : F.in[IN_RCONVB][n * 128 + (i & 127)];
            n_cur = n;
            { const bf16* wap = WSP(bf16, WS_WG) + (size_t)((0 * 2 + wdir) * 10 + n) * 16384 + (size_t)chl * 128 + hi * 8;
              const bf16* wxp = WSP(bf16, WS_WG) + (size_t)((1 * 2 + wdir) * 10 + n) * 16384 + (size_t)chl * 128 + hi * 8;
#pragma unroll
              for (int ks = 0; ks < 8; ++ks) { wa[ks] = *(const bf16x8*)(wap + ks * 16); wx[ks] = *(const bf16x8*)(wxp + ks * 16); } }
            ba = F.in[IN_RBA][wdir * DRNN + n * 128 + chl] * -1.4426950408889634f; bx = F.in[IN_RBX][wdir * DRNN + n * 128 + chl] * -1.4426950408889634f;
            { const float lamv = F.in[IN_RLAM][wdir * DRNN + n * 128 + chl]; sp8 = -8.0f * (lamv > 20.f ? __expf(-lamv) : log1pf(__expf(-lamv))); }
            __syncthreads();
        }
        { float a[16];
#pragma unroll
          for (int e = 0; e < 16; ++e) a[e] = CW[512 + (e >> 3) * 64 + cg * 8 + (e & 7)];
#pragma unroll
          for (int j = 0; j < 4; ++j) { const int t = t0 + tk - 1 + j; const float msk = (t >= 0 && t < seq_len) ? 1.0f : 0.0f;
              const unsigned w[8] = {xr[2 * j].x, xr[2 * j].y, xr[2 * j].z, xr[2 * j].w, xr[2 * j + 1].x, xr[2 * j + 1].y, xr[2 * j + 1].z, xr[2 * j + 1].w};
#pragma unroll
              for (int e = 0; e < 8; ++e) { const int c0 = (e >> 2) * 64 + cg * 8 + 2 * (e & 3); a[2 * e] += (CW[j * 128 + c0] * msk) * bflo(w[e]); a[2 * e + 1] += (CW[j * 128 + c0 + 1] * msk) * bfhi(w[e]); } }
          v4u o0, o1; o0.x = pk2(a[0], a[1]); o0.y = pk2(a[2], a[3]); o0.z = pk2(a[4], a[5]); o0.w = pk2(a[6], a[7]); o1.x = pk2(a[8], a[9]); o1.y = pk2(a[10], a[11]); o1.z = pk2(a[12], a[13]); o1.w = pk2(a[14], a[15]);
          LAS v4u* xp = (LAS v4u*)(lds + SC_XC + tk * 272 + cg * 16); xp[0] = o0; xp[8] = o1; }
        __syncthreads();
        if (u + 1 < u_hi) SC_LOADX(u + 1);
        { LAS f32x2* AU = (LAS f32x2*)(lds + (wdir ? SC_AUB : SC_AUF));
#pragma unroll 1
          for (int rb = 0; rb < 2; ++rb) {
            f32x16 ra, ia;
#pragma unroll
            for (int r = 0; r < 16; ++r) { ra[r] = ba; ia[r] = bx; }
            { const LAS unsigned char* ap = lds + SC_XC + (rb * 32 + r32) * 272 + hi * 16;
#pragma unroll
              for (int ks = 0; ks < 8; ++ks) { const bf16x8 af = *(const LAS bf16x8*)(ap + ks * 32);
                  ra = __builtin_amdgcn_mfma_f32_32x32x16_bf16(af, wa[ks], ra, 0, 0, 0);
                  ia = __builtin_amdgcn_mfma_f32_32x32x16_bf16(af, wx[ks], ia, 0, 0, 0); } }
#pragma unroll
            for (int r = 0; r < 16; ++r) {
                const int row = rb * 32 + crow(r, hi);
                const float rr = __builtin_amdgcn_rcpf(1.0f + __builtin_amdgcn_exp2f(ra[r]));
                const float ii = __builtin_amdgcn_rcpf(1.0f + __builtin_amdgcn_exp2f(ia[r]));
                const float x = sp8 * rr;
                const float em = -x * (1.0f + x * (0.5f + x * (0.16666667f + x * (0.041666668f + x * 0.0083333338f))));
                const float av = 1.0f - em;
                const float om = __builtin_fmaf(em, av, em);
                const float xv = bf2f(*(const LAS unsigned short*)(lds + SC_XC + row * 272 + chl * 2));
                AU[row * 128 + chl] = (f32x2){av, __builtin_amdgcn_sqrtf(om) * ii * xv};
            }
          } }
        __syncthreads();
        if (tid >= 256) {
            const int sch = tid & 127, sd = (tid >> 7) & 1;
            LAS f32x2* AU = (LAS f32x2*)(lds + (sd ? SC_AUB : SC_AUF)) + sch;
            float h = 0.f, pprod = 1.0f;
            f32x2 auA[8], auB[8];
#define SC_LD(dst, s0_) do { _Pragma("unroll") for (int j = 0; j < 8; ++j) { const int row = sd == 0 ? (s0_) + j : 63 - (s0_) - j; dst[j] = AU[row * 128]; } } while (0)
#define SC_RUN(src, s0_) do { _Pragma("unroll") for (int j = 0; j < 8; ++j) { const int row = sd == 0 ? (s0_) + j : 63 - (s0_) - j; h = src[j].x * h + src[j].y; pprod *= src[j].x; AU[row * 128] = (f32x2){h, pprod}; } } while (0)
            SC_LD(auA, 0);
#pragma unroll 1
            for (int s0 = 0; s0 < 64; s0 += 16) {
                SC_LD(auB, s0 + 8);
                SC_RUN(auA, s0);
                if (s0 + 16 < 64) SC_LD(auA, s0 + 16);
                SC_RUN(auB, s0 + 8);
            }
#undef SC_LD
#undef SC_RUN
            SUM[(size_t)cidx * 2 * DRNN + sd * DRNN + n * 128 + sch] = (f32x2){pprod, h};
        }
        __syncthreads();
        {
            const LAS f32x4* hfp = (const LAS f32x4*)(lds + SC_AUF) + lane; const LAS f32x4* hbp = (const LAS f32x4*)(lds + SC_AUB) + lane;
            const size_t eoff = (seq0 + t0 + wid * 8) * DRNN + n * 128;
            unsigned* gp = (unsigned*)(GG + eoff) + lane; unsigned* fp = (unsigned*)(XR + eoff) + lane; unsigned* bp = (unsigned*)(ABG + eoff) + lane;
            unsigned gw[8];
#pragma unroll
            for (int i = 0; i < 8; ++i) gw[i] = gp[(size_t)i * (DRNN / 2)];
#pragma unroll
            for (int i = 0; i < 8; ++i) {
                const f32x4 hf = hfp[(wid * 8 + i) * 64], hb = hbp[(wid * 8 + i) * 64];
                const float g0 = bflo(gw[i]), g1 = bfhi(gw[i]);
                gp[(size_t)i * (DRNN / 2)] = pk2((hf[0] + hb[0]) * g0, (hf[2] + hb[2]) * g1);
                fp[(size_t)i * (DRNN / 2)] = pk2(hf[1] * g0, hf[3] * g1);
                bp[(size_t)i * (DRNN / 2)] = pk2(hb[1] * g0, hb[3] * g1);
            }
        }
        __syncthreads();
    }
#undef SC_DECODE
#undef SC_LOADX
}
__device__ __forceinline__ void scan_correct_phase(Frame& F) {
    bf16* GG = WSP(bf16, WS_BIG); const bf16* XR = WSP(bf16, WS_BIG) + (size_t)T_ALL * DRNN; const bf16* ABG = (const bf16*)F.out;
    const float* CAR = WSP(float, WS_H + 8 * MiB);
    const int gt = F.vcu * NTHREADS + F.tid, NGT = F.G * NTHREADS;
    for (int i = gt; i < T_ALL * (DRNN / 8); i += NGT) {
        const int row = i / (DRNN / 8), c8 = (i % (DRNN / 8)) * 8;
        const size_t off = (size_t)row * DRNN + c8;
        const v4u yl = *(const v4u*)(GG + off), af = *(const v4u*)(XR + off), ab = *(const v4u*)(ABG + off);
        const float* cf = CAR + (size_t)(row >> 6) * 2 * DRNN + c8; const float* cbp = cf + DRNN;
        const f32x4 f0 = *(const f32x4*)cf, f1 = *(const f32x4*)(cf + 4), b0 = *(const f32x4*)cbp, b1 = *(const f32x4*)(cbp + 4);
        const unsigned wy[4] = {yl.x, yl.y, yl.z, yl.w}, wf[4] = {af.x, af.y, af.z, af.w}, wb[4] = {ab.x, ab.y, ab.z, ab.w};
        const float cfv[8] = {f0[0], f0[1], f0[2], f0[3], f1[0], f1[1], f1[2], f1[3]}, cbv[8] = {b0[0], b0[1], b0[2], b0[3], b1[0], b1[1], b1[2], b1[3]};
        unsigned o[4];
#pragma unroll
        for (int e = 0; e < 4; ++e) o[e] = pk2(bflo(wy[e]) + bflo(wf[e]) * cfv[2 * e] + bflo(wb[e]) * cbv[2 * e], bfhi(wy[e]) + bfhi(wf[e]) * cfv[2 * e + 1] + bfhi(wb[e]) * cbv[2 * e + 1]);
        v4u ov; ov.x = o[0]; ov.y = o[1]; ov.z = o[2]; ov.w = o[3];
        *(v4u*)(GG + off) = ov;
    }
}

__device__ __forceinline__ void scan_carry_phase(Frame& F) {
    const f32x2* SUM = WSP(f32x2, WS_H); float* CAR = WSP(float, WS_H + 8 * MiB);
    const int gt = F.vcu * NTHREADS + F.tid, NGT = F.G * NTHREADS;
    for (int i = gt; i < 10240 + 81920; i += NGT) {
        const bool lat = i < 10240; const int j = lat ? i : i - 10240;
        const int ch = j % DRNN, sd = (j / DRNN) & 1, b = j / (2 * DRNN);
        const int nch = lat ? 64 : 4, cfirst = lat ? 128 + b * 64 : b * 4;
        float h = lat ? F.in[sd ? IN_SB : IN_SF][b * DRNN + ch] : 0.f;
        const f32x2* sp = SUM + (size_t)cfirst * 2 * DRNN + sd * DRNN + ch; float* cp = CAR + (size_t)cfirst * 2 * DRNN + sd * DRNN + ch;
        for (int k0 = 0; k0 < nch; k0 += 4) {
            f32x2 s[4];
#pragma unroll
            for (int q = 0; q < 4; ++q) { const int c = sd == 0 ? k0 + q : nch - 1 - k0 - q; s[q] = sp[(size_t)c * 2 * DRNN]; }
#pragma unroll
            for (int q = 0; q < 4; ++q) { const int c = sd == 0 ? k0 + q : nch - 1 - k0 - q; cp[(size_t)c * 2 * DRNN] = h; h = s[q].x * h + s[q].y; }
        }
        if (!lat) F.out[(sd ? OUT_SB : OUT_SF) + b * DRNN + ch] = h;
    }
}

constexpr int N_PHASES = 23;
__global__ void __launch_bounds__(NTHREADS, 2) fwd_kernel(Args args) {
    extern __shared__ __attribute__((aligned(16))) unsigned char lds_raw[];
    Frame F;
    F.lds = (LAS unsigned char*)lds_raw;
    F.tid = threadIdx.x; F.lane = F.tid & 63; F.wave = __builtin_amdgcn_readfirstlane(F.tid >> 6);
    F.G = gridDim.x; { const int bx = blockIdx.x; F.vcu = (F.G % 8 == 0) ? (bx % 8) * (F.G / 8) + bx / 8 : bx; }
    F.in = args.in; F.out = args.out; F.ws = args.ws;
    volatile LAS unsigned* MISC = (volatile LAS unsigned*)(F.lds + MISC_OFF);
    if (F.tid < 32) MISC[F.tid] = 0u;
    __syncthreads();
    XcdBarrier bar; bar.bar = (unsigned*)(args.ws + WS_CTL) + 1024; bar.x = 0; bar.st = nullptr;
    if (args.use_bar) bar = xcd_barrier_post((unsigned*)(args.ws + WS_CTL) + 1024, MISC + 8);
    const int lo = args.ph_lo, hi = args.ph_hi;
#ifndef PHMASK
#define PHMASK 0x7fffff
#endif
#ifndef REP_PHASE
#define REP_PHASE -1
#endif
#ifndef REP_N
#define REP_N 1
#endif
#define IN(k) (((PHMASK >> (k)) & 1) && lo <= (k) && (k) < hi)
#define REPS(k) for (int rep_ = 0; rep_ < (((k) == REP_PHASE) ? REP_N : 1); ++rep_)
#define SEAM(k) do { if (IN(k) && IN((k) + 1)) xcd_barrier(bar); } while (0)
    bf16* XA = (bf16*)((unsigned char*)F.out + 64 * MiB);
    bf16* XB = WSP(bf16, WS_BIG + 120 * MiB);
    const float* MOD = WSP(float, WS_MOD);
    bf16* H = WSP(bf16, WS_H);
    PG8_LAS unsigned char* ring = (PG8_LAS unsigned char*)lds_raw;

    if (IN(0)) REPS(0) { Frame P = fresh(F); p0_prologue(P); } SEAM(0);
    if (IN(1)) REPS(1) { Frame P = fresh(F); norm_mod_pass(P, F.in[IN_XP], F.in[IN_XS], F.in[IN_NORM1], MOD, 0, 1024, H); } SEAM(1);
    if (IN(2)) REPS(2) {
        pg8::Gemm g{H, WSP(bf16, WS_WIN), T_ALL, QKV_LD, DM}; pg8::StaticOrder S; S.init(T_ALL, QKV_LD, F.G, (int)blockIdx.x);
        pg8::EpiInProj E{WSP(bf16, WS_BIG), F.out, WSP(pg8::f32x2, WS_ROPE)};
        pg8::gemm_phase<pg8::EpiInProj, pg8::StaticOrder, true, true>(ring, g, S, E);
        { const int nfull = (T_ALL / 256) * (QKV_LD / 256) % F.G; Frame P = fresh(F);
          if (nfull == 0) p_deferred_transposes(P, (int)blockIdx.x, F.G); else if ((int)blockIdx.x >= nfull) p_deferred_transposes(P, (int)blockIdx.x - nfull, F.G - nfull); }
    } SEAM(2);
    if (IN(3)) REPS(3) { Frame P = fresh(F); attention_phase(P); } SEAM(3);
    if (IN(4)) REPS(4) {
        pg8::Gemm g{H, WSP(bf16, WS_WOUT), T_ALL, DM, DM}; pg8::StaticOrder S; S.init(T_ALL, DM, F.G, (int)blockIdx.x, 192);
        pg8::EpiRes<true> E{F.in[IN_XP], F.in[IN_XS], XA, XB, MOD + 2048, 0};
        pg8::gemm_phase<pg8::EpiRes<true>, pg8::StaticOrder, true, true, 96>(ring, g, S, E);
    } SEAM(4);
#pragma unroll 1
    for (int layer = 0; layer < 2; ++layer) {
        const int pb = layer == 0 ? 5 : 16;
        const float* MODL = MOD + (size_t)layer * 5 * 6144;
        if (IN(pb)) REPS(pb) { Frame P = fresh(F); norm_mod_pass_bf(P, XA, XB, F.in[IN_NORM2] + layer * DM, MODL, 3072, 4096, H); } SEAM(pb);
#pragma unroll 1
        for (int half = 0; half < 2; ++half) {
            const int row0 = half * (T_ALL / 2);
            if (IN(pb + 1 + 2 * half)) REPS(pb + 1 + 2 * half) {
                pg8::Gemm g{H + (size_t)row0 * DM, WSP(bf16, WS_W1) + (size_t)layer * DFF * DM, T_ALL / 2, DFF, DM}; pg8::StaticOrder S; S.init(T_ALL / 2, DFF, F.G, (int)blockIdx.x);
                pg8::EpiSqRelu E{WSP(bf16, WS_BIG), DFF};
                pg8::gemm_phase<pg8::EpiSqRelu, pg8::StaticOrder, true, true>(ring, g, S, E);
            } SEAM(pb + 1 + 2 * half);
            if (IN(pb + 2 + 2 * half)) REPS(pb + 2 + 2 * half) {
                pg8::Gemm g{WSP(bf16, WS_BIG), WSP(bf16, WS_W2) + (size_t)layer * DM * DFF, T_ALL / 2, DM, DFF}; pg8::StaticOrder S; S.init(T_ALL / 2, DM, F.G, (int)blockIdx.x, 192);
                pg8::EpiRes<false> E{nullptr, nullptr, XA, XB, MODL + 5120, row0};
                pg8::gemm_phase<pg8::EpiRes<false>, pg8::StaticOrder, true, true, 96>(ring, g, S, E);
            } SEAM(pb + 2 + 2 * half);
        }
        if (layer == 0) {
            const float* MOD1 = MOD + 5 * 6144;
            if (IN(10)) REPS(10) { Frame P = fresh(F); norm_mod_pass_bf(P, XA, XB, F.in[IN_NORM1] + DM, MOD1, 0, 1024, H); } SEAM(10);
            if (IN(11)) REPS(11) {
                pg8::Gemm g{H, WSP(bf16, WS_WRIN), T_ALL, 2 * DRNN, DM}; pg8::StaticOrder S; S.init(T_ALL, 2 * DRNN, F.G, (int)blockIdx.x);
                pg8::EpiRecIn E{WSP(bf16, WS_BIG), WSP(bf16, WS_BIG) + (size_t)T_ALL * DRNN, WSP(bf16, WS_BIG + 136 * MiB)};
                pg8::gemm_phase<pg8::EpiRecIn, pg8::StaticOrder, true, true>(ring, g, S, E);
            } SEAM(11);
            if (IN(12)) REPS(12) { Frame P = fresh(F); scan_pass(P); } SEAM(12);
            if (IN(13)) REPS(13) { Frame P = fresh(F); scan_carry_phase(P); } SEAM(13);
            if (IN(14)) REPS(14) { Frame P = fresh(F); scan_correct_phase(P); } SEAM(14);
            if (IN(15)) REPS(15) {
                pg8::Gemm g{WSP(bf16, WS_BIG), WSP(bf16, WS_WROUT), T_ALL, DM, DRNN}; pg8::StaticOrder S; S.init(T_ALL, DM, F.G, (int)blockIdx.x, 192);
                pg8::EpiRes<false> E{nullptr, nullptr, XA, XB, MOD1 + 2048, 0};
                pg8::gemm_phase<pg8::EpiRes<false>, pg8::StaticOrder, true, true, 96>(ring, g, S, E);
            } SEAM(15);
        }
    }
    if (IN(21)) REPS(21) { Frame P = fresh(F); final_norm_pass(P, XA, XB, F.out, F.in[IN_FNORM], 0, X_SPLIT); } SEAM(21);
    if (IN(22)) REPS(22) { Frame P = fresh(F); final_norm_pass(P, XA, XB, F.out, F.in[IN_FNORM], X_SPLIT, T_ALL); }
#undef IN
#undef SEAM
}

#ifndef MK_ONE_LAUNCH
#define MK_ONE_LAUNCH 1
#endif
extern "C" void kernel_launch(void* const* d_in, const int* in_sizes, int n_in, void* d_out, int out_size, void* d_ws, size_t ws_size, hipStream_t stream) {
    static int grid = 0;
    if (grid == 0) {
        if (n_in != 31 || ws_size < WS_END) { fprintf(stderr, "kernel_launch: unexpected n_in %d / ws_size %zu\n", n_in, ws_size); grid = -1; return; }
        int dev = 0, cus = 0, per_cu = 0;
        if (hipGetDevice(&dev) != hipSuccess || hipDeviceGetAttribute(&cus, hipDeviceAttributeMultiprocessorCount, dev) != hipSuccess) { grid = -1; return; }
        if (hipFuncSetAttribute((const void*)fwd_kernel, hipFuncAttributeMaxDynamicSharedMemorySize, LDS_BYTES) != hipSuccess) { fprintf(stderr, "kernel_launch: hipFuncSetAttribute failed\n"); grid = -1; return; }
        if (hipOccupancyMaxActiveBlocksPerMultiprocessor(&per_cu, (const void*)fwd_kernel, NTHREADS, LDS_BYTES) != hipSuccess || per_cu < 1) { fprintf(stderr, "kernel_launch: occupancy query says %d\n", per_cu); (void)hipGetLastError(); grid = -1; return; }
        grid = cus;
    }
    if (grid < 0) return;
    (void)hipMemsetAsync((char*)d_ws + WS_CTL, 0, CTL_ZERO_BYTES, stream);
    Args a{};
    for (int i = 0; i < 31; ++i) a.in[i] = (const float*)d_in[i];
    a.out = (float*)d_out; a.ws = (unsigned char*)d_ws;
#if MK_ONE_LAUNCH
    a.ph_lo = 0; a.ph_hi = N_PHASES; a.use_bar = 1;
    hipLaunchKernelGGL(fwd_kernel, dim3(grid), dim3(NTHREADS), LDS_BYTES, stream, a);
#else
    for (int p = 0; p < N_PHASES; ++p) { a.ph_lo = p; a.ph_hi = p + 1; a.use_bar = 0; hipLaunchKernelGGL(fwd_kernel, dim3(grid), dim3(NTHREADS), LDS_BYTES, stream, a); }
#endif
}
```

```cpp
#include <hip/hip_runtime.h>
#include <cstdio>
#include <cstdint>
#include <cmath>
namespace pg8 {
#define PG8_LAS __attribute__((address_space(3)))
typedef unsigned short bf16_t;
typedef short bf16x8 __attribute__((ext_vector_type(8)));
typedef float f32x4 __attribute__((ext_vector_type(4)));
typedef unsigned u32x4 __attribute__((ext_vector_type(4)));
constexpr int BM = 256, BK = 64, HALF = 128, HTB = HALF * BK * 2  , STAGE_BYTES = 8 * HTB, NXCD = 8, WGM = 8;

__host__ __device__ __forceinline__ int lds_byte(int r, int c) { const int st = (r >> 4) * 2 + (c >> 5), rr = r & 15, cc = c & 31, ob = rr * 64 + cc * 2; return st * 1024 + (ob ^ (((ob >> 9) & 1) << 5)); }
__host__ __device__ __forceinline__ void stage_rc(int b, int& R, int& C) { const int st = b / 1024, sb = b % 1024, swz = sb ^ (((sb >> 9) & 1) << 5); R = (st >> 1) * 16 + swz / 64; C = (st & 1) * 32 + (swz % 64) / 2; }
__host__ __device__ __forceinline__ int perm32(int rho) { const int n = rho >> 4, i = rho & 15; return 8 * (i >> 2) + 4 * n + (i & 3); }

struct Unit { int pm, pn; };
struct Gemm { const bf16_t* A; const bf16_t* Bt; int M, N, K; };

struct StaticOrder {
    int nM, nN, nwg, G, c;
    __host__ __device__ void init(int M, int N, int G_, int c_, int bmr = BM) { nM = M / bmr; nN = N / BM; nwg = nM * nN; G = G_; c = c_; }
    __host__ __device__ bool next(int i, Unit& u) const {
        const long L = (long)i * G + c; if (L >= nwg) return false;
        int wgid = (int)L; { const int q = nwg / NXCD, r = nwg % NXCD, xcd = wgid % NXCD, off = wgid / NXCD; wgid = (xcd < r ? xcd * (q + 1) : r * (q + 1) + (xcd - r) * q) + off; }
        const int nig = WGM * nN, gid = wgid / nig, fm = gid * WGM, gsz = (nM - fm) < WGM ? (nM - fm) : WGM;
        u.pm = fm + ((wgid % nig) % gsz); u.pn = (wgid % nig) / gsz; return true;
    }
    __device__ __forceinline__ void a_ready(const Unit&) const {}
    __device__ __forceinline__ void done(const Unit&) const {}
};

__device__ __forceinline__ unsigned cvt_pk_bf16(float lo, float hi) { unsigned r; asm volatile("v_cvt_pk_bf16_f32 %0, %1, %2" : "=v"(r) : "v"(lo), "v"(hi)); return r; }
typedef float f32x2 __attribute__((ext_vector_type(2)));
typedef unsigned u32x2 __attribute__((ext_vector_type(2)));
constexpr int T_CTX = 8192, QKV_LD = 2304;
constexpr float QSCALE = 0.125f * 1.4426950408889634f;
struct EpiInProj {
    static constexpr bool PERM = true, AFTER_DRAIN = false;
    bf16_t* QKV; float* out; const f32x2* rope;
    template <int MR> __device__ __forceinline__ void operator()(const f32x4 (&acc)[2][2][MR][2], const Unit& u, int wr, int wc, int fr, int fq) const {
        constexpr int HRr = MR * 32, BMR = 2 * HRr, WRO = HRr / 2;
        const bool hi_half = fq >= 2;
#pragma unroll
        for (int bj = 0; bj < 2; ++bj) {
            const int colbase = u.pn * BM + bj * HALF + wc * 32;
            const bool rope_col = (colbase < 640 || (colbase >= 768 && colbase < 1792));
            const bool q_col = (colbase < 512 || (colbase >= 768 && colbase < 1280));
            long ooff = -1; int ow = 0, cs = 0;
            if (colbase >= 512 && colbase < 640) { ooff = 25165824; ow = 128; cs = 512; }
            else if (colbase >= 640 && colbase < 768) { ooff = 26214400; ow = 128; cs = 640; }
            else if (colbase >= 1280 && colbase < 1792) { ooff = 27262976; ow = 512; cs = 1280; }
            else if (colbase >= 1792) { ooff = 31457280; ow = 512; cs = 1792; }
#pragma unroll
            for (int ai = 0; ai < 2; ++ai)
#pragma unroll
                for (int m = 0; m < MR; ++m) {
                    const int rowg = u.pm * BMR + ai * HRr + wr * WRO + m * 16;
                    const bool lat = rowg >= T_CTX;
                    const int row = rowg + fr;
                    f32x4 v[2] = {acc[ai][bj][m][0], acc[ai][bj][m][1]};
                    if (rope_col && lat) {
                        const int t = (row - T_CTX) & 4095;
                        const int pos = (wc & 1) ? (t & 63) : (t >> 6);
                        const f32x4* rp = (const f32x4*)(rope + pos * 16 + 8 * (fq & 1));
#pragma unroll
                        for (int n = 0; n < 2; ++n) {
                            const f32x4 c01 = rp[2 * n], c23 = rp[2 * n + 1];
                            const float cs_[4] = {c01[0], c01[2], c23[0], c23[2]}, sn_[4] = {c01[1], c01[3], c23[1], c23[3]};
#pragma unroll
                            for (int e = 0; e < 4; ++e) {
                                const float p = __shfl_xor(v[n][e], 32);
                                v[n][e] = hi_half ? (p * sn_[e] + v[n][e] * cs_[e]) : (v[n][e] * cs_[e] - p * sn_[e]);
                            }
                        }
                    }
                    if (q_col) { v[0] = v[0] * QSCALE; v[1] = v[1] * QSCALE; }
                    bf16_t* qp = QKV + (size_t)row * QKV_LD + colbase + 8 * fq;
                    u32x4 w; w.x = cvt_pk_bf16(v[0][0], v[0][1]); w.y = cvt_pk_bf16(v[0][2], v[0][3]); w.z = cvt_pk_bf16(v[1][0], v[1][1]); w.w = cvt_pk_bf16(v[1][2], v[1][3]);
                    *(u32x4*)qp = w;
                    if (ooff >= 0 && !lat) { float* op = out + ooff + (size_t)row * ow + (colbase - cs) + 8 * fq; *(f32x4*)op = v[0]; *(f32x4*)(op + 4) = v[1]; }
                }
        }
    }
};
constexpr int X_SPLIT = 16384;
template <bool IN_F32>
struct EpiRes {
    static constexpr bool PERM = true, AFTER_DRAIN = false;
    const float* xin_ctx; const float* xin_lat; bf16_t* XA; bf16_t* XB; const float* gate; int row0;
    template <int MR> __device__ __forceinline__ void operator()(const f32x4 (&acc)[2][2][MR][2], const Unit& u, int wr, int wc, int fr, int fq) const {
        constexpr int HRr = MR * 32, BMR = 2 * HRr, WRO = HRr / 2;
        const int rowt = row0 + u.pm * BMR;
#pragma unroll
        for (int ai = 0; ai < 2; ++ai)
#pragma unroll
            for (int m = 0; m < MR; ++m) {
                const int rowg = rowt + ai * HRr + wr * WRO + m * 16;
                const int midx = rowg < T_CTX ? 4 : ((rowg - T_CTX) >> 12);
                const float* g = gate + (size_t)midx * 6144;
                bf16_t* xr = (rowg < X_SPLIT ? XA + (size_t)rowg * 1024 : XB + (size_t)(rowg - X_SPLIT) * 1024) + (size_t)fr * 1024;
                const float* xf = (rowg < T_CTX ? xin_ctx : xin_lat - (size_t)T_CTX * 1024) + (size_t)(rowg + fr) * 1024;
#pragma unroll
                for (int bj = 0; bj < 2; ++bj) {
                    const int col = u.pn * BM + bj * HALF + wc * 32 + 8 * fq;
                    const f32x4 gv0 = *(const f32x4*)(g + col), gv1 = *(const f32x4*)(g + col + 4);
                    f32x4 x0, x1;
                    if (IN_F32) { x0 = *(const f32x4*)(xf + col); x1 = *(const f32x4*)(xf + col + 4); }
                    else { const u32x4 w = *(const u32x4*)(xr + col);
                        x0[0] = __builtin_bit_cast(float, w.x << 16); x0[1] = __builtin_bit_cast(float, w.x & 0xffff0000u); x0[2] = __builtin_bit_cast(float, w.y << 16); x0[3] = __builtin_bit_cast(float, w.y & 0xffff0000u);
                        x1[0] = __builtin_bit_cast(float, w.z << 16); x1[1] = __builtin_bit_cast(float, w.z & 0xffff0000u); x1[2] = __builtin_bit_cast(float, w.w << 16); x1[3] = __builtin_bit_cast(float, w.w & 0xffff0000u); }
                    x0 = x0 + gv0 * acc[ai][bj][m][0]; x1 = x1 + gv1 * acc[ai][bj][m][1];
                    u32x4 o; o.x = cvt_pk_bf16(x0[0], x0[1]); o.y = cvt_pk_bf16(x0[2], x0[3]); o.z = cvt_pk_bf16(x1[0], x1[1]); o.w = cvt_pk_bf16(x1[2], x1[3]);
                    *(u32x4*)(xr + col) = o;
                }
            }
    }
};
struct EpiSqRelu {
    static constexpr bool PERM = true, AFTER_DRAIN = false;
    bf16_t* O; int ldc;
    template <int MR> __device__ __forceinline__ void operator()(const f32x4 (&acc)[2][2][MR][2], const Unit& u, int wr, int wc, int fr, int fq) const {
        constexpr int HRr = MR * 32, BMR = 2 * HRr, WRO = HRr / 2;
#pragma unroll
        for (int ai = 0; ai < 2; ++ai)
#pragma unroll
            for (int m = 0; m < MR; ++m) {
                bf16_t* rowp = O + (size_t)(u.pm * BMR + ai * HRr + wr * WRO + m * 16 + fr) * ldc + u.pn * BM + wc * 32 + 8 * fq;
#pragma unroll
                for (int bj = 0; bj < 2; ++bj) {
                    f32x4 v0 = acc[ai][bj][m][0], v1 = acc[ai][bj][m][1];
#pragma unroll
                    for (int e = 0; e < 4; ++e) { const float a = fmaxf(v0[e], 0.f), b = fmaxf(v1[e], 0.f); v0[e] = a * a; v1[e] = b * b; }
                    u32x4 w; w.x = cvt_pk_bf16(v0[0], v0[1]); w.y = cvt_pk_bf16(v0[2], v0[3]); w.z = cvt_pk_bf16(v1[0], v1[1]); w.w = cvt_pk_bf16(v1[2], v1[3]);
                    *(u32x4*)(rowp + bj * HALF) = w;
                }
            }
    }
};
__device__ __forceinline__ float gelu_tanh(float x) {
    const float u2 = 1.5957691216057308f * (x + 0.044715f * x * x * x);
    return x * __builtin_amdgcn_rcpf(1.0f + __builtin_amdgcn_exp2f(-1.4426950408889634f * u2));
}
struct EpiRecIn {
    static constexpr bool PERM = true, AFTER_DRAIN = false;
    bf16_t* GG; bf16_t* XR; bf16_t* HALO;
    template <int MR> __device__ __forceinline__ void operator()(const f32x4 (&acc)[2][2][MR][2], const Unit& u, int wr, int wc, int fr, int fq) const {
        constexpr int HRr = MR * 32, BMR = 2 * HRr, WRO = HRr / 2;
        const bool isg = u.pn < 5;
        bf16_t* base = isg ? GG : XR; const int colt = (isg ? u.pn : u.pn - 5) * BM;
#pragma unroll
        for (int ai = 0; ai < 2; ++ai)
#pragma unroll
            for (int m = 0; m < MR; ++m) {
                const int row = u.pm * BMR + ai * HRr + wr * WRO + m * 16 + fr;
                bf16_t* rowp = base + (size_t)row * 1280 + colt + wc * 32 + 8 * fq;
                const int rl = row & 63; const bool halo = !isg && (rl == 63 || rl <= 1);
                bf16_t* hp = HALO + ((size_t)(row >> 6) * 3 + (rl == 63 ? 0 : rl + 1)) * 1280 + colt + wc * 32 + 8 * fq;
#pragma unroll
                for (int bj = 0; bj < 2; ++bj) {
                    f32x4 v0 = acc[ai][bj][m][0], v1 = acc[ai][bj][m][1];
                    if (isg) {
#pragma unroll
                        for (int e = 0; e < 4; ++e) { v0[e] = gelu_tanh(v0[e]); v1[e] = gelu_tanh(v1[e]); }
                    }
                    u32x4 w; w.x = cvt_pk_bf16(v0[0], v0[1]); w.y = cvt_pk_bf16(v0[2], v0[3]); w.z = cvt_pk_bf16(v1[0], v1[1]); w.w = cvt_pk_bf16(v1[2], v1[3]);
                    *(u32x4*)(rowp + bj * HALF) = w;
                    if (halo) *(u32x4*)(hp + bj * HALF) = w;
                }
            }
    }
};
template <class Epi, class Sched, bool ALIGN_EPI = false, bool SP2 = false, int HR = 128>
__device__ __forceinline__ void gemm_phase(PG8_LAS unsigned char* lds, const Gemm g, const Sched& S, const Epi& E) {
    int tid_ = threadIdx.x; asm volatile("" : "+v"(tid_));
    const int tid = tid_, wid = __builtin_amdgcn_readfirstlane(tid >> 6), lane = tid & 63, wr = wid >> 2, wc = wid & 3, fr = lane & 15, fq = lane >> 4;
    constexpr int MR = HR / 32;
    const int K = g.K, nt = K / BK;
    unsigned voffA[2], voffB[2];
#pragma unroll
    for (int i = 0; i < 2; ++i) { int R, C; stage_rc(tid * 16 + i * 8192, R, C); const int Rb = Epi::PERM ? ((R & ~31) + perm32(R & 31)) : R;
        voffA[i] = (unsigned)(R * K + C) * 2u; voffB[i] = (unsigned)(Rb * K + C) * 2u; }
    const size_t kstep = (size_t)(BK * 2);
    const size_t hstep = (size_t)HALF * K * 2;
    const size_t tstep = 2 * hstep;
    const size_t hstepA = (size_t)HR * K * 2, tstepA = 2 * hstepA;
    const unsigned ldsw = (unsigned)wid * 1024u;
    const int aoff = lds_byte(wr * (HR / 2) + fr, fq * 8), boff = lds_byte(wc * 32 + fr, fq * 8);
#define PG8_SA(b, h) (((b) * 2 + (h)) * HTB)
#define PG8_SB(b, h) ((4 + (b) * 2 + (h)) * HTB)
#define PG8_STAGE(bufoff, gbase, voff) do { _Pragma("unroll") for (int _i = 0; _i < 2; ++_i) \
        __builtin_amdgcn_global_load_lds((const unsigned*)((const char*)(gbase) + (voff)[_i]), (PG8_LAS unsigned*)(lds + (bufoff) + ldsw + _i * 8192), 16, 0, 0); } while (0)
#define PG8_LDA(dst, b, h) do { _Pragma("unroll") for (int m = 0; m < MR; ++m) _Pragma("unroll") for (int k = 0; k < 2; ++k) dst[m][k] = *(const PG8_LAS bf16x8*)(lds + PG8_SA(b, h) + aoff + m * 2048 + k * 1024); } while (0)
#define PG8_LDB(dst, b, h) do { _Pragma("unroll") for (int n = 0; n < 2; ++n) _Pragma("unroll") for (int k = 0; k < 2; ++k) dst[n][k] = *(const PG8_LAS bf16x8*)(lds + PG8_SB(b, h) + boff + n * 2048 + k * 1024); } while (0)
#define PG8_MMA(ai, bj, At, Bt) do { __builtin_amdgcn_s_setprio(1); _Pragma("unroll") for (int m = 0; m < MR; ++m) _Pragma("unroll") for (int n = 0; n < 2; ++n) _Pragma("unroll") for (int k = 0; k < 2; ++k) \
        acc[ai][bj][m][n] = __builtin_amdgcn_mfma_f32_16x16x32_bf16(Bt[n][k], At[m][k], acc[ai][bj][m][n], 0, 0, 0); __builtin_amdgcn_s_setprio(0); } while (0)
#define PG8_WAIT_V(n) asm volatile("s_waitcnt vmcnt(" #n ")" ::: "memory")
#define PG8_WAIT_L(n) asm volatile("s_waitcnt lgkmcnt(" #n ")" ::: "memory")
#define PG8_BAR __builtin_amdgcn_s_barrier()
#define PG8_SCHED __builtin_amdgcn_sched_barrier(0)
    Unit cur, nxt; int ui = 0;
    if (!S.next(0, cur)) return;
    f32x4 acc[2][2][MR][2];
#pragma unroll
    for (int a = 0; a < 2; ++a)
#pragma unroll
        for (int b = 0; b < 2; ++b)
#pragma unroll
            for (int m = 0; m < MR; ++m)
#pragma unroll
                for (int n = 0; n < 2; ++n) acc[a][b][m][n] = (f32x4){0.f, 0.f, 0.f, 0.f};
    bf16x8 At[MR][2], B0[2][2], B1[2][2];
    const char* cA = (const char*)g.A + (size_t)cur.pm * tstepA; const char* cB = (const char*)g.Bt + (size_t)cur.pn * tstep;
    S.a_ready(cur);
    if constexpr (SP2) {
        PG8_STAGE(PG8_SB(0, 0), cB, voffB); PG8_STAGE(PG8_SB(0, 1), cB + hstep, voffB); PG8_STAGE(PG8_SA(0, 0), cA, voffA); PG8_STAGE(PG8_SA(0, 1), cA + hstepA, voffA);
        if (wr == 1) PG8_BAR;
        PG8_WAIT_V(2); PG8_BAR;
        PG8_STAGE(PG8_SB(1, 0), cB + kstep, voffB); PG8_STAGE(PG8_SA(1, 0), cA + kstep, voffA); PG8_STAGE(PG8_SB(1, 1), cB + hstep + kstep, voffB);
        PG8_WAIT_V(6); PG8_BAR;
    } else {
        PG8_STAGE(PG8_SB(0, 0), cB, voffB); PG8_STAGE(PG8_SA(0, 0), cA, voffA); PG8_STAGE(PG8_SB(0, 1), cB + hstep, voffB); PG8_STAGE(PG8_SA(0, 1), cA + hstepA, voffA);
        if (wr == 1) PG8_BAR;
        PG8_WAIT_V(4); PG8_BAR;
        PG8_STAGE(PG8_SB(1, 0), cB + kstep, voffB); PG8_STAGE(PG8_SA(1, 0), cA + kstep, voffA); PG8_STAGE(PG8_SB(1, 1), cB + hstep + kstep, voffB);
        PG8_WAIT_V(6); PG8_BAR;
    }
    for (;;) {
        const bool has_next = S.next(ui + 1, nxt);
        const char* nA = has_next ? (const char*)g.A + (size_t)nxt.pm * tstepA : cA; const char* nB = has_next ? (const char*)g.Bt + (size_t)nxt.pn * tstep : cB;
        for (int t = 0; t < nt; t += 2) {
            const bool last = (t == nt - 2);
            const char* a1 = cA + (size_t)(t + 1) * kstep;
            const char* a2 = last ? nA : cA + (size_t)(t + 2) * kstep; const char* b2 = last ? nB : cB + (size_t)(t + 2) * kstep;
            const char* a3 = a2 + kstep; const char* b3 = b2 + kstep;
            if (last && has_next) S.a_ready(nxt);
            if constexpr (SP2) {
            PG8_LDB(B0, 0, 0); PG8_LDB(B1, 0, 1); PG8_SCHED; PG8_LDA(At, 0, 0); PG8_STAGE(PG8_SA(1, 1), a1 + hstepA, voffA);
            PG8_WAIT_V(8); PG8_WAIT_L(0); PG8_BAR; PG8_MMA(0, 0, At, B0); PG8_MMA(0, 1, At, B1); PG8_BAR; PG8_SCHED;
            PG8_LDA(At, 0, 1); PG8_STAGE(PG8_SB(0, 0), b2, voffB); PG8_STAGE(PG8_SB(0, 1), b2 + hstep, voffB); PG8_STAGE(PG8_SA(0, 0), a2, voffA);
            PG8_WAIT_V(8); PG8_WAIT_L(0); PG8_BAR; PG8_MMA(1, 0, At, B0); PG8_MMA(1, 1, At, B1); PG8_BAR; PG8_SCHED;
            PG8_LDB(B0, 1, 0); PG8_LDB(B1, 1, 1); PG8_SCHED; PG8_LDA(At, 1, 0); PG8_STAGE(PG8_SA(0, 1), a2 + hstepA, voffA);
            PG8_WAIT_V(8); PG8_WAIT_L(0); PG8_BAR; PG8_MMA(0, 0, At, B0); PG8_MMA(0, 1, At, B1); PG8_BAR; PG8_SCHED;
            PG8_LDA(At, 1, 1); PG8_STAGE(PG8_SB(1, 0), b3, voffB); PG8_STAGE(PG8_SB(1, 1), b3 + hstep, voffB); PG8_STAGE(PG8_SA(1, 0), a3, voffA);
            PG8_WAIT_V(8); PG8_WAIT_L(0); PG8_BAR; PG8_MMA(1, 0, At, B0); PG8_MMA(1, 1, At, B1); PG8_BAR; PG8_SCHED;
            } else {
            PG8_LDB(B0, 0, 0); PG8_SCHED; PG8_LDA(At, 0, 0); PG8_STAGE(PG8_SA(1, 1), a1 + hstepA, voffA);
            PG8_WAIT_L(8); PG8_BAR; PG8_WAIT_L(0); PG8_MMA(0, 0, At, B0); PG8_BAR; PG8_SCHED;
            PG8_LDB(B1, 0, 1); PG8_STAGE(PG8_SB(0, 0), b2, voffB);
            PG8_BAR; PG8_WAIT_L(0); PG8_MMA(0, 1, At, B1); PG8_BAR;
            PG8_LDA(At, 0, 1); PG8_STAGE(PG8_SA(0, 0), a2, voffA);
            PG8_BAR; PG8_WAIT_L(0); PG8_MMA(1, 0, At, B0); PG8_BAR; PG8_SCHED;
            PG8_STAGE(PG8_SB(0, 1), b2 + hstep, voffB);
            PG8_WAIT_V(6); PG8_BAR; PG8_MMA(1, 1, At, B1); PG8_BAR;
            PG8_LDB(B0, 1, 0); PG8_SCHED; PG8_LDA(At, 1, 0); PG8_STAGE(PG8_SA(0, 1), a2 + hstepA, voffA);
            PG8_WAIT_L(8); PG8_BAR; PG8_WAIT_L(0); PG8_MMA(0, 0, At, B0); PG8_BAR; PG8_SCHED;
            PG8_LDB(B1, 1, 1); PG8_STAGE(PG8_SB(1, 0), b3, voffB);
            PG8_BAR; PG8_WAIT_L(0); PG8_MMA(0, 1, At, B1); PG8_BAR;
            PG8_LDA(At, 1, 1); PG8_STAGE(PG8_SA(1, 0), a3, voffA);
            PG8_BAR; PG8_WAIT_L(0); PG8_MMA(1, 0, At, B0); PG8_BAR; PG8_SCHED;
            PG8_STAGE(PG8_SB(1, 1), b3 + hstep, voffB);
            PG8_WAIT_V(6); PG8_BAR; PG8_MMA(1, 1, At, B1); PG8_BAR;
            }
        }
        if constexpr (ALIGN_EPI) { if (wr == 0) PG8_BAR; }
        if constexpr (!Epi::AFTER_DRAIN) { E.template operator()<MR>(acc, cur, wr, wc, fr, fq); S.done(cur); }
        if (!has_next) break;
#pragma unroll
        for (int a = 0; a < 2; ++a)
#pragma unroll
            for (int b = 0; b < 2; ++b)
#pragma unroll
                for (int m = 0; m < MR; ++m)
#pragma unroll
                    for (int n = 0; n < 2; ++n) acc[a][b][m][n] = (f32x4){0.f, 0.f, 0.f, 0.f};
        cur = nxt; cA = nA; cB = nB; ++ui;
        if constexpr (ALIGN_EPI) { if (wr == 1) PG8_BAR; }
    }
    PG8_WAIT_V(0);
    if constexpr (!ALIGN_EPI) { if (wr == 0) PG8_BAR; }
    PG8_BAR;
    if constexpr (Epi::AFTER_DRAIN) { E.fused(acc, cur, wr, wc, fr, fq, lds, wid, lane); S.done(cur); }
#undef PG8_SA
#undef PG8_SB
#undef PG8_STAGE
#undef PG8_LDA
#undef PG8_LDB
#undef PG8_MMA
#undef PG8_WAIT_V
#undef PG8_WAIT_L
#undef PG8_BAR
#undef PG8_SCHED
}
}
constexpr int NWAVES = 8, NTHREADS = 512;
constexpr int DM = 1024, T_CTX = 8192, T_LAT = 16384, T_ALL = 24576, LAT_SEQ = 4096, CTX_SEQ = 256;
constexpr int QKV_LD = 2304, DFF = 4096, DRNN = 1280;
constexpr int QA_OFF = 0, KA_OFF = 512, VA_OFF = 640, QB_OFF = 768, KB_OFF = 1280, VB_OFF = 1792;
constexpr float EPSN = 1e-6f;
constexpr float SM_C = 0.125f * 1.4426950408889634f;
constexpr long OUT_AK = 25165824, OUT_AV = 26214400, OUT_BK = 27262976, OUT_BV = 31457280, OUT_SF = 35651584, OUT_SB = 35692544;
constexpr size_t MiB = 1u << 20;
constexpr size_t WS_CTL = 0, CTL_ZERO_BYTES = 64 * 1024;
constexpr size_t WS_MOD = 1 * MiB;
constexpr size_t WS_ROPE = 1 * MiB + 256 * 1024;
constexpr size_t WS_LAM = WS_ROPE + 16 * 1024;
constexpr size_t WS_CAK = 2 * MiB, WS_CAV = WS_CAK + 256 * 1024, WS_CBK = WS_CAV + 256 * 1024, WS_CBV = WS_CBK + 1 * MiB;
constexpr size_t WS_WIN = 5 * MiB;
constexpr size_t WS_WOUT = 10 * MiB;
constexpr size_t WS_W1 = 12 * MiB;
constexpr size_t WS_W2 = 28 * MiB;
constexpr size_t WS_WRIN = 44 * MiB;
constexpr size_t WS_WROUT = 49 * MiB;
constexpr size_t WS_WG = 52 * MiB;
constexpr size_t WS_SUM = 54 * MiB;
constexpr size_t WS_H = 56 * MiB;
constexpr size_t WS_BIG = 104 * MiB;
constexpr size_t WS_END = 256 * MiB;
static_assert(WS_BIG + (size_t)T_ALL * QKV_LD * 2 <= WS_END && WS_BIG + (size_t)(T_ALL / 2) * DFF * 2 <= WS_END && WS_BIG + (size_t)T_ALL * DRNN * 4 <= WS_END, "ws map");
constexpr int LDS_BYTES = 160 * 1024;
constexpr int MISC_OFF = 152 * 1024;

#define GAS __attribute__((address_space(1)))
#define LAS __attribute__((address_space(3)))
typedef unsigned short bf16;
typedef unsigned v4u __attribute__((ext_vector_type(4)));
typedef unsigned v2u __attribute__((ext_vector_type(2)));
typedef float f32x4 __attribute__((ext_vector_type(4)));
typedef float f32x2 __attribute__((ext_vector_type(2)));
typedef float f32x16 __attribute__((ext_vector_type(16)));
typedef short bf16x8 __attribute__((ext_vector_type(8)));
typedef short s16x4 __attribute__((ext_vector_type(4)));
typedef GAS unsigned gu32;
#define RLX_AGENT __ATOMIC_RELAXED, __HIP_MEMORY_SCOPE_AGENT
__device__ __forceinline__ unsigned f2bf(float f) { unsigned u = __builtin_bit_cast(unsigned, f); return (u + 0x7fffu + ((u >> 16) & 1u)) >> 16; }
__device__ __forceinline__ unsigned pk2(float lo, float hi) { return f2bf(lo) | (f2bf(hi) << 16); }
__device__ __forceinline__ float bf2f(unsigned short b) { return __builtin_bit_cast(float, (unsigned)b << 16); }
__device__ __forceinline__ float bflo(unsigned w) { return __builtin_bit_cast(float, w << 16); }
__device__ __forceinline__ float bfhi(unsigned w) { return __builtin_bit_cast(float, w & 0xffff0000u); }

#define XB_TMO      128
#define XB_XCNT(j)  (256  + 64 * (j))
#define XB_XSUB(j)  (1280 + 64 * (j))
#define XB_XGEN(j)  (2304 + 64 * (j))
#define XB_TOP      3328
#define XB_TOPGEN   3392
#define XCD_BAR_WORDS 3456
#define XB_SPIN_CAP (1u << 18)
__device__ __forceinline__ unsigned xb_ld(unsigned* p)              { return __hip_atomic_load(p, __ATOMIC_RELAXED, __HIP_MEMORY_SCOPE_AGENT); }
__device__ __forceinline__ unsigned xb_add(unsigned* p, unsigned v) { return __hip_atomic_fetch_add(p, v, __ATOMIC_RELAXED, __HIP_MEMORY_SCOPE_AGENT); }
__device__ __forceinline__ unsigned xb_xcc_id() { return (unsigned)__builtin_amdgcn_s_getreg((3 << 11) | 20) & 0xFu; }
#define XB_SPIN(cond, bar) do { unsigned _sp = 0; while (cond) { __builtin_amdgcn_s_sleep(1); \
    if ((++_sp & 255u) == 0u) { if (xb_ld(&(bar)[XB_TMO])) break; if (_sp > XB_SPIN_CAP) { atomicAdd(&(bar)[XB_TMO], 1u); break; } } } } while (0)
struct XcdBarrier { unsigned* bar; unsigned x; volatile LAS unsigned* st; };
__device__ __forceinline__ XcdBarrier xcd_barrier_post(unsigned* bar, volatile LAS unsigned* st) {
    XcdBarrier b; b.bar = bar; b.x = xb_xcc_id(); b.st = st;
    if (threadIdx.x == 0) (void)xb_add(&bar[XB_XCNT(b.x)], 1u);
    return b;
}
__device__ __forceinline__ void xcd_barrier_complete(unsigned* bar, unsigned x, unsigned& nloc, unsigned& nx) {
    const unsigned G = gridDim.x * gridDim.y * gridDim.z;
    unsigned sum, cnt, mine, sp = 0u;
    for (;;) {
        sum = 0u; cnt = 0u; mine = 0u;
#pragma unroll
        for (unsigned j = 0; j < 16; ++j) { const unsigned c = xb_ld(&bar[XB_XCNT(j)]); sum += c; cnt += (c > 0u) ? 1u : 0u; mine = (j == x) ? c : mine; }
        if (sum == G) break;
        __builtin_amdgcn_s_sleep(1);
        if ((++sp & 255u) == 0u) { if (xb_ld(&bar[XB_TMO])) break; if (sp > XB_SPIN_CAP) { atomicAdd(&bar[XB_TMO], 1u); break; } }
    }
    nloc = mine > 0u ? mine : 1u; nx = cnt > 0u ? cnt : 1u;
}
__device__ __forceinline__ void xcd_barrier(const XcdBarrier& b) {
    asm volatile("s_waitcnt vmcnt(0)" ::: "memory");
    __syncthreads();
    if (threadIdx.x == 0) {
        unsigned* bar = b.bar;
        __builtin_amdgcn_s_waitcnt(0);
        unsigned nloc = b.st[0], nx = b.st[1];
        if (nloc == 0u) { xcd_barrier_complete(bar, b.x, nloc, nx); b.st[0] = nloc; b.st[1] = nx; }
        const unsigned old = xb_add(&bar[XB_XSUB(b.x)], 1u);
        const unsigned gen = old / nloc;
        if (old + 1u == (gen + 1u) * nloc) {
            __builtin_amdgcn_fence(__ATOMIC_RELEASE, "agent");
            asm volatile("s_waitcnt vmcnt(0)" ::: "memory");
            const unsigned og = xb_add(&bar[XB_TOP], 1u);
            const unsigned tg = og / nx;
            if (og + 1u == (tg + 1u) * nx) xb_add(&bar[XB_TOPGEN], 1u);
            else XB_SPIN(xb_ld(&bar[XB_TOPGEN]) == tg, bar);
            __builtin_amdgcn_fence(__ATOMIC_ACQUIRE, "agent");
            xb_add(&bar[XB_XGEN(b.x)], 1u);
            asm volatile("s_waitcnt vmcnt(0)" ::: "memory");
        } else {
            XB_SPIN(xb_ld(&bar[XB_XGEN(b.x)]) == gen, bar);
            __builtin_amdgcn_fence(__ATOMIC_ACQUIRE, "agent");
            asm volatile("s_waitcnt vmcnt(0)" ::: "memory");
        }
    }
    __syncthreads();
}

struct Args { const float* in[31]; float* out; unsigned char* ws; int ph_lo, ph_hi; int use_bar, pad; };
struct Frame {
    LAS unsigned char* lds;
    int tid, lane, wave, vcu, G;
    const float* const* in; float* out; unsigned char* ws;
};
#define WSP(T, off) ((T*)(F.ws + (off)))
__device__ __forceinline__ Frame fresh(const Frame& F) { Frame P = F; int t = threadIdx.x; asm volatile("" : "+v"(t)); P.tid = t; P.lane = t & 63; P.wave = __builtin_amdgcn_readfirstlane(t >> 6); return P; }
enum { IN_XP = 0, IN_XS, IN_CAK, IN_CAV, IN_CBK, IN_CBV, IN_SF, IN_SB, IN_C, IN_CCTX, IN_NORM1, IN_NORM2, IN_WADA, IN_BADA, IN_WMLP1, IN_WMLP2, IN_AWIN, IN_AWOUT, IN_SINK, IN_LAMQK, IN_SUBLN,
       IN_RWIN, IN_RCONVW, IN_RCONVB, IN_RWA, IN_RBA, IN_RWX, IN_RBX, IN_RLAM, IN_RWOUT, IN_FNORM };

__device__ __forceinline__ float wave_sum(float v) {
#pragma unroll
    for (int o = 1; o < 64; o <<= 1) v += __shfl_xor(v, o);
    return v;
}

__device__ __forceinline__ void p0_transpose_item(const float* W, int K, int N, bf16* WT, LAS float* scr, int item, int lane, float wscale = 1.0f) {
    const int nblk = N / 32, kb = item / nblk, nb = item % nblk, k0 = 64 * kb, n0 = 32 * nb;
#pragma unroll 8
    for (int i = 0; i < 32; ++i) { const int kk = 2 * i + (lane >> 5); scr[kk * 33 + (lane & 31)] = W[(size_t)(k0 + kk) * N + n0 + (lane & 31)]; }
    asm volatile("s_waitcnt lgkmcnt(0)" ::: "memory");
    const int c = lane & 7;
#pragma unroll
    for (int j = 0; j < 4; ++j) { const int n = (lane >> 3) + 8 * j; const LAS float* s = scr + (8 * c) * 33 + n;
        v4u o; o.x = pk2(s[0 * 33] * wscale, s[1 * 33] * wscale); o.y = pk2(s[2 * 33] * wscale, s[3 * 33] * wscale); o.z = pk2(s[4 * 33] * wscale, s[5 * 33] * wscale); o.w = pk2(s[6 * 33] * wscale, s[7 * 33] * wscale);
        *(GAS v4u*)(WT + (size_t)(n0 + n) * K + k0 + 8 * c) = o; }
    asm volatile("s_waitcnt lgkmcnt(0)" ::: "memory");
}
__device__ __forceinline__ void p0_prologue(Frame& F) {
    const float* const* in = F.in;
    {
        LAS float* SC = (LAS float*)(F.lds);
        LAS float* RED = (LAS float*)(F.lds + 20480);
        for (int i = F.tid; i < 5 * 1024; i += NTHREADS) { const int v = i >> 10, k = i & 1023; const float c = v < 4 ? in[IN_C][v * 1024 + k] : in[IN_CCTX][k]; SC[i] = c / (1.0f + __expf(-c)); }
        __syncthreads();
        float* MOD = WSP(float, WS_MOD);
        for (int u = blockIdx.x; u < 384; u += F.G) {
            const int l = u / 192, n0 = (u % 192) * 32;
            const float* W = in[IN_WADA] + (size_t)l * 1024 * 6144 + n0 + (F.lane & 31);
            float a[5] = {0.f, 0.f, 0.f, 0.f, 0.f};
            const int kb = F.wave * 128 + (F.lane >> 5);
#pragma unroll 8
            for (int kk = 0; kk < 64; ++kk) { const int k = kb + 2 * kk; const float w = W[(size_t)k * 6144];
#pragma unroll
                for (int v = 0; v < 5; ++v) a[v] += SC[v * 1024 + k] * w; }
#pragma unroll
            for (int v = 0; v < 5; ++v) { a[v] += __shfl_xor(a[v], 32); if (F.lane < 32) RED[(F.wave * 5 + v) * 32 + F.lane] = a[v]; }
            __syncthreads();
            if (F.tid < 160) { const int v = F.tid >> 5, c = F.tid & 31; float s = in[IN_BADA][l * 6144 + n0 + c];
#pragma unroll
                for (int w = 0; w < 8; ++w) s += RED[(w * 5 + v) * 32 + c];
                MOD[((size_t)l * 5 + v) * 6144 + n0 + c] = s; }
            __syncthreads();
        }
    }
    {
        LAS float* scr = (LAS float*)(F.lds + 32768 + F.wave * 8704);
        const int gw = F.vcu * NWAVES + F.wave, NGW = F.G * NWAVES;
        constexpr int I_IN = 16 * 72, I_OUT = 16 * 32;
        for (int it = gw; it < I_IN + I_OUT; it += NGW) {
            if (it < I_IN) p0_transpose_item(in[IN_AWIN], 1024, 2304, WSP(bf16, WS_WIN), scr, it, F.lane);
            else p0_transpose_item(in[IN_AWOUT], 1024, 1024, WSP(bf16, WS_WOUT), scr, it - I_IN, F.lane);
        }
    }
    {
        const int gt = F.vcu * NTHREADS + F.tid, NGT = F.G * NTHREADS;
        for (int i = gt; i < 4 * 256 * 128 / 4; i += NGT) {
            const f32x4 a = ((const f32x4*)in[IN_CAK])[i], b = ((const f32x4*)in[IN_CAV])[i];
            v2u o; o.x = pk2(a[0], a[1]); o.y = pk2(a[2], a[3]); WSP(v2u, WS_CAK)[i] = o; o.x = pk2(b[0], b[1]); o.y = pk2(b[2], b[3]); WSP(v2u, WS_CAV)[i] = o; }
        for (int i = gt; i < 4 * 256 * 512 / 4; i += NGT) {
            const f32x4 a = ((const f32x4*)in[IN_CBK])[i], b = ((const f32x4*)in[IN_CBV])[i];
            v2u o; o.x = pk2(a[0], a[1]); o.y = pk2(a[2], a[3]); WSP(v2u, WS_CBK)[i] = o; o.x = pk2(b[0], b[1]); o.y = pk2(b[2], b[3]); WSP(v2u, WS_CBV)[i] = o; }
        if (gt < 1024) { const int pos = gt >> 4, i = gt & 15; const double ang = (double)pos * pow(10000.0, -(double)i / 16.0);
            WSP(f32x2, WS_ROPE)[gt] = (f32x2){(float)cos(ang), (float)sin(ang)}; }
        if (gt == 0) { const float* lq = in[IN_LAMQK]; float s1 = 0.f, s2 = 0.f; for (int i = 0; i < 64; ++i) { s1 += lq[i] * lq[64 + i]; s2 += lq[128 + i] * lq[192 + i]; }
            WSP(float, WS_LAM)[0] = __expf(s1) - __expf(s2) + 0.2f; }
    }
}

__device__ __forceinline__ void p_deferred_transposes(Frame& F, int iw, int nw) {
    const float* const* in = F.in;
    LAS float* scr = (LAS float*)(F.lds + 32768 + F.wave * 8704);
    const int gw = iw * NWAVES + F.wave, NGW = nw * NWAVES;
    constexpr int I_M1 = 16 * 128, I_M2 = 64 * 32, I_RIN = 16 * 80, I_ROUT = 20 * 32, I_G = 8;
    constexpr int NITEMS = 2 * I_M1 + 2 * I_M2 + I_RIN + I_ROUT + 40 * I_G;
    for (int it = gw; it < NITEMS; it += NGW) {
        int r = it;
        if (r < 2 * I_M1) { const int l = r / I_M1; p0_transpose_item(in[IN_WMLP1] + (size_t)l * 1024 * 4096, 1024, 4096, WSP(bf16, WS_W1) + (size_t)l * 4096 * 1024, scr, r % I_M1, F.lane); continue; } r -= 2 * I_M1;
        if (r < 2 * I_M2) { const int l = r / I_M2; p0_transpose_item(in[IN_WMLP2] + (size_t)l * 4096 * 1024, 4096, 1024, WSP(bf16, WS_W2) + (size_t)l * 1024 * 4096, scr, r % I_M2, F.lane); continue; } r -= 2 * I_M2;
        if (r < I_RIN) { p0_transpose_item(in[IN_RWIN], 1024, 2560, WSP(bf16, WS_WRIN), scr, r, F.lane); continue; } r -= I_RIN;
        if (r < I_ROUT) { p0_transpose_item(in[IN_RWOUT], 1280, 1024, WSP(bf16, WS_WROUT), scr, r, F.lane); continue; } r -= I_ROUT;
        { const int mtx = r / I_G, gate = mtx / 20, db = mtx % 20;
          p0_transpose_item(in[gate ? IN_RWX : IN_RWA] + (size_t)db * 16384, 128, 128, WSP(bf16, WS_WG) + (size_t)(gate * 20 + db) * 16384, scr, r % I_G, F.lane, -1.4426950408889634f); }
    }
}

__device__ __forceinline__ void norm_mod_pass(Frame& F, const float* x_ctx, const float* x_lat, const float* g, const float* mod  , int shift_off, int scale_off, bf16* H) {
    const int gw = F.vcu * NWAVES + F.wave, NGW = F.G * NWAVES;
    for (int m = gw; m < T_ALL; m += NGW) {
        const float* xr = m < T_CTX ? x_ctx + (size_t)m * DM : x_lat + (size_t)(m - T_CTX) * DM;
        const int midx = m < T_CTX ? 4 : ((m - T_CTX) >> 12);
        const float* mv = mod + (size_t)midx * 6144;
        f32x4 v[4]; float s = 0.f;
#pragma unroll
        for (int j = 0; j < 4; ++j) { v[j] = ((const f32x4*)xr)[F.lane + 64 * j]; s += (v[j][0] * v[j][0] + v[j][1] * v[j][1]) + (v[j][2] * v[j][2] + v[j][3] * v[j][3]); }
        const float rstd = 1.0f / sqrtf(wave_sum(s) * (1.0f / DM) + EPSN);
#pragma unroll
        for (int j = 0; j < 4; ++j) {
            const int c = 4 * (F.lane + 64 * j);
            const f32x4 gg = *(const f32x4*)(g + c), sc = *(const f32x4*)(mv + scale_off + c), sh = *(const f32x4*)(mv + shift_off + c);
            f32x4 o = (v[j] * rstd) * gg; o = o * (sc + 1.0f) + sh;
            v2u w; w.x = pk2(o[0], o[1]); w.y = pk2(o[2], o[3]);
            *(v2u*)(H + (size_t)m * DM + c) = w;
        }
    }
}
constexpr int X_SPLIT = 16384;
__device__ __forceinline__ const bf16* xrow_bf(const bf16* XA, const bf16* XB, int m) { return m < X_SPLIT ? XA + (size_t)m * DM : XB + (size_t)(m - X_SPLIT) * DM; }
__device__ __forceinline__ void unpack16(const v4u a, const v4u b, float (&v)[16]) {
    const unsigned w[8] = {a.x, a.y, a.z, a.w, b.x, b.y, b.z, b.w};
#pragma unroll
    for (int e = 0; e < 8; ++e) { v[2 * e] = bflo(w[e]); v[2 * e + 1] = bfhi(w[e]); }
}
__device__ __forceinline__ void norm_mod_pass_bf(Frame& F, const bf16* XA, const bf16* XB, const float* g, const float* mod  , int shift_off, int scale_off, bf16* H) {
    const int gw = F.vcu * NWAVES + F.wave, NGW = F.G * NWAVES;
    for (int m = gw; m < T_ALL; m += NGW) {
        const v4u* xp = (const v4u*)(xrow_bf(XA, XB, m) + F.lane * 8);
        const int midx = m < T_CTX ? 4 : ((m - T_CTX) >> 12);
        const float* mv = mod + (size_t)midx * 6144;
        float v[16]; unpack16(xp[0], xp[64], v);
        float s = 0.f;
#pragma unroll
        for (int e = 0; e < 16; ++e) s += v[e] * v[e];
        const float rstd = 1.0f / sqrtf(wave_sum(s) * (1.0f / DM) + EPSN);
        unsigned ow[8];
#pragma unroll
        for (int q = 0; q < 4; ++q) {
            const int c = 8 * F.lane + (q >> 1) * 512 + (q & 1) * 4;
            const f32x4 gg = *(const f32x4*)(g + c), sc = *(const f32x4*)(mv + scale_off + c), sh = *(const f32x4*)(mv + shift_off + c);
            const float o0 = (v[4 * q] * rstd) * gg[0] * (sc[0] + 1.0f) + sh[0], o1 = (v[4 * q + 1] * rstd) * gg[1] * (sc[1] + 1.0f) + sh[1];
            const float o2 = (v[4 * q + 2] * rstd) * gg[2] * (sc[2] + 1.0f) + sh[2], o3 = (v[4 * q + 3] * rstd) * gg[3] * (sc[3] + 1.0f) + sh[3];
            ow[2 * q] = pk2(o0, o1); ow[2 * q + 1] = pk2(o2, o3);
        }
        v4u* hp = (v4u*)(H + (size_t)m * DM + 8 * F.lane);
        v4u a, b2; a.x = ow[0]; a.y = ow[1]; a.z = ow[2]; a.w = ow[3]; b2.x = ow[4]; b2.y = ow[5]; b2.z = ow[6]; b2.w = ow[7];
        hp[0] = a; hp[64] = b2;
    }
}
__device__ __forceinline__ void final_norm_pass(Frame& F, const bf16* XA, const bf16* XB, float* Y, const float* g, int m_lo, int m_hi) {
    const int gw = F.vcu * NWAVES + F.wave, NGW = F.G * NWAVES;
    for (int m = m_lo + gw; m < m_hi; m += NGW) {
        const v4u* xp = (const v4u*)(xrow_bf(XA, XB, m) + F.lane * 8);
        float v[16]; unpack16(xp[0], xp[64], v);
        float s = 0.f;
#pragma unroll
        for (int e = 0; e < 16; ++e) s += v[e] * v[e];
        const float rstd = 1.0f / sqrtf(wave_sum(s) * (1.0f / DM) + EPSN);
#pragma unroll
        for (int q = 0; q < 4; ++q) { const int c = 8 * F.lane + (q >> 1) * 512 + (q & 1) * 4; const f32x4 gg = *(const f32x4*)(g + c);
            f32x4 o; o[0] = v[4 * q] * rstd * gg[0]; o[1] = v[4 * q + 1] * rstd * gg[1]; o[2] = v[4 * q + 2] * rstd * gg[2]; o[3] = v[4 * q + 3] * rstd * gg[3];
            *(f32x4*)(Y + (size_t)m * DM + c) = o; }
    }
}

constexpr float ATT_THR = 8.0f;
constexpr int AT_K0 = 0, AT_K1 = 9216;
constexpr int AT_V0 = 18432, AT_V1 = 38912;
constexpr int AT_WS = 59392;
constexpr int AT_O1 = 61440;
static_assert(AT_O1 + 65536 <= MISC_OFF, "attention LDS map");
__device__ __forceinline__ int crow(int r, int hi) { return (r & 3) + 8 * (r >> 2) + 4 * hi; }
__device__ __forceinline__ unsigned cvtpk_s(float lo, float hi) { typedef __bf16 bf16x2_t __attribute__((ext_vector_type(2))); f32x2 v = {lo, hi}; bf16x2_t b = __builtin_convertvector(v, bf16x2_t); return __builtin_bit_cast(unsigned, b); }
__device__ __forceinline__ s16x4 vtr(const LAS unsigned char* p) { typedef short v4i16_t __attribute__((ext_vector_type(4))); return __builtin_bit_cast(s16x4, __builtin_amdgcn_ds_read_tr16_b64_v4i16((LAS v4i16_t*)p)); }

struct AttnSrc {
    const bf16* K0; const bf16* V0; int ld0, n0;
    const bf16* K1; const bf16* V1; int ld1, t_lo, t_hi;
};
template <int DV, bool WINDOW>
__device__ __forceinline__ void attn_pass(Frame& F, const bf16* Q, int ldq, const AttnSrc& S, int qpos0, float m_init, float l_init, bool start_exact, f32x16 (&o)[DV / 32], float& m_out, float& l_out) {
    constexpr int RSV = DV == 128 ? 320 : 192, NVL = DV / 64;
    LAS unsigned char* lds = F.lds;
    const int tid = F.tid, lane = F.lane, wid = F.wave, r32 = lane & 31, hi = lane >> 5;
    LAS float* wsf = (LAS float*)(lds + AT_WS) + wid * 64;
    bf16x8 qr[4];
    { const bf16* qp = Q + (size_t)(wid * 32 + r32) * ldq + hi * 8;
#pragma unroll
      for (int d0 = 0; d0 < 4; ++d0) qr[d0] = *(const bf16x8*)(qp + d0 * 16); }
#pragma unroll
    for (int d = 0; d < DV / 32; ++d) o[d] = f32x16{};
    float m = m_init, l = l_init;
    f32x16 negm;
#pragma unroll
    for (int r = 0; r < 16; ++r) negm[r] = -m_init;
    const int nt = S.n0 + (S.t_hi - S.t_lo);
    v4u kreg, vreg[NVL];
    const int krow = tid >> 3, kch = tid & 7;
#define AT_ISSUE(it_) do { const int it__ = (it_); const bf16* Kp; const bf16* Vp; int ld; \
        if (it__ < S.n0) { Kp = S.K0 + (size_t)(it__ * 64) * S.ld0; Vp = S.V0 + (size_t)(it__ * 64) * S.ld0; ld = S.ld0; } \
        else { const int t = S.t_lo + it__ - S.n0; Kp = S.K1 + (size_t)(t * 64) * S.ld1; Vp = S.V1 + (size_t)(t * 64) * S.ld1; ld = S.ld1; } \
        kreg = *(const v4u*)(Kp + (size_t)krow * ld + kch * 8); \
        if (DV == 128) { _Pragma("unroll") for (int i = 0; i < NVL; ++i) { const int idx = tid + 512 * i; vreg[i] = *(const v4u*)(Vp + (size_t)(idx >> 4) * ld + (idx & 15) * 8); } } \
        else vreg[0] = *(const v4u*)(Vp + (size_t)krow * ld + kch * 8); } while (0)
#define AT_COMMIT(buf_) do { const int kb_ = (buf_) ? AT_K1 : AT_K0, vb_ = (buf_) ? AT_V1 : AT_V0; \
        *(LAS v4u*)(lds + kb_ + krow * 144 + kch * 16) = kreg; \
        if (DV == 128) { _Pragma("unroll") for (int i = 0; i < NVL; ++i) { const int idx = tid + 512 * i; *(LAS v4u*)(lds + vb_ + (idx >> 4) * RSV + (idx & 15) * 16) = vreg[i]; } } \
        else *(LAS v4u*)(lds + vb_ + krow * RSV + kch * 16) = vreg[0]; } while (0)
    const int koff = r32 * 144 + hi * 16;
    const int voff = (4 * hi + ((lane & 15) >> 2)) * RSV + ((lane >> 4) & 1) * 32 + (lane & 3) * 8;
    const int qw0 = qpos0 + 32 * wid;
    if (wid >= 4) __builtin_amdgcn_s_setprio(1);
    __syncthreads();
    AT_ISSUE(0); AT_COMMIT(0);
    if (nt > 1) AT_ISSUE(1);
#pragma unroll 1
    for (int it = 0; it < nt; ++it) {
        __syncthreads();
        const LAS unsigned char* kbase = lds + ((it & 1) ? AT_K1 : AT_K0) + koff;
        const LAS unsigned char* vbase = lds + ((it & 1) ? AT_V1 : AT_V0) + voff;
        bool skip = false, need_mask = false;
        int kp0 = 0;
        if (WINDOW && it >= S.n0) {
            kp0 = (S.t_lo + it - S.n0) * 64;
            skip = (kp0 + 63 < qw0 - 128 || kp0 > qw0 + 31 + 128);
            need_mask = !(kp0 >= qw0 + 31 - 128 && kp0 + 63 <= qw0 + 128);
        }
        if (!skip) {
            f32x16 p0, p1;
#pragma unroll
            for (int d0 = 0; d0 < 4; ++d0) {
                const bf16x8 k0 = *(const LAS bf16x8*)(kbase + d0 * 32);
                const bf16x8 k1 = *(const LAS bf16x8*)(kbase + 32 * 144 + d0 * 32);
                if (d0 == 0) { p0 = __builtin_amdgcn_mfma_f32_32x32x16_bf16(k0, qr[0], negm, 0, 0, 0); p1 = __builtin_amdgcn_mfma_f32_32x32x16_bf16(k1, qr[0], negm, 0, 0, 0); }
                else { p0 = __builtin_amdgcn_mfma_f32_32x32x16_bf16(k0, qr[d0], p0, 0, 0, 0); p1 = __builtin_amdgcn_mfma_f32_32x32x16_bf16(k1, qr[d0], p1, 0, 0, 0); }
            }
            if (WINDOW && need_mask) {
                const int q = qw0 + r32;
#pragma unroll
                for (int r = 0; r < 16; ++r) { const int kv = kp0 + crow(r, hi); int d0 = q - kv; d0 = d0 < 0 ? -d0 : d0; int d1 = q - kv - 32; d1 = d1 < 0 ? -d1 : d1;
                    if (d0 > 128) p0[r] = -1e30f; if (d1 > 128) p1[r] = -1e30f; }
            }
            float rm = fmaxf(p0[0], p1[0]);
#pragma unroll
            for (int r = 1; r < 16; ++r) rm = fmaxf(fmaxf(rm, p0[r]), p1[r]);
            const bool exact = start_exact && it == 0;
            if (exact || __any(rm > ATT_THR)) {
                rm = fmaxf(rm, __shfl_xor(rm, 32));
                const float dl = exact ? rm : fmaxf(rm, 0.f);
                m += dl;
#pragma unroll
                for (int r = 0; r < 16; ++r) { p0[r] -= dl; p1[r] -= dl; negm[r] = -m; }
                const float alpha = exact ? 1.0f : __builtin_amdgcn_exp2f(-dl);
                l *= alpha;
                if (hi == 0) wsf[r32] = alpha;
                asm volatile("s_waitcnt lgkmcnt(0)" ::: "memory");
#pragma unroll
                for (int r = 0; r < 16; ++r) { const float a = wsf[crow(r, hi)];
#pragma unroll
                    for (int d = 0; d < DV / 32; ++d) o[d][r] *= a; }
            }
            float ps = 0.f;
            bf16x8 pa[4];
#define AT_ECHUNK(P_, B_, c_) do { v4u w_; \
                _Pragma("unroll") for (int j = 0; j < 4; ++j) { const float e0 = __builtin_amdgcn_exp2f(P_[(B_) + 2 * j]), e1 = __builtin_amdgcn_exp2f(P_[(B_) + 2 * j + 1]); \
                    ps += e0 + e1; w_[j] = cvtpk_s(e0, e1); } \
                pa[c_] = __builtin_bit_cast(bf16x8, w_); } while (0)
#define AT_PVSTEP(s_) do { _Pragma("unroll") for (int d = 0; d < DV / 32; ++d) { \
                const s16x4 lo = vtr(vbase + (16 * (s_)) * RSV + d * 64); const s16x4 hh = vtr(vbase + (16 * (s_) + 8) * RSV + d * 64); \
                const bf16x8 vf = (bf16x8){lo[0], lo[1], lo[2], lo[3], hh[0], hh[1], hh[2], hh[3]}; \
                o[d] = __builtin_amdgcn_mfma_f32_32x32x16_bf16(pa[s_], vf, o[d], 0, 0, 0); } } while (0)
            AT_ECHUNK(p0, 0, 0);
            AT_ECHUNK(p0, 8, 1); AT_PVSTEP(0);
            AT_ECHUNK(p1, 0, 2); AT_PVSTEP(1);
            AT_ECHUNK(p1, 8, 3); AT_PVSTEP(2);
            AT_PVSTEP(3);
            l += ps;
#undef AT_ECHUNK
#undef AT_PVSTEP
        }
        if (it + 1 < nt) { AT_COMMIT((it + 1) & 1); if (it + 2 < nt) AT_ISSUE(it + 2); }
    }
#undef AT_ISSUE
#undef AT_COMMIT
    __builtin_amdgcn_s_setprio(0);
    m_out = m; l_out = l;
}
__device__ __forceinline__ void row_recip(Frame& F, float l, float (&rli)[16]) {
    LAS float* wsf = (LAS float*)(F.lds + AT_WS) + F.wave * 64;
    const int r32 = F.lane & 31, hi = F.lane >> 5;
    l += __shfl_xor(l, 32);
    asm volatile("s_waitcnt lgkmcnt(0)" ::: "memory");
    if (hi == 0) wsf[r32] = 1.0f / l;
    asm volatile("s_waitcnt lgkmcnt(0)" ::: "memory");
#pragma unroll
    for (int r = 0; r < 16; ++r) rli[r] = wsf[crow(r, hi)];
    asm volatile("s_waitcnt lgkmcnt(0)" ::: "memory");
}
template <bool WINDOW>
__device__ __forceinline__ void attn_a_unit(Frame& F, const bf16* QKV, size_t row0, int h, const AttnSrc& S, int qpos0, float sink, bf16* OM) {
    f32x16 o[2]; float m, l;
    attn_pass<64, WINDOW>(F, QKV + row0 * QKV_LD + QA_OFF + h * 64, QKV_LD, S, qpos0, sink * 1.4426950408889634f, (F.lane >> 5) == 0 ? 1.0f : 0.0f, false, o, m, l);
    float rli[16]; row_recip(F, l, rli);
    const int r32 = F.lane & 31, hi = F.lane >> 5;
    bf16* op = OM + (row0 + F.wave * 32) * DM + h * 64 + r32;
#pragma unroll
    for (int r = 0; r < 16; ++r)
#pragma unroll
        for (int d = 0; d < 2; ++d) op[(size_t)crow(r, hi) * DM + d * 32] = (bf16)f2bf(o[d][r] * rli[r]);
}
__device__ __forceinline__ void attn_b_unit(Frame& F, const bf16* QKV, size_t row0, int h, AttnSrc S, float lam, const float* subln, bf16* OM) {
    f32x16 o[4]; float m, l; float rli[16];
    const bf16* K0 = S.K0; const bf16* K1 = S.K1;
    const int r32 = F.lane & 31, hi = F.lane >> 5;
    LAS unsigned* o1s = (LAS unsigned*)(F.lds + AT_O1) + F.wave * 2048 + F.lane;
    attn_pass<128, false>(F, QKV + row0 * QKV_LD + QB_OFF + h * 128, QKV_LD, S, 0, 0.f, 0.f, true, o, m, l);
    row_recip(F, l, rli);
#pragma unroll
    for (int d = 0; d < 4; ++d)
#pragma unroll
        for (int r = 0; r < 8; ++r) o1s[(d * 8 + r) * 64] = cvtpk_s(o[d][2 * r] * rli[2 * r], o[d][2 * r + 1] * rli[2 * r + 1]);
    S.K0 = K0 + 64; S.K1 = K1 + 64;
    attn_pass<128, false>(F, QKV + row0 * QKV_LD + QB_OFF + h * 128 + 64, QKV_LD, S, 0, 0.f, 0.f, true, o, m, l);
    row_recip(F, l, rli);
    float ss[16];
#pragma unroll
    for (int r = 0; r < 16; ++r) { float s = 0.f;
#pragma unroll
        for (int d = 0; d < 4; ++d) { const unsigned w = o1s[(d * 8 + (r >> 1)) * 64]; const float o1 = (r & 1) ? bfhi(w) : bflo(w); const float v = o1 - lam * (o[d][r] * rli[r]); o[d][r] = v; s += v * v; }
        ss[r] = s; }
#pragma unroll
    for (int r = 0; r < 16; ++r) { float s = ss[r];
#pragma unroll
        for (int x = 1; x < 32; x <<= 1) s += __shfl_xor(s, x);
        ss[r] = 0.8f / sqrtf(s * (1.0f / 128.0f) + EPSN); }
    float gs[4];
#pragma unroll
    for (int d = 0; d < 4; ++d) gs[d] = subln[d * 32 + r32];
    bf16* op = OM + (row0 + F.wave * 32) * DM + 512 + h * 128 + r32;
#pragma unroll
    for (int r = 0; r < 16; ++r)
#pragma unroll
        for (int d = 0; d < 4; ++d) op[(size_t)crow(r, hi) * DM + d * 32] = (bf16)f2bf(o[d][r] * ss[r] * gs[d]);
}
__device__ __forceinline__ void attention_phase(Frame& F) {
    const bf16* QKV = WSP(bf16, WS_BIG); bf16* OM = WSP(bf16, WS_H);
    const float lam = WSP(float, WS_LAM)[0];
    const float* sinkp = F.in[IN_SINK]; const float* subln = F.in[IN_SUBLN];
    for (int u = F.vcu; u < 256; u += F.G) {
        const int b = u >> 6, h = (u >> 4) & 3, qb = u & 15;
        const size_t seq0 = T_CTX + (size_t)b * LAT_SEQ;
        AttnSrc S; S.K0 = WSP(bf16, WS_CBK) + (size_t)b * 256 * 512 + h * 128; S.V0 = WSP(bf16, WS_CBV) + (size_t)b * 256 * 512 + h * 128; S.ld0 = 512; S.n0 = 4;
        S.K1 = QKV + seq0 * QKV_LD + KB_OFF + h * 128; S.V1 = QKV + seq0 * QKV_LD + VB_OFF + h * 128; S.ld1 = QKV_LD; S.t_lo = 0; S.t_hi = 64;
        attn_b_unit(F, QKV, seq0 + qb * 256, h, S, lam, subln, OM);
    }
    for (int u = F.vcu; u < 512; u += F.G) {
        const int b = u >> 7, h = (u >> 4) & 7, qb = u & 15, kvh = h >> 2;
        const size_t seq0 = T_CTX + (size_t)b * LAT_SEQ;
        AttnSrc S; S.K0 = WSP(bf16, WS_CAK) + (size_t)b * 256 * 128 + kvh * 64; S.V0 = WSP(bf16, WS_CAV) + (size_t)b * 256 * 128 + kvh * 64; S.ld0 = 128; S.n0 = 4;
        S.K1 = QKV + seq0 * QKV_LD + KA_OFF + kvh * 64; S.V1 = QKV + seq0 * QKV_LD + VA_OFF + kvh * 64; S.ld1 = QKV_LD;
        S.t_lo = 4 * qb - 2 < 0 ? 0 : 4 * qb - 2; S.t_hi = 4 * qb + 6 > 64 ? 64 : 4 * qb + 6;
        attn_a_unit<true>(F, QKV, seq0 + qb * 256, h, S, qb * 256, sinkp[h], OM);
    }
    for (int u = F.vcu; u < 256; u += F.G) {
        const int b = u >> 3, h = u & 7, kvh = h >> 2;
        const size_t seq0 = (size_t)b * CTX_SEQ;
        AttnSrc S; S.K0 = nullptr; S.V0 = nullptr; S.ld0 = 0; S.n0 = 0;
        S.K1 = QKV + seq0 * QKV_LD + KA_OFF + kvh * 64; S.V1 = QKV + seq0 * QKV_LD + VA_OFF + kvh * 64; S.ld1 = QKV_LD; S.t_lo = 0; S.t_hi = 4;
        attn_a_unit<false>(F, QKV, seq0, h, S, 0, sinkp[h], OM);
    }
    for (int u = F.vcu; u < 128; u += F.G) {
        const int b = u >> 2, h = u & 3;
        const size_t seq0 = (size_t)b * CTX_SEQ;
        AttnSrc S; S.K0 = nullptr; S.V0 = nullptr; S.ld0 = 0; S.n0 = 0;
        S.K1 = QKV + seq0 * QKV_LD + KB_OFF + h * 128; S.V1 = QKV + seq0 * QKV_LD + VB_OFF + h * 128; S.ld1 = QKV_LD; S.t_lo = 0; S.t_hi = 4;
        attn_b_unit(F, QKV, seq0, h, S, lam, subln, OM);
    }
}

constexpr int SC_XC = 0;
constexpr int SC_AUF = 17408;
constexpr int SC_AUB = 17408 + 65536;
constexpr int SC_CW = 17408 + 131072;
static_assert(SC_CW + 2560 <= MISC_OFF, "scan LDS map");
#ifndef DUP_EPI
#define DUP_EPI 1
#endif
#ifndef DUP_SCAN
#define DUP_SCAN 1
#endif
#ifndef DUP_CONV
#define DUP_CONV 1
#endif
constexpr int SCAN_UNITS = 3840;
__device__ __forceinline__ void scan_pass(Frame& F) {
    LAS unsigned char* lds = F.lds;
    const int tid = F.tid, lane = F.lane, wid = F.wave, r32 = lane & 31, hi = lane >> 5;
    bf16* XR = WSP(bf16, WS_BIG) + (size_t)T_ALL * DRNN; bf16* GG = WSP(bf16, WS_BIG); bf16* ABG = (bf16*)F.out;
    const bf16* HALO = WSP(bf16, WS_BIG + 136 * MiB);
    f32x2* SUM = WSP(f32x2, WS_H);
    const int wdir = wid >> 2, cb = wid & 3, chl = cb * 32 + r32;
    const int tk = tid >> 3, cg = tid & 7;
    LAS float* CW = (LAS float*)(lds + SC_CW);
    const int per = (SCAN_UNITS + F.G - 1) / F.G, u_lo = F.vcu * per, u_hi = (u_lo + per) < SCAN_UNITS ? (u_lo + per) : SCAN_UNITS;
    int n_cur = -1;
    v4u xr[8];
    bf16x8 wa[8], wx[8]; float ba = 0.f, bx = 0.f, sp8 = 0.f;
#define SC_DECODE(u_) const int n = (u_) / 384, cidx = (u_) % 384; const bool isctx = cidx < 128; const int b = isctx ? (cidx >> 2) : ((cidx - 128) >> 6); const int c = isctx ? (cidx & 3) : ((cidx - 128) & 63); \
        const size_t seq0 = isctx ? (size_t)b * CTX_SEQ : (size_t)T_CTX + (size_t)b * LAT_SEQ; const int seq_len = isctx ? CTX_SEQ : LAT_SEQ, t0 = c * 64;
#define SC_LOADX(u_) do { SC_DECODE(u_) (void)b; (void)seq_len; \
        _Pragma("unroll") for (int j = 0; j < 4; ++j) { const int tl = tk - 1 + j; \
            const bf16* src = tl < 0 ? HALO + (size_t)((cidx > 0 ? cidx - 1 : 0) * 3 + 0) * DRNN : (tl >= 64 ? HALO + (size_t)((cidx < 383 ? cidx + 1 : 383) * 3 + 1 + (tl - 64)) * DRNN : XR + (seq0 + t0 + tl) * DRNN); \
            const v4u* p = (const v4u*)(src + n * 128 + cg * 8); xr[2 * j] = p[0]; xr[2 * j + 1] = p[8]; } } while (0)
    if (wid >= 4) __builtin_amdgcn_s_setprio(1);
    if (u_lo < u_hi) SC_LOADX(u_lo);
#pragma unroll 1
    for (int u = u_lo; u < u_hi; ++u) {
        SC_DECODE(u)
        (void)b;
        if (n != n_cur) {
            __syncthreads();
            for (int i = tid; i < 640; i += NTHREADS) CW[i] = i < 512 ? F.in[IN_RCONVW][(i >> 7) * DRNN + n * 128 + (i & 127)] : F.in[IN_RCONVB][n * 128 + (i & 127)];
            n_cur = n;
            { const bf16* wap = WSP(bf16, WS_WG) + (size_t)((0 * 2 + wdir) * 10 + n) * 16384 + (size_t)chl * 128 + hi * 8;
              const bf16* wxp = WSP(bf16, WS_WG) + (size_t)((1 * 2 + wdir) * 10 + n) * 16384 + (size_t)chl * 128 + hi * 8;
#pragma unroll
              for (int ks = 0; ks < 8; ++ks) { wa[ks] = *(const bf16x8*)(wap + ks * 16); wx[ks] = *(const bf16x8*)(wxp + ks * 16); } }
            ba = F.in[IN_RBA][wdir * DRNN + n * 128 + chl] * -1.4426950408889634f; bx = F.in[IN_RBX][wdir * DRNN + n * 128 + chl] * -1.4426950408889634f;
            { const float lamv = F.in[IN_RLAM][wdir * DRNN + n * 128 + chl]; sp8 = -8.0f * (lamv > 20.f ? __expf(-lamv) : log1pf(__expf(-lamv))); }
            __syncthreads();
        }
        { float a[16];
#pragma unroll
          for (int e = 0; e < 16; ++e) a[e] = CW[512 + (e >> 3) * 64 + cg * 8 + (e & 7)];
#pragma unroll
          for (int j = 0; j < 4; ++j) { const int t = t0 + tk - 1 + j; const float msk = (t >= 0 && t < seq_len) ? 1.0f : 0.0f;
              const unsigned w[8] = {xr[2 * j].x, xr[2 * j].y, xr[2 * j].z, xr[2 * j].w, xr[2 * j + 1].x, xr[2 * j + 1].y, xr[2 * j + 1].z, xr[2 * j + 1].w};
#pragma unroll
              for (int e = 0; e < 8; ++e) { const int c0 = (e >> 2) * 64 + cg * 8 + 2 * (e & 3); a[2 * e] += (CW[j * 128 + c0] * msk) * bflo(w[e]); a[2 * e + 1] += (CW[j * 128 + c0 + 1] * msk) * bfhi(w[e]); } }
          v4u o0, o1; o0.x = pk2(a[0], a[1]); o0.y = pk2(a[2], a[3]); o0.z = pk2(a[4], a[5]); o0.w = pk2(a[6], a[7]); o1.x = pk2(a[8], a[9]); o1.y = pk2(a[10], a[11]); o1.z = pk2(a[12], a[13]); o1.w = pk2(a[14], a[15]);
          LAS v4u* xp = (LAS v4u*)(lds + SC_XC + tk * 272 + cg * 16); xp[0] = o0; xp[8] = o1; }
        __syncthreads();
        if (u + 1 < u_hi) SC_LOADX(u + 1);
        { LAS f32x2* AU = (LAS f32x2*)(lds + (wdir ? SC_AUB : SC_AUF));
#pragma unroll 1
          for (int rb = 0; rb < 2; ++rb) {
            f32x16 ra, ia;
#pragma unroll
            for (int r = 0; r < 16; ++r) { ra[r] = ba; ia[r] = bx; }
            { const LAS unsigned char* ap = lds + SC_XC + (rb * 32 + r32) * 272 + hi * 16;
#pragma unroll
              for (int ks = 0; ks < 8; ++ks) { const bf16x8 af = *(const LAS bf16x8*)(ap + ks * 32);
                  ra = __builtin_amdgcn_mfma_f32_32x32x16_bf16(af, wa[ks], ra, 0, 0, 0);
                  ia = __builtin_amdgcn_mfma_f32_32x32x16_bf16(af, wx[ks], ia, 0, 0, 0); } }
#pragma unroll
            for (int r = 0; r < 16; ++r) {
                const int row = rb * 32 + crow(r, hi);
                const float rr = __builtin_amdgcn_rcpf(1.0f + __builtin_amdgcn_exp2f(ra[r]));
                const float ii = __builtin_amdgcn_rcpf(1.0f + __builtin_amdgcn_exp2f(ia[r]));
                const float x = sp8 * rr;
                const float em = -x * (1.0f + x * (0.5f + x * (0.16666667f + x * (0.041666668f + x * 0.0083333338f))));
                const float av = 1.0f - em;
                const float om = __builtin_fmaf(em, av, em);
                const float xv = bf2f(*(const LAS unsigned short*)(lds + SC_XC + row * 272 + chl * 2));
                AU[row * 128 + chl] = (f32x2){av, __builtin_amdgcn_sqrtf(om) * ii * xv};
            }
          } }
        __syncthreads();
        if (tid >= 256) {
            const int sch = tid & 127, sd = (tid >> 7) & 1;
            LAS f32x2* AU = (LAS f32x2*)(lds + (sd ? SC_AUB : SC_AUF)) + sch;
            float h = 0.f, pprod = 1.0f;
            f32x2 auA[8], auB[8];
#define SC_LD(dst, s0_) do { _Pragma("unroll") for (int j = 0; j < 8; ++j) { const int row = sd == 0 ? (s0_) + j : 63 - (s0_) - j; dst[j] = AU[row * 128]; } } while (0)
#define SC_RUN(src, s0_) do { _Pragma("unroll") for (int j = 0; j < 8; ++j) { const int row = sd == 0 ? (s0_) + j : 63 - (s0_) - j; h = src[j].x * h + src[j].y; pprod *= src[j].x; AU[row * 128] = (f32x2){h, pprod}; } } while (0)
            SC_LD(auA, 0);
#pragma unroll 1
            for (int s0 = 0; s0 < 64; s0 += 16) {
                SC_LD(auB, s0 + 8);
                SC_RUN(auA, s0);
                if (s0 + 16 < 64) SC_LD(auA, s0 + 16);
                SC_RUN(auB, s0 + 8);
            }
#undef SC_LD
#undef SC_RUN
            SUM[(size_t)cidx * 2 * DRNN + sd * DRNN + n * 128 + sch] = (f32x2){pprod, h};
        }
        __syncthreads();
        {
            const LAS f32x4* hfp = (const LAS f32x4*)(lds + SC_AUF) + lane; const LAS f32x4* hbp = (const LAS f32x4*)(lds + SC_AUB) + lane;
            const size_t eoff = (seq0 + t0 + wid * 8) * DRNN + n * 128;
            unsigned* gp = (unsigned*)(GG + eoff) + lane; unsigned* fp = (unsigned*)(XR + eoff) + lane; unsigned* bp = (unsigned*)(ABG + eoff) + lane;
            unsigned gw[8];
#pragma unroll
            for (int i = 0; i < 8; ++i) gw[i] = gp[(size_t)i * (DRNN / 2)];
#pragma unroll
            for (int i = 0; i < 8; ++i) {
                const f32x4 hf = hfp[(wid * 8 + i) * 64], hb = hbp[(wid * 8 + i) * 64];
                const float g0 = bflo(gw[i]), g1 = bfhi(gw[i]);
                gp[(size_t)i * (DRNN / 2)] = pk2((hf[0] + hb[0]) * g0, (hf[2] + hb[2]) * g1);
                fp[(size_t)i * (DRNN / 2)] = pk2(hf[1] * g0, hf[3] * g1);
                bp[(size_t)i * (DRNN / 2)] = pk2(hb[1] * g0, hb[3] * g1);
            }
        }
        __syncthreads();
    }
    __builtin_amdgcn_s_setprio(0);
#undef SC_DECODE
#undef SC_LOADX
}
__device__ __forceinline__ void scan_correct_phase(Frame& F) {
    bf16* GG = WSP(bf16, WS_BIG); const bf16* XR = WSP(bf16, WS_BIG) + (size_t)T_ALL * DRNN; const bf16* ABG = (const bf16*)F.out;
    const float* CAR = WSP(float, WS_H + 8 * MiB);
    const int gt = F.vcu * NTHREADS + F.tid, NGT = F.G * NTHREADS;
    for (int i = gt; i < T_ALL * (DRNN / 8); i += NGT) {
        const int row = i / (DRNN / 8), c8 = (i % (DRNN / 8)) * 8;
        const size_t off = (size_t)row * DRNN + c8;
        const v4u yl = *(const v4u*)(GG + off), af = *(const v4u*)(XR + off), ab = *(const v4u*)(ABG + off);
        const float* cf = CAR + (size_t)(row >> 6) * 2 * DRNN + c8; const float* cbp = cf + DRNN;
        const f32x4 f0 = *(const f32x4*)cf, f1 = *(const f32x4*)(cf + 4), b0 = *(const f32x4*)cbp, b1 = *(const f32x4*)(cbp + 4);
        const unsigned wy[4] = {yl.x, yl.y, yl.z, yl.w}, wf[4] = {af.x, af.y, af.z, af.w}, wb[4] = {ab.x, ab.y, ab.z, ab.w};
        const float cfv[8] = {f0[0], f0[1], f0[2], f0[3], f1[0], f1[1], f1[2], f1[3]}, cbv[8] = {b0[0], b0[1], b0[2], b0[3], b1[0], b1[1], b1[2], b1[3]};
        unsigned o[4];
#pragma unroll
        for (int e = 0; e < 4; ++e) o[e] = pk2(bflo(wy[e]) + bflo(wf[e]) * cfv[2 * e] + bflo(wb[e]) * cbv[2 * e], bfhi(wy[e]) + bfhi(wf[e]) * cfv[2 * e + 1] + bfhi(wb[e]) * cbv[2 * e + 1]);
        v4u ov; ov.x = o[0]; ov.y = o[1]; ov.z = o[2]; ov.w = o[3];
        *(v4u*)(GG + off) = ov;
    }
}

__device__ __forceinline__ void scan_carry_phase(Frame& F) {
    const f32x2* SUM = WSP(f32x2, WS_H); float* CAR = WSP(float, WS_H + 8 * MiB);
    const int gt = F.vcu * NTHREADS + F.tid, NGT = F.G * NTHREADS;
    for (int i = gt; i < 10240 + 81920; i += NGT) {
        const bool lat = i < 10240; const int j = lat ? i : i - 10240;
        const int ch = j % DRNN, sd = (j / DRNN) & 1, b = j / (2 * DRNN);
        const int nch = lat ? 64 : 4, cfirst = lat ? 128 + b * 64 : b * 4;
        float h = lat ? F.in[sd ? IN_SB : IN_SF][b * DRNN + ch] : 0.f;
        const f32x2* sp = SUM + (size_t)cfirst * 2 * DRNN + sd * DRNN + ch; float* cp = CAR + (size_t)cfirst * 2 * DRNN + sd * DRNN + ch;
        for (int k0 = 0; k0 < nch; k0 += 4) {
            f32x2 s[4];
#pragma unroll
            for (int q = 0; q < 4; ++q) { const int c = sd == 0 ? k0 + q : nch - 1 - k0 - q; s[q] = sp[(size_t)c * 2 * DRNN]; }
#pragma unroll
            for (int q = 0; q < 4; ++q) { const int c = sd == 0 ? k0 + q : nch - 1 - k0 - q; cp[(size_t)c * 2 * DRNN] = h; h = s[q].x * h + s[q].y; }
        }
        if (!lat) F.out[(sd ? OUT_SB : OUT_SF) + b * DRNN + ch] = h;
    }
}

constexpr int N_PHASES = 23;
__global__ void __launch_bounds__(NTHREADS, 2) fwd_kernel(Args args) {
    extern __shared__ __attribute__((aligned(16))) unsigned char lds_raw[];
    Frame F;
    F.lds = (LAS unsigned char*)lds_raw;
    F.tid = threadIdx.x; F.lane = F.tid & 63; F.wave = __builtin_amdgcn_readfirstlane(F.tid >> 6);
    F.G = gridDim.x; { const int bx = blockIdx.x; F.vcu = (F.G % 8 == 0) ? (bx % 8) * (F.G / 8) + bx / 8 : bx; }
    F.in = args.in; F.out = args.out; F.ws = args.ws;
    volatile LAS unsigned* MISC = (volatile LAS unsigned*)(F.lds + MISC_OFF);
    if (F.tid < 32) MISC[F.tid] = 0u;
    __syncthreads();
    XcdBarrier bar; bar.bar = (unsigned*)(args.ws + WS_CTL) + 1024; bar.x = 0; bar.st = nullptr;
    if (args.use_bar) bar = xcd_barrier_post((unsigned*)(args.ws + WS_CTL) + 1024, MISC + 8);
    const int lo = args.ph_lo, hi = args.ph_hi;
#ifndef PHMASK
#define PHMASK 0x7fffff
#endif
#ifndef REP_PHASE
#define REP_PHASE -1
#endif
#ifndef REP_N
#define REP_N 1
#endif
#define IN(k) (((PHMASK >> (k)) & 1) && lo <= (k) && (k) < hi)
#define REPS(k) for (int rep_ = 0; rep_ < (((k) == REP_PHASE) ? REP_N : 1); ++rep_)
#define SEAM(k) do { if (IN(k) && IN((k) + 1)) xcd_barrier(bar); } while (0)
    bf16* XA = (bf16*)((unsigned char*)F.out + 64 * MiB);
    bf16* XB = WSP(bf16, WS_BIG + 120 * MiB);
    const float* MOD = WSP(float, WS_MOD);
    bf16* H = WSP(bf16, WS_H);
    PG8_LAS unsigned char* ring = (PG8_LAS unsigned char*)lds_raw;

    if (IN(0)) REPS(0) { Frame P = fresh(F); p0_prologue(P); } SEAM(0);
    if (IN(1)) REPS(1) { Frame P = fresh(F); norm_mod_pass(P, F.in[IN_XP], F.in[IN_XS], F.in[IN_NORM1], MOD, 0, 1024, H); } SEAM(1);
    if (IN(2)) REPS(2) {
        pg8::Gemm g{H, WSP(bf16, WS_WIN), T_ALL, QKV_LD, DM}; pg8::StaticOrder S; S.init(T_ALL, QKV_LD, F.G, (int)blockIdx.x);
        pg8::EpiInProj E{WSP(bf16, WS_BIG), F.out, WSP(pg8::f32x2, WS_ROPE)};
        pg8::gemm_phase<pg8::EpiInProj, pg8::StaticOrder, true, true>(ring, g, S, E);
        { const int nfull = (T_ALL / 256) * (QKV_LD / 256) % F.G; Frame P = fresh(F);
          if (nfull == 0) p_deferred_transposes(P, (int)blockIdx.x, F.G); else if ((int)blockIdx.x >= nfull) p_deferred_transposes(P, (int)blockIdx.x - nfull, F.G - nfull); }
    } SEAM(2);
    if (IN(3)) REPS(3) { Frame P = fresh(F); attention_phase(P); } SEAM(3);
    if (IN(4)) REPS(4) {
        pg8::Gemm g{H, WSP(bf16, WS_WOUT), T_ALL, DM, DM}; pg8::StaticOrder S; S.init(T_ALL, DM, F.G, (int)blockIdx.x, 192);
        pg8::EpiRes<true> E{F.in[IN_XP], F.in[IN_XS], XA, XB, MOD + 2048, 0};
        pg8::gemm_phase<pg8::EpiRes<true>, pg8::StaticOrder, true, true, 96>(ring, g, S, E);
    } SEAM(4);
#pragma unroll 1
    for (int layer = 0; layer < 2; ++layer) {
        const int pb = layer == 0 ? 5 : 16;
        const float* MODL = MOD + (size_t)layer * 5 * 6144;
        if (IN(pb)) REPS(pb) { Frame P = fresh(F); norm_mod_pass_bf(P, XA, XB, F.in[IN_NORM2] + layer * DM, MODL, 3072, 4096, H); } SEAM(pb);
#pragma unroll 1
        for (int half = 0; half < 2; ++half) {
            const int row0 = half * (T_ALL / 2);
            if (IN(pb + 1 + 2 * half)) REPS(pb + 1 + 2 * half) {
                pg8::Gemm g{H + (size_t)row0 * DM, WSP(bf16, WS_W1) + (size_t)layer * DFF * DM, T_ALL / 2, DFF, DM}; pg8::StaticOrder S; S.init(T_ALL / 2, DFF, F.G, (int)blockIdx.x);
                pg8::EpiSqRelu E{WSP(bf16, WS_BIG), DFF};
                pg8::gemm_phase<pg8::EpiSqRelu, pg8::StaticOrder, true, true>(ring, g, S, E);
            } SEAM(pb + 1 + 2 * half);
            if (IN(pb + 2 + 2 * half)) REPS(pb + 2 + 2 * half) {
                pg8::Gemm g{WSP(bf16, WS_BIG), WSP(bf16, WS_W2) + (size_t)layer * DM * DFF, T_ALL / 2, DM, DFF}; pg8::StaticOrder S; S.init(T_ALL / 2, DM, F.G, (int)blockIdx.x, 192);
                pg8::EpiRes<false> E{nullptr, nullptr, XA, XB, MODL + 5120, row0};
                pg8::gemm_phase<pg8::EpiRes<false>, pg8::StaticOrder, true, true, 96>(ring, g, S, E);
            } SEAM(pb + 2 + 2 * half);
        }
        if (layer == 0) {
            const float* MOD1 = MOD + 5 * 6144;
            if (IN(10)) REPS(10) { Frame P = fresh(F); norm_mod_pass_bf(P, XA, XB, F.in[IN_NORM1] + DM, MOD1, 0, 1024, H); } SEAM(10);
            if (IN(11)) REPS(11) {
                pg8::Gemm g{H, WSP(bf16, WS_WRIN), T_ALL, 2 * DRNN, DM}; pg8::StaticOrder S; S.init(T_ALL, 2 * DRNN, F.G, (int)blockIdx.x);
                pg8::EpiRecIn E{WSP(bf16, WS_BIG), WSP(bf16, WS_BIG) + (size_t)T_ALL * DRNN, WSP(bf16, WS_BIG + 136 * MiB)};
                pg8::gemm_phase<pg8::EpiRecIn, pg8::StaticOrder, true, true>(ring, g, S, E);
            } SEAM(11);
            if (IN(12)) REPS(12) { Frame P = fresh(F); scan_pass(P); } SEAM(12);
            if (IN(13)) REPS(13) { Frame P = fresh(F); scan_carry_phase(P); } SEAM(13);
            if (IN(14)) REPS(14) { Frame P = fresh(F); scan_correct_phase(P); } SEAM(14);
            if (IN(15)) REPS(15) {
                pg8::Gemm g{WSP(bf16, WS_BIG), WSP(bf16, WS_WROUT), T_ALL, DM, DRNN}; pg8::StaticOrder S; S.init(T_ALL, DM, F.G, (int)blockIdx.x, 192);
                pg8::EpiRes<false> E{nullptr, nullptr, XA, XB, MOD1 + 2048, 0};
                pg8::gemm_phase<pg8::EpiRes<false>, pg8::StaticOrder, true, true, 96>(ring, g, S, E);
            } SEAM(15);
        }
    }
    if (IN(21)) REPS(21) { Frame P = fresh(F); final_norm_pass(P, XA, XB, F.out, F.in[IN_FNORM], 0, X_SPLIT); } SEAM(21);
    if (IN(22)) REPS(22) { Frame P = fresh(F); final_norm_pass(P, XA, XB, F.out, F.in[IN_FNORM], X_SPLIT, T_ALL); }
#undef IN
#undef SEAM
}

#ifndef MK_ONE_LAUNCH
#define MK_ONE_LAUNCH 1
#endif
extern "C" void kernel_launch(void* const* d_in, const int* in_sizes, int n_in, void* d_out, int out_size, void* d_ws, size_t ws_size, hipStream_t stream) {
    static int grid = 0;
    if (grid == 0) {
        if (n_in != 31 || ws_size < WS_END) { fprintf(stderr, "kernel_launch: unexpected n_in %d / ws_size %zu\n", n_in, ws_size); grid = -1; return; }
        int dev = 0, cus = 0, per_cu = 0;
        if (hipGetDevice(&dev) != hipSuccess || hipDeviceGetAttribute(&cus, hipDeviceAttributeMultiprocessorCount, dev) != hipSuccess) { grid = -1; return; }
        if (hipFuncSetAttribute((const void*)fwd_kernel, hipFuncAttributeMaxDynamicSharedMemorySize, LDS_BYTES) != hipSuccess) { fprintf(stderr, "kernel_launch: hipFuncSetAttribute failed\n"); grid = -1; return; }
        if (hipOccupancyMaxActiveBlocksPerMultiprocessor(&per_cu, (const void*)fwd_kernel, NTHREADS, LDS_BYTES) != hipSuccess || per_cu < 1) { fprintf(stderr, "kernel_launch: occupancy query says %d\n", per_cu); (void)hipGetLastError(); grid = -1; return; }
        grid = cus;
    }
    if (grid < 0) return;
    (void)hipMemsetAsync((char*)d_ws + WS_CTL, 0, CTL_ZERO_BYTES, stream);
    Args a{};
    for (int i = 0; i < 31; ++i) a.in[i] = (const float*)d_in[i];
    a.out = (float*)d_out; a.ws = (unsigned char*)d_ws;
#if MK_ONE_LAUNCH
    a.ph_lo = 0; a.ph_hi = N_PHASES; a.use_bar = 1;
    hipLaunchKernelGGL(fwd_kernel, dim3(grid), dim3(NTHREADS), LDS_BYTES, stream, a);
#else
    for (int p = 0; p < N_PHASES; ++p) { a.ph_lo = p; a.ph_hi = p + 1; a.use_bar = 0; hipLaunchKernelGGL(fwd_kernel, dim3(grid), dim3(NTHREADS), LDS_BYTES, stream, a); }
#endif
}
```

```cpp
#include <hip/hip_runtime.h>
#include <cstdio>
#include <cstdint>
#include <cmath>
namespace pg8 {
#define PG8_LAS __attribute__((address_space(3)))
typedef unsigned short bf16_t;
typedef short bf16x8 __attribute__((ext_vector_type(8)));
typedef float f32x4 __attribute__((ext_vector_type(4)));
typedef unsigned u32x4 __attribute__((ext_vector_type(4)));
constexpr int BM = 256, BK = 64, HALF = 128, HTB = HALF * BK * 2  , STAGE_BYTES = 8 * HTB, NXCD = 8, WGM = 8;

__host__ __device__ __forceinline__ int lds_byte(int r, int c) { const int st = (r >> 4) * 2 + (c >> 5), rr = r & 15, cc = c & 31, ob = rr * 64 + cc * 2; return st * 1024 + (ob ^ (((ob >> 9) & 1) << 5)); }
__host__ __device__ __forceinline__ void stage_rc(int b, int& R, int& C) { const int st = b / 1024, sb = b % 1024, swz = sb ^ (((sb >> 9) & 1) << 5); R = (st >> 1) * 16 + swz / 64; C = (st & 1) * 32 + (swz % 64) / 2; }
__host__ __device__ __forceinline__ int perm32(int rho) { const int n = rho >> 4, i = rho & 15; return 8 * (i >> 2) + 4 * n + (i & 3); }

struct Unit { int pm, pn; };
struct Gemm { const bf16_t* A; const bf16_t* Bt; int M, N, K; };

struct StaticOrder {
    int nM, nN, nwg, G, c;
    __host__ __device__ void init(int M, int N, int G_, int c_, int bmr = BM) { nM = M / bmr; nN = N / BM; nwg = nM * nN; G = G_; c = c_; }
    __host__ __device__ bool next(int i, Unit& u) const {
        const long L = (long)i * G + c; if (L >= nwg) return false;
        int wgid = (int)L; { const int q = nwg / NXCD, r = nwg % NXCD, xcd = wgid % NXCD, off = wgid / NXCD; wgid = (xcd < r ? xcd * (q + 1) : r * (q + 1) + (xcd - r) * q) + off; }
        const int nig = WGM * nN, gid = wgid / nig, fm = gid * WGM, gsz = (nM - fm) < WGM ? (nM - fm) : WGM;
        u.pm = fm + ((wgid % nig) % gsz); u.pn = (wgid % nig) / gsz; return true;
    }
    __device__ __forceinline__ void a_ready(const Unit&) const {}
    __device__ __forceinline__ void done(const Unit&) const {}
};

__device__ __forceinline__ unsigned cvt_pk_bf16(float lo, float hi) { unsigned r; asm volatile("v_cvt_pk_bf16_f32 %0, %1, %2" : "=v"(r) : "v"(lo), "v"(hi)); return r; }
typedef float f32x2 __attribute__((ext_vector_type(2)));
typedef unsigned u32x2 __attribute__((ext_vector_type(2)));
constexpr int T_CTX = 8192, QKV_LD = 2304;
constexpr float QSCALE = 0.125f * 1.4426950408889634f;
struct EpiInProj {
    static constexpr bool PERM = true, AFTER_DRAIN = false;
    bf16_t* QKV; float* out; const f32x2* rope;
    template <int MR> __device__ __forceinline__ void operator()(const f32x4 (&acc)[2][2][MR][2], const Unit& u, int wr, int wc, int fr, int fq) const {
        constexpr int HRr = MR * 32, BMR = 2 * HRr, WRO = HRr / 2;
        const bool hi_half = fq >= 2;
#pragma unroll
        for (int bj = 0; bj < 2; ++bj) {
            const int colbase = u.pn * BM + bj * HALF + wc * 32;
            const bool rope_col = (colbase < 640 || (colbase >= 768 && colbase < 1792));
            const bool q_col = (colbase < 512 || (colbase >= 768 && colbase < 1280));
            long ooff = -1; int ow = 0, cs = 0;
            if (colbase >= 512 && colbase < 640) { ooff = 25165824; ow = 128; cs = 512; }
            else if (colbase >= 640 && colbase < 768) { ooff = 26214400; ow = 128; cs = 640; }
            else if (colbase >= 1280 && colbase < 1792) { ooff = 27262976; ow = 512; cs = 1280; }
            else if (colbase >= 1792) { ooff = 31457280; ow = 512; cs = 1792; }
#pragma unroll
            for (int ai = 0; ai < 2; ++ai)
#pragma unroll
                for (int m = 0; m < MR; ++m) {
                    const int rowg = u.pm * BMR + ai * HRr + wr * WRO + m * 16;
                    const bool lat = rowg >= T_CTX;
                    const int row = rowg + fr;
                    f32x4 v[2] = {acc[ai][bj][m][0], acc[ai][bj][m][1]};
                    if (rope_col && lat) {
                        const int t = (row - T_CTX) & 4095;
                        const int pos = (wc & 1) ? (t & 63) : (t >> 6);
                        const f32x4* rp = (const f32x4*)(rope + pos * 16 + 8 * (fq & 1));
#pragma unroll
                        for (int n = 0; n < 2; ++n) {
                            const f32x4 c01 = rp[2 * n], c23 = rp[2 * n + 1];
                            const float cs_[4] = {c01[0], c01[2], c23[0], c23[2]}, sn_[4] = {c01[1], c01[3], c23[1], c23[3]};
#pragma unroll
                            for (int e = 0; e < 4; ++e) {
                                const float p = __shfl_xor(v[n][e], 32);
                                v[n][e] = hi_half ? (p * sn_[e] + v[n][e] * cs_[e]) : (v[n][e] * cs_[e] - p * sn_[e]);
                            }
                        }
                    }
                    if (q_col) { v[0] = v[0] * QSCALE; v[1] = v[1] * QSCALE; }
                    bf16_t* qp = QKV + (size_t)row * QKV_LD + colbase + 8 * fq;
                    u32x4 w; w.x = cvt_pk_bf16(v[0][0], v[0][1]); w.y = cvt_pk_bf16(v[0][2], v[0][3]); w.z = cvt_pk_bf16(v[1][0], v[1][1]); w.w = cvt_pk_bf16(v[1][2], v[1][3]);
                    *(u32x4*)qp = w;
                    if (ooff >= 0 && !lat) { float* op = out + ooff + (size_t)row * ow + (colbase - cs) + 8 * fq; *(f32x4*)op = v[0]; *(f32x4*)(op + 4) = v[1]; }
                }
        }
    }
};
constexpr int X_SPLIT = 16384;
template <bool IN_F32>
struct EpiRes {
    static constexpr bool PERM = true, AFTER_DRAIN = false;
    const float* xin_ctx; const float* xin_lat; bf16_t* XA; bf16_t* XB; const float* gate; int row0;
    template <int MR> __device__ __forceinline__ void operator()(const f32x4 (&acc)[2][2][MR][2], const Unit& u, int wr, int wc, int fr, int fq) const {
        constexpr int HRr = MR * 32, BMR = 2 * HRr, WRO = HRr / 2;
        const int rowt = row0 + u.pm * BMR;
#pragma unroll
        for (int ai = 0; ai < 2; ++ai)
#pragma unroll
            for (int m = 0; m < MR; ++m) {
                const int rowg = rowt + ai * HRr + wr * WRO + m * 16;
                const int midx = rowg < T_CTX ? 4 : ((rowg - T_CTX) >> 12);
                const float* g = gate + (size_t)midx * 6144;
                bf16_t* xr = (rowg < X_SPLIT ? XA + (size_t)rowg * 1024 : XB + (size_t)(rowg - X_SPLIT) * 1024) + (size_t)fr * 1024;
                const float* xf = (rowg < T_CTX ? xin_ctx : xin_lat - (size_t)T_CTX * 1024) + (size_t)(rowg + fr) * 1024;
#pragma unroll
                for (int bj = 0; bj < 2; ++bj) {
                    const int col = u.pn * BM + bj * HALF + wc * 32 + 8 * fq;
                    const f32x4 gv0 = *(const f32x4*)(g + col), gv1 = *(const f32x4*)(g + col + 4);
                    f32x4 x0, x1;
                    if (IN_F32) { x0 = *(const f32x4*)(xf + col); x1 = *(const f32x4*)(xf + col + 4); }
                    else { const u32x4 w = *(const u32x4*)(xr + col);
                        x0[0] = __builtin_bit_cast(float, w.x << 16); x0[1] = __builtin_bit_cast(float, w.x & 0xffff0000u); x0[2] = __builtin_bit_cast(float, w.y << 16); x0[3] = __builtin_bit_cast(float, w.y & 0xffff0000u);
                        x1[0] = __builtin_bit_cast(float, w.z << 16); x1[1] = __builtin_bit_cast(float, w.z & 0xffff0000u); x1[2] = __builtin_bit_cast(float, w.w << 16); x1[3] = __builtin_bit_cast(float, w.w & 0xffff0000u); }
                    x0 = x0 + gv0 * acc[ai][bj][m][0]; x1 = x1 + gv1 * acc[ai][bj][m][1];
                    u32x4 o; o.x = cvt_pk_bf16(x0[0], x0[1]); o.y = cvt_pk_bf16(x0[2], x0[3]); o.z = cvt_pk_bf16(x1[0], x1[1]); o.w = cvt_pk_bf16(x1[2], x1[3]);
                    *(u32x4*)(xr + col) = o;
                }
            }
    }
};
struct EpiSqRelu {
    static constexpr bool PERM = true, AFTER_DRAIN = false;
    bf16_t* O; int ldc;
    template <int MR> __device__ __forceinline__ void operator()(const f32x4 (&acc)[2][2][MR][2], const Unit& u, int wr, int wc, int fr, int fq) const {
        constexpr int HRr = MR * 32, BMR = 2 * HRr, WRO = HRr / 2;
#pragma unroll
        for (int ai = 0; ai < 2; ++ai)
#pragma unroll
            for (int m = 0; m < MR; ++m) {
                bf16_t* rowp = O + (size_t)(u.pm * BMR + ai * HRr + wr * WRO + m * 16 + fr) * ldc + u.pn * BM + wc * 32 + 8 * fq;
#pragma unroll
                for (int bj = 0; bj < 2; ++bj) {
                    f32x4 v0 = acc[ai][bj][m][0], v1 = acc[ai][bj][m][1];
#pragma unroll
                    for (int e = 0; e < 4; ++e) { const float a = fmaxf(v0[e], 0.f), b = fmaxf(v1[e], 0.f); v0[e] = a * a; v1[e] = b * b; }
                    u32x4 w; w.x = cvt_pk_bf16(v0[0], v0[1]); w.y = cvt_pk_bf16(v0[2], v0[3]); w.z = cvt_pk_bf16(v1[0], v1[1]); w.w = cvt_pk_bf16(v1[2], v1[3]);
                    *(u32x4*)(rowp + bj * HALF) = w;
                }
            }
    }
};
__device__ __forceinline__ float gelu_tanh(float x) {
    const float u2 = 1.5957691216057308f * (x + 0.044715f * x * x * x);
    return x * __builtin_amdgcn_rcpf(1.0f + __builtin_amdgcn_exp2f(-1.4426950408889634f * u2));
}
struct EpiRecIn {
    static constexpr bool PERM = true, AFTER_DRAIN = false;
    bf16_t* GG; bf16_t* XR; bf16_t* HALO;
    template <int MR> __device__ __forceinline__ void operator()(const f32x4 (&acc)[2][2][MR][2], const Unit& u, int wr, int wc, int fr, int fq) const {
        constexpr int HRr = MR * 32, BMR = 2 * HRr, WRO = HRr / 2;
        const bool isg = u.pn < 5;
        bf16_t* base = isg ? GG : XR; const int colt = (isg ? u.pn : u.pn - 5) * BM;
#pragma unroll
        for (int ai = 0; ai < 2; ++ai)
#pragma unroll
            for (int m = 0; m < MR; ++m) {
                const int row = u.pm * BMR + ai * HRr + wr * WRO + m * 16 + fr;
                bf16_t* rowp = base + (size_t)row * 1280 + colt + wc * 32 + 8 * fq;
                const int rl = row & 63; const bool halo = !isg && (rl == 63 || rl <= 1);
                bf16_t* hp = HALO + ((size_t)(row >> 6) * 3 + (rl == 63 ? 0 : rl + 1)) * 1280 + colt + wc * 32 + 8 * fq;
#pragma unroll
                for (int bj = 0; bj < 2; ++bj) {
                    f32x4 v0 = acc[ai][bj][m][0], v1 = acc[ai][bj][m][1];
                    if (isg) {
#pragma unroll
                        for (int e = 0; e < 4; ++e) { v0[e] = gelu_tanh(v0[e]); v1[e] = gelu_tanh(v1[e]); }
                    }
                    u32x4 w; w.x = cvt_pk_bf16(v0[0], v0[1]); w.y = cvt_pk_bf16(v0[2], v0[3]); w.z = cvt_pk_bf16(v1[0], v1[1]); w.w = cvt_pk_bf16(v1[2], v1[3]);
                    *(u32x4*)(rowp + bj * HALF) = w;
                    if (halo) *(u32x4*)(hp + bj * HALF) = w;
                }
            }
    }
};
template <class Epi, class Sched, bool ALIGN_EPI = false, bool SP2 = false, int HR = 128>
__device__ __forceinline__ void gemm_phase(PG8_LAS unsigned char* lds, const Gemm g, const Sched& S, const Epi& E) {
    int tid_ = threadIdx.x; asm volatile("" : "+v"(tid_));
    const int tid = tid_, wid = __builtin_amdgcn_readfirstlane(tid >> 6), lane = tid & 63, wr = wid >> 2, wc = wid & 3, fr = lane & 15, fq = lane >> 4;
    constexpr int MR = HR / 32;
    const int K = g.K, nt = K / BK;
    unsigned voffA[2], voffB[2];
#pragma unroll
    for (int i = 0; i < 2; ++i) { int R, C; stage_rc(tid * 16 + i * 8192, R, C); const int Rb = Epi::PERM ? ((R & ~31) + perm32(R & 31)) : R;
        voffA[i] = (unsigned)(R * K + C) * 2u; voffB[i] = (unsigned)(Rb * K + C) * 2u; }
    const size_t kstep = (size_t)(BK * 2);
    const size_t hstep = (size_t)HALF * K * 2;
    const size_t tstep = 2 * hstep;
    const size_t hstepA = (size_t)HR * K * 2, tstepA = 2 * hstepA;
    const unsigned ldsw = (unsigned)wid * 1024u;
    const int aoff = lds_byte(wr * (HR / 2) + fr, fq * 8), boff = lds_byte(wc * 32 + fr, fq * 8);
#define PG8_SA(b, h) (((b) * 2 + (h)) * HTB)
#define PG8_SB(b, h) ((4 + (b) * 2 + (h)) * HTB)
#define PG8_STAGE(bufoff, gbase, voff) do { _Pragma("unroll") for (int _i = 0; _i < 2; ++_i) \
        __builtin_amdgcn_global_load_lds((const unsigned*)((const char*)(gbase) + (voff)[_i]), (PG8_LAS unsigned*)(lds + (bufoff) + ldsw + _i * 8192), 16, 0, 0); } while (0)
#define PG8_LDA(dst, b, h) do { _Pragma("unroll") for (int m = 0; m < MR; ++m) _Pragma("unroll") for (int k = 0; k < 2; ++k) dst[m][k] = *(const PG8_LAS bf16x8*)(lds + PG8_SA(b, h) + aoff + m * 2048 + k * 1024); } while (0)
#define PG8_LDB(dst, b, h) do { _Pragma("unroll") for (int n = 0; n < 2; ++n) _Pragma("unroll") for (int k = 0; k < 2; ++k) dst[n][k] = *(const PG8_LAS bf16x8*)(lds + PG8_SB(b, h) + boff + n * 2048 + k * 1024); } while (0)
#define PG8_MMA(ai, bj, At, Bt) do { __builtin_amdgcn_s_setprio(1); _Pragma("unroll") for (int m = 0; m < MR; ++m) _Pragma("unroll") for (int n = 0; n < 2; ++n) _Pragma("unroll") for (int k = 0; k < 2; ++k) \
        acc[ai][bj][m][n] = __builtin_amdgcn_mfma_f32_16x16x32_bf16(Bt[n][k], At[m][k], acc[ai][bj][m][n], 0, 0, 0); __builtin_amdgcn_s_setprio(0); } while (0)
#define PG8_WAIT_V(n) asm volatile("s_waitcnt vmcnt(" #n ")" ::: "memory")
#define PG8_WAIT_L(n) asm volatile("s_waitcnt lgkmcnt(" #n ")" ::: "memory")
#define PG8_BAR __builtin_amdgcn_s_barrier()
#define PG8_SCHED __builtin_amdgcn_sched_barrier(0)
    Unit cur, nxt; int ui = 0;
    if (!S.next(0, cur)) return;
    f32x4 acc[2][2][MR][2];
#pragma unroll
    for (int a = 0; a < 2; ++a)
#pragma unroll
        for (int b = 0; b < 2; ++b)
#pragma unroll
            for (int m = 0; m < MR; ++m)
#pragma unroll
                for (int n = 0; n < 2; ++n) acc[a][b][m][n] = (f32x4){0.f, 0.f, 0.f, 0.f};
    bf16x8 At[MR][2], B0[2][2], B1[2][2];
    const char* cA = (const char*)g.A + (size_t)cur.pm * tstepA; const char* cB = (const char*)g.Bt + (size_t)cur.pn * tstep;
    S.a_ready(cur);
    if constexpr (SP2) {
        PG8_STAGE(PG8_SB(0, 0), cB, voffB); PG8_STAGE(PG8_SB(0, 1), cB + hstep, voffB); PG8_STAGE(PG8_SA(0, 0), cA, voffA); PG8_STAGE(PG8_SA(0, 1), cA + hstepA, voffA);
        if (wr == 1) PG8_BAR;
        PG8_WAIT_V(2); PG8_BAR;
        PG8_STAGE(PG8_SB(1, 0), cB + kstep, voffB); PG8_STAGE(PG8_SA(1, 0), cA + kstep, voffA); PG8_STAGE(PG8_SB(1, 1), cB + hstep + kstep, voffB);
        PG8_WAIT_V(6); PG8_BAR;
    } else {
        PG8_STAGE(PG8_SB(0, 0), cB, voffB); PG8_STAGE(PG8_SA(0, 0), cA, voffA); PG8_STAGE(PG8_SB(0, 1), cB + hstep, voffB); PG8_STAGE(PG8_SA(0, 1), cA + hstepA, voffA);
        if (wr == 1) PG8_BAR;
        PG8_WAIT_V(4); PG8_BAR;
        PG8_STAGE(PG8_SB(1, 0), cB + kstep, voffB); PG8_STAGE(PG8_SA(1, 0), cA + kstep, voffA); PG8_STAGE(PG8_SB(1, 1), cB + hstep + kstep, voffB);
        PG8_WAIT_V(6); PG8_BAR;
    }
    for (;;) {
        const bool has_next = S.next(ui + 1, nxt);
        const char* nA = has_next ? (const char*)g.A + (size_t)nxt.pm * tstepA : cA; const char* nB = has_next ? (const char*)g.Bt + (size_t)nxt.pn * tstep : cB;
        for (int t = 0; t < nt; t += 2) {
            const bool last = (t == nt - 2);
            const char* a1 = cA + (size_t)(t + 1) * kstep;
            const char* a2 = last ? nA : cA + (size_t)(t + 2) * kstep; const char* b2 = last ? nB : cB + (size_t)(t + 2) * kstep;
            const char* a3 = a2 + kstep; const char* b3 = b2 + kstep;
            if (last && has_next) S.a_ready(nxt);
            if constexpr (SP2) {
            PG8_LDB(B0, 0, 0); PG8_LDB(B1, 0, 1); PG8_SCHED; PG8_LDA(At, 0, 0); PG8_STAGE(PG8_SA(1, 1), a1 + hstepA, voffA);
            PG8_WAIT_V(8); PG8_WAIT_L(0); PG8_BAR; PG8_MMA(0, 0, At, B0); PG8_MMA(0, 1, At, B1); PG8_BAR; PG8_SCHED;
            PG8_LDA(At, 0, 1); PG8_STAGE(PG8_SB(0, 0), b2, voffB); PG8_STAGE(PG8_SB(0, 1), b2 + hstep, voffB); PG8_STAGE(PG8_SA(0, 0), a2, voffA);
            PG8_WAIT_V(8); PG8_WAIT_L(0); PG8_BAR; PG8_MMA(1, 0, At, B0); PG8_MMA(1, 1, At, B1); PG8_BAR; PG8_SCHED;
            PG8_LDB(B0, 1, 0); PG8_LDB(B1, 1, 1); PG8_SCHED; PG8_LDA(At, 1, 0); PG8_STAGE(PG8_SA(0, 1), a2 + hstepA, voffA);
            PG8_WAIT_V(8); PG8_WAIT_L(0); PG8_BAR; PG8_MMA(0, 0, At, B0); PG8_MMA(0, 1, At, B1); PG8_BAR; PG8_SCHED;
            PG8_LDA(At, 1, 1); PG8_STAGE(PG8_SB(1, 0), b3, voffB); PG8_STAGE(PG8_SB(1, 1), b3 + hstep, voffB); PG8_STAGE(PG8_SA(1, 0), a3, voffA);
            PG8_WAIT_V(8); PG8_WAIT_L(0); PG8_BAR; PG8_MMA(1, 0, At, B0); PG8_MMA(1, 1, At, B1); PG8_BAR; PG8_SCHED;
            } else {
            PG8_LDB(B0, 0, 0); PG8_SCHED; PG8_LDA(At, 0, 0); PG8_STAGE(PG8_SA(1, 1), a1 + hstepA, voffA);
            PG8_WAIT_L(8); PG8_BAR; PG8_WAIT_L(0); PG8_MMA(0, 0, At, B0); PG8_BAR; PG8_SCHED;
            PG8_LDB(B1, 0, 1); PG8_STAGE(PG8_SB(0, 0), b2, voffB);
            PG8_BAR; PG8_WAIT_L(0); PG8_MMA(0, 1, At, B1); PG8_BAR;
            PG8_LDA(At, 0, 1); PG8_STAGE(PG8_SA(0, 0), a2, voffA);
            PG8_BAR; PG8_WAIT_L(0); PG8_MMA(1, 0, At, B0); PG8_BAR; PG8_SCHED;
            PG8_STAGE(PG8_SB(0, 1), b2 + hstep, voffB);
            PG8_WAIT_V(6); PG8_BAR; PG8_MMA(1, 1, At, B1); PG8_BAR;
            PG8_LDB(B0, 1, 0); PG8_SCHED; PG8_LDA(At, 1, 0); PG8_STAGE(PG8_SA(0, 1), a2 + hstepA, voffA);
            PG8_WAIT_L(8); PG8_BAR; PG8_WAIT_L(0); PG8_MMA(0, 0, At, B0); PG8_BAR; PG8_SCHED;
            PG8_LDB(B1, 1, 1); PG8_STAGE(PG8_SB(1, 0), b3, voffB);
            PG8_BAR; PG8_WAIT_L(0); PG8_MMA(0, 1, At, B1); PG8_BAR;
            PG8_LDA(At, 1, 1); PG8_STAGE(PG8_SA(1, 0), a3, voffA);
            PG8_BAR; PG8_WAIT_L(0); PG8_MMA(1, 0, At, B0); PG8_BAR; PG8_SCHED;
            PG8_STAGE(PG8_SB(1, 1), b3 + hstep, voffB);
            PG8_WAIT_V(6); PG8_BAR; PG8_MMA(1, 1, At, B1); PG8_BAR;
            }
        }
        if constexpr (ALIGN_EPI) { if (wr == 0) PG8_BAR; }
        if constexpr (!Epi::AFTER_DRAIN) { E.template operator()<MR>(acc, cur, wr, wc, fr, fq); S.done(cur); }
        if (!has_next) break;
#pragma unroll
        for (int a = 0; a < 2; ++a)
#pragma unroll
            for (int b = 0; b < 2; ++b)
#pragma unroll
                for (int m = 0; m < MR; ++m)
#pragma unroll
                    for (int n = 0; n < 2; ++n) acc[a][b][m][n] = (f32x4){0.f, 0.f, 0.f, 0.f};
        cur = nxt; cA = nA; cB = nB; ++ui;
        if constexpr (ALIGN_EPI) { if (wr == 1) PG8_BAR; }
    }
    PG8_WAIT_V(0);
    if constexpr (!ALIGN_EPI) { if (wr == 0) PG8_BAR; }
    PG8_BAR;
    if constexpr (Epi::AFTER_DRAIN) { E.fused(acc, cur, wr, wc, fr, fq, lds, wid, lane); S.done(cur); }
#undef PG8_SA
#undef PG8_SB
#undef PG8_STAGE
#undef PG8_LDA
#undef PG8_LDB
#undef PG8_MMA
#undef PG8_WAIT_V
#undef PG8_WAIT_L
#undef PG8_BAR
#undef PG8_SCHED
}
}
constexpr int NWAVES = 8, NTHREADS = 512;
constexpr int DM = 1024, T_CTX = 8192, T_LAT = 16384, T_ALL = 24576, LAT_SEQ = 4096, CTX_SEQ = 256;
constexpr int QKV_LD = 2304, DFF = 4096, DRNN = 1280;
constexpr int QA_OFF = 0, KA_OFF = 512, VA_OFF = 640, QB_OFF = 768, KB_OFF = 1280, VB_OFF = 1792;
constexpr float EPSN = 1e-6f;
constexpr float SM_C = 0.125f * 1.4426950408889634f;
constexpr long OUT_AK = 25165824, OUT_AV = 26214400, OUT_BK = 27262976, OUT_BV = 31457280, OUT_SF = 35651584, OUT_SB = 35692544;
constexpr size_t MiB = 1u << 20;
constexpr size_t WS_CTL = 0, CTL_ZERO_BYTES = 64 * 1024;
constexpr size_t WS_MOD = 1 * MiB;
constexpr size_t WS_ROPE = 1 * MiB + 256 * 1024;
constexpr size_t WS_LAM = WS_ROPE + 16 * 1024;
constexpr size_t WS_CAK = 2 * MiB, WS_CAV = WS_CAK + 256 * 1024, WS_CBK = WS_CAV + 256 * 1024, WS_CBV = WS_CBK + 1 * MiB;
constexpr size_t WS_WIN = 5 * MiB;
constexpr size_t WS_WOUT = 10 * MiB;
constexpr size_t WS_W1 = 12 * MiB;
constexpr size_t WS_W2 = 28 * MiB;
constexpr size_t WS_WRIN = 44 * MiB;
constexpr size_t WS_WROUT = 49 * MiB;
constexpr size_t WS_WG = 52 * MiB;
constexpr size_t WS_SUM = 54 * MiB;
constexpr size_t WS_H = 56 * MiB;
constexpr size_t WS_BIG = 104 * MiB;
constexpr size_t WS_END = 256 * MiB;
static_assert(WS_BIG + (size_t)T_ALL * QKV_LD * 2 <= WS_END && WS_BIG + (size_t)(T_ALL / 2) * DFF * 2 <= WS_END && WS_BIG + (size_t)T_ALL * DRNN * 4 <= WS_END, "ws map");
constexpr int LDS_BYTES = 160 * 1024;
constexpr int MISC_OFF = 152 * 1024;

#define GAS __attribute__((address_space(1)))
#define LAS __attribute__((address_space(3)))
typedef unsigned short bf16;
typedef unsigned v4u __attribute__((ext_vector_type(4)));
typedef unsigned v2u __attribute__((ext_vector_type(2)));
typedef float f32x4 __attribute__((ext_vector_type(4)));
typedef float f32x2 __attribute__((ext_vector_type(2)));
typedef float f32x16 __attribute__((ext_vector_type(16)));
typedef short bf16x8 __attribute__((ext_vector_type(8)));
typedef short s16x4 __attribute__((ext_vector_type(4)));
typedef GAS unsigned gu32;
#define RLX_AGENT __ATOMIC_RELAXED, __HIP_MEMORY_SCOPE_AGENT
__device__ __forceinline__ unsigned f2bf(float f) { unsigned u = __builtin_bit_cast(unsigned, f); return (u + 0x7fffu + ((u >> 16) & 1u)) >> 16; }
__device__ __forceinline__ unsigned pk2(float lo, float hi) { return f2bf(lo) | (f2bf(hi) << 16); }
__device__ __forceinline__ float bf2f(unsigned short b) { return __builtin_bit_cast(float, (unsigned)b << 16); }
__device__ __forceinline__ float bflo(unsigned w) { return __builtin_bit_cast(float, w << 16); }
__device__ __forceinline__ float bfhi(unsigned w) { return __builtin_bit_cast(float, w & 0xffff0000u); }

#define XB_TMO      128
#define XB_XCNT(j)  (256  + 64 * (j))
#define XB_XSUB(j)  (1280 + 64 * (j))
#define XB_XGEN(j)  (2304 + 64 * (j))
#define XB_TOP      3328
#define XB_TOPGEN   3392
#define XCD_BAR_WORDS 3456
#define XB_SPIN_CAP (1u << 18)
__device__ __forceinline__ unsigned xb_ld(unsigned* p)              { return __hip_atomic_load(p, __ATOMIC_RELAXED, __HIP_MEMORY_SCOPE_AGENT); }
__device__ __forceinline__ unsigned xb_add(unsigned* p, unsigned v) { return __hip_atomic_fetch_add(p, v, __ATOMIC_RELAXED, __HIP_MEMORY_SCOPE_AGENT); }
__device__ __forceinline__ unsigned xb_xcc_id() { return (unsigned)__builtin_amdgcn_s_getreg((3 << 11) | 20) & 0xFu; }
#define XB_SPIN(cond, bar) do { unsigned _sp = 0; while (cond) { __builtin_amdgcn_s_sleep(1); \
    if ((++_sp & 255u) == 0u) { if (xb_ld(&(bar)[XB_TMO])) break; if (_sp > XB_SPIN_CAP) { atomicAdd(&(bar)[XB_TMO], 1u); break; } } } } while (0)
struct XcdBarrier { unsigned* bar; unsigned x; volatile LAS unsigned* st; };
__device__ __forceinline__ XcdBarrier xcd_barrier_post(unsigned* bar, volatile LAS unsigned* st) {
    XcdBarrier b; b.bar = bar; b.x = xb_xcc_id(); b.st = st;
    if (threadIdx.x == 0) (void)xb_add(&bar[XB_XCNT(b.x)], 1u);
    return b;
}
__device__ __forceinline__ void xcd_barrier_complete(unsigned* bar, unsigned x, unsigned& nloc, unsigned& nx) {
    const unsigned G = gridDim.x * gridDim.y * gridDim.z;
    unsigned sum, cnt, mine, sp = 0u;
    for (;;) {
        sum = 0u; cnt = 0u; mine = 0u;
#pragma unroll
        for (unsigned j = 0; j < 16; ++j) { const unsigned c = xb_ld(&bar[XB_XCNT(j)]); sum += c; cnt += (c > 0u) ? 1u : 0u; mine = (j == x) ? c : mine; }
        if (sum == G) break;
        __builtin_amdgcn_s_sleep(1);
        if ((++sp & 255u) == 0u) { if (xb_ld(&bar[XB_TMO])) break; if (sp > XB_SPIN_CAP) { atomicAdd(&bar[XB_TMO], 1u); break; } }
    }
    nloc = mine > 0u ? mine : 1u; nx = cnt > 0u ? cnt : 1u;
}
__device__ __forceinline__ void xcd_barrier(const XcdBarrier& b) {
    asm volatile("s_waitcnt vmcnt(0)" ::: "memory");
    __syncthreads();
    if (threadIdx.x == 0) {
        unsigned* bar = b.bar;
        __builtin_amdgcn_s_waitcnt(0);
        unsigned nloc = b.st[0], nx = b.st[1];
        if (nloc == 0u) { xcd_barrier_complete(bar, b.x, nloc, nx); b.st[0] = nloc; b.st[1] = nx; }
        const unsigned old = xb_add(&bar[XB_XSUB(b.x)], 1u);
        const unsigned gen = old / nloc;
        if (old + 1u == (gen + 1u) * nloc) {
            __builtin_amdgcn_fence(__ATOMIC_RELEASE, "agent");
            asm volatile("s_waitcnt vmcnt(0)" ::: "memory");
            const unsigned og = xb_add(&bar[XB_TOP], 1u);
            const unsigned tg = og / nx;
            if (og + 1u == (tg + 1u) * nx) xb_add(&bar[XB_TOPGEN], 1u);
            else XB_SPIN(xb_ld(&bar[XB_TOPGEN]) == tg, bar);
            __builtin_amdgcn_fence(__ATOMIC_ACQUIRE, "agent");
            xb_add(&bar[XB_XGEN(b.x)], 1u);
            asm volatile("s_waitcnt vmcnt(0)" ::: "memory");
        } else {
            XB_SPIN(xb_ld(&bar[XB_XGEN(b.x)]) == gen, bar);
            __builtin_amdgcn_fence(__ATOMIC_ACQUIRE, "agent");
            asm volatile("s_waitcnt vmcnt(0)" ::: "memory");
        }
    }
    __syncthreads();
}

struct Args { const float* in[31]; float* out; unsigned char* ws; int ph_lo, ph_hi; int use_bar, pad; };
struct Frame {
    LAS unsigned char* lds;
    int tid, lane, wave, vcu, G;
    const float* const* in; float* out; unsigned char* ws;
};
#define WSP(T, off) ((T*)(F.ws + (off)))
__device__ __forceinline__ Frame fresh(const Frame& F) { Frame P = F; int t = threadIdx.x; asm volatile("" : "+v"(t)); P.tid = t; P.lane = t & 63; P.wave = __builtin_amdgcn_readfirstlane(t >> 6); return P; }
enum { IN_XP = 0, IN_XS, IN_CAK, IN_CAV, IN_CBK, IN_CBV, IN_SF, IN_SB, IN_C, IN_CCTX, IN_NORM1, IN_NORM2, IN_WADA, IN_BADA, IN_WMLP1, IN_WMLP2, IN_AWIN, IN_AWOUT, IN_SINK, IN_LAMQK, IN_SUBLN,
       IN_RWIN, IN_RCONVW, IN_RCONVB, IN_RWA, IN_RBA, IN_RWX, IN_RBX, IN_RLAM, IN_RWOUT, IN_FNORM };

__device__ __forceinline__ float wave_sum(float v) {
#pragma unroll
    for (int o = 1; o < 64; o <<= 1) v += __shfl_xor(v, o);
    return v;
}

__device__ __forceinline__ void p0_transpose_item(const float* W, int K, int N, bf16* WT, LAS float* scr, int item, int lane, float wscale = 1.0f) {
    const int nblk = N / 32, kb = item / nblk, nb = item % nblk, k0 = 64 * kb, n0 = 32 * nb;
#pragma unroll 8
    for (int i = 0; i < 32; ++i) { const int kk = 2 * i + (lane >> 5); scr[kk * 33 + (lane & 31)] = W[(size_t)(k0 + kk) * N + n0 + (lane & 31)]; }
    asm volatile("s_waitcnt lgkmcnt(0)" ::: "memory");
    const int c = lane & 7;
#pragma unroll
    for (int j = 0; j < 4; ++j) { const int n = (lane >> 3) + 8 * j; const LAS float* s = scr + (8 * c) * 33 + n;
        v4u o; o.x = pk2(s[0 * 33] * wscale, s[1 * 33] * wscale); o.y = pk2(s[2 * 33] * wscale, s[3 * 33] * wscale); o.z = pk2(s[4 * 33] * wscale, s[5 * 33] * wscale); o.w = pk2(s[6 * 33] * wscale, s[7 * 33] * wscale);
        *(GAS v4u*)(WT + (size_t)(n0 + n) * K + k0 + 8 * c) = o; }
    asm volatile("s_waitcnt lgkmcnt(0)" ::: "memory");
}
__device__ __forceinline__ void p0_prologue(Frame& F) {
    const float* const* in = F.in;
    {
        LAS float* SC = (LAS float*)(F.lds);
        LAS float* RED = (LAS float*)(F.lds + 20480);
        for (int i = F.tid; i < 5 * 1024; i += NTHREADS) { const int v = i >> 10, k = i & 1023; const float c = v < 4 ? in[IN_C][v * 1024 + k] : in[IN_CCTX][k]; SC[i] = c / (1.0f + __expf(-c)); }
        __syncthreads();
        float* MOD = WSP(float, WS_MOD);
        for (int u = blockIdx.x; u < 384; u += F.G) {
            const int l = u / 192, n0 = (u % 192) * 32;
            const float* W = in[IN_WADA] + (size_t)l * 1024 * 6144 + n0 + (F.lane & 31);
            float a[5] = {0.f, 0.f, 0.f, 0.f, 0.f};
            const int kb = F.wave * 128 + (F.lane >> 5);
#pragma unroll 8
            for (int kk = 0; kk < 64; ++kk) { const int k = kb + 2 * kk; const float w = W[(size_t)k * 6144];
#pragma unroll
                for (int v = 0; v < 5; ++v) a[v] += SC[v * 1024 + k] * w; }
#pragma unroll
            for (int v = 0; v < 5; ++v) { a[v] += __shfl_xor(a[v], 32); if (F.lane < 32) RED[(F.wave * 5 + v) * 32 + F.lane] = a[v]; }
            __syncthreads();
            if (F.tid < 160) { const int v = F.tid >> 5, c = F.tid & 31; float s = in[IN_BADA][l * 6144 + n0 + c];
#pragma unroll
                for (int w = 0; w < 8; ++w) s += RED[(w * 5 + v) * 32 + c];
                MOD[((size_t)l * 5 + v) * 6144 + n0 + c] = s; }
            __syncthreads();
        }
    }
    {
        LAS float* scr = (LAS float*)(F.lds + 32768 + F.wave * 8704);
        const int gw = F.vcu * NWAVES + F.wave, NGW = F.G * NWAVES;
        constexpr int I_IN = 16 * 72, I_OUT = 16 * 32;
        for (int it = gw; it < I_IN + I_OUT; it += NGW) {
            if (it < I_IN) p0_transpose_item(in[IN_AWIN], 1024, 2304, WSP(bf16, WS_WIN), scr, it, F.lane);
            else p0_transpose_item(in[IN_AWOUT], 1024, 1024, WSP(bf16, WS_WOUT), scr, it - I_IN, F.lane);
        }
    }
    {
        const int gt = F.vcu * NTHREADS + F.tid, NGT = F.G * NTHREADS;
        for (int i = gt; i < 4 * 256 * 128 / 4; i += NGT) {
            const f32x4 a = ((const f32x4*)in[IN_CAK])[i], b = ((const f32x4*)in[IN_CAV])[i];
            v2u o; o.x = pk2(a[0], a[1]); o.y = pk2(a[2], a[3]); WSP(v2u, WS_CAK)[i] = o; o.x = pk2(b[0], b[1]); o.y = pk2(b[2], b[3]); WSP(v2u, WS_CAV)[i] = o; }
        for (int i = gt; i < 4 * 256 * 512 / 4; i += NGT) {
            const f32x4 a = ((const f32x4*)in[IN_CBK])[i], b = ((const f32x4*)in[IN_CBV])[i];
            v2u o; o.x = pk2(a[0], a[1]); o.y = pk2(a[2], a[3]); WSP(v2u, WS_CBK)[i] = o; o.x = pk2(b[0], b[1]); o.y = pk2(b[2], b[3]); WSP(v2u, WS_CBV)[i] = o; }
        if (gt < 1024) { const int pos = gt >> 4, i = gt & 15; const double ang = (double)pos * pow(10000.0, -(double)i / 16.0);
            WSP(f32x2, WS_ROPE)[gt] = (f32x2){(float)cos(ang), (float)sin(ang)}; }
        if (gt == 0) { const float* lq = in[IN_LAMQK]; float s1 = 0.f, s2 = 0.f; for (int i = 0; i < 64; ++i) { s1 += lq[i] * lq[64 + i]; s2 += lq[128 + i] * lq[192 + i]; }
            WSP(float, WS_LAM)[0] = __expf(s1) - __expf(s2) + 0.2f; }
    }
}

__device__ __forceinline__ void p_deferred_transposes(Frame& F, int iw, int nw) {
    const float* const* in = F.in;
    LAS float* scr = (LAS float*)(F.lds + 32768 + F.wave * 8704);
    const int gw = iw * NWAVES + F.wave, NGW = nw * NWAVES;
    constexpr int I_M1 = 16 * 128, I_M2 = 64 * 32, I_RIN = 16 * 80, I_ROUT = 20 * 32, I_G = 8;
    constexpr int NITEMS = 2 * I_M1 + 2 * I_M2 + I_RIN + I_ROUT + 40 * I_G;
    for (int it = gw; it < NITEMS; it += NGW) {
        int r = it;
        if (r < 2 * I_M1) { const int l = r / I_M1; p0_transpose_item(in[IN_WMLP1] + (size_t)l * 1024 * 4096, 1024, 4096, WSP(bf16, WS_W1) + (size_t)l * 4096 * 1024, scr, r % I_M1, F.lane); continue; } r -= 2 * I_M1;
        if (r < 2 * I_M2) { const int l = r / I_M2; p0_transpose_item(in[IN_WMLP2] + (size_t)l * 4096 * 1024, 4096, 1024, WSP(bf16, WS_W2) + (size_t)l * 1024 * 4096, scr, r % I_M2, F.lane); continue; } r -= 2 * I_M2;
        if (r < I_RIN) { p0_transpose_item(in[IN_RWIN], 1024, 2560, WSP(bf16, WS_WRIN), scr, r, F.lane); continue; } r -= I_RIN;
        if (r < I_ROUT) { p0_transpose_item(in[IN_RWOUT], 1280, 1024, WSP(bf16, WS_WROUT), scr, r, F.lane); continue; } r -= I_ROUT;
        { const int mtx = r / I_G, gate = mtx / 20, db = mtx % 20;
          p0_transpose_item(in[gate ? IN_RWX : IN_RWA] + (size_t)db * 16384, 128, 128, WSP(bf16, WS_WG) + (size_t)(gate * 20 + db) * 16384, scr, r % I_G, F.lane, -1.4426950408889634f); }
    }
}

__device__ __forceinline__ void norm_mod_pass(Frame& F, const float* x_ctx, const float* x_lat, const float* g, const float* mod  , int shift_off, int scale_off, bf16* H) {
    const int gw = F.vcu * NWAVES + F.wave, NGW = F.G * NWAVES;
    for (int m = gw; m < T_ALL; m += NGW) {
        const float* xr = m < T_CTX ? x_ctx + (size_t)m * DM : x_lat + (size_t)(m - T_CTX) * DM;
        const int midx = m < T_CTX ? 4 : ((m - T_CTX) >> 12);
        const float* mv = mod + (size_t)midx * 6144;
        f32x4 v[4]; float s = 0.f;
#pragma unroll
        for (int j = 0; j < 4; ++j) { v[j] = ((const f32x4*)xr)[F.lane + 64 * j]; s += (v[j][0] * v[j][0] + v[j][1] * v[j][1]) + (v[j][2] * v[j][2] + v[j][3] * v[j][3]); }
        const float rstd = 1.0f / sqrtf(wave_sum(s) * (1.0f / DM) + EPSN);
#pragma unroll
        for (int j = 0; j < 4; ++j) {
            const int c = 4 * (F.lane + 64 * j);
            const f32x4 gg = *(const f32x4*)(g + c), sc = *(const f32x4*)(mv + scale_off + c), sh = *(const f32x4*)(mv + shift_off + c);
            f32x4 o = (v[j] * rstd) * gg; o = o * (sc + 1.0f) + sh;
            v2u w; w.x = pk2(o[0], o[1]); w.y = pk2(o[2], o[3]);
            *(v2u*)(H + (size_t)m * DM + c) = w;
        }
    }
}
constexpr int X_SPLIT = 16384;
__device__ __forceinline__ const bf16* xrow_bf(const bf16* XA, const bf16* XB, int m) { return m < X_SPLIT ? XA + (size_t)m * DM : XB + (size_t)(m - X_SPLIT) * DM; }
__device__ __forceinline__ void unpack16(const v4u a, const v4u b, float (&v)[16]) {
    const unsigned w[8] = {a.x, a.y, a.z, a.w, b.x, b.y, b.z, b.w};
#pragma unroll
    for (int e = 0; e < 8; ++e) { v[2 * e] = bflo(w[e]); v[2 * e + 1] = bfhi(w[e]); }
}
__device__ __forceinline__ void norm_mod_pass_bf(Frame& F, const bf16* XA, const bf16* XB, const float* g, const float* mod  , int shift_off, int scale_off, bf16* H) {
    const int gw = F.vcu * NWAVES + F.wave, NGW = F.G * NWAVES;
    for (int m = gw; m < T_ALL; m += NGW) {
        const v4u* xp = (const v4u*)(xrow_bf(XA, XB, m) + F.lane * 8);
        const int midx = m < T_CTX ? 4 : ((m - T_CTX) >> 12);
        const float* mv = mod + (size_t)midx * 6144;
        float v[16]; unpack16(xp[0], xp[64], v);
        float s = 0.f;
#pragma unroll
        for (int e = 0; e < 16; ++e) s += v[e] * v[e];
        const float rstd = 1.0f / sqrtf(wave_sum(s) * (1.0f / DM) + EPSN);
        unsigned ow[8];
#pragma unroll
        for (int q = 0; q < 4; ++q) {
            const int c = 8 * F.lane + (q >> 1) * 512 + (q & 1) * 4;
            const f32x4 gg = *(const f32x4*)(g + c), sc = *(const f32x4*)(mv + scale_off + c), sh = *(const f32x4*)(mv + shift_off + c);
            const float o0 = (v[4 * q] * rstd) * gg[0] * (sc[0] + 1.0f) + sh[0], o1 = (v[4 * q + 1] * rstd) * gg[1] * (sc[1] + 1.0f) + sh[1];
            const float o2 = (v[4 * q + 2] * rstd) * gg[2] * (sc[2] + 1.0f) + sh[2], o3 = (v[4 * q + 3] * rstd) * gg[3] * (sc[3] + 1.0f) + sh[3];
            ow[2 * q] = pk2(o0, o1); ow[2 * q + 1] = pk2(o2, o3);
        }
        v4u* hp = (v4u*)(H + (size_t)m * DM + 8 * F.lane);
        v4u a, b2; a.x = ow[0]; a.y = ow[1]; a.z = ow[2]; a.w = ow[3]; b2.x = ow[4]; b2.y = ow[5]; b2.z = ow[6]; b2.w = ow[7];
        hp[0] = a; hp[64] = b2;
    }
}
__device__ __forceinline__ void final_norm_pass(Frame& F, const bf16* XA, const bf16* XB, float* Y, const float* g, int m_lo, int m_hi) {
    const int gw = F.vcu * NWAVES + F.wave, NGW = F.G * NWAVES;
    for (int m = m_lo + gw; m < m_hi; m += NGW) {
        const v4u* xp = (const v4u*)(xrow_bf(XA, XB, m) + F.lane * 8);
        float v[16]; unpack16(xp[0], xp[64], v);
        float s = 0.f;
#pragma unroll
        for (int e = 0; e < 16; ++e) s += v[e] * v[e];
        const float rstd = 1.0f / sqrtf(wave_sum(s) * (1.0f / DM) + EPSN);
#pragma unroll
        for (int q = 0; q < 4; ++q) { const int c = 8 * F.lane + (q >> 1) * 512 + (q & 1) * 4; const f32x4 gg = *(const f32x4*)(g + c);
            f32x4 o; o[0] = v[4 * q] * rstd * gg[0]; o[1] = v[4 * q + 1] * rstd * gg[1]; o[2] = v[4 * q + 2] * rstd * gg[2]; o[3] = v[4 * q + 3] * rstd * gg[3];
            *(f32x4*)(Y + (size_t)m * DM + c) = o; }
    }
}

constexpr float ATT_THR = 8.0f;
constexpr int AT_K0 = 0, AT_K1 = 9216;
constexpr int AT_V0 = 18432, AT_V1 = 38912;
constexpr int AT_WS = 59392;
constexpr int AT_O1 = 61440;
static_assert(AT_O1 + 65536 <= MISC_OFF, "attention LDS map");
__device__ __forceinline__ int crow(int r, int hi) { return (r & 3) + 8 * (r >> 2) + 4 * hi; }
__device__ __forceinline__ unsigned cvtpk_s(float lo, float hi) { typedef __bf16 bf16x2_t __attribute__((ext_vector_type(2))); f32x2 v = {lo, hi}; bf16x2_t b = __builtin_convertvector(v, bf16x2_t); return __builtin_bit_cast(unsigned, b); }
__device__ __forceinline__ s16x4 vtr(const LAS unsigned char* p) { typedef short v4i16_t __attribute__((ext_vector_type(4))); return __builtin_bit_cast(s16x4, __builtin_amdgcn_ds_read_tr16_b64_v4i16((LAS v4i16_t*)p)); }

struct AttnSrc {
    const bf16* K0; const bf16* V0; int ld0, n0;
    const bf16* K1; const bf16* V1; int ld1, t_lo, t_hi;
};
template <int DV, bool WINDOW>
__device__ __forceinline__ void attn_pass(Frame& F, const bf16* Q, int ldq, const AttnSrc& S, int qpos0, float m_init, float l_init, bool start_exact, f32x16 (&o)[DV / 32], float& m_out, float& l_out) {
    constexpr int RSV = DV == 128 ? 320 : 192, NVL = DV / 64;
    LAS unsigned char* lds = F.lds;
    const int tid = F.tid, lane = F.lane, wid = F.wave, r32 = lane & 31, hi = lane >> 5;
    LAS float* wsf = (LAS float*)(lds + AT_WS) + wid * 64;
    bf16x8 qr[4];
    { const bf16* qp = Q + (size_t)(wid * 32 + r32) * ldq + hi * 8;
#pragma unroll
      for (int d0 = 0; d0 < 4; ++d0) qr[d0] = *(const bf16x8*)(qp + d0 * 16); }
#pragma unroll
    for (int d = 0; d < DV / 32; ++d) o[d] = f32x16{};
    float m = m_init, l = l_init;
    f32x16 negm;
#pragma unroll
    for (int r = 0; r < 16; ++r) negm[r] = -m_init;
    const int nt = S.n0 + (S.t_hi - S.t_lo);
    v4u kreg, vreg[NVL];
    const int krow = tid >> 3, kch = tid & 7;
#define AT_ISSUE(it_) do { const int it__ = (it_); const bf16* Kp; const bf16* Vp; int ld; \
        if (it__ < S.n0) { Kp = S.K0 + (size_t)(it__ * 64) * S.ld0; Vp = S.V0 + (size_t)(it__ * 64) * S.ld0; ld = S.ld0; } \
        else { const int t = S.t_lo + it__ - S.n0; Kp = S.K1 + (size_t)(t * 64) * S.ld1; Vp = S.V1 + (size_t)(t * 64) * S.ld1; ld = S.ld1; } \
        kreg = *(const v4u*)(Kp + (size_t)krow * ld + kch * 8); \
        if (DV == 128) { _Pragma("unroll") for (int i = 0; i < NVL; ++i) { const int idx = tid + 512 * i; vreg[i] = *(const v4u*)(Vp + (size_t)(idx >> 4) * ld + (idx & 15) * 8); } } \
        else vreg[0] = *(const v4u*)(Vp + (size_t)krow * ld + kch * 8); } while (0)
#define AT_COMMIT(buf_) do { const int kb_ = (buf_) ? AT_K1 : AT_K0, vb_ = (buf_) ? AT_V1 : AT_V0; \
        *(LAS v4u*)(lds + kb_ + krow * 144 + kch * 16) = kreg; \
        if (DV == 128) { _Pragma("unroll") for (int i = 0; i < NVL; ++i) { const int idx = tid + 512 * i; *(LAS v4u*)(lds + vb_ + (idx >> 4) * RSV + (idx & 15) * 16) = vreg[i]; } } \
        else *(LAS v4u*)(lds + vb_ + krow * RSV + kch * 16) = vreg[0]; } while (0)
    const int koff = r32 * 144 + hi * 16;
    const int voff = (4 * hi + ((lane & 15) >> 2)) * RSV + ((lane >> 4) & 1) * 32 + (lane & 3) * 8;
    const int qw0 = qpos0 + 32 * wid;
    if (wid >= 4) __builtin_amdgcn_s_setprio(1);
    __syncthreads();
    AT_ISSUE(0); AT_COMMIT(0);
    if (nt > 1) AT_ISSUE(1);
#pragma unroll 1
    for (int it = 0; it < nt; ++it) {
        __syncthreads();
        const LAS unsigned char* kbase = lds + ((it & 1) ? AT_K1 : AT_K0) + koff;
        const LAS unsigned char* vbase = lds + ((it & 1) ? AT_V1 : AT_V0) + voff;
        bool skip = false, need_mask = false;
        int kp0 = 0;
        if (WINDOW && it >= S.n0) {
            kp0 = (S.t_lo + it - S.n0) * 64;
            skip = (kp0 + 63 < qw0 - 128 || kp0 > qw0 + 31 + 128);
            need_mask = !(kp0 >= qw0 + 31 - 128 && kp0 + 63 <= qw0 + 128);
        }
        if (!skip) {
            f32x16 p0, p1;
#pragma unroll
            for (int d0 = 0; d0 < 4; ++d0) {
                const bf16x8 k0 = *(const LAS bf16x8*)(kbase + d0 * 32);
                const bf16x8 k1 = *(const LAS bf16x8*)(kbase + 32 * 144 + d0 * 32);
                if (d0 == 0) { p0 = __builtin_amdgcn_mfma_f32_32x32x16_bf16(k0, qr[0], negm, 0, 0, 0); p1 = __builtin_amdgcn_mfma_f32_32x32x16_bf16(k1, qr[0], negm, 0, 0, 0); }
                else { p0 = __builtin_amdgcn_mfma_f32_32x32x16_bf16(k0, qr[d0], p0, 0, 0, 0); p1 = __builtin_amdgcn_mfma_f32_32x32x16_bf16(k1, qr[d0], p1, 0, 0, 0); }
            }
            if (WINDOW && need_mask) {
                const int q = qw0 + r32;
#pragma unroll
                for (int r = 0; r < 16; ++r) { const int kv = kp0 + crow(r, hi); int d0 = q - kv; d0 = d0 < 0 ? -d0 : d0; int d1 = q - kv - 32; d1 = d1 < 0 ? -d1 : d1;
                    if (d0 > 128) p0[r] = -1e30f; if (d1 > 128) p1[r] = -1e30f; }
            }
            float rm = fmaxf(p0[0], p1[0]);
#pragma unroll
            for (int r = 1; r < 16; ++r) rm = fmaxf(fmaxf(rm, p0[r]), p1[r]);
            const bool exact = start_exact && it == 0;
            if (exact || __any(rm > ATT_THR)) {
                rm = fmaxf(rm, __shfl_xor(rm, 32));
                const float dl = exact ? rm : fmaxf(rm, 0.f);
                m += dl;
#pragma unroll
                for (int r = 0; r < 16; ++r) { p0[r] -= dl; p1[r] -= dl; negm[r] = -m; }
                const float alpha = exact ? 1.0f : __builtin_amdgcn_exp2f(-dl);
                l *= alpha;
                if (hi == 0) wsf[r32] = alpha;
                asm volatile("s_waitcnt lgkmcnt(0)" ::: "memory");
#pragma unroll
                for (int r = 0; r < 16; ++r) { const float a = wsf[crow(r, hi)];
#pragma unroll
                    for (int d = 0; d < DV / 32; ++d) o[d][r] *= a; }
            }
            float ps = 0.f;
            bf16x8 pa[4];
#define AT_ECHUNK(P_, B_, c_) do { v4u w_; \
                _Pragma("unroll") for (int j = 0; j < 4; ++j) { const float e0 = __builtin_amdgcn_exp2f(P_[(B_) + 2 * j]), e1 = __builtin_amdgcn_exp2f(P_[(B_) + 2 * j + 1]); \
                    ps += e0 + e1; w_[j] = cvtpk_s(e0, e1); } \
                pa[c_] = __builtin_bit_cast(bf16x8, w_); } while (0)
#define AT_PVSTEP(s_) do { _Pragma("unroll") for (int d = 0; d < DV / 32; ++d) { \
                const s16x4 lo = vtr(vbase + (16 * (s_)) * RSV + d * 64); const s16x4 hh = vtr(vbase + (16 * (s_) + 8) * RSV + d * 64); \
                const bf16x8 vf = (bf16x8){lo[0], lo[1], lo[2], lo[3], hh[0], hh[1], hh[2], hh[3]}; \
                o[d] = __builtin_amdgcn_mfma_f32_32x32x16_bf16(pa[s_], vf, o[d], 0, 0, 0); } } while (0)
            AT_ECHUNK(p0, 0, 0);
            AT_ECHUNK(p0, 8, 1); AT_PVSTEP(0);
            AT_ECHUNK(p1, 0, 2); AT_PVSTEP(1);
            AT_ECHUNK(p1, 8, 3); AT_PVSTEP(2);
            AT_PVSTEP(3);
            l += ps;
#undef AT_ECHUNK
#undef AT_PVSTEP
        }
        if (it + 1 < nt) { AT_COMMIT((it + 1) & 1); if (it + 2 < nt) AT_ISSUE(it + 2); }
    }
#undef AT_ISSUE
#undef AT_COMMIT
    __builtin_amdgcn_s_setprio(0);
    m_out = m; l_out = l;
}
__device__ __forceinline__ void row_recip(Frame& F, float l, float (&rli)[16]) {
    LAS float* wsf = (LAS float*)(F.lds + AT_WS) + F.wave * 64;
    const int r32 = F.lane & 31, hi = F.lane >> 5;
    l += __shfl_xor(l, 32);
    asm volatile("s_waitcnt lgkmcnt(0)" ::: "memory");
    if (hi == 0) wsf[r32] = 1.0f / l;
    asm volatile("s_waitcnt lgkmcnt(0)" ::: "memory");
#pragma unroll
    for (int r = 0; r < 16; ++r) rli[r] = wsf[crow(r, hi)];
    asm volatile("s_waitcnt lgkmcnt(0)" ::: "memory");
}
template <bool WINDOW>
__device__ __forceinline__ void attn_a_unit(Frame& F, const bf16* QKV, size_t row0, int h, const AttnSrc& S, int qpos0, float sink, bf16* OM) {
    f32x16 o[2]; float m, l;
    attn_pass<64, WINDOW>(F, QKV + row0 * QKV_LD + QA_OFF + h * 64, QKV_LD, S, qpos0, sink * 1.4426950408889634f, (F.lane >> 5) == 0 ? 1.0f : 0.0f, false, o, m, l);
    float rli[16]; row_recip(F, l, rli);
    const int r32 = F.lane & 31, hi = F.lane >> 5;
    bf16* op = OM + (row0 + F.wave * 32) * DM + h * 64 + r32;
#pragma unroll
    for (int r = 0; r < 16; ++r)
#pragma unroll
        for (int d = 0; d < 2; ++d) op[(size_t)crow(r, hi) * DM + d * 32] = (bf16)f2bf(o[d][r] * rli[r]);
}
__device__ __forceinline__ void attn_b_unit(Frame& F, const bf16* QKV, size_t row0, int h, AttnSrc S, float lam, const float* subln, bf16* OM) {
    f32x16 o[4]; float m, l; float rli[16];
    const bf16* K0 = S.K0; const bf16* K1 = S.K1;
    const int r32 = F.lane & 31, hi = F.lane >> 5;
    LAS unsigned* o1s = (LAS unsigned*)(F.lds + AT_O1) + F.wave * 2048 + F.lane;
    attn_pass<128, false>(F, QKV + row0 * QKV_LD + QB_OFF + h * 128, QKV_LD, S, 0, 0.f, 0.f, true, o, m, l);
    row_recip(F, l, rli);
#pragma unroll
    for (int d = 0; d < 4; ++d)
#pragma unroll
        for (int r = 0; r < 8; ++r) o1s[(d * 8 + r) * 64] = cvtpk_s(o[d][2 * r] * rli[2 * r], o[d][2 * r + 1] * rli[2 * r + 1]);
    S.K0 = K0 + 64; S.K1 = K1 + 64;
    attn_pass<128, false>(F, QKV + row0 * QKV_LD + QB_OFF + h * 128 + 64, QKV_LD, S, 0, 0.f, 0.f, true, o, m, l);
    row_recip(F, l, rli);
    float ss[16];
#pragma unroll
    for (int r = 0; r < 16; ++r) { float s = 0.f;
#pragma unroll
        for (int d = 0; d < 4; ++d) { const unsigned w = o1s[(d * 8 + (r >> 1)) * 64]; const float o1 = (r & 1) ? bfhi(w) : bflo(w); const float v = o1 - lam * (o[d][r] * rli[r]); o[d][r] = v; s += v * v; }
        ss[r] = s; }
#pragma unroll
    for (int r = 0; r < 16; ++r) { float s = ss[r];
#pragma unroll
        for (int x = 1; x < 32; x <<= 1) s += __shfl_xor(s, x);
        ss[r] = 0.8f / sqrtf(s * (1.0f / 128.0f) + EPSN); }
    float gs[4];
#pragma unroll
    for (int d = 0; d < 4; ++d) gs[d] = subln[d * 32 + r32];
    bf16* op = OM + (row0 + F.wave * 32) * DM + 512 + h * 128 + r32;
#pragma unroll
    for (int r = 0; r < 16; ++r)
#pragma unroll
        for (int d = 0; d < 4; ++d) op[(size_t)crow(r, hi) * DM + d * 32] = (bf16)f2bf(o[d][r] * ss[r] * gs[d]);
}
__device__ __forceinline__ void attention_phase(Frame& F) {
    const bf16* QKV = WSP(bf16, WS_BIG); bf16* OM = WSP(bf16, WS_H);
    const float lam = WSP(float, WS_LAM)[0];
    const float* sinkp = F.in[IN_SINK]; const float* subln = F.in[IN_SUBLN];
    for (int u = F.vcu; u < 256; u += F.G) {
        const int b = u >> 6, h = (u >> 4) & 3, qb = u & 15;
        const size_t seq0 = T_CTX + (size_t)b * LAT_SEQ;
        AttnSrc S; S.K0 = WSP(bf16, WS_CBK) + (size_t)b * 256 * 512 + h * 128; S.V0 = WSP(bf16, WS_CBV) + (size_t)b * 256 * 512 + h * 128; S.ld0 = 512; S.n0 = 4;
        S.K1 = QKV + seq0 * QKV_LD + KB_OFF + h * 128; S.V1 = QKV + seq0 * QKV_LD + VB_OFF + h * 128; S.ld1 = QKV_LD; S.t_lo = 0; S.t_hi = 64;
        attn_b_unit(F, QKV, seq0 + qb * 256, h, S, lam, subln, OM);
    }
    for (int u = F.vcu; u < 512; u += F.G) {
        const int b = u >> 7, h = (u >> 4) & 7, qb = u & 15, kvh = h >> 2;
        const size_t seq0 = T_CTX + (size_t)b * LAT_SEQ;
        AttnSrc S; S.K0 = WSP(bf16, WS_CAK) + (size_t)b * 256 * 128 + kvh * 64; S.V0 = WSP(bf16, WS_CAV) + (size_t)b * 256 * 128 + kvh * 64; S.ld0 = 128; S.n0 = 4;
        S.K1 = QKV + seq0 * QKV_LD + KA_OFF + kvh * 64; S.V1 = QKV + seq0 * QKV_LD + VA_OFF + kvh * 64; S.ld1 = QKV_LD;
        S.t_lo = 4 * qb - 2 < 0 ? 0 : 4 * qb - 2; S.t_hi = 4 * qb + 6 > 64 ? 64 : 4 * qb + 6;
        attn_a_unit<true>(F, QKV, seq0 + qb * 256, h, S, qb * 256, sinkp[h], OM);
    }
    for (int u = (F.G == 256 ? (F.vcu >= 128 ? F.vcu - 128 : 256) : F.vcu); u < 256; u += (F.G == 256 ? 128 : F.G)) {
        const int b = u >> 3, h = u & 7, kvh = h >> 2;
        const size_t seq0 = (size_t)b * CTX_SEQ;
        AttnSrc S; S.K0 = nullptr; S.V0 = nullptr; S.ld0 = 0; S.n0 = 0;
        S.K1 = QKV + seq0 * QKV_LD + KA_OFF + kvh * 64; S.V1 = QKV + seq0 * QKV_LD + VA_OFF + kvh * 64; S.ld1 = QKV_LD; S.t_lo = 0; S.t_hi = 4;
        attn_a_unit<false>(F, QKV, seq0, h, S, 0, sinkp[h], OM);
    }
    for (int u = F.vcu; u < 128; u += F.G) {
        const int b = u >> 2, h = u & 3;
        const size_t seq0 = (size_t)b * CTX_SEQ;
        AttnSrc S; S.K0 = nullptr; S.V0 = nullptr; S.ld0 = 0; S.n0 = 0;
        S.K1 = QKV + seq0 * QKV_LD + KB_OFF + h * 128; S.V1 = QKV + seq0 * QKV_LD + VB_OFF + h * 128; S.ld1 = QKV_LD; S.t_lo = 0; S.t_hi = 4;
        attn_b_unit(F, QKV, seq0, h, S, lam, subln, OM);
    }
}

constexpr int SC_XC = 0;
constexpr int SC_AUF = 17408;
constexpr int SC_AUB = 17408 + 65536;
constexpr int SC_CW = 17408 + 131072;
static_assert(SC_CW + 2560 <= MISC_OFF, "scan LDS map");
#ifndef DUP_EPI
#define DUP_EPI 1
#endif
#ifndef DUP_SCAN
#define DUP_SCAN 1
#endif
#ifndef DUP_CONV
#define DUP_CONV 1
#endif
constexpr int SCAN_UNITS = 3840;
__device__ __forceinline__ void scan_pass(Frame& F) {
    LAS unsigned char* lds = F.lds;
    const int tid = F.tid, lane = F.lane, wid = F.wave, r32 = lane & 31, hi = lane >> 5;
    bf16* XR = WSP(bf16, WS_BIG) + (size_t)T_ALL * DRNN; bf16* GG = WSP(bf16, WS_BIG); bf16* ABG = (bf16*)F.out;
    const bf16* HALO = WSP(bf16, WS_BIG + 136 * MiB);
    f32x2* SUM = WSP(f32x2, WS_H);
    const int wdir = wid >> 2, cb = wid & 3, chl = cb * 32 + r32;
    const int tk = tid >> 3, cg = tid & 7;
    LAS float* CW = (LAS float*)(lds + SC_CW);
    const int per = (SCAN_UNITS + F.G - 1) / F.G, u_lo = F.vcu * per, u_hi = (u_lo + per) < SCAN_UNITS ? (u_lo + per) : SCAN_UNITS;
    int n_cur = -1;
    v4u xr[8];
    bf16x8 wa[8], wx[8]; float ba = 0.f, bx = 0.f, sp8 = 0.f;
#define SC_DECODE(u_) const int n = (u_) / 384, cidx = (u_) % 384; const bool isctx = cidx < 128; const int b = isctx ? (cidx >> 2) : ((cidx - 128) >> 6); const int c = isctx ? (cidx & 3) : ((cidx - 128) & 63); \
        const size_t seq0 = isctx ? (size_t)b * CTX_SEQ : (size_t)T_CTX + (size_t)b * LAT_SEQ; const int seq_len = isctx ? CTX_SEQ : LAT_SEQ, t0 = c * 64;
#define SC_LOADX(u_) do { SC_DECODE(u_) (void)b; (void)seq_len; \
        _Pragma("unroll") for (int j = 0; j < 4; ++j) { const int tl = tk - 1 + j; \
            const bf16* src = tl < 0 ? HALO + (size_t)((cidx > 0 ? cidx - 1 : 0) * 3 + 0) * DRNN : (tl >= 64 ? HALO + (size_t)((cidx < 383 ? cidx + 1 : 383) * 3 + 1 + (tl - 64)) * DRNN : XR + (seq0 + t0 + tl) * DRNN); \
            const v4u* p = (const v4u*)(src + n * 128 + cg * 8); xr[2 * j] = p[0]; xr[2 * j + 1] = p[8]; } } while (0)
    if (wid >= 4) __builtin_amdgcn_s_setprio(1);
    if (u_lo < u_hi) SC_LOADX(u_lo);
#pragma unroll 1
    for (int u = u_lo; u < u_hi; ++u) {
        SC_DECODE(u)
        (void)b;
        if (n != n_cur) {
            __syncthreads();
            for (int i = tid; i < 640; i += NTHREADS) CW[i] = i < 512 ? F.in[IN_RCONVW][(i >> 7) * DRNN + n * 128 + (i & 127)] : F.in[IN_RCONVB][n * 128 + (i & 127)];
            n_cur = n;
            { const bf16* wap = WSP(bf16, WS_WG) + (size_t)((0 * 2 + wdir) * 10 + n) * 16384 + (size_t)chl * 128 + hi * 8;
              const bf16* wxp = WSP(bf16, WS_WG) + (size_t)((1 * 2 + wdir) * 10 + n) * 16384 + (size_t)chl * 128 + hi * 8;
#pragma unroll
              for (int ks = 0; ks < 8; ++ks) { wa[ks] = *(const bf16x8*)(wap + ks * 16); wx[ks] = *(const bf16x8*)(wxp + ks * 16); } }
            ba = F.in[IN_RBA][wdir * DRNN + n * 128 + chl] * -1.4426950408889634f; bx = F.in[IN_RBX][wdir * DRNN + n * 128 + chl] * -1.4426950408889634f;
            { const float lamv = F.in[IN_RLAM][wdir * DRNN + n * 128 + chl]; sp8 = -8.0f * (lamv > 20.f ? __expf(-lamv) : log1pf(__expf(-lamv))); }
            __syncthreads();
        }
        { float a[16];
#pragma unroll
          for (int e = 0; e < 16; ++e) a[e] = CW[512 + (e >> 3) * 64 + cg * 8 + (e & 7)];
#pragma unroll
          for (int j = 0; j < 4; ++j) { const int t = t0 + tk - 1 + j; const float msk = (t >= 0 && t < seq_len) ? 1.0f : 0.0f;
              const unsigned w[8] = {xr[2 * j].x, xr[2 * j].y, xr[2 * j].z, xr[2 * j].w, xr[2 * j + 1].x, xr[2 * j + 1].y, xr[2 * j + 1].z, xr[2 * j + 1].w};
#pragma unroll
              for (int e = 0; e < 8; ++e) { const int c0 = (e >> 2) * 64 + cg * 8 + 2 * (e & 3); a[2 * e] += (CW[j * 128 + c0] * msk) * bflo(w[e]); a[2 * e + 1] += (CW[j * 128 + c0 + 1] * msk) * bfhi(w[e]); } }
          v4u o0, o1; o0.x = pk2(a[0], a[1]); o0.y = pk2(a[2], a[3]); o0.z = pk2(a[4], a[5]); o0.w = pk2(a[6], a[7]); o1.x = pk2(a[8], a[9]); o1.y = pk2(a[10], a[11]); o1.z = pk2(a[12], a[13]); o1.w = pk2(a[14], a[15]);
          LAS v4u* xp = (LAS v4u*)(lds + SC_XC + tk * 272 + cg * 16); xp[0] = o0; xp[8] = o1; }
        __syncthreads();
        if (u + 1 < u_hi) SC_LOADX(u + 1);
        { LAS f32x2* AU = (LAS f32x2*)(lds + (wdir ? SC_AUB : SC_AUF));
#pragma unroll 1
          for (int rb = 0; rb < 2; ++rb) {
            f32x16 ra, ia;
#pragma unroll
            for (int r = 0; r < 16; ++r) { ra[r] = ba; ia[r] = bx; }
            { const LAS unsigned char* ap = lds + SC_XC + (rb * 32 + r32) * 272 + hi * 16;
#pragma unroll
              for (int ks = 0; ks < 8; ++ks) { const bf16x8 af = *(const LAS bf16x8*)(ap + ks * 32);
                  ra = __builtin_amdgcn_mfma_f32_32x32x16_bf16(af, wa[ks], ra, 0, 0, 0);
                  ia = __builtin_amdgcn_mfma_f32_32x32x16_bf16(af, wx[ks], ia, 0, 0, 0); } }
#pragma unroll
            for (int r = 0; r < 16; ++r) {
                const int row = rb * 32 + crow(r, hi);
                const float rr = __builtin_amdgcn_rcpf(1.0f + __builtin_amdgcn_exp2f(ra[r]));
                const float ii = __builtin_amdgcn_rcpf(1.0f + __builtin_amdgcn_exp2f(ia[r]));
                const float x = sp8 * rr;
                const float em = -x * (1.0f + x * (0.5f + x * (0.16666667f + x * (0.041666668f + x * 0.0083333338f))));
                const float av = 1.0f - em;
                const float om = __builtin_fmaf(em, av, em);
                const float xv = bf2f(*(const LAS unsigned short*)(lds + SC_XC + row * 272 + chl * 2));
                AU[row * 128 + chl] = (f32x2){av, __builtin_amdgcn_sqrtf(om) * ii * xv};
            }
          } }
        __syncthreads();
        if (tid >= 256) {
            const int sch = tid & 127, sd = (tid >> 7) & 1;
            LAS f32x2* AU = (LAS f32x2*)(lds + (sd ? SC_AUB : SC_AUF)) + sch;
            float h = 0.f, pprod = 1.0f;
            f32x2 auA[8], auB[8];
#define SC_LD(dst, s0_) do { _Pragma("unroll") for (int j = 0; j < 8; ++j) { const int row = sd == 0 ? (s0_) + j : 63 - (s0_) - j; dst[j] = AU[row * 128]; } } while (0)
#define SC_RUN(src, s0_) do { _Pragma("unroll") for (int j = 0; j < 8; ++j) { const int row = sd == 0 ? (s0_) + j : 63 - (s0_) - j; h = src[j].x * h + src[j].y; pprod *= src[j].x; AU[row * 128] = (f32x2){h, pprod}; } } while (0)
            SC_LD(auA, 0);
#pragma unroll 1
            for (int s0 = 0; s0 < 64; s0 += 16) {
                SC_LD(auB, s0 + 8);
                SC_RUN(auA, s0);
                if (s0 + 16 < 64) SC_LD(auA, s0 + 16);
                SC_RUN(auB, s0 + 8);
            }
#undef SC_LD
#undef SC_RUN
            SUM[(size_t)cidx * 2 * DRNN + sd * DRNN + n * 128 + sch] = (f32x2){pprod, h};
        }
        __syncthreads();
        {
            const LAS f32x4* hfp = (const LAS f32x4*)(lds + SC_AUF) + lane; const LAS f32x4* hbp = (const LAS f32x4*)(lds + SC_AUB) + lane;
            const size_t eoff = (seq0 + t0 + wid * 8) * DRNN + n * 128;
            unsigned* gp = (unsigned*)(GG + eoff) + lane; unsigned* fp = (unsigned*)(XR + eoff) + lane; unsigned* bp = (unsigned*)(ABG + eoff) + lane;
            unsigned gw[8];
#pragma unroll
            for (int i = 0; i < 8; ++i) gw[i] = gp[(size_t)i * (DRNN / 2)];
#pragma unroll
            for (int i = 0; i < 8; ++i) {
                const f32x4 hf = hfp[(wid * 8 + i) * 64], hb = hbp[(wid * 8 + i) * 64];
                const float g0 = bflo(gw[i]), g1 = bfhi(gw[i]);
                gp[(size_t)i * (DRNN / 2)] = pk2((hf[0] + hb[0]) * g0, (hf[2] + hb[2]) * g1);
                fp[(size_t)i * (DRNN / 2)] = pk2(hf[1] * g0, hf[3] * g1);
                bp[(size_t)i * (DRNN / 2)] = pk2(hb[1] * g0, hb[3] * g1);
            }
        }
        __syncthreads();
    }
    __builtin_amdgcn_s_setprio(0);
#undef SC_DECODE
#undef SC_LOADX
}
__device__ __forceinline__ void scan_correct_phase(Frame& F) {
    bf16* GG = WSP(bf16, WS_BIG); const bf16* XR = WSP(bf16, WS_BIG) + (size_t)T_ALL * DRNN; const bf16* ABG = (const bf16*)F.out;
    const float* CAR = WSP(float, WS_H + 8 * MiB);
    const int gt = F.vcu * NTHREADS + F.tid, NGT = F.G * NTHREADS;
    for (int i = gt; i < T_ALL * (DRNN / 8); i += NGT) {
        const int row = i / (DRNN / 8), c8 = (i % (DRNN / 8)) * 8;
        const size_t off = (size_t)row * DRNN + c8;
        const v4u yl = *(const v4u*)(GG + off), af = *(const v4u*)(XR + off), ab = *(const v4u*)(ABG + off);
        const float* cf = CAR + (size_t)(row >> 6) * 2 * DRNN + c8; const float* cbp = cf + DRNN;
        const f32x4 f0 = *(const f32x4*)cf, f1 = *(const f32x4*)(cf + 4), b0 = *(const f32x4*)cbp, b1 = *(const f32x4*)(cbp + 4);
        const unsigned wy[4] = {yl.x, yl.y, yl.z, yl.w}, wf[4] = {af.x, af.y, af.z, af.w}, wb[4] = {ab.x, ab.y, ab.z, ab.w};
        const float cfv[8] = {f0[0], f0[1], f0[2], f0[3], f1[0], f1[1], f1[2], f1[3]}, cbv[8] = {b0[0], b0[1], b0[2], b0[3], b1[0], b1[1], b1[2], b1[3]};
        unsigned o[4];
#pragma unroll
        for (int e = 0; e < 4; ++e) o[e] = pk2(bflo(wy[e]) + bflo(wf[e]) * cfv[2 * e] + bflo(wb[e]) * cbv[2 * e], bfhi(wy[e]) + bfhi(wf[e]) * cfv[2 * e + 1] + bfhi(wb[e]) * cbv[2 * e + 1]);
        v4u ov; ov.x = o[0]; ov.y = o[1]; ov.z = o[2]; ov.w = o[3];
        *(v4u*)(GG + off) = ov;
    }
}

__device__ __forceinline__ void scan_carry_phase(Frame& F) {
    const f32x2* SUM = WSP(f32x2, WS_H); float* CAR = WSP(float, WS_H + 8 * MiB);
    const int gt = F.vcu * NTHREADS + F.tid, NGT = F.G * NTHREADS;
    for (int i = gt; i < 10240 + 81920; i += NGT) {
        const bool lat = i < 10240; const int j = lat ? i : i - 10240;
        const int ch = j % DRNN, sd = (j / DRNN) & 1, b = j / (2 * DRNN);
        const int nch = lat ? 64 : 4, cfirst = lat ? 128 + b * 64 : b * 4;
        float h = lat ? F.in[sd ? IN_SB : IN_SF][b * DRNN + ch] : 0.f;
        const f32x2* sp = SUM + (size_t)cfirst * 2 * DRNN + sd * DRNN + ch; float* cp = CAR + (size_t)cfirst * 2 * DRNN + sd * DRNN + ch;
        for (int k0 = 0; k0 < nch; k0 += 4) {
            f32x2 s[4];
#pragma unroll
            for (int q = 0; q < 4; ++q) { const int c = sd == 0 ? k0 + q : nch - 1 - k0 - q; s[q] = sp[(size_t)c * 2 * DRNN]; }
#pragma unroll
            for (int q = 0; q < 4; ++q) { const int c = sd == 0 ? k0 + q : nch - 1 - k0 - q; cp[(size_t)c * 2 * DRNN] = h; h = s[q].x * h + s[q].y; }
        }
        if (!lat) F.out[(sd ? OUT_SB : OUT_SF) + b * DRNN + ch] = h;
    }
}

constexpr int N_PHASES = 23;
__global__ void __launch_bounds__(NTHREADS, 2) fwd_kernel(Args args) {
    extern __shared__ __attribute__((aligned(16))) unsigned char lds_raw[];
    Frame F;
    F.lds = (LAS unsigned char*)lds_raw;
    F.tid = threadIdx.x; F.lane = F.tid & 63; F.wave = __builtin_amdgcn_readfirstlane(F.tid >> 6);
    F.G = gridDim.x; { const int bx = blockIdx.x; F.vcu = (F.G % 8 == 0) ? (bx % 8) * (F.G / 8) + bx / 8 : bx; }
    F.in = args.in; F.out = args.out; F.ws = args.ws;
    volatile LAS unsigned* MISC = (volatile LAS unsigned*)(F.lds + MISC_OFF);
    if (F.tid < 32) MISC[F.tid] = 0u;
    __syncthreads();
    XcdBarrier bar; bar.bar = (unsigned*)(args.ws + WS_CTL) + 1024; bar.x = 0; bar.st = nullptr;
    if (args.use_bar) bar = xcd_barrier_post((unsigned*)(args.ws + WS_CTL) + 1024, MISC + 8);
    const int lo = args.ph_lo, hi = args.ph_hi;
#ifndef PHMASK
#define PHMASK 0x7fffff
#endif
#ifndef REP_PHASE
#define REP_PHASE -1
#endif
#ifndef REP_N
#define REP_N 1
#endif
#define IN(k) (((PHMASK >> (k)) & 1) && lo <= (k) && (k) < hi)
#define REPS(k) for (int rep_ = 0; rep_ < (((k) == REP_PHASE) ? REP_N : 1); ++rep_)
#define SEAM(k) do { if (IN(k) && IN((k) + 1)) xcd_barrier(bar); } while (0)
    bf16* XA = (bf16*)((unsigned char*)F.out + 64 * MiB);
    bf16* XB = WSP(bf16, WS_BIG + 120 * MiB);
    const float* MOD = WSP(float, WS_MOD);
    bf16* H = WSP(bf16, WS_H);
    PG8_LAS unsigned char* ring = (PG8_LAS unsigned char*)lds_raw;

    if (IN(0)) REPS(0) { Frame P = fresh(F); p0_prologue(P); } SEAM(0);
    if (IN(1)) REPS(1) { Frame P = fresh(F); norm_mod_pass(P, F.in[IN_XP], F.in[IN_XS], F.in[IN_NORM1], MOD, 0, 1024, H); } SEAM(1);
    if (IN(2)) REPS(2) {
        pg8::Gemm g{H, WSP(bf16, WS_WIN), T_ALL, QKV_LD, DM}; pg8::StaticOrder S; S.init(T_ALL, QKV_LD, F.G, (int)blockIdx.x);
        pg8::EpiInProj E{WSP(bf16, WS_BIG), F.out, WSP(pg8::f32x2, WS_ROPE)};
        pg8::gemm_phase<pg8::EpiInProj, pg8::StaticOrder, true, true>(ring, g, S, E);
        { const int nfull = (T_ALL / 256) * (QKV_LD / 256) % F.G; Frame P = fresh(F);
          if (nfull == 0) p_deferred_transposes(P, (int)blockIdx.x, F.G); else if ((int)blockIdx.x >= nfull) p_deferred_transposes(P, (int)blockIdx.x - nfull, F.G - nfull); }
    } SEAM(2);
    if (IN(3)) REPS(3) { Frame P = fresh(F); attention_phase(P); } SEAM(3);
    if (IN(4)) REPS(4) {
        pg8::Gemm g{H, WSP(bf16, WS_WOUT), T_ALL, DM, DM}; pg8::StaticOrder S; S.init(T_ALL, DM, F.G, (int)blockIdx.x, 192);
        pg8::EpiRes<true> E{F.in[IN_XP], F.in[IN_XS], XA, XB, MOD + 2048, 0};
        pg8::gemm_phase<pg8::EpiRes<true>, pg8::StaticOrder, true, true, 96>(ring, g, S, E);
    } SEAM(4);
#pragma unroll 1
    for (int layer = 0; layer < 2; ++layer) {
        const int pb = layer == 0 ? 5 : 16;
        const float* MODL = MOD + (size_t)layer * 5 * 6144;
        if (IN(pb)) REPS(pb) { Frame P = fresh(F); norm_mod_pass_bf(P, XA, XB, F.in[IN_NORM2] + layer * DM, MODL, 3072, 4096, H); } SEAM(pb);
#pragma unroll 1
        for (int half = 0; half < 2; ++half) {
            const int row0 = half * (T_ALL / 2);
            if (IN(pb + 1 + 2 * half)) REPS(pb + 1 + 2 * half) {
                pg8::Gemm g{H + (size_t)row0 * DM, WSP(bf16, WS_W1) + (size_t)layer * DFF * DM, T_ALL / 2, DFF, DM}; pg8::StaticOrder S; S.init(T_ALL / 2, DFF, F.G, (int)blockIdx.x);
                pg8::EpiSqRelu E{WSP(bf16, WS_BIG), DFF};
                pg8::gemm_phase<pg8::EpiSqRelu, pg8::StaticOrder, true, true>(ring, g, S, E);
            } SEAM(pb + 1 + 2 * half);
            if (IN(pb + 2 + 2 * half)) REPS(pb + 2 + 2 * half) {
                pg8::Gemm g{WSP(bf16, WS_BIG), WSP(bf16, WS_W2) + (size_t)layer * DM * DFF, T_ALL / 2, DM, DFF}; pg8::StaticOrder S; S.init(T_ALL / 2, DM, F.G, (int)blockIdx.x, 192);
                pg8::EpiRes<false> E{nullptr, nullptr, XA, XB, MODL + 5120, row0};
                pg8::gemm_phase<pg8::EpiRes<false>, pg8::StaticOrder, true, true, 96>(ring, g, S, E);
            } SEAM(pb + 2 + 2 * half);
        }
        if (layer == 0) {
            const float* MOD1 = MOD + 5 * 6144;
            if (IN(10)) REPS(10) { Frame P = fresh(F); norm_mod_pass_bf(P, XA, XB, F.in[IN_NORM1] + DM, MOD1, 0, 1024, H); } SEAM(10);
            if (IN(11)) REPS(11) {
                pg8::Gemm g{H, WSP(bf16, WS_WRIN), T_ALL, 2 * DRNN, DM}; pg8::StaticOrder S; S.init(T_ALL, 2 * DRNN, F.G, (int)blockIdx.x);
                pg8::EpiRecIn E{WSP(bf16, WS_BIG), WSP(bf16, WS_BIG) + (size_t)T_ALL * DRNN, WSP(bf16, WS_BIG + 136 * MiB)};
                pg8::gemm_phase<pg8::EpiRecIn, pg8::StaticOrder, true, true>(ring, g, S, E);
            } SEAM(11);
            if (IN(12)) REPS(12) { Frame P = fresh(F); scan_pass(P); } SEAM(12);
            if (IN(13)) REPS(13) { Frame P = fresh(F); scan_carry_phase(P); } SEAM(13);
            if (IN(14)) REPS(14) { Frame P = fresh(F); scan_correct_phase(P); } SEAM(14);
            if (IN(15)) REPS(15) {
                pg8::Gemm g{WSP(bf16, WS_BIG), WSP(bf16, WS_WROUT), T_ALL, DM, DRNN}; pg8::StaticOrder S; S.init(T_ALL, DM, F.G, (int)blockIdx.x, 192);
                pg8::EpiRes<false> E{nullptr, nullptr, XA, XB, MOD1 + 2048, 0};
                pg8::gemm_phase<pg8::EpiRes<false>, pg8::StaticOrder, true, true, 96>(ring, g, S, E);
            } SEAM(15);
        }
    }
    if (IN(21)) REPS(21) { Frame P = fresh(F); final_norm_pass(P, XA, XB, F.out, F.in[IN_FNORM], 0, X_SPLIT); } SEAM(21);
    if (IN(22)) REPS(22) { Frame P = fresh(F); final_norm_pass(P, XA, XB, F.out, F.in[IN_FNORM], X_SPLIT, T_ALL); }
#undef IN
#undef SEAM
}

#ifndef MK_ONE_LAUNCH
#define MK_ONE_LAUNCH 1
#endif
extern "C" void kernel_launch(void* const* d_in, const int* in_sizes, int n_in, void* d_out, int out_size, void* d_ws, size_t ws_size, hipStream_t stream) {
    static int grid = 0;
    if (grid == 0) {
        if (n_in != 31 || ws_size < WS_END) { fprintf(stderr, "kernel_launch: unexpected n_in %d / ws_size %zu\n", n_in, ws_size); grid = -1; return; }
        int dev = 0, cus = 0, per_cu = 0;
        if (hipGetDevice(&dev) != hipSuccess || hipDeviceGetAttribute(&cus, hipDeviceAttributeMultiprocessorCount, dev) != hipSuccess) { grid = -1; return; }
        if (hipFuncSetAttribute((const void*)fwd_kernel, hipFuncAttributeMaxDynamicSharedMemorySize, LDS_BYTES) != hipSuccess) { fprintf(stderr, "kernel_launch: hipFuncSetAttribute failed\n"); grid = -1; return; }
        if (hipOccupancyMaxActiveBlocksPerMultiprocessor(&per_cu, (const void*)fwd_kernel, NTHREADS, LDS_BYTES) != hipSuccess || per_cu < 1) { fprintf(stderr, "kernel_launch: occupancy query says %d\n", per_cu); (void)hipGetLastError(); grid = -1; return; }
        grid = cus;
    }
    if (grid < 0) return;
    (void)hipMemsetAsync((char*)d_ws + WS_CTL, 0, CTL_ZERO_BYTES, stream);
    Args a{};
    for (int i = 0; i < 31; ++i) a.in[i] = (const float*)d_in[i];
    a.out = (float*)d_out; a.ws = (unsigned char*)d_ws;
#if MK_ONE_LAUNCH
    a.ph_lo = 0; a.ph_hi = N_PHASES; a.use_bar = 1;
    hipLaunchKernelGGL(fwd_kernel, dim3(grid), dim3(NTHREADS), LDS_BYTES, stream, a);
#else
    for (int p = 0; p < N_PHASES; ++p) { a.ph_lo = p; a.ph_hi = p + 1; a.use_bar = 0; hipLaunchKernelGGL(fwd_kernel, dim3(grid), dim3(NTHREADS), LDS_BYTES, stream, a); }
#endif
}
```

```cpp
#include <hip/hip_runtime.h>
#include <cstdio>
#include <cstdint>
#include <cmath>
#ifndef DUPK_SEL
#define DUPK_SEL 0
#endif
#ifndef RELAX_EPI
#define RELAX_EPI 1
#endif
__device__ __forceinline__ int lane_now() { int l; asm volatile("v_mbcnt_lo_u32_b32 %0, -1, 0\n\tv_mbcnt_hi_u32_b32 %0, -1, %0" : "=v"(l)); return l; }
namespace pg8 {
#define PG8_LAS __attribute__((address_space(3)))
typedef unsigned short bf16_t;
typedef short bf16x8 __attribute__((ext_vector_type(8)));
typedef float f32x4 __attribute__((ext_vector_type(4)));
typedef unsigned u32x4 __attribute__((ext_vector_type(4)));
constexpr int BM = 256, BK = 64, HALF = 128, HTB = HALF * BK * 2  , STAGE_BYTES = 8 * HTB, NXCD = 8, WGM = 8;

__host__ __device__ __forceinline__ int lds_byte(int r, int c) { const int st = (r >> 4) * 2 + (c >> 5), rr = r & 15, cc = c & 31, ob = rr * 64 + cc * 2; return st * 1024 + (ob ^ (((ob >> 9) & 1) << 5)); }
__host__ __device__ __forceinline__ void stage_rc(int b, int& R, int& C) { const int st = b / 1024, sb = b % 1024, swz = sb ^ (((sb >> 9) & 1) << 5); R = (st >> 1) * 16 + swz / 64; C = (st & 1) * 32 + (swz % 64) / 2; }
__host__ __device__ __forceinline__ int perm32(int rho) { const int n = rho >> 4, i = rho & 15; return 8 * (i >> 2) + 4 * n + (i & 3); }

struct Unit { int pm, pn; };
struct Gemm { const bf16_t* A; const bf16_t* Bt; int M, N, K, lda; };

struct StaticOrder {
    int nM, nN, nwg, G, c;
    __host__ __device__ void init(int M, int N, int G_, int c_, int bmr = BM) { nM = M / bmr; nN = N / BM; nwg = nM * nN; G = G_; c = c_; }
    __host__ __device__ bool next(int i, Unit& u) const {
        const long L = (long)i * G + c; if (L >= nwg) return false;
        int wgid = (int)L; { const int q = nwg / NXCD, r = nwg % NXCD, xcd = wgid % NXCD, off = wgid / NXCD; wgid = (xcd < r ? xcd * (q + 1) : r * (q + 1) + (xcd - r) * q) + off; }
        const int nig = WGM * nN, gid = wgid / nig, fm = gid * WGM, gsz = (nM - fm) < WGM ? (nM - fm) : WGM;
        u.pm = fm + ((wgid % nig) % gsz); u.pn = (wgid % nig) / gsz; return true;
    }
    __device__ __forceinline__ void a_ready(const Unit&) const {}
    __device__ __forceinline__ void done(const Unit&) const {}
};

__device__ __forceinline__ unsigned cvt_pk_bf16(float lo, float hi) { unsigned r; asm volatile("v_cvt_pk_bf16_f32 %0, %1, %2" : "=v"(r) : "v"(lo), "v"(hi)); return r; }
typedef float f32x2 __attribute__((ext_vector_type(2)));
typedef unsigned u32x2 __attribute__((ext_vector_type(2)));
constexpr int T_CTX = 8192, QKV_LD = 2304;
constexpr float QSCALE = 0.125f * 1.4426950408889634f;
struct EpiInProj {
    static constexpr bool PERM = true, AFTER_DRAIN = false, DUPK = (DUPK_SEL == 1), RELAX = false;
    bf16_t* QKV; float* out; const f32x2* rope;
    template <int MR> __device__ __forceinline__ void operator()(const f32x4 (&acc)[2][2][MR][2], const Unit& u, int wr, int wc, int fr, int fq) const {
        constexpr int HRr = MR * 32, BMR = 2 * HRr, WRO = HRr / 2;
        const bool hi_half = fq >= 2;
#pragma unroll
        for (int bj = 0; bj < 2; ++bj) {
            const int colbase = u.pn * BM + bj * HALF + wc * 32;
            const bool rope_col = (colbase < 640 || (colbase >= 768 && colbase < 1792));
            const bool q_col = (colbase < 512 || (colbase >= 768 && colbase < 1280));
            long ooff = -1; int ow = 0, cs = 0;
            if (colbase >= 512 && colbase < 640) { ooff = 25165824; ow = 128; cs = 512; }
            else if (colbase >= 640 && colbase < 768) { ooff = 26214400; ow = 128; cs = 640; }
            else if (colbase >= 1280 && colbase < 1792) { ooff = 27262976; ow = 512; cs = 1280; }
            else if (colbase >= 1792) { ooff = 31457280; ow = 512; cs = 1792; }
#pragma unroll
            for (int ai = 0; ai < 2; ++ai)
#pragma unroll
                for (int m = 0; m < MR; ++m) {
                    const int rowg = u.pm * BMR + ai * HRr + wr * WRO + m * 16;
                    const bool lat = rowg >= T_CTX;
                    const int row = rowg + fr;
                    f32x4 v[2] = {acc[ai][bj][m][0], acc[ai][bj][m][1]};
                    if (rope_col && lat) {
                        const int t = (row - T_CTX) & 4095;
                        const int pos = (wc & 1) ? (t & 63) : (t >> 6);
                        const f32x4* rp = (const f32x4*)(rope + pos * 16 + 8 * (fq & 1));
#pragma unroll
                        for (int n = 0; n < 2; ++n) {
                            const f32x4 c01 = rp[2 * n], c23 = rp[2 * n + 1];
                            const float cs_[4] = {c01[0], c01[2], c23[0], c23[2]}, sn_[4] = {c01[1], c01[3], c23[1], c23[3]};
#pragma unroll
                            for (int e = 0; e < 4; ++e) {
                                const float p = __shfl_xor(v[n][e], 32);
                                v[n][e] = hi_half ? (p * sn_[e] + v[n][e] * cs_[e]) : (v[n][e] * cs_[e] - p * sn_[e]);
                            }
                        }
                    }
                    if (q_col) { v[0] = v[0] * QSCALE; v[1] = v[1] * QSCALE; }
                    bf16_t* qp = QKV + (size_t)row * QKV_LD + colbase + 8 * fq;
                    u32x4 w; w.x = cvt_pk_bf16(v[0][0], v[0][1]); w.y = cvt_pk_bf16(v[0][2], v[0][3]); w.z = cvt_pk_bf16(v[1][0], v[1][1]); w.w = cvt_pk_bf16(v[1][2], v[1][3]);
                    *(u32x4*)qp = w;
                    if (ooff >= 0 && !lat) { float* op = out + ooff + (size_t)row * ow + (colbase - cs) + 8 * fq; *(f32x4*)op = v[0]; *(f32x4*)(op + 4) = v[1]; }
                }
        }
    }
};
constexpr int X_SPLIT = 16384;
template <bool IN_F32>
struct EpiRes {
    static constexpr bool PERM = true, AFTER_DRAIN = false, DUPK = (DUPK_SEL == 2), RELAX = false;
    const float* xin_ctx; const float* xin_lat; bf16_t* XA; bf16_t* XB; const float* gate; int row0;
    template <int MR> __device__ __forceinline__ void operator()(const f32x4 (&acc)[2][2][MR][2], const Unit& u, int wr, int wc, int fr, int fq) const {
        constexpr int HRr = MR * 32, BMR = 2 * HRr, WRO = HRr / 2;
        const int rowt = row0 + u.pm * BMR;
#pragma unroll
        for (int ai = 0; ai < 2; ++ai)
#pragma unroll
            for (int m = 0; m < MR; ++m) {
                const int rowg = rowt + ai * HRr + wr * WRO + m * 16;
                const int midx = rowg < T_CTX ? 4 : ((rowg - T_CTX) >> 12);
                const float* g = gate + (size_t)midx * 6144;
                bf16_t* xr = (rowg < X_SPLIT ? XA + (size_t)rowg * 1024 : XB + (size_t)(rowg - X_SPLIT) * 1024) + (size_t)fr * 1024;
                const float* xf = (rowg < T_CTX ? xin_ctx : xin_lat - (size_t)T_CTX * 1024) + (size_t)(rowg + fr) * 1024;
#pragma unroll
                for (int bj = 0; bj < 2; ++bj) {
                    const int col = u.pn * BM + bj * HALF + wc * 32 + 8 * fq;
                    const f32x4 gv0 = *(const f32x4*)(g + col), gv1 = *(const f32x4*)(g + col + 4);
                    f32x4 x0, x1;
                    if (IN_F32) { x0 = *(const f32x4*)(xf + col); x1 = *(const f32x4*)(xf + col + 4); }
                    else { const u32x4 w = *(const u32x4*)(xr + col);
                        x0[0] = __builtin_bit_cast(float, w.x << 16); x0[1] = __builtin_bit_cast(float, w.x & 0xffff0000u); x0[2] = __builtin_bit_cast(float, w.y << 16); x0[3] = __builtin_bit_cast(float, w.y & 0xffff0000u);
                        x1[0] = __builtin_bit_cast(float, w.z << 16); x1[1] = __builtin_bit_cast(float, w.z & 0xffff0000u); x1[2] = __builtin_bit_cast(float, w.w << 16); x1[3] = __builtin_bit_cast(float, w.w & 0xffff0000u); }
                    x0 = x0 + gv0 * acc[ai][bj][m][0]; x1 = x1 + gv1 * acc[ai][bj][m][1];
                    u32x4 o; o.x = cvt_pk_bf16(x0[0], x0[1]); o.y = cvt_pk_bf16(x0[2], x0[3]); o.z = cvt_pk_bf16(x1[0], x1[1]); o.w = cvt_pk_bf16(x1[2], x1[3]);
                    *(u32x4*)(xr + col) = o;
                }
            }
    }
};
__device__ __forceinline__ float relu_raw(float x) { float r; asm("v_max_f32 %0, 0, %1" : "=v"(r) : "v"(x)); return r; }
struct EpiSqRelu {
    static constexpr bool PERM = true, AFTER_DRAIN = false, DUPK = (DUPK_SEL == 3), RELAX = (RELAX_EPI & 1) != 0;
    bf16_t* O; int ldc;
    template <int MR> __device__ __forceinline__ void operator()(const f32x4 (&acc)[2][2][MR][2], const Unit& u, int wr, int wc, int fr, int fq) const {
        constexpr int HRr = MR * 32, BMR = 2 * HRr, WRO = HRr / 2;
        const int lane = fq * 16 + fr, frp = lane >> 2, fqp = lane & 3, src4 = (fqp * 16 + frp) * 4;
#pragma unroll
        for (int ai = 0; ai < 2; ++ai)
#pragma unroll
            for (int m = 0; m < MR; ++m) {
                bf16_t* rowp = O + (size_t)(u.pm * BMR + ai * HRr + wr * WRO + m * 16 + frp) * ldc + u.pn * BM + wc * 32 + 8 * fqp;
#pragma unroll
                for (int bj = 0; bj < 2; ++bj) {
                    f32x4 v0 = acc[ai][bj][m][0], v1 = acc[ai][bj][m][1];
#pragma unroll
                    for (int e = 0; e < 4; ++e) { v0[e] = relu_raw(v0[e]); v1[e] = relu_raw(v1[e]); }
                    v0 = v0 * v0; v1 = v1 * v1;
                    u32x4 w; w.x = cvt_pk_bf16(v0[0], v0[1]); w.y = cvt_pk_bf16(v0[2], v0[3]); w.z = cvt_pk_bf16(v1[0], v1[1]); w.w = cvt_pk_bf16(v1[2], v1[3]);
                    w.x = (unsigned)__builtin_amdgcn_ds_bpermute(src4, (int)w.x); w.y = (unsigned)__builtin_amdgcn_ds_bpermute(src4, (int)w.y);
                    w.z = (unsigned)__builtin_amdgcn_ds_bpermute(src4, (int)w.z); w.w = (unsigned)__builtin_amdgcn_ds_bpermute(src4, (int)w.w);
                    *(u32x4*)(rowp + bj * HALF) = w;
                }
            }
    }
};
__device__ __forceinline__ float gelu_tanh(float x) {
    const float u2 = 1.5957691216057308f * (x + 0.044715f * x * x * x);
    return x * __builtin_amdgcn_rcpf(1.0f + __builtin_amdgcn_exp2f(-1.4426950408889634f * u2));
}
struct EpiRecIn {
    static constexpr bool PERM = true, AFTER_DRAIN = false, DUPK = (DUPK_SEL == 4), RELAX = (RELAX_EPI & 2) != 0;
    bf16_t* GG; bf16_t* XR; bf16_t* HALO;
    template <int MR> __device__ __forceinline__ void operator()(const f32x4 (&acc)[2][2][MR][2], const Unit& u, int wr, int wc, int fr, int fq) const {
        constexpr int HRr = MR * 32, BMR = 2 * HRr, WRO = HRr / 2;
        const bool isg = u.pn < 5;
        bf16_t* base = isg ? GG : XR; const int colt = (isg ? u.pn : u.pn - 5) * BM;
#pragma unroll
        for (int ai = 0; ai < 2; ++ai)
#pragma unroll
            for (int m = 0; m < MR; ++m) {
                const int row = u.pm * BMR + ai * HRr + wr * WRO + m * 16 + fr;
                bf16_t* rowp = base + (size_t)row * 1280 + colt + wc * 32 + 8 * fq;
                const int rl = row & 63; const bool halo = !isg && (rl == 63 || rl <= 1);
                bf16_t* hp = HALO + ((size_t)(row >> 6) * 3 + (rl == 63 ? 0 : rl + 1)) * 1280 + colt + wc * 32 + 8 * fq;
#pragma unroll
                for (int bj = 0; bj < 2; ++bj) {
                    f32x4 v0 = acc[ai][bj][m][0], v1 = acc[ai][bj][m][1];
                    if (isg) {
#pragma unroll
                        for (int e = 0; e < 4; ++e) { v0[e] = gelu_tanh(v0[e]); v1[e] = gelu_tanh(v1[e]); }
                    }
                    u32x4 w; w.x = cvt_pk_bf16(v0[0], v0[1]); w.y = cvt_pk_bf16(v0[2], v0[3]); w.z = cvt_pk_bf16(v1[0], v1[1]); w.w = cvt_pk_bf16(v1[2], v1[3]);
                    *(u32x4*)(rowp + bj * HALF) = w;
                    if (halo) *(u32x4*)(hp + bj * HALF) = w;
                }
            }
    }
};
template <class Epi, class Sched, bool ALIGN_EPI = false, bool SP2 = false, int HR = 128>
__device__ __forceinline__ void gemm_phase(PG8_LAS unsigned char* lds, const Gemm g, const Sched& S, const Epi& E, const int wave_s) {
    int tid_ = wave_s * 64 + lane_now(); asm volatile("" : "+v"(tid_));
    const int tid = tid_, wid = __builtin_amdgcn_readfirstlane(tid >> 6), lane = tid & 63, wr = wid >> 2, wc = wid & 3, fr = lane & 15, fq = lane >> 4;
    constexpr int MR = HR / 32;
    const int K = g.K, nt = K / BK;
    unsigned voffA[2], voffB[2];
#pragma unroll
    for (int i = 0; i < 2; ++i) { int R, C; stage_rc(tid * 16 + i * 8192, R, C); const int Rb = Epi::PERM ? ((R & ~31) + perm32(R & 31)) : R;
        voffA[i] = (unsigned)(R * g.lda + C) * 2u; voffB[i] = (unsigned)(Rb * K + C) * 2u; }
    const size_t kstep = (size_t)(BK * 2);
    const size_t hstep = (size_t)HALF * K * 2;
    const size_t tstep = 2 * hstep;
    const size_t hstepA = (size_t)HR * g.lda * 2, tstepA = 2 * hstepA;
    const unsigned ldsw = (unsigned)wid * 1024u;
    const int aoff = lds_byte(wr * (HR / 2) + fr, fq * 8), boff = lds_byte(wc * 32 + fr, fq * 8);
#define PG8_SA(b, h) (((b) * 2 + (h)) * HTB)
#define PG8_SB(b, h) ((4 + (b) * 2 + (h)) * HTB)
#define PG8_STAGE(bufoff, gbase, voff) do { _Pragma("unroll") for (int _i = 0; _i < 2; ++_i) \
        __builtin_amdgcn_global_load_lds((const unsigned*)((const char*)(gbase) + (voff)[_i]), (PG8_LAS unsigned*)(lds + (bufoff) + ldsw + _i * 8192), 16, 0, 0); } while (0)
#define PG8_LDA(dst, b, h) do { _Pragma("unroll") for (int m = 0; m < MR; ++m) _Pragma("unroll") for (int k = 0; k < 2; ++k) dst[m][k] = *(const PG8_LAS bf16x8*)(lds + PG8_SA(b, h) + aoff + m * 2048 + k * 1024); } while (0)
#define PG8_LDB(dst, b, h) do { _Pragma("unroll") for (int n = 0; n < 2; ++n) _Pragma("unroll") for (int k = 0; k < 2; ++k) dst[n][k] = *(const PG8_LAS bf16x8*)(lds + PG8_SB(b, h) + boff + n * 2048 + k * 1024); } while (0)
#define PG8_MMA(ai, bj, At, Bt) do { __builtin_amdgcn_s_setprio(1); _Pragma("unroll") for (int m = 0; m < MR; ++m) _Pragma("unroll") for (int n = 0; n < 2; ++n) _Pragma("unroll") for (int k = 0; k < 2; ++k) \
        acc[ai][bj][m][n] = __builtin_amdgcn_mfma_f32_16x16x32_bf16(Bt[n][k], At[m][k], acc[ai][bj][m][n], 0, 0, 0); __builtin_amdgcn_s_setprio(0); } while (0)
#define PG8_MMA0(ai, bj, At, Bt) do { __builtin_amdgcn_s_setprio(1); _Pragma("unroll") for (int m = 0; m < MR; ++m) _Pragma("unroll") for (int n = 0; n < 2; ++n) { \
        acc[ai][bj][m][n] = __builtin_amdgcn_mfma_f32_16x16x32_bf16(Bt[n][0], At[m][0], (f32x4){0.f, 0.f, 0.f, 0.f}, 0, 0, 0); \
        acc[ai][bj][m][n] = __builtin_amdgcn_mfma_f32_16x16x32_bf16(Bt[n][1], At[m][1], acc[ai][bj][m][n], 0, 0, 0); } __builtin_amdgcn_s_setprio(0); } while (0)
#define PG8_WAIT_V_(n) asm volatile("s_waitcnt vmcnt(" #n ")" ::: "memory")
#define PG8_WAIT_V(n) PG8_WAIT_V_(n)
#define PG8_WAIT_L(n) asm volatile("s_waitcnt lgkmcnt(" #n ")" ::: "memory")
#define PG8_BAR __builtin_amdgcn_s_barrier()
#define PG8_SCHED __builtin_amdgcn_sched_barrier(0)
#define PG8_PAIR(W1, MMAF) do { \
            PG8_LDB(B0, 0, 0); PG8_LDB(B1, 0, 1); PG8_SCHED; PG8_LDA(At, 0, 0); PG8_STAGE(PG8_SA(1, 1), a1 + hstepA, voffA); \
            PG8_WAIT_V(W1); PG8_WAIT_L(0); PG8_BAR; MMAF(0, 0, At, B0); MMAF(0, 1, At, B1); PG8_BAR; PG8_SCHED; \
            PG8_LDA(At, 0, 1); PG8_STAGE(PG8_SB(0, 0), b2, voffB); PG8_STAGE(PG8_SB(0, 1), b2 + hstep, voffB); PG8_STAGE(PG8_SA(0, 0), a2, voffA); \
            PG8_WAIT_V(W1); PG8_WAIT_L(0); PG8_BAR; MMAF(1, 0, At, B0); MMAF(1, 1, At, B1); PG8_BAR; PG8_SCHED; \
            PG8_LDB(B0, 1, 0); PG8_LDB(B1, 1, 1); PG8_SCHED; PG8_LDA(At, 1, 0); PG8_STAGE(PG8_SA(0, 1), a2 + hstepA, voffA); \
            PG8_WAIT_V(8); PG8_WAIT_L(0); PG8_BAR; PG8_MMA(0, 0, At, B0); PG8_MMA(0, 1, At, B1); PG8_BAR; PG8_SCHED; \
            PG8_LDA(At, 1, 1); PG8_STAGE(PG8_SB(1, 0), b3, voffB); PG8_STAGE(PG8_SB(1, 1), b3 + hstep, voffB); PG8_STAGE(PG8_SA(1, 0), a3, voffA); \
            PG8_WAIT_V(8); PG8_WAIT_L(0); PG8_BAR; PG8_MMA(1, 0, At, B0); PG8_MMA(1, 1, At, B1); PG8_BAR; PG8_SCHED; } while (0)
    Unit cur, nxt; int ui = 0, t0 = 0;
    if (!S.next(0, cur)) return;
    f32x4 acc[2][2][MR][2];
#pragma unroll
    for (int a = 0; a < 2; ++a)
#pragma unroll
        for (int b = 0; b < 2; ++b)
#pragma unroll
            for (int m = 0; m < MR; ++m)
#pragma unroll
                for (int n = 0; n < 2; ++n) acc[a][b][m][n] = (f32x4){0.f, 0.f, 0.f, 0.f};
    bf16x8 At[MR][2], B0[2][2], B1[2][2];
    const char* cA = (const char*)g.A + (size_t)cur.pm * tstepA; const char* cB = (const char*)g.Bt + (size_t)cur.pn * tstep;
    S.a_ready(cur);
    if constexpr (SP2) {
        PG8_STAGE(PG8_SB(0, 0), cB, voffB); PG8_STAGE(PG8_SB(0, 1), cB + hstep, voffB); PG8_STAGE(PG8_SA(0, 0), cA, voffA); PG8_STAGE(PG8_SA(0, 1), cA + hstepA, voffA);
        if (wr == 1) PG8_BAR;
        PG8_WAIT_V(2); PG8_BAR;
        PG8_STAGE(PG8_SB(1, 0), cB + kstep, voffB); PG8_STAGE(PG8_SA(1, 0), cA + kstep, voffA); PG8_STAGE(PG8_SB(1, 1), cB + hstep + kstep, voffB);
        PG8_WAIT_V(6); PG8_BAR;
    } else {
        PG8_STAGE(PG8_SB(0, 0), cB, voffB); PG8_STAGE(PG8_SA(0, 0), cA, voffA); PG8_STAGE(PG8_SB(0, 1), cB + hstep, voffB); PG8_STAGE(PG8_SA(0, 1), cA + hstepA, voffA);
        if (wr == 1) PG8_BAR;
        PG8_WAIT_V(4); PG8_BAR;
        PG8_STAGE(PG8_SB(1, 0), cB + kstep, voffB); PG8_STAGE(PG8_SA(1, 0), cA + kstep, voffA); PG8_STAGE(PG8_SB(1, 1), cB + hstep + kstep, voffB);
        PG8_WAIT_V(6); PG8_BAR;
    }
    for (;;) {
        const bool has_next = S.next(ui + 1, nxt);
        const char* nA = has_next ? (const char*)g.A + (size_t)nxt.pm * tstepA : cA; const char* nB = has_next ? (const char*)g.Bt + (size_t)nxt.pn * tstep : cB;
#ifdef DUP_KLOOP
        constexpr int NDUP = Epi::DUPK ? DUP_KLOOP : 1;
#else
        constexpr int NDUP = 1;
#endif
#pragma unroll 1
        for (int dup = 0; dup < NDUP; ++dup) {
        if (dup > 0) {
#pragma unroll
            for (int a = 0; a < 2; ++a)
#pragma unroll
                for (int b = 0; b < 2; ++b)
#pragma unroll
                    for (int m = 0; m < MR; ++m)
#pragma unroll
                        for (int n = 0; n < 2; ++n) acc[a][b][m][n] = (f32x4){0.f, 0.f, 0.f, 0.f};
        }
        const char* nA2 = dup < NDUP - 1 ? cA : nA; const char* nB2 = dup < NDUP - 1 ? cB : nB;
        for (int t = t0; t < nt; t += 2) {
            const bool last = (t == nt - 2);
            const char* a1 = cA + (size_t)(t + 1) * kstep;
            const char* a2 = last ? nA2 : cA + (size_t)(t + 2) * kstep; const char* b2 = last ? nB2 : cB + (size_t)(t + 2) * kstep;
            const char* a3 = a2 + kstep; const char* b3 = b2 + kstep;
            if (last && has_next) S.a_ready(nxt);
            if constexpr (SP2) {
            PG8_PAIR(8, PG8_MMA);
            } else {
            PG8_LDB(B0, 0, 0); PG8_SCHED; PG8_LDA(At, 0, 0); PG8_STAGE(PG8_SA(1, 1), a1 + hstepA, voffA);
            PG8_WAIT_L(8); PG8_BAR; PG8_WAIT_L(0); PG8_MMA(0, 0, At, B0); PG8_BAR; PG8_SCHED;
            PG8_LDB(B1, 0, 1); PG8_STAGE(PG8_SB(0, 0), b2, voffB);
            PG8_BAR; PG8_WAIT_L(0); PG8_MMA(0, 1, At, B1); PG8_BAR;
            PG8_LDA(At, 0, 1); PG8_STAGE(PG8_SA(0, 0), a2, voffA);
            PG8_BAR; PG8_WAIT_L(0); PG8_MMA(1, 0, At, B0); PG8_BAR; PG8_SCHED;
            PG8_STAGE(PG8_SB(0, 1), b2 + hstep, voffB);
            PG8_WAIT_V(6); PG8_BAR; PG8_MMA(1, 1, At, B1); PG8_BAR;
            PG8_LDB(B0, 1, 0); PG8_SCHED; PG8_LDA(At, 1, 0); PG8_STAGE(PG8_SA(0, 1), a2 + hstepA, voffA);
            PG8_WAIT_L(8); PG8_BAR; PG8_WAIT_L(0); PG8_MMA(0, 0, At, B0); PG8_BAR; PG8_SCHED;
            PG8_LDB(B1, 1, 1); PG8_STAGE(PG8_SB(1, 0), b3, voffB);
            PG8_BAR; PG8_WAIT_L(0); PG8_MMA(0, 1, At, B1); PG8_BAR;
            PG8_LDA(At, 1, 1); PG8_STAGE(PG8_SA(1, 0), a3, voffA);
            PG8_BAR; PG8_WAIT_L(0); PG8_MMA(1, 0, At, B0); PG8_BAR; PG8_SCHED;
            PG8_STAGE(PG8_SB(1, 1), b3 + hstep, voffB);
            PG8_WAIT_V(6); PG8_BAR; PG8_MMA(1, 1, At, B1); PG8_BAR;
            }
        }
        }
        if constexpr (ALIGN_EPI) { if (wr == 0) PG8_BAR; }
        if constexpr (!Epi::AFTER_DRAIN) { E.template operator()<MR>(acc, cur, wr, wc, fr, fq); S.done(cur); }
        if (!has_next) break;
        if constexpr (!(SP2 && MR == 4 && Epi::RELAX)) {
#pragma unroll
        for (int a = 0; a < 2; ++a)
#pragma unroll
            for (int b = 0; b < 2; ++b)
#pragma unroll
                for (int m = 0; m < MR; ++m)
#pragma unroll
                    for (int n = 0; n < 2; ++n) acc[a][b][m][n] = (f32x4){0.f, 0.f, 0.f, 0.f};
        }
        cur = nxt; cA = nA; cB = nB; ++ui;
        if constexpr (ALIGN_EPI) { if (wr == 1) PG8_BAR; }
        if constexpr (SP2 && MR == 4 && Epi::RELAX) {
            const char* a1 = cA + kstep; const char* a2 = cA + 2 * kstep; const char* b2 = cB + 2 * kstep; const char* a3 = a2 + kstep; const char* b3 = b2 + kstep;
            PG8_PAIR(24, PG8_MMA0); t0 = 2;
        }
    }
    PG8_WAIT_V(0);
    if constexpr (!ALIGN_EPI) { if (wr == 0) PG8_BAR; }
    PG8_BAR;
    if constexpr (Epi::AFTER_DRAIN) { E.fused(acc, cur, wr, wc, fr, fq, lds, wid, lane); S.done(cur); }
#undef PG8_SA
#undef PG8_SB
#undef PG8_STAGE
#undef PG8_LDA
#undef PG8_LDB
#undef PG8_MMA
#undef PG8_WAIT_V
#undef PG8_WAIT_L
#undef PG8_BAR
#undef PG8_SCHED
#undef PG8_PAIR
#undef PG8_MMA0
#undef PG8_WAIT_V_
}
}
constexpr int NWAVES = 8, NTHREADS = 512;
constexpr int DM = 1024, T_CTX = 8192, T_LAT = 16384, T_ALL = 24576, LAT_SEQ = 4096, CTX_SEQ = 256;
constexpr int QKV_LD = 2304, DFF = 4096, DRNN = 1280;
#ifndef LDH_PAD
#define LDH_PAD 64
#endif
constexpr int LDH = DFF + LDH_PAD;
constexpr int QA_OFF = 0, KA_OFF = 512, VA_OFF = 640, QB_OFF = 768, KB_OFF = 1280, VB_OFF = 1792;
constexpr float EPSN = 1e-6f;
constexpr float SM_C = 0.125f * 1.4426950408889634f;
constexpr long OUT_AK = 25165824, OUT_AV = 26214400, OUT_BK = 27262976, OUT_BV = 31457280, OUT_SF = 35651584, OUT_SB = 35692544;
constexpr size_t MiB = 1u << 20;
constexpr size_t WS_CTL = 0, CTL_ZERO_BYTES = 64 * 1024;
constexpr size_t WS_MOD = 1 * MiB;
constexpr size_t WS_ROPE = 1 * MiB + 256 * 1024;
constexpr size_t WS_LAM = WS_ROPE + 16 * 1024;
constexpr size_t WS_SP8 = WS_LAM + 1024;
constexpr size_t WS_CAK = 2 * MiB, WS_CAV = WS_CAK + 256 * 1024, WS_CBK = WS_CAV + 256 * 1024, WS_CBV = WS_CBK + 1 * MiB;
constexpr size_t WS_WIN = 5 * MiB;
constexpr size_t WS_WOUT = 10 * MiB;
constexpr size_t WS_W1 = 12 * MiB;
constexpr size_t WS_W2 = 28 * MiB;
constexpr size_t WS_WRIN = 44 * MiB;
constexpr size_t WS_WROUT = 49 * MiB;
constexpr size_t WS_WG = 52 * MiB;
constexpr size_t WS_SUM = 54 * MiB;
constexpr size_t WS_H = 56 * MiB;
constexpr size_t WS_BIG = 104 * MiB;
constexpr size_t WS_END = 256 * MiB;
static_assert(WS_BIG + (size_t)T_ALL * QKV_LD * 2 <= WS_END && WS_BIG + (size_t)(T_ALL / 2) * LDH * 2 <= WS_BIG + 120 * MiB && WS_BIG + (size_t)T_ALL * DRNN * 4 <= WS_END, "ws map");
constexpr int LDS_BYTES = 160 * 1024;
constexpr int MISC_OFF = 152 * 1024;

#define GAS __attribute__((address_space(1)))
#define LAS __attribute__((address_space(3)))
typedef unsigned short bf16;
typedef unsigned v4u __attribute__((ext_vector_type(4)));
typedef unsigned v2u __attribute__((ext_vector_type(2)));
typedef float f32x4 __attribute__((ext_vector_type(4)));
typedef float f32x2 __attribute__((ext_vector_type(2)));
typedef float f32x16 __attribute__((ext_vector_type(16)));
typedef short bf16x8 __attribute__((ext_vector_type(8)));
typedef short s16x4 __attribute__((ext_vector_type(4)));
typedef GAS unsigned gu32;
#define RLX_AGENT __ATOMIC_RELAXED, __HIP_MEMORY_SCOPE_AGENT
__device__ __forceinline__ unsigned f2bf(float f) { unsigned u = __builtin_bit_cast(unsigned, f); return (u + 0x7fffu + ((u >> 16) & 1u)) >> 16; }
__device__ __forceinline__ unsigned pk2(float lo, float hi) { return f2bf(lo) | (f2bf(hi) << 16); }
__device__ __forceinline__ float bf2f(unsigned short b) { return __builtin_bit_cast(float, (unsigned)b << 16); }
__device__ __forceinline__ float bflo(unsigned w) { return __builtin_bit_cast(float, w << 16); }
__device__ __forceinline__ float bfhi(unsigned w) { return __builtin_bit_cast(float, w & 0xffff0000u); }

#define XB_TMO      128
#define XB_XCNT(j)  (256  + 64 * (j))
#define XB_XSUB(j)  (1280 + 64 * (j))
#define XB_XGEN(j)  (2304 + 64 * (j))
#define XB_TOP      3328
#define XB_TOPGEN   3392
#define XCD_BAR_WORDS 3456
#define XB_SPIN_CAP (1u << 18)
__device__ __forceinline__ unsigned xb_ld(unsigned* p)              { return __hip_atomic_load(p, __ATOMIC_RELAXED, __HIP_MEMORY_SCOPE_AGENT); }
__device__ __forceinline__ unsigned xb_add(unsigned* p, unsigned v) { return __hip_atomic_fetch_add(p, v, __ATOMIC_RELAXED, __HIP_MEMORY_SCOPE_AGENT); }
__device__ __forceinline__ unsigned xb_xcc_id() { return (unsigned)__builtin_amdgcn_s_getreg((3 << 11) | 20) & 0xFu; }
#define XB_SPIN(cond, bar) do { unsigned _sp = 0; while (cond) { __builtin_amdgcn_s_sleep(1); \
    if ((++_sp & 255u) == 0u) { if (xb_ld(&(bar)[XB_TMO])) break; if (_sp > XB_SPIN_CAP) { atomicAdd(&(bar)[XB_TMO], 1u); break; } } } } while (0)
struct XcdBarrier { unsigned* bar; unsigned x; volatile LAS unsigned* st; int wave; };
__device__ __forceinline__ XcdBarrier xcd_barrier_post(unsigned* bar, volatile LAS unsigned* st, int wave) {
    XcdBarrier b; b.bar = bar; b.x = xb_xcc_id(); b.st = st; b.wave = wave;
    if (wave == 0 && lane_now() == 0) (void)xb_add(&bar[XB_XCNT(b.x)], 1u);
    return b;
}
__device__ __forceinline__ void xcd_barrier_complete(unsigned* bar, unsigned x, unsigned& nloc, unsigned& nx) {
    const unsigned G = gridDim.x * gridDim.y * gridDim.z;
    unsigned sum, cnt, mine, sp = 0u;
    for (;;) {
        sum = 0u; cnt = 0u; mine = 0u;
#pragma unroll
        for (unsigned j = 0; j < 16; ++j) { const unsigned c = xb_ld(&bar[XB_XCNT(j)]); sum += c; cnt += (c > 0u) ? 1u : 0u; mine = (j == x) ? c : mine; }
        if (sum == G) break;
        __builtin_amdgcn_s_sleep(1);
        if ((++sp & 255u) == 0u) { if (xb_ld(&bar[XB_TMO])) break; if (sp > XB_SPIN_CAP) { atomicAdd(&bar[XB_TMO], 1u); break; } }
    }
    nloc = mine > 0u ? mine : 1u; nx = cnt > 0u ? cnt : 1u;
}
__device__ __forceinline__ void xcd_barrier(const XcdBarrier& b) {
    asm volatile("s_waitcnt vmcnt(0)" ::: "memory");
    __syncthreads();
    if (b.wave == 0 && lane_now() == 0) {
        unsigned* bar = b.bar;
        __builtin_amdgcn_s_waitcnt(0);
        unsigned nloc = b.st[0], nx = b.st[1];
        if (nloc == 0u) { xcd_barrier_complete(bar, b.x, nloc, nx); b.st[0] = nloc; b.st[1] = nx; }
        const unsigned old = xb_add(&bar[XB_XSUB(b.x)], 1u);
        const unsigned gen = old / nloc;
        if (old + 1u == (gen + 1u) * nloc) {
            __builtin_amdgcn_fence(__ATOMIC_RELEASE, "agent");
            asm volatile("s_waitcnt vmcnt(0)" ::: "memory");
            const unsigned og = xb_add(&bar[XB_TOP], 1u);
            const unsigned tg = og / nx;
            if (og + 1u == (tg + 1u) * nx) xb_add(&bar[XB_TOPGEN], 1u);
            else XB_SPIN(xb_ld(&bar[XB_TOPGEN]) == tg, bar);
            __builtin_amdgcn_fence(__ATOMIC_ACQUIRE, "agent");
            xb_add(&bar[XB_XGEN(b.x)], 1u);
            asm volatile("s_waitcnt vmcnt(0)" ::: "memory");
        } else {
            XB_SPIN(xb_ld(&bar[XB_XGEN(b.x)]) == gen, bar);
            __builtin_amdgcn_fence(__ATOMIC_ACQUIRE, "agent");
            asm volatile("s_waitcnt vmcnt(0)" ::: "memory");
        }
    }
    __syncthreads();
}

struct Args { const float* in[31]; float* out; unsigned char* ws; int ph_lo, ph_hi; int use_bar, pad; };
struct Frame {
    LAS unsigned char* lds;
    int tid, lane, wave, vcu, G;
    const float* const* in; float* out; unsigned char* ws;
};
#define WSP(T, off) ((T*)(F.ws + (off)))
__device__ __forceinline__ Frame fresh(const Frame& F) { Frame P = F; int t = F.wave * 64 + lane_now(); asm volatile("" : "+v"(t)); P.tid = t; P.lane = t & 63; P.wave = __builtin_amdgcn_readfirstlane(t >> 6); return P; }
enum { IN_XP = 0, IN_XS, IN_CAK, IN_CAV, IN_CBK, IN_CBV, IN_SF, IN_SB, IN_C, IN_CCTX, IN_NORM1, IN_NORM2, IN_WADA, IN_BADA, IN_WMLP1, IN_WMLP2, IN_AWIN, IN_AWOUT, IN_SINK, IN_LAMQK, IN_SUBLN,
       IN_RWIN, IN_RCONVW, IN_RCONVB, IN_RWA, IN_RBA, IN_RWX, IN_RBX, IN_RLAM, IN_RWOUT, IN_FNORM };

__device__ __forceinline__ float wave_sum(float v) {
#define WS_DPP(x, ctrl, rmask) __builtin_bit_cast(float, __builtin_amdgcn_update_dpp(0, __builtin_bit_cast(int, x), ctrl, rmask, 0xf, false))
    v += WS_DPP(v, 0xB1, 0xf); v += WS_DPP(v, 0x4E, 0xf); v += WS_DPP(v, 0x141, 0xf); v += WS_DPP(v, 0x140, 0xf);
    v += WS_DPP(v, 0x142, 0xa); v += WS_DPP(v, 0x143, 0xc);
#undef WS_DPP
    return __builtin_bit_cast(float, __builtin_amdgcn_readlane(__builtin_bit_cast(int, v), 63));
}

__device__ __forceinline__ void p0_transpose_item(const float* W, int K, int N, bf16* WT, LAS float* scr, int item, int lane, float wscale = 1.0f) {
    const int nblk = N / 32, kb = item / nblk, nb = item % nblk, k0 = 64 * kb, n0 = 32 * nb;
#pragma unroll 8
    for (int i = 0; i < 32; ++i) { const int kk = 2 * i + (lane >> 5); scr[kk * 33 + (lane & 31)] = W[(size_t)(k0 + kk) * N + n0 + (lane & 31)]; }
    asm volatile("s_waitcnt lgkmcnt(0)" ::: "memory");
    const int c = lane & 7;
#pragma unroll
    for (int j = 0; j < 4; ++j) { const int n = (lane >> 3) + 8 * j; const LAS float* s = scr + (8 * c) * 33 + n;
        v4u o; o.x = pk2(s[0 * 33] * wscale, s[1 * 33] * wscale); o.y = pk2(s[2 * 33] * wscale, s[3 * 33] * wscale); o.z = pk2(s[4 * 33] * wscale, s[5 * 33] * wscale); o.w = pk2(s[6 * 33] * wscale, s[7 * 33] * wscale);
        *(GAS v4u*)(WT + (size_t)(n0 + n) * K + k0 + 8 * c) = o; }
    asm volatile("s_waitcnt lgkmcnt(0)" ::: "memory");
}
__device__ __forceinline__ void p0_prologue(Frame& F) {
    const float* const* in = F.in;
    {
        LAS float* SC = (LAS float*)(F.lds);
        LAS float* RED = (LAS float*)(F.lds + 20480);
        for (int i = F.tid; i < 5 * 1024; i += NTHREADS) { const int v = i >> 10, k = i & 1023; const float c = v < 4 ? in[IN_C][v * 1024 + k] : in[IN_CCTX][k]; SC[i] = c / (1.0f + __expf(-c)); }
        __syncthreads();
        float* MOD = WSP(float, WS_MOD);
        for (int u = blockIdx.x; u < 384; u += F.G) {
            const int l = u / 192, n0 = (u % 192) * 32;
            const float* W = in[IN_WADA] + (size_t)l * 1024 * 6144 + n0 + (F.lane & 31);
            float a[5] = {0.f, 0.f, 0.f, 0.f, 0.f};
            const int kb = F.wave * 128 + (F.lane >> 5);
#pragma unroll 8
            for (int kk = 0; kk < 64; ++kk) { const int k = kb + 2 * kk; const float w = W[(size_t)k * 6144];
#pragma unroll
                for (int v = 0; v < 5; ++v) a[v] += SC[v * 1024 + k] * w; }
#pragma unroll
            for (int v = 0; v < 5; ++v) { a[v] += __shfl_xor(a[v], 32); if (F.lane < 32) RED[(F.wave * 5 + v) * 32 + F.lane] = a[v]; }
            __syncthreads();
            if (F.tid < 160) { const int v = F.tid >> 5, c = F.tid & 31; float s = in[IN_BADA][l * 6144 + n0 + c];
#pragma unroll
                for (int w = 0; w < 8; ++w) s += RED[(w * 5 + v) * 32 + c];
                MOD[((size_t)l * 5 + v) * 6144 + n0 + c] = s; }
            __syncthreads();
        }
    }
    {
        LAS float* scr = (LAS float*)(F.lds + 32768 + F.wave * 8704);
        const int gw = F.vcu * NWAVES + F.wave, NGW = F.G * NWAVES;
        constexpr int I_IN = 16 * 72, I_OUT = 16 * 32;
        for (int it = gw; it < I_IN + I_OUT; it += NGW) {
            if (it < I_IN) p0_transpose_item(in[IN_AWIN], 1024, 2304, WSP(bf16, WS_WIN), scr, it, F.lane);
            else p0_transpose_item(in[IN_AWOUT], 1024, 1024, WSP(bf16, WS_WOUT), scr, it - I_IN, F.lane);
        }
    }
    {
        const int gt = F.vcu * NTHREADS + F.tid, NGT = F.G * NTHREADS;
        for (int i = gt; i < 4 * 256 * 128 / 4; i += NGT) {
            const f32x4 a = ((const f32x4*)in[IN_CAK])[i], b = ((const f32x4*)in[IN_CAV])[i];
            v2u o; o.x = pk2(a[0], a[1]); o.y = pk2(a[2], a[3]); WSP(v2u, WS_CAK)[i] = o; o.x = pk2(b[0], b[1]); o.y = pk2(b[2], b[3]); WSP(v2u, WS_CAV)[i] = o; }
        for (int i = gt; i < 4 * 256 * 512 / 4; i += NGT) {
            const f32x4 a = ((const f32x4*)in[IN_CBK])[i], b = ((const f32x4*)in[IN_CBV])[i];
            v2u o; o.x = pk2(a[0], a[1]); o.y = pk2(a[2], a[3]); WSP(v2u, WS_CBK)[i] = o; o.x = pk2(b[0], b[1]); o.y = pk2(b[2], b[3]); WSP(v2u, WS_CBV)[i] = o; }
        if (gt < 1024) { const int pos = gt >> 4, i = gt & 15; const double ang = (double)pos * pow(10000.0, -(double)i / 16.0);
            WSP(f32x2, WS_ROPE)[gt] = (f32x2){(float)cos(ang), (float)sin(ang)}; }
        if (gt == 0) { const float* lq = in[IN_LAMQK]; float s1 = 0.f, s2 = 0.f; for (int i = 0; i < 64; ++i) { s1 += lq[i] * lq[64 + i]; s2 += lq[128 + i] * lq[192 + i]; }
            WSP(float, WS_LAM)[0] = __expf(s1) - __expf(s2) + 0.2f; }
        if (gt >= 1024 && gt < 1024 + 2 * DRNN) { const float lamv = in[IN_RLAM][gt - 1024]; WSP(float, WS_SP8)[gt - 1024] = -8.0f * (lamv > 20.f ? __expf(-lamv) : log1pf(__expf(-lamv))); }
    }
}

__device__ __forceinline__ void p_deferred_transposes(Frame& F, int iw, int nw) {
    const float* const* in = F.in;
    LAS float* scr = (LAS float*)(F.lds + 32768 + F.wave * 8704);
    const int gw = iw * NWAVES + F.wave, NGW = nw * NWAVES;
    constexpr int I_M1 = 16 * 128, I_M2 = 64 * 32, I_RIN = 16 * 80, I_ROUT = 20 * 32, I_G = 8;
    constexpr int NITEMS = 2 * I_M1 + 2 * I_M2 + I_RIN + I_ROUT + 40 * I_G;
    for (int it = gw; it < NITEMS; it += NGW) {
        int r = it;
        if (r < 2 * I_M1) { const int l = r / I_M1; p0_transpose_item(in[IN_WMLP1] + (size_t)l * 1024 * 4096, 1024, 4096, WSP(bf16, WS_W1) + (size_t)l * 4096 * 1024, scr, r % I_M1, F.lane); continue; } r -= 2 * I_M1;
        if (r < 2 * I_M2) { const int l = r / I_M2; p0_transpose_item(in[IN_WMLP2] + (size_t)l * 4096 * 1024, 4096, 1024, WSP(bf16, WS_W2) + (size_t)l * 1024 * 4096, scr, r % I_M2, F.lane); continue; } r -= 2 * I_M2;
        if (r < I_RIN) { p0_transpose_item(in[IN_RWIN], 1024, 2560, WSP(bf16, WS_WRIN), scr, r, F.lane); continue; } r -= I_RIN;
        if (r < I_ROUT) { p0_transpose_item(in[IN_RWOUT], 1280, 1024, WSP(bf16, WS_WROUT), scr, r, F.lane); continue; } r -= I_ROUT;
        { const int mtx = r / I_G, gate = mtx / 20, db = mtx % 20;
          p0_transpose_item(in[gate ? IN_RWX : IN_RWA] + (size_t)db * 16384, 128, 128, WSP(bf16, WS_WG) + (size_t)(gate * 20 + db) * 16384, scr, r % I_G, F.lane, -1.4426950408889634f); }
    }
}

__device__ __forceinline__ void norm_mod_pass(Frame& F, const float* x_ctx, const float* x_lat, const float* g, const float* mod  , int shift_off, int scale_off, bf16* H) {
    const int gw = F.vcu * NWAVES + F.wave, NGW = F.G * NWAVES;
    for (int m = gw; m < T_ALL; m += NGW) {
        const float* xr = m < T_CTX ? x_ctx + (size_t)m * DM : x_lat + (size_t)(m - T_CTX) * DM;
        const int midx = m < T_CTX ? 4 : ((m - T_CTX) >> 12);
        const float* mv = mod + (size_t)midx * 6144;
        f32x4 v[4]; float s = 0.f;
#pragma unroll
        for (int j = 0; j < 4; ++j) { v[j] = ((const f32x4*)xr)[F.lane + 64 * j]; s += (v[j][0] * v[j][0] + v[j][1] * v[j][1]) + (v[j][2] * v[j][2] + v[j][3] * v[j][3]); }
        const float rstd = 1.0f / sqrtf(wave_sum(s) * (1.0f / DM) + EPSN);
#pragma unroll
        for (int j = 0; j < 4; ++j) {
            const int c = 4 * (F.lane + 64 * j);
            const f32x4 gg = *(const f32x4*)(g + c), sc = *(const f32x4*)(mv + scale_off + c), sh = *(const f32x4*)(mv + shift_off + c);
            f32x4 o = (v[j] * rstd) * gg; o = o * (sc + 1.0f) + sh;
            v2u w; w.x = pk2(o[0], o[1]); w.y = pk2(o[2], o[3]);
            *(v2u*)(H + (size_t)m * DM + c) = w;
        }
    }
}
constexpr int X_SPLIT = 16384;
__device__ __forceinline__ const bf16* xrow_bf(const bf16* XA, const bf16* XB, int m) { return m < X_SPLIT ? XA + (size_t)m * DM : XB + (size_t)(m - X_SPLIT) * DM; }
__device__ __forceinline__ void unpack16(const v4u a, const v4u b, float (&v)[16]) {
    const unsigned w[8] = {a.x, a.y, a.z, a.w, b.x, b.y, b.z, b.w};
#pragma unroll
    for (int e = 0; e < 8; ++e) { v[2 * e] = bflo(w[e]); v[2 * e + 1] = bfhi(w[e]); }
}
__device__ __forceinline__ void norm_mod_pass_bf(Frame& F, const bf16* XA, const bf16* XB, const float* g, const float* mod  , int shift_off, int scale_off, bf16* H) {
    const int gw = F.vcu * NWAVES + F.wave, NGW = F.G * NWAVES;
    for (int m = gw; m < T_ALL; m += NGW) {
        const v4u* xp = (const v4u*)(xrow_bf(XA, XB, m) + F.lane * 8);
        const int midx = m < T_CTX ? 4 : ((m - T_CTX) >> 12);
        const float* mv = mod + (size_t)midx * 6144;
        float v[16]; unpack16(xp[0], xp[64], v);
        float s = 0.f;
#pragma unroll
        for (int e = 0; e < 16; ++e) s += v[e] * v[e];
        const float rstd = 1.0f / sqrtf(wave_sum(s) * (1.0f / DM) + EPSN);
        unsigned ow[8];
#pragma unroll
        for (int q = 0; q < 4; ++q) {
            const int c = 8 * F.lane + (q >> 1) * 512 + (q & 1) * 4;
            const f32x4 gg = *(const f32x4*)(g + c), sc = *(const f32x4*)(mv + scale_off + c), sh = *(const f32x4*)(mv + shift_off + c);
            const float o0 = (v[4 * q] * rstd) * gg[0] * (sc[0] + 1.0f) + sh[0], o1 = (v[4 * q + 1] * rstd) * gg[1] * (sc[1] + 1.0f) + sh[1];
            const float o2 = (v[4 * q + 2] * rstd) * gg[2] * (sc[2] + 1.0f) + sh[2], o3 = (v[4 * q + 3] * rstd) * gg[3] * (sc[3] + 1.0f) + sh[3];
            ow[2 * q] = pk2(o0, o1); ow[2 * q + 1] = pk2(o2, o3);
        }
        v4u* hp = (v4u*)(H + (size_t)m * DM + 8 * F.lane);
        v4u a, b2; a.x = ow[0]; a.y = ow[1]; a.z = ow[2]; a.w = ow[3]; b2.x = ow[4]; b2.y = ow[5]; b2.z = ow[6]; b2.w = ow[7];
        hp[0] = a; hp[64] = b2;
    }
}
__device__ __forceinline__ void final_norm_pass(Frame& F, const bf16* XA, const bf16* XB, float* Y, const float* g, int m_lo, int m_hi) {
    const int gw = F.vcu * NWAVES + F.wave, NGW = F.G * NWAVES;
    for (int m = m_lo + gw; m < m_hi; m += NGW) {
        const v4u* xp = (const v4u*)(xrow_bf(XA, XB, m) + F.lane * 8);
        float v[16]; unpack16(xp[0], xp[64], v);
        float s = 0.f;
#pragma unroll
        for (int e = 0; e < 16; ++e) s += v[e] * v[e];
        const float rstd = 1.0f / sqrtf(wave_sum(s) * (1.0f / DM) + EPSN);
#pragma unroll
        for (int q = 0; q < 4; ++q) { const int c = 8 * F.lane + (q >> 1) * 512 + (q & 1) * 4; const f32x4 gg = *(const f32x4*)(g + c);
            f32x4 o; o[0] = v[4 * q] * rstd * gg[0]; o[1] = v[4 * q + 1] * rstd * gg[1]; o[2] = v[4 * q + 2] * rstd * gg[2]; o[3] = v[4 * q + 3] * rstd * gg[3];
            *(f32x4*)(Y + (size_t)m * DM + c) = o; }
    }
}

constexpr float ATT_THR = 8.0f;
constexpr int AT_K0 = 0, AT_K1 = 9216;
constexpr int AT_V0 = 18432, AT_V1 = 38912;
constexpr int AT_WS = 59392;
constexpr int AT_O1 = 61440;
static_assert(AT_O1 + 65536 <= MISC_OFF, "attention LDS map");
__device__ __forceinline__ int crow(int r, int hi) { return (r & 3) + 8 * (r >> 2) + 4 * hi; }
__device__ __forceinline__ unsigned cvtpk_s(float lo, float hi) { typedef __bf16 bf16x2_t __attribute__((ext_vector_type(2))); f32x2 v = {lo, hi}; bf16x2_t b = __builtin_convertvector(v, bf16x2_t); return __builtin_bit_cast(unsigned, b); }
__device__ __forceinline__ s16x4 vtr(const LAS unsigned char* p) { typedef short v4i16_t __attribute__((ext_vector_type(4))); return __builtin_bit_cast(s16x4, __builtin_amdgcn_ds_read_tr16_b64_v4i16((LAS v4i16_t*)p)); }

struct AttnSrc {
    const bf16* K0; const bf16* V0; int ld0, n0;
    const bf16* K1; const bf16* V1; int ld1, t_lo, t_hi;
};
template <int DV, bool WINDOW>
__device__ __forceinline__ void attn_pass(Frame& F, const bf16* Q, int ldq, const AttnSrc& S, int qpos0, float m_init, float l_init, bool start_exact, f32x16 (&o)[DV / 32], float& m_out, float& l_out) {
    constexpr int RSV = DV == 128 ? 320 : 192, NVL = DV / 64;
    LAS unsigned char* lds = F.lds;
    const int tid = F.tid, lane = F.lane, wid = F.wave, r32 = lane & 31, hi = lane >> 5;
    LAS float* wsf = (LAS float*)(lds + AT_WS) + wid * 64;
    bf16x8 qr[4];
    { const bf16* qp = Q + (size_t)(wid * 32 + r32) * ldq + hi * 8;
#pragma unroll
      for (int d0 = 0; d0 < 4; ++d0) qr[d0] = *(const bf16x8*)(qp + d0 * 16); }
#pragma unroll
    for (int d = 0; d < DV / 32; ++d) o[d] = f32x16{};
    float m = m_init, l = l_init;
    f32x16 negm;
#pragma unroll
    for (int r = 0; r < 16; ++r) negm[r] = -m_init;
    const int nt = S.n0 + (S.t_hi - S.t_lo);
    v4u kreg, vreg[NVL];
    const int krow = tid >> 3, kch = tid & 7;
#define AT_ISSUE(it_) do { const int it__ = (it_); const bf16* Kp; const bf16* Vp; int ld; \
        if (it__ < S.n0) { Kp = S.K0 + (size_t)(it__ * 64) * S.ld0; Vp = S.V0 + (size_t)(it__ * 64) * S.ld0; ld = S.ld0; } \
        else { const int t = S.t_lo + it__ - S.n0; Kp = S.K1 + (size_t)(t * 64) * S.ld1; Vp = S.V1 + (size_t)(t * 64) * S.ld1; ld = S.ld1; } \
        kreg = *(const v4u*)(Kp + (size_t)krow * ld + kch * 8); \
        if (DV == 128) { _Pragma("unroll") for (int i = 0; i < NVL; ++i) { const int idx = tid + 512 * i; vreg[i] = *(const v4u*)(Vp + (size_t)(idx >> 4) * ld + (idx & 15) * 8); } } \
        else vreg[0] = *(const v4u*)(Vp + (size_t)krow * ld + kch * 8); } while (0)
#define AT_COMMIT(buf_) do { const int kb_ = (buf_) ? AT_K1 : AT_K0, vb_ = (buf_) ? AT_V1 : AT_V0; \
        *(LAS v4u*)(lds + kb_ + krow * 144 + kch * 16) = kreg; \
        if (DV == 128) { _Pragma("unroll") for (int i = 0; i < NVL; ++i) { const int idx = tid + 512 * i; *(LAS v4u*)(lds + vb_ + (idx >> 4) * RSV + (idx & 15) * 16) = vreg[i]; } } \
        else *(LAS v4u*)(lds + vb_ + krow * RSV + kch * 16) = vreg[0]; } while (0)
    const int koff = r32 * 144 + hi * 16;
    const int voff = (4 * hi + ((lane & 15) >> 2)) * RSV + ((lane >> 4) & 1) * 32 + (lane & 3) * 8;
    const int qw0 = qpos0 + 32 * wid;
    if (wid >= 4) __builtin_amdgcn_s_setprio(1);
    __syncthreads();
    AT_ISSUE(0); AT_COMMIT(0);
    if (nt > 1) AT_ISSUE(1);
#pragma unroll 1
    for (int it = 0; it < nt; ++it) {
        __syncthreads();
        const LAS unsigned char* kbase = lds + ((it & 1) ? AT_K1 : AT_K0) + koff;
        const LAS unsigned char* vbase = lds + ((it & 1) ? AT_V1 : AT_V0) + voff;
        bool skip = false, need_mask = false;
        int kp0 = 0;
        if (WINDOW && it >= S.n0) {
            kp0 = (S.t_lo + it - S.n0) * 64;
            skip = (kp0 + 63 < qw0 - 128 || kp0 > qw0 + 31 + 128);
            need_mask = !(kp0 >= qw0 + 31 - 128 && kp0 + 63 <= qw0 + 128);
        }
        if (!skip) {
            f32x16 p0, p1;
#pragma unroll
            for (int d0 = 0; d0 < 4; ++d0) {
                const bf16x8 k0 = *(const LAS bf16x8*)(kbase + d0 * 32);
                const bf16x8 k1 = *(const LAS bf16x8*)(kbase + 32 * 144 + d0 * 32);
                if (d0 == 0) { p0 = __builtin_amdgcn_mfma_f32_32x32x16_bf16(k0, qr[0], negm, 0, 0, 0); p1 = __builtin_amdgcn_mfma_f32_32x32x16_bf16(k1, qr[0], negm, 0, 0, 0); }
                else { p0 = __builtin_amdgcn_mfma_f32_32x32x16_bf16(k0, qr[d0], p0, 0, 0, 0); p1 = __builtin_amdgcn_mfma_f32_32x32x16_bf16(k1, qr[d0], p1, 0, 0, 0); }
            }
            if (WINDOW && need_mask) {
                const int q = qw0 + r32;
#pragma unroll
                for (int r = 0; r < 16; ++r) { const int kv = kp0 + crow(r, hi); int d0 = q - kv; d0 = d0 < 0 ? -d0 : d0; int d1 = q - kv - 32; d1 = d1 < 0 ? -d1 : d1;
                    if (d0 > 128) p0[r] = -1e30f; if (d1 > 128) p1[r] = -1e30f; }
            }
            float rm = fmaxf(p0[0], p1[0]);
#pragma unroll
            for (int r = 1; r < 16; ++r) rm = fmaxf(fmaxf(rm, p0[r]), p1[r]);
            const bool exact = start_exact && it == 0;
            if (exact || __any(rm > ATT_THR)) {
                rm = fmaxf(rm, __shfl_xor(rm, 32));
                const float dl = exact ? rm : fmaxf(rm, 0.f);
                m += dl;
#pragma unroll
                for (int r = 0; r < 16; ++r) { p0[r] -= dl; p1[r] -= dl; negm[r] = -m; }
                const float alpha = exact ? 1.0f : __builtin_amdgcn_exp2f(-dl);
                l *= alpha;
                if (hi == 0) wsf[r32] = alpha;
                asm volatile("s_waitcnt lgkmcnt(0)" ::: "memory");
#pragma unroll
                for (int r = 0; r < 16; ++r) { const float a = wsf[crow(r, hi)];
#pragma unroll
                    for (int d = 0; d < DV / 32; ++d) o[d][r] *= a; }
            }
            float ps = 0.f;
            bf16x8 pa[4];
#define AT_ECHUNK(P_, B_, c_) do { v4u w_; \
                _Pragma("unroll") for (int j = 0; j < 4; ++j) { const float e0 = __builtin_amdgcn_exp2f(P_[(B_) + 2 * j]), e1 = __builtin_amdgcn_exp2f(P_[(B_) + 2 * j + 1]); \
                    ps += e0 + e1; w_[j] = cvtpk_s(e0, e1); } \
                pa[c_] = __builtin_bit_cast(bf16x8, w_); } while (0)
#define AT_PVSTEP(s_) do { _Pragma("unroll") for (int d = 0; d < DV / 32; ++d) { \
                const s16x4 lo = vtr(vbase + (16 * (s_)) * RSV + d * 64); const s16x4 hh = vtr(vbase + (16 * (s_) + 8) * RSV + d * 64); \
                const bf16x8 vf = (bf16x8){lo[0], lo[1], lo[2], lo[3], hh[0], hh[1], hh[2], hh[3]}; \
                o[d] = __builtin_amdgcn_mfma_f32_32x32x16_bf16(pa[s_], vf, o[d], 0, 0, 0); } } while (0)
            AT_ECHUNK(p0, 0, 0);
            AT_ECHUNK(p0, 8, 1); AT_PVSTEP(0);
            AT_ECHUNK(p1, 0, 2); AT_PVSTEP(1);
            AT_ECHUNK(p1, 8, 3); AT_PVSTEP(2);
            AT_PVSTEP(3);
            l += ps;
#undef AT_ECHUNK
#undef AT_PVSTEP
        }
        if (it + 1 < nt) { AT_COMMIT((it + 1) & 1); if (it + 2 < nt) AT_ISSUE(it + 2); }
    }
#undef AT_ISSUE
#undef AT_COMMIT
    __builtin_amdgcn_s_setprio(0);
    m_out = m; l_out = l;
}
__device__ __forceinline__ void row_recip(Frame& F, float l, float (&rli)[16]) {
    LAS float* wsf = (LAS float*)(F.lds + AT_WS) + F.wave * 64;
    const int r32 = F.lane & 31, hi = F.lane >> 5;
    l += __shfl_xor(l, 32);
    asm volatile("s_waitcnt lgkmcnt(0)" ::: "memory");
    if (hi == 0) wsf[r32] = 1.0f / l;
    asm volatile("s_waitcnt lgkmcnt(0)" ::: "memory");
#pragma unroll
    for (int r = 0; r < 16; ++r) rli[r] = wsf[crow(r, hi)];
    asm volatile("s_waitcnt lgkmcnt(0)" ::: "memory");
}
template <bool WINDOW>
__device__ __forceinline__ void attn_a_unit(Frame& F, const bf16* QKV, size_t row0, int h, const AttnSrc& S, int qpos0, float sink, bf16* OM) {
    f32x16 o[2]; float m, l;
    attn_pass<64, WINDOW>(F, QKV + row0 * QKV_LD + QA_OFF + h * 64, QKV_LD, S, qpos0, sink * 1.4426950408889634f, (F.lane >> 5) == 0 ? 1.0f : 0.0f, false, o, m, l);
    float rli[16]; row_recip(F, l, rli);
    const int r32 = F.lane & 31, hi = F.lane >> 5;
    bf16* op = OM + (row0 + F.wave * 32) * DM + h * 64 + r32;
#pragma unroll
    for (int r = 0; r < 16; ++r)
#pragma unroll
        for (int d = 0; d < 2; ++d) op[(size_t)crow(r, hi) * DM + d * 32] = (bf16)f2bf(o[d][r] * rli[r]);
}
__device__ __forceinline__ void attn_b_unit(Frame& F, const bf16* QKV, size_t row0, int h, AttnSrc S, float lam, const float* subln, bf16* OM) {
    f32x16 o[4]; float m, l; float rli[16];
    const bf16* K0 = S.K0; const bf16* K1 = S.K1;
    const int r32 = F.lane & 31, hi = F.lane >> 5;
    LAS unsigned* o1s = (LAS unsigned*)(F.lds + AT_O1) + F.wave * 2048 + F.lane;
    attn_pass<128, false>(F, QKV + row0 * QKV_LD + QB_OFF + h * 128, QKV_LD, S, 0, 0.f, 0.f, true, o, m, l);
    row_recip(F, l, rli);
#pragma unroll
    for (int d = 0; d < 4; ++d)
#pragma unroll
        for (int r = 0; r < 8; ++r) o1s[(d * 8 + r) * 64] = cvtpk_s(o[d][2 * r] * rli[2 * r], o[d][2 * r + 1] * rli[2 * r + 1]);
    S.K0 = K0 + 64; S.K1 = K1 + 64;
    attn_pass<128, false>(F, QKV + row0 * QKV_LD + QB_OFF + h * 128 + 64, QKV_LD, S, 0, 0.f, 0.f, true, o, m, l);
    row_recip(F, l, rli);
    float ss[16];
#pragma unroll
    for (int r = 0; r < 16; ++r) { float s = 0.f;
#pragma unroll
        for (int d = 0; d < 4; ++d) { const unsigned w = o1s[(d * 8 + (r >> 1)) * 64]; const float o1 = (r & 1) ? bfhi(w) : bflo(w); const float v = o1 - lam * (o[d][r] * rli[r]); o[d][r] = v; s += v * v; }
        ss[r] = s; }
#pragma unroll
    for (int r = 0; r < 16; ++r) { float s = ss[r];
#pragma unroll
        for (int x = 1; x < 32; x <<= 1) s += __shfl_xor(s, x);
        ss[r] = 0.8f / sqrtf(s * (1.0f / 128.0f) + EPSN); }
    float gs[4];
#pragma unroll
    for (int d = 0; d < 4; ++d) gs[d] = subln[d * 32 + r32];
    bf16* op = OM + (row0 + F.wave * 32) * DM + 512 + h * 128 + r32;
#pragma unroll
    for (int r = 0; r < 16; ++r)
#pragma unroll
        for (int d = 0; d < 4; ++d) op[(size_t)crow(r, hi) * DM + d * 32] = (bf16)f2bf(o[d][r] * ss[r] * gs[d]);
}
__device__ __forceinline__ void attention_phase(Frame& F) {
    const bf16* QKV = WSP(bf16, WS_BIG); bf16* OM = WSP(bf16, WS_H);
    const float lam = WSP(float, WS_LAM)[0];
    const float* sinkp = F.in[IN_SINK]; const float* subln = F.in[IN_SUBLN];
    for (int u = F.vcu; u < 256; u += F.G) {
        const int b = u >> 6, h = (u >> 4) & 3, qb = u & 15;
        const size_t seq0 = T_CTX + (size_t)b * LAT_SEQ;
        AttnSrc S; S.K0 = WSP(bf16, WS_CBK) + (size_t)b * 256 * 512 + h * 128; S.V0 = WSP(bf16, WS_CBV) + (size_t)b * 256 * 512 + h * 128; S.ld0 = 512; S.n0 = 4;
        S.K1 = QKV + seq0 * QKV_LD + KB_OFF + h * 128; S.V1 = QKV + seq0 * QKV_LD + VB_OFF + h * 128; S.ld1 = QKV_LD; S.t_lo = 0; S.t_hi = 64;
        attn_b_unit(F, QKV, seq0 + qb * 256, h, S, lam, subln, OM);
    }
    for (int u = F.vcu; u < 512; u += F.G) {
        const int b = u >> 7, h = (u >> 4) & 7, qb = u & 15, kvh = h >> 2;
        const size_t seq0 = T_CTX + (size_t)b * LAT_SEQ;
        AttnSrc S; S.K0 = WSP(bf16, WS_CAK) + (size_t)b * 256 * 128 + kvh * 64; S.V0 = WSP(bf16, WS_CAV) + (size_t)b * 256 * 128 + kvh * 64; S.ld0 = 128; S.n0 = 4;
        S.K1 = QKV + seq0 * QKV_LD + KA_OFF + kvh * 64; S.V1 = QKV + seq0 * QKV_LD + VA_OFF + kvh * 64; S.ld1 = QKV_LD;
        S.t_lo = 4 * qb - 2 < 0 ? 0 : 4 * qb - 2; S.t_hi = 4 * qb + 6 > 64 ? 64 : 4 * qb + 6;
        attn_a_unit<true>(F, QKV, seq0 + qb * 256, h, S, qb * 256, sinkp[h], OM);
    }
    for (int u = (F.G == 256 ? (F.vcu >= 128 ? F.vcu - 128 : 256) : F.vcu); u < 256; u += (F.G == 256 ? 128 : F.G)) {
        const int b = u >> 3, h = u & 7, kvh = h >> 2;
        const size_t seq0 = (size_t)b * CTX_SEQ;
        AttnSrc S; S.K0 = nullptr; S.V0 = nullptr; S.ld0 = 0; S.n0 = 0;
        S.K1 = QKV + seq0 * QKV_LD + KA_OFF + kvh * 64; S.V1 = QKV + seq0 * QKV_LD + VA_OFF + kvh * 64; S.ld1 = QKV_LD; S.t_lo = 0; S.t_hi = 4;
        attn_a_unit<false>(F, QKV, seq0, h, S, 0, sinkp[h], OM);
    }
    for (int u = F.vcu; u < 128; u += F.G) {
        const int b = u >> 2, h = u & 3;
        const size_t seq0 = (size_t)b * CTX_SEQ;
        AttnSrc S; S.K0 = nullptr; S.V0 = nullptr; S.ld0 = 0; S.n0 = 0;
        S.K1 = QKV + seq0 * QKV_LD + KB_OFF + h * 128; S.V1 = QKV + seq0 * QKV_LD + VB_OFF + h * 128; S.ld1 = QKV_LD; S.t_lo = 0; S.t_hi = 4;
        attn_b_unit(F, QKV, seq0, h, S, lam, subln, OM);
    }
}

constexpr int SC_XC = 0;
constexpr int SC_AUF = 17408;
constexpr int SC_AUB = 17408 + 65536;
constexpr int SC_CW = 17408 + 131072;
static_assert(SC_CW + 2560 <= MISC_OFF, "scan LDS map");
#ifndef DUP_EPI
#define DUP_EPI 1
#endif
#ifndef DUP_SCAN
#define DUP_SCAN 1
#endif
#ifndef DUP_CONV
#define DUP_CONV 1
#endif
constexpr int SCAN_UNITS = 3840;
__device__ __forceinline__ void scan_pass(Frame& F) {
    LAS unsigned char* lds = F.lds;
    const int tid = F.tid, lane = F.lane, wid = F.wave, r32 = lane & 31, hi = lane >> 5;
    bf16* XR = WSP(bf16, WS_BIG) + (size_t)T_ALL * DRNN; bf16* GG = WSP(bf16, WS_BIG); bf16* ABG = (bf16*)F.out;
    const bf16* HALO = WSP(bf16, WS_BIG + 136 * MiB);
    f32x2* SUM = WSP(f32x2, WS_H);
    const int wdir = wid >> 2, cb = wid & 3, chl = cb * 32 + r32;
    const int tk = tid >> 3, cg = tid & 7;
    LAS float* CW = (LAS float*)(lds + SC_CW);
    const int per = (SCAN_UNITS + F.G - 1) / F.G, u_lo = F.vcu * per, u_hi = (u_lo + per) < SCAN_UNITS ? (u_lo + per) : SCAN_UNITS;
    int n_cur = -1;
    v4u xr[8];
    bf16x8 wa[8], wx[8]; float ba = 0.f, bx = 0.f, sp8 = 0.f;
#define SC_DECODE(u_) const int n = (u_) / 384, cidx = (u_) % 384; const bool isctx = cidx < 128; const int b = isctx ? (cidx >> 2) : ((cidx - 128) >> 6); const int c = isctx ? (cidx & 3) : ((cidx - 128) & 63); \
        const size_t seq0 = isctx ? (size_t)b * CTX_SEQ : (size_t)T_CTX + (size_t)b * LAT_SEQ; const int seq_len = isctx ? CTX_SEQ : LAT_SEQ, t0 = c * 64;
#define SC_LOADX(u_) do { SC_DECODE(u_) (void)b; (void)seq_len; \
        _Pragma("unroll") for (int j = 0; j < 4; ++j) { const int tl = tk - 1 + j; \
            const bf16* src = tl < 0 ? HALO + (size_t)((cidx > 0 ? cidx - 1 : 0) * 3 + 0) * DRNN : (tl >= 64 ? HALO + (size_t)((cidx < 383 ? cidx + 1 : 383) * 3 + 1 + (tl - 64)) * DRNN : XR + (seq0 + t0 + tl) * DRNN); \
            const v4u* p = (const v4u*)(src + n * 128 + cg * 8); xr[2 * j] = p[0]; xr[2 * j + 1] = p[8]; } } while (0)
    if (wid >= 4) __builtin_amdgcn_s_setprio(1);
    if (u_lo < u_hi) SC_LOADX(u_lo);
#pragma unroll 1
    for (int u = u_lo; u < u_hi; ++u) {
        SC_DECODE(u)
        (void)b;
        if (n != n_cur) {
            __syncthreads();
            for (int i = tid; i < 640; i += NTHREADS) CW[i] = i < 512 ? F.in[IN_RCONVW][(i >> 7) * DRNN + n * 128 + (i & 127)] : F.in[IN_RCONVB][n * 128 + (i & 127)];
            n_cur = n;
            { const bf16* wap = WSP(bf16, WS_WG) + (size_t)((0 * 2 + wdir) * 10 + n) * 16384 + (size_t)chl * 128 + hi * 8;
              const bf16* wxp = WSP(bf16, WS_WG) + (size_t)((1 * 2 + wdir) * 10 + n) * 16384 + (size_t)chl * 128 + hi * 8;
#pragma unroll
              for (int ks = 0; ks < 8; ++ks) { wa[ks] = *(const bf16x8*)(wap + ks * 16); wx[ks] = *(const bf16x8*)(wxp + ks * 16); } }
            ba = F.in[IN_RBA][wdir * DRNN + n * 128 + chl] * -1.4426950408889634f; bx = F.in[IN_RBX][wdir * DRNN + n * 128 + chl] * -1.4426950408889634f;
            sp8 = WSP(float, WS_SP8)[wdir * DRNN + n * 128 + chl];
            __syncthreads();
        }
        { float a[16];
#pragma unroll
          for (int e = 0; e < 16; ++e) a[e] = CW[512 + (e >> 3) * 64 + cg * 8 + (e & 7)];
#pragma unroll
          for (int j = 0; j < 4; ++j) { const int t = t0 + tk - 1 + j; const float msk = (t >= 0 && t < seq_len) ? 1.0f : 0.0f;
              const unsigned w[8] = {xr[2 * j].x, xr[2 * j].y, xr[2 * j].z, xr[2 * j].w, xr[2 * j + 1].x, xr[2 * j + 1].y, xr[2 * j + 1].z, xr[2 * j + 1].w};
#pragma unroll
              for (int e = 0; e < 8; ++e) { const int c0 = (e >> 2) * 64 + cg * 8 + 2 * (e & 3); a[2 * e] += (CW[j * 128 + c0] * msk) * bflo(w[e]); a[2 * e + 1] += (CW[j * 128 + c0 + 1] * msk) * bfhi(w[e]); } }
          v4u o0, o1; o0.x = pk2(a[0], a[1]); o0.y = pk2(a[2], a[3]); o0.z = pk2(a[4], a[5]); o0.w = pk2(a[6], a[7]); o1.x = pk2(a[8], a[9]); o1.y = pk2(a[10], a[11]); o1.z = pk2(a[12], a[13]); o1.w = pk2(a[14], a[15]);
          LAS v4u* xp = (LAS v4u*)(lds + SC_XC + tk * 272 + cg * 16); xp[0] = o0; xp[8] = o1; }
        __syncthreads();
        if (u + 1 < u_hi) SC_LOADX(u + 1);
        { LAS f32x2* AU = (LAS f32x2*)(lds + (wdir ? SC_AUB : SC_AUF));
#pragma unroll 1
          for (int rb = 0; rb < 2; ++rb) {
            f32x16 ra, ia;
#pragma unroll
            for (int r = 0; r < 16; ++r) { ra[r] = ba; ia[r] = bx; }
            { const LAS unsigned char* ap = lds + SC_XC + (rb * 32 + r32) * 272 + hi * 16;
#pragma unroll
              for (int ks = 0; ks < 8; ++ks) { const bf16x8 af = *(const LAS bf16x8*)(ap + ks * 32);
                  ra = __builtin_amdgcn_mfma_f32_32x32x16_bf16(af, wa[ks], ra, 0, 0, 0);
                  ia = __builtin_amdgcn_mfma_f32_32x32x16_bf16(af, wx[ks], ia, 0, 0, 0); } }
#pragma unroll
            for (int r = 0; r < 16; ++r) {
                const int row = rb * 32 + crow(r, hi);
                const float rr = __builtin_amdgcn_rcpf(1.0f + __builtin_amdgcn_exp2f(ra[r]));
                const float ii = __builtin_amdgcn_rcpf(1.0f + __builtin_amdgcn_exp2f(ia[r]));
                const float x = sp8 * rr;
                const float em = -x * (1.0f + x * (0.5f + x * (0.16666667f + x * (0.041666668f + x * 0.0083333338f))));
                const float av = 1.0f - em;
                const float om = __builtin_fmaf(em, av, em);
                const float xv = bf2f(*(const LAS unsigned short*)(lds + SC_XC + row * 272 + chl * 2));
                AU[row * 128 + chl] = (f32x2){av, __builtin_amdgcn_sqrtf(om) * ii * xv};
            }
          } }
        __syncthreads();
        if (tid >= 256) {
            const int sch = tid & 127, sd = (tid >> 7) & 1;
            LAS f32x2* AU = (LAS f32x2*)(lds + (sd ? SC_AUB : SC_AUF)) + sch;
            float h = 0.f, pprod = 1.0f;
            f32x2 auA[8], auB[8];
#define SC_LD(dst, s0_) do { _Pragma("unroll") for (int j = 0; j < 8; ++j) { const int row = sd == 0 ? (s0_) + j : 63 - (s0_) - j; dst[j] = AU[row * 128]; } } while (0)
#define SC_RUN(src, s0_) do { _Pragma("unroll") for (int j = 0; j < 8; ++j) { const int row = sd == 0 ? (s0_) + j : 63 - (s0_) - j; h = src[j].x * h + src[j].y; pprod *= src[j].x; AU[row * 128] = (f32x2){h, pprod}; } } while (0)
            SC_LD(auA, 0);
#pragma unroll 1
            for (int s0 = 0; s0 < 64; s0 += 16) {
                SC_LD(auB, s0 + 8);
                SC_RUN(auA, s0);
                if (s0 + 16 < 64) SC_LD(auA, s0 + 16);
                SC_RUN(auB, s0 + 8);
            }
#undef SC_LD
#undef SC_RUN
            SUM[(size_t)cidx * 2 * DRNN + sd * DRNN + n * 128 + sch] = (f32x2){pprod, h};
        }
        __syncthreads();
        {
            const LAS f32x4* hfp = (const LAS f32x4*)(lds + SC_AUF) + lane; const LAS f32x4* hbp = (const LAS f32x4*)(lds + SC_AUB) + lane;
            const size_t eoff = (seq0 + t0 + wid * 8) * DRNN + n * 128;
            unsigned* gp = (unsigned*)(GG + eoff) + lane; unsigned* fp = (unsigned*)(XR + eoff) + lane; unsigned* bp = (unsigned*)(ABG + eoff) + lane;
            unsigned gw[8];
#pragma unroll
            for (int i = 0; i < 8; ++i) gw[i] = gp[(size_t)i * (DRNN / 2)];
#pragma unroll
            for (int i = 0; i < 8; ++i) {
                const f32x4 hf = hfp[(wid * 8 + i) * 64], hb = hbp[(wid * 8 + i) * 64];
                const float g0 = bflo(gw[i]), g1 = bfhi(gw[i]);
                gp[(size_t)i * (DRNN / 2)] = pk2((hf[0] + hb[0]) * g0, (hf[2] + hb[2]) * g1);
                fp[(size_t)i * (DRNN / 2)] = pk2(hf[1] * g0, hf[3] * g1);
                bp[(size_t)i * (DRNN / 2)] = pk2(hb[1] * g0, hb[3] * g1);
            }
        }
        __syncthreads();
    }
    __builtin_amdgcn_s_setprio(0);
#undef SC_DECODE
#undef SC_LOADX
}
__device__ __forceinline__ void scan_correct_phase(Frame& F) {
    bf16* GG = WSP(bf16, WS_BIG); const bf16* XR = WSP(bf16, WS_BIG) + (size_t)T_ALL * DRNN; const bf16* ABG = (const bf16*)F.out;
    const float* CAR = WSP(float, WS_H + 8 * MiB);
    const int gt = F.vcu * NTHREADS + F.tid, NGT = F.G * NTHREADS;
    for (int i = gt; i < T_ALL * (DRNN / 8); i += NGT) {
        const int row = i / (DRNN / 8), c8 = (i % (DRNN / 8)) * 8;
        const size_t off = (size_t)row * DRNN + c8;
        const v4u yl = *(const v4u*)(GG + off), af = *(const v4u*)(XR + off), ab = *(const v4u*)(ABG + off);
        const float* cf = CAR + (size_t)(row >> 6) * 2 * DRNN + c8; const float* cbp = cf + DRNN;
        const f32x4 f0 = *(const f32x4*)cf, f1 = *(const f32x4*)(cf + 4), b0 = *(const f32x4*)cbp, b1 = *(const f32x4*)(cbp + 4);
        const unsigned wy[4] = {yl.x, yl.y, yl.z, yl.w}, wf[4] = {af.x, af.y, af.z, af.w}, wb[4] = {ab.x, ab.y, ab.z, ab.w};
        const float cfv[8] = {f0[0], f0[1], f0[2], f0[3], f1[0], f1[1], f1[2], f1[3]}, cbv[8] = {b0[0], b0[1], b0[2], b0[3], b1[0], b1[1], b1[2], b1[3]};
        unsigned o[4];
#pragma unroll
        for (int e = 0; e < 4; ++e) o[e] = pk2(bflo(wy[e]) + bflo(wf[e]) * cfv[2 * e] + bflo(wb[e]) * cbv[2 * e], bfhi(wy[e]) + bfhi(wf[e]) * cfv[2 * e + 1] + bfhi(wb[e]) * cbv[2 * e + 1]);
        v4u ov; ov.x = o[0]; ov.y = o[1]; ov.z = o[2]; ov.w = o[3];
        *(v4u*)(GG + off) = ov;
    }
}

__device__ __forceinline__ void scan_carry_phase(Frame& F) {
    const f32x2* SUM = WSP(f32x2, WS_H); float* CAR = WSP(float, WS_H + 8 * MiB);
    const int gt = F.vcu * NTHREADS + F.tid, NGT = F.G * NTHREADS;
    for (int i = gt; i < 10240 + 81920; i += NGT) {
        const bool lat = i < 10240; const int j = lat ? i : i - 10240;
        const int ch = j % DRNN, sd = (j / DRNN) & 1, b = j / (2 * DRNN);
        const int nch = lat ? 64 : 4, cfirst = lat ? 128 + b * 64 : b * 4;
        float h = lat ? F.in[sd ? IN_SB : IN_SF][b * DRNN + ch] : 0.f;
        const f32x2* sp = SUM + (size_t)cfirst * 2 * DRNN + sd * DRNN + ch; float* cp = CAR + (size_t)cfirst * 2 * DRNN + sd * DRNN + ch;
        if (lat) {
            for (int k0 = 0; k0 < 64; k0 += 16) {
                f32x2 s[16];
#pragma unroll
                for (int q = 0; q < 16; ++q) { const int c = sd == 0 ? k0 + q : 63 - k0 - q; s[q] = sp[(size_t)c * 2 * DRNN]; }
#pragma unroll
                for (int q = 0; q < 16; ++q) { const int c = sd == 0 ? k0 + q : 63 - k0 - q; cp[(size_t)c * 2 * DRNN] = h; h = s[q].x * h + s[q].y; }
            }
        } else {
            f32x2 s[4];
#pragma unroll
            for (int q = 0; q < 4; ++q) { const int c = sd == 0 ? q : 3 - q; s[q] = sp[(size_t)c * 2 * DRNN]; }
#pragma unroll
            for (int q = 0; q < 4; ++q) { const int c = sd == 0 ? q : 3 - q; cp[(size_t)c * 2 * DRNN] = h; h = s[q].x * h + s[q].y; }
        }
        if (!lat) F.out[(sd ? OUT_SB : OUT_SF) + b * DRNN + ch] = h;
    }
}

constexpr int N_PHASES = 23;
__global__ void __launch_bounds__(NTHREADS, 2) fwd_kernel(Args args) {
    extern __shared__ __attribute__((aligned(16))) unsigned char lds_raw[];
    Frame F;
    F.lds = (LAS unsigned char*)lds_raw;
    F.tid = threadIdx.x; F.lane = F.tid & 63; F.wave = __builtin_amdgcn_readfirstlane(F.tid >> 6);
    F.G = gridDim.x; { const int bx = blockIdx.x; F.vcu = (F.G % 8 == 0) ? (bx % 8) * (F.G / 8) + bx / 8 : bx; }
    F.in = args.in; F.out = args.out; F.ws = args.ws;
    volatile LAS unsigned* MISC = (volatile LAS unsigned*)(F.lds + MISC_OFF);
    if (F.tid < 32) MISC[F.tid] = 0u;
    __syncthreads();
    XcdBarrier bar; bar.bar = (unsigned*)(args.ws + WS_CTL) + 1024; bar.x = 0; bar.st = nullptr; bar.wave = F.wave;
    if (args.use_bar) bar = xcd_barrier_post((unsigned*)(args.ws + WS_CTL) + 1024, MISC + 8, F.wave);
    const int lo = args.ph_lo, hi = args.ph_hi;
#ifndef PHMASK
#define PHMASK 0x7fffff
#endif
#ifndef REP_PHASE
#define REP_PHASE -1
#endif
#ifndef REP_N
#define REP_N 1
#endif
#define IN(k) (((PHMASK >> (k)) & 1) && lo <= (k) && (k) < hi)
#define REPS(k) for (int rep_ = 0; rep_ < (((k) == REP_PHASE) ? REP_N : 1); ++rep_)
#define SEAM(k) do { if (IN(k) && IN((k) + 1)) xcd_barrier(bar); } while (0)
    bf16* XA = (bf16*)((unsigned char*)F.out + 64 * MiB);
    bf16* XB = WSP(bf16, WS_BIG + 120 * MiB);
    const float* MOD = WSP(float, WS_MOD);
    bf16* H = WSP(bf16, WS_H);
    PG8_LAS unsigned char* ring = (PG8_LAS unsigned char*)lds_raw;

    if (IN(0)) REPS(0) { Frame P = fresh(F); p0_prologue(P); } SEAM(0);
    if (IN(1)) REPS(1) { Frame P = fresh(F); norm_mod_pass(P, F.in[IN_XP], F.in[IN_XS], F.in[IN_NORM1], MOD, 0, 1024, H); } SEAM(1);
    if (IN(2)) REPS(2) {
        pg8::Gemm g{H, WSP(bf16, WS_WIN), T_ALL, QKV_LD, DM, DM}; pg8::StaticOrder S; S.init(T_ALL, QKV_LD, F.G, (int)blockIdx.x);
        pg8::EpiInProj E{WSP(bf16, WS_BIG), F.out, WSP(pg8::f32x2, WS_ROPE)};
        pg8::gemm_phase<pg8::EpiInProj, pg8::StaticOrder, true, true>(ring, g, S, E, F.wave);
        { const int nfull = (T_ALL / 256) * (QKV_LD / 256) % F.G; Frame P = fresh(F);
          if (nfull == 0) p_deferred_transposes(P, (int)blockIdx.x, F.G); else if ((int)blockIdx.x >= nfull) p_deferred_transposes(P, (int)blockIdx.x - nfull, F.G - nfull); }
    } SEAM(2);
    if (IN(3)) REPS(3) { Frame P = fresh(F); attention_phase(P); } SEAM(3);
    if (IN(4)) REPS(4) {
        pg8::Gemm g{H, WSP(bf16, WS_WOUT), T_ALL, DM, DM, DM}; pg8::StaticOrder S; S.init(T_ALL, DM, F.G, (int)blockIdx.x, 192);
        pg8::EpiRes<true> E{F.in[IN_XP], F.in[IN_XS], XA, XB, MOD + 2048, 0};
        pg8::gemm_phase<pg8::EpiRes<true>, pg8::StaticOrder, true, true, 96>(ring, g, S, E, F.wave);
    } SEAM(4);
#pragma unroll 1
    for (int layer = 0; layer < 2; ++layer) {
        const int pb = layer == 0 ? 5 : 16;
        const float* MODL = MOD + (size_t)layer * 5 * 6144;
        if (IN(pb)) REPS(pb) { Frame P = fresh(F); norm_mod_pass_bf(P, XA, XB, F.in[IN_NORM2] + layer * DM, MODL, 3072, 4096, H); } SEAM(pb);
#pragma unroll 1
        for (int half = 0; half < 2; ++half) {
            const int row0 = half * (T_ALL / 2);
            if (IN(pb + 1 + 2 * half)) REPS(pb + 1 + 2 * half) {
                pg8::Gemm g{H + (size_t)row0 * DM, WSP(bf16, WS_W1) + (size_t)layer * DFF * DM, T_ALL / 2, DFF, DM, DM}; pg8::StaticOrder S; S.init(T_ALL / 2, DFF, F.G, (int)blockIdx.x);
                pg8::EpiSqRelu E{WSP(bf16, WS_BIG), LDH};
#ifdef STAGGER_TICKS
                if ((blockIdx.x >> 3) & 1) { const unsigned long long t0 = __builtin_amdgcn_s_memrealtime(); while (__builtin_amdgcn_s_memrealtime() - t0 < STAGGER_TICKS) __builtin_amdgcn_s_sleep(8); }
#endif
                pg8::gemm_phase<pg8::EpiSqRelu, pg8::StaticOrder, true, true>(ring, g, S, E, F.wave);
            } SEAM(pb + 1 + 2 * half);
            if (IN(pb + 2 + 2 * half)) REPS(pb + 2 + 2 * half) {
                pg8::Gemm g{WSP(bf16, WS_BIG), WSP(bf16, WS_W2) + (size_t)layer * DM * DFF, T_ALL / 2, DM, DFF, LDH}; pg8::StaticOrder S; S.init(T_ALL / 2, DM, F.G, (int)blockIdx.x, 192);
                pg8::EpiRes<false> E{nullptr, nullptr, XA, XB, MODL + 5120, row0};
                pg8::gemm_phase<pg8::EpiRes<false>, pg8::StaticOrder, true, true, 96>(ring, g, S, E, F.wave);
            } SEAM(pb + 2 + 2 * half);
        }
        if (layer == 0) {
            const float* MOD1 = MOD + 5 * 6144;
            if (IN(10)) REPS(10) { Frame P = fresh(F); norm_mod_pass_bf(P, XA, XB, F.in[IN_NORM1] + DM, MOD1, 0, 1024, H); } SEAM(10);
            if (IN(11)) REPS(11) {
                pg8::Gemm g{H, WSP(bf16, WS_WRIN), T_ALL, 2 * DRNN, DM, DM}; pg8::StaticOrder S; S.init(T_ALL, 2 * DRNN, F.G, (int)blockIdx.x);
                pg8::EpiRecIn E{WSP(bf16, WS_BIG), WSP(bf16, WS_BIG) + (size_t)T_ALL * DRNN, WSP(bf16, WS_BIG + 136 * MiB)};
                pg8::gemm_phase<pg8::EpiRecIn, pg8::StaticOrder, true, true>(ring, g, S, E, F.wave);
            } SEAM(11);
            if (IN(12)) REPS(12) { Frame P = fresh(F); scan_pass(P); } SEAM(12);
            if (IN(13)) REPS(13) { Frame P = fresh(F); scan_carry_phase(P); } SEAM(13);
            if (IN(14)) REPS(14) { Frame P = fresh(F); scan_correct_phase(P); } SEAM(14);
            if (IN(15)) REPS(15) {
                pg8::Gemm g{WSP(bf16, WS_BIG), WSP(bf16, WS_WROUT), T_ALL, DM, DRNN, DRNN}; pg8::StaticOrder S; S.init(T_ALL, DM, F.G, (int)blockIdx.x, 192);
                pg8::EpiRes<false> E{nullptr, nullptr, XA, XB, MOD1 + 2048, 0};
                pg8::gemm_phase<pg8::EpiRes<false>, pg8::StaticOrder, true, true, 96>(ring, g, S, E, F.wave);
            } SEAM(15);
        }
    }
    if (IN(21)) REPS(21) { Frame P = fresh(F); final_norm_pass(P, XA, XB, F.out, F.in[IN_FNORM], 0, X_SPLIT); } SEAM(21);
    if (IN(22)) REPS(22) { Frame P = fresh(F); final_norm_pass(P, XA, XB, F.out, F.in[IN_FNORM], X_SPLIT, T_ALL); }
#undef IN
#undef SEAM
}

#ifndef MK_ONE_LAUNCH
#define MK_ONE_LAUNCH 1
#endif
extern "C" void kernel_launch(void* const* d_in, const int* in_sizes, int n_in, void* d_out, int out_size, void* d_ws, size_t ws_size, hipStream_t stream) {
    static int grid = 0;
    if (grid == 0) {
        if (n_in != 31 || ws_size < WS_END) { fprintf(stderr, "kernel_launch: unexpected n_in %d / ws_size %zu\n", n_in, ws_size); grid = -1; return; }
        int dev = 0, cus = 0, per_cu = 0;
        if (hipGetDevice(&dev) != hipSuccess || hipDeviceGetAttribute(&cus, hipDeviceAttributeMultiprocessorCount, dev) != hipSuccess) { grid = -1; return; }
        if (hipFuncSetAttribute((const void*)fwd_kernel, hipFuncAttributeMaxDynamicSharedMemorySize, LDS_BYTES) != hipSuccess) { fprintf(stderr, "kernel_launch: hipFuncSetAttribute failed\n"); grid = -1; return; }
        if (hipOccupancyMaxActiveBlocksPerMultiprocessor(&per_cu, (const void*)fwd_kernel, NTHREADS, LDS_BYTES) != hipSuccess || per_cu < 1) { fprintf(stderr, "kernel_launch: occupancy query says %d\n", per_cu); (void)hipGetLastError(); grid = -1; return; }
        grid = cus;
    }
    if (grid < 0) return;
    (void)hipMemsetAsync((char*)d_ws + WS_CTL, 0, CTL_ZERO_BYTES, stream);
    Args a{};
    for (int i = 0; i < 31; ++i) a.in[i] = (const float*)d_in[i];
    a.out = (float*)d_out; a.ws = (unsigned char*)d_ws;
#if MK_ONE_LAUNCH
    a.ph_lo = 0; a.ph_hi = N_PHASES; a.use_bar = 1;
    hipLaunchKernelGGL(fwd_kernel, dim3(grid), dim3(NTHREADS), LDS_BYTES, stream, a);
#else
    for (int p = 0; p < N_PHASES; ++p) { a.ph_lo = p; a.ph_hi = p + 1; a.use_bar = 0; hipLaunchKernelGGL(fwd_kernel, dim3(grid), dim3(NTHREADS), LDS_BYTES, stream, a); }
#endif
}
```

```cpp
#include <hip/hip_runtime.h>
#include <cstdio>
#include <cstdint>
#include <cmath>
#ifndef DUPK_SEL
#define DUPK_SEL 0
#endif
#ifndef RELAX_EPI
#define RELAX_EPI 1
#endif
__device__ __forceinline__ int lane_now() { int l; asm volatile("v_mbcnt_lo_u32_b32 %0, -1, 0\n\tv_mbcnt_hi_u32_b32 %0, -1, %0" : "=v"(l)); return l; }
namespace pg8 {
#define PG8_LAS __attribute__((address_space(3)))
typedef unsigned short bf16_t;
typedef short bf16x8 __attribute__((ext_vector_type(8)));
typedef float f32x4 __attribute__((ext_vector_type(4)));
typedef unsigned u32x4 __attribute__((ext_vector_type(4)));
constexpr int BM = 256, BK = 64, HALF = 128, HTB = HALF * BK * 2  , STAGE_BYTES = 8 * HTB, NXCD = 8, WGM = 8;

__host__ __device__ __forceinline__ int lds_byte(int r, int c) { const int st = (r >> 4) * 2 + (c >> 5), rr = r & 15, cc = c & 31, ob = rr * 64 + cc * 2; return st * 1024 + (ob ^ (((ob >> 9) & 1) << 5)); }
__host__ __device__ __forceinline__ void stage_rc(int b, int& R, int& C) { const int st = b / 1024, sb = b % 1024, swz = sb ^ (((sb >> 9) & 1) << 5); R = (st >> 1) * 16 + swz / 64; C = (st & 1) * 32 + (swz % 64) / 2; }
__host__ __device__ __forceinline__ int perm32(int rho) { const int n = rho >> 4, i = rho & 15; return 8 * (i >> 2) + 4 * n + (i & 3); }

struct Unit { int pm, pn; };
struct Gemm { const bf16_t* A; const bf16_t* Bt; int M, N, K, lda; };

struct StaticOrder {
    int nM, nN, nwg, G, c;
    __host__ __device__ void init(int M, int N, int G_, int c_, int bmr = BM) { nM = M / bmr; nN = N / BM; nwg = nM * nN; G = G_; c = c_; }
    __host__ __device__ bool next(int i, Unit& u) const {
        const long L = (long)i * G + c; if (L >= nwg) return false;
        int wgid = (int)L; { const int q = nwg / NXCD, r = nwg % NXCD, xcd = wgid % NXCD, off = wgid / NXCD; wgid = (xcd < r ? xcd * (q + 1) : r * (q + 1) + (xcd - r) * q) + off; }
        const int nig = WGM * nN, gid = wgid / nig, fm = gid * WGM, gsz = (nM - fm) < WGM ? (nM - fm) : WGM;
        u.pm = fm + ((wgid % nig) % gsz); u.pn = (wgid % nig) / gsz; return true;
    }
    __device__ __forceinline__ void a_ready(const Unit&) const {}
    __device__ __forceinline__ void done(const Unit&) const {}
};

__device__ __forceinline__ float bperm1(int a, float v) { return __builtin_bit_cast(float, __builtin_amdgcn_ds_bpermute(a, __builtin_bit_cast(int, v))); }
__device__ __forceinline__ f32x4 bperm4(int a, f32x4 v) { const float x = bperm1(a, v[0]), y = bperm1(a, v[1]), z = bperm1(a, v[2]), w = bperm1(a, v[3]); return (f32x4){x, y, z, w}; }
__device__ __forceinline__ unsigned cvt_pk_bf16(float lo, float hi) { unsigned r; asm volatile("v_cvt_pk_bf16_f32 %0, %1, %2" : "=v"(r) : "v"(lo), "v"(hi)); return r; }
typedef float f32x2 __attribute__((ext_vector_type(2)));
typedef unsigned u32x2 __attribute__((ext_vector_type(2)));
constexpr int T_CTX = 8192, QKV_LD = 2304;
constexpr float QSCALE = 0.125f * 1.4426950408889634f;
struct EpiInProj {
    static constexpr bool PERM = true, AFTER_DRAIN = false, DUPK = (DUPK_SEL == 1), RELAX = false;
    bf16_t* QKV; float* out; const f32x2* rope;
    template <int MR> __device__ __forceinline__ void operator()(const f32x4 (&acc)[2][2][MR][2], const Unit& u, int wr, int wc, int fr, int fq) const {
        constexpr int HRr = MR * 32, BMR = 2 * HRr, WRO = HRr / 2;
        const bool hi_half = fq >= 2;
#pragma unroll
        for (int bj = 0; bj < 2; ++bj) {
            const int colbase = u.pn * BM + bj * HALF + wc * 32;
            const bool rope_col = (colbase < 640 || (colbase >= 768 && colbase < 1792));
            const bool q_col = (colbase < 512 || (colbase >= 768 && colbase < 1280));
            long ooff = -1; int ow = 0, cs = 0;
            if (colbase >= 512 && colbase < 640) { ooff = 25165824; ow = 128; cs = 512; }
            else if (colbase >= 640 && colbase < 768) { ooff = 26214400; ow = 128; cs = 640; }
            else if (colbase >= 1280 && colbase < 1792) { ooff = 27262976; ow = 512; cs = 1280; }
            else if (colbase >= 1792) { ooff = 31457280; ow = 512; cs = 1792; }
#pragma unroll
            for (int ai = 0; ai < 2; ++ai)
#pragma unroll
                for (int m = 0; m < MR; ++m) {
                    const int rowg = u.pm * BMR + ai * HRr + wr * WRO + m * 16;
                    const bool lat = rowg >= T_CTX;
                    const int row = rowg + fr;
                    f32x4 v[2] = {acc[ai][bj][m][0], acc[ai][bj][m][1]};
                    if (rope_col && lat) {
                        const int t = (row - T_CTX) & 4095;
                        const int pos = (wc & 1) ? (t & 63) : (t >> 6);
                        const f32x4* rp = (const f32x4*)(rope + pos * 16 + 8 * (fq & 1));
#pragma unroll
                        for (int n = 0; n < 2; ++n) {
                            const f32x4 c01 = rp[2 * n], c23 = rp[2 * n + 1];
                            const float cs_[4] = {c01[0], c01[2], c23[0], c23[2]}, sn_[4] = {c01[1], c01[3], c23[1], c23[3]};
#pragma unroll
                            for (int e = 0; e < 4; ++e) {
                                const float p = __shfl_xor(v[n][e], 32);
                                v[n][e] = hi_half ? (p * sn_[e] + v[n][e] * cs_[e]) : (v[n][e] * cs_[e] - p * sn_[e]);
                            }
                        }
                    }
                    if (q_col) { v[0] = v[0] * QSCALE; v[1] = v[1] * QSCALE; }
                    bf16_t* qp = QKV + (size_t)row * QKV_LD + colbase + 8 * fq;
                    u32x4 w; w.x = cvt_pk_bf16(v[0][0], v[0][1]); w.y = cvt_pk_bf16(v[0][2], v[0][3]); w.z = cvt_pk_bf16(v[1][0], v[1][1]); w.w = cvt_pk_bf16(v[1][2], v[1][3]);
                    *(u32x4*)qp = w;
                    if (ooff >= 0 && !lat) { float* op = out + ooff + (size_t)row * ow + (colbase - cs) + 8 * fq; *(f32x4*)op = v[0]; *(f32x4*)(op + 4) = v[1]; }
                }
        }
    }
};
constexpr int X_SPLIT = 16384;
template <bool IN_F32>
struct EpiRes {
    static constexpr bool PERM = true, AFTER_DRAIN = false, DUPK = (DUPK_SEL == 2), RELAX = false;
    const float* xin_ctx; const float* xin_lat; bf16_t* XA; bf16_t* XB; const float* gate; int row0;
    template <int MR> __device__ __forceinline__ void operator()(const f32x4 (&acc)[2][2][MR][2], const Unit& u, int wr, int wc, int fr, int fq) const {
        constexpr int HRr = MR * 32, BMR = 2 * HRr, WRO = HRr / 2;
        const int rowt = row0 + u.pm * BMR;
        const int lane = fq * 16 + fr, frp = lane >> 2, fqp = lane & 3, src4 = (fqp * 16 + frp) * 4;
#pragma unroll
        for (int ai = 0; ai < 2; ++ai)
#pragma unroll
            for (int m = 0; m < MR; ++m) {
                const int rowg = rowt + ai * HRr + wr * WRO + m * 16;
                const int midx = rowg < T_CTX ? 4 : ((rowg - T_CTX) >> 12);
                const float* g = gate + (size_t)midx * 6144;
                bf16_t* xr = (rowg < X_SPLIT ? XA + (size_t)rowg * 1024 : XB + (size_t)(rowg - X_SPLIT) * 1024) + (size_t)frp * 1024;
                const float* xf = (rowg < T_CTX ? xin_ctx : xin_lat - (size_t)T_CTX * 1024) + (size_t)(rowg + frp) * 1024;
#pragma unroll
                for (int bj = 0; bj < 2; ++bj) {
                    const int colm = u.pn * BM + bj * HALF + wc * 32 + 8 * fq, col = u.pn * BM + bj * HALF + wc * 32 + 8 * fqp;
                    const f32x4 gv0 = *(const f32x4*)(g + colm), gv1 = *(const f32x4*)(g + colm + 4);
                    f32x4 x0, x1;
                    if (IN_F32) { x0 = *(const f32x4*)(xf + col); x1 = *(const f32x4*)(xf + col + 4); }
                    else { const u32x4 w = *(const u32x4*)(xr + col);
                        x0[0] = __builtin_bit_cast(float, w.x << 16); x0[1] = __builtin_bit_cast(float, w.x & 0xffff0000u); x0[2] = __builtin_bit_cast(float, w.y << 16); x0[3] = __builtin_bit_cast(float, w.y & 0xffff0000u);
                        x1[0] = __builtin_bit_cast(float, w.z << 16); x1[1] = __builtin_bit_cast(float, w.z & 0xffff0000u); x1[2] = __builtin_bit_cast(float, w.w << 16); x1[3] = __builtin_bit_cast(float, w.w & 0xffff0000u); }
                    f32x4 t0 = gv0 * acc[ai][bj][m][0], t1 = gv1 * acc[ai][bj][m][1];
                    x0 = x0 + bperm4(src4, t0); x1 = x1 + bperm4(src4, t1);
                    u32x4 o; o.x = cvt_pk_bf16(x0[0], x0[1]); o.y = cvt_pk_bf16(x0[2], x0[3]); o.z = cvt_pk_bf16(x1[0], x1[1]); o.w = cvt_pk_bf16(x1[2], x1[3]);
                    *(u32x4*)(xr + col) = o;
                }
            }
    }
};
__device__ __forceinline__ float relu_raw(float x) { float r; asm("v_max_f32 %0, 0, %1" : "=v"(r) : "v"(x)); return r; }
struct EpiSqRelu {
    static constexpr bool PERM = true, AFTER_DRAIN = false, DUPK = (DUPK_SEL == 3), RELAX = (RELAX_EPI & 1) != 0;
    bf16_t* O; int ldc;
    template <int MR> __device__ __forceinline__ void operator()(const f32x4 (&acc)[2][2][MR][2], const Unit& u, int wr, int wc, int fr, int fq) const {
        constexpr int HRr = MR * 32, BMR = 2 * HRr, WRO = HRr / 2;
        const int lane = fq * 16 + fr, frp = lane >> 2, fqp = lane & 3, src4 = (fqp * 16 + frp) * 4;
#pragma unroll
        for (int ai = 0; ai < 2; ++ai)
#pragma unroll
            for (int m = 0; m < MR; ++m) {
                bf16_t* rowp = O + (size_t)(u.pm * BMR + ai * HRr + wr * WRO + m * 16 + frp) * ldc + u.pn * BM + wc * 32 + 8 * fqp;
#pragma unroll
                for (int bj = 0; bj < 2; ++bj) {
                    f32x4 v0 = acc[ai][bj][m][0], v1 = acc[ai][bj][m][1];
#pragma unroll
                    for (int e = 0; e < 4; ++e) { v0[e] = relu_raw(v0[e]); v1[e] = relu_raw(v1[e]); }
                    v0 = v0 * v0; v1 = v1 * v1;
                    u32x4 w; w.x = cvt_pk_bf16(v0[0], v0[1]); w.y = cvt_pk_bf16(v0[2], v0[3]); w.z = cvt_pk_bf16(v1[0], v1[1]); w.w = cvt_pk_bf16(v1[2], v1[3]);
                    w.x = (unsigned)__builtin_amdgcn_ds_bpermute(src4, (int)w.x); w.y = (unsigned)__builtin_amdgcn_ds_bpermute(src4, (int)w.y);
                    w.z = (unsigned)__builtin_amdgcn_ds_bpermute(src4, (int)w.z); w.w = (unsigned)__builtin_amdgcn_ds_bpermute(src4, (int)w.w);
                    *(u32x4*)(rowp + bj * HALF) = w;
                }
            }
    }
};
__device__ __forceinline__ float gelu_tanh(float x) {
    const float u2 = 1.5957691216057308f * (x + 0.044715f * x * x * x);
    return x * __builtin_amdgcn_rcpf(1.0f + __builtin_amdgcn_exp2f(-1.4426950408889634f * u2));
}
struct EpiRecIn {
    static constexpr bool PERM = true, AFTER_DRAIN = false, DUPK = (DUPK_SEL == 4), RELAX = (RELAX_EPI & 2) != 0;
    bf16_t* GG; bf16_t* XR; bf16_t* HALO;
    template <int MR> __device__ __forceinline__ void operator()(const f32x4 (&acc)[2][2][MR][2], const Unit& u, int wr, int wc, int fr, int fq) const {
        constexpr int HRr = MR * 32, BMR = 2 * HRr, WRO = HRr / 2;
        const bool isg = u.pn < 5;
        bf16_t* base = isg ? GG : XR; const int colt = (isg ? u.pn : u.pn - 5) * BM;
        const int lane = fq * 16 + fr, frp = lane >> 2, fqp = lane & 3, src4 = (fqp * 16 + frp) * 4;
#pragma unroll
        for (int ai = 0; ai < 2; ++ai)
#pragma unroll
            for (int m = 0; m < MR; ++m) {
                const int row = u.pm * BMR + ai * HRr + wr * WRO + m * 16 + frp;
                bf16_t* rowp = base + (size_t)row * 1280 + colt + wc * 32 + 8 * fqp;
                const int rl = row & 63; const bool halo = !isg && (rl == 63 || rl <= 1);
                bf16_t* hp = HALO + ((size_t)(row >> 6) * 3 + (rl == 63 ? 0 : rl + 1)) * 1280 + colt + wc * 32 + 8 * fqp;
#pragma unroll
                for (int bj = 0; bj < 2; ++bj) {
                    f32x4 v0 = acc[ai][bj][m][0], v1 = acc[ai][bj][m][1];
                    if (isg) {
#pragma unroll
                        for (int e = 0; e < 4; ++e) { v0[e] = gelu_tanh(v0[e]); v1[e] = gelu_tanh(v1[e]); }
                    }
                    u32x4 w; w.x = cvt_pk_bf16(v0[0], v0[1]); w.y = cvt_pk_bf16(v0[2], v0[3]); w.z = cvt_pk_bf16(v1[0], v1[1]); w.w = cvt_pk_bf16(v1[2], v1[3]);
                    w.x = (unsigned)__builtin_amdgcn_ds_bpermute(src4, (int)w.x); w.y = (unsigned)__builtin_amdgcn_ds_bpermute(src4, (int)w.y);
                    w.z = (unsigned)__builtin_amdgcn_ds_bpermute(src4, (int)w.z); w.w = (unsigned)__builtin_amdgcn_ds_bpermute(src4, (int)w.w);
                    *(u32x4*)(rowp + bj * HALF) = w;
                    if (halo) *(u32x4*)(hp + bj * HALF) = w;
                }
            }
    }
};
template <class Epi, class Sched, bool ALIGN_EPI = false, bool SP2 = false, int HR = 128>
__device__ __forceinline__ void gemm_phase(PG8_LAS unsigned char* lds, const Gemm g, const Sched& S, const Epi& E, const int wave_s) {
    int tid_ = wave_s * 64 + lane_now(); asm volatile("" : "+v"(tid_));
    const int tid = tid_, wid = __builtin_amdgcn_readfirstlane(tid >> 6), lane = tid & 63, wr = wid >> 2, wc = wid & 3, fr = lane & 15, fq = lane >> 4;
    constexpr int MR = HR / 32;
    const int K = g.K, nt = K / BK;
    unsigned voffA[2], voffB[2];
#pragma unroll
    for (int i = 0; i < 2; ++i) { int R, C; stage_rc(tid * 16 + i * 8192, R, C); const int Rb = Epi::PERM ? ((R & ~31) + perm32(R & 31)) : R;
        voffA[i] = (unsigned)(R * g.lda + C) * 2u; voffB[i] = (unsigned)(Rb * K + C) * 2u; }
    const size_t kstep = (size_t)(BK * 2);
    const size_t hstep = (size_t)HALF * K * 2;
    const size_t tstep = 2 * hstep;
    const size_t hstepA = (size_t)HR * g.lda * 2, tstepA = 2 * hstepA;
    const unsigned ldsw = (unsigned)wid * 1024u;
    const int aoff = lds_byte(wr * (HR / 2) + fr, fq * 8), boff = lds_byte(wc * 32 + fr, fq * 8);
#define PG8_SA(b, h) (((b) * 2 + (h)) * HTB)
#define PG8_SB(b, h) ((4 + (b) * 2 + (h)) * HTB)
#define PG8_STAGE(bufoff, gbase, voff) do { _Pragma("unroll") for (int _i = 0; _i < 2; ++_i) \
        __builtin_amdgcn_global_load_lds((const unsigned*)((const char*)(gbase) + (voff)[_i]), (PG8_LAS unsigned*)(lds + (bufoff) + ldsw + _i * 8192), 16, 0, 0); } while (0)
#define PG8_LDA(dst, b, h) do { _Pragma("unroll") for (int m = 0; m < MR; ++m) _Pragma("unroll") for (int k = 0; k < 2; ++k) dst[m][k] = *(const PG8_LAS bf16x8*)(lds + PG8_SA(b, h) + aoff + m * 2048 + k * 1024); } while (0)
#define PG8_LDB(dst, b, h) do { _Pragma("unroll") for (int n = 0; n < 2; ++n) _Pragma("unroll") for (int k = 0; k < 2; ++k) dst[n][k] = *(const PG8_LAS bf16x8*)(lds + PG8_SB(b, h) + boff + n * 2048 + k * 1024); } while (0)
#define PG8_MMA(ai, bj, At, Bt) do { __builtin_amdgcn_s_setprio(1); _Pragma("unroll") for (int m = 0; m < MR; ++m) _Pragma("unroll") for (int n = 0; n < 2; ++n) _Pragma("unroll") for (int k = 0; k < 2; ++k) \
        acc[ai][bj][m][n] = __builtin_amdgcn_mfma_f32_16x16x32_bf16(Bt[n][k], At[m][k], acc[ai][bj][m][n], 0, 0, 0); __builtin_amdgcn_s_setprio(0); } while (0)
#define PG8_MMA0(ai, bj, At, Bt) do { __builtin_amdgcn_s_setprio(1); _Pragma("unroll") for (int m = 0; m < MR; ++m) _Pragma("unroll") for (int n = 0; n < 2; ++n) { \
        acc[ai][bj][m][n] = __builtin_amdgcn_mfma_f32_16x16x32_bf16(Bt[n][0], At[m][0], (f32x4){0.f, 0.f, 0.f, 0.f}, 0, 0, 0); \
        acc[ai][bj][m][n] = __builtin_amdgcn_mfma_f32_16x16x32_bf16(Bt[n][1], At[m][1], acc[ai][bj][m][n], 0, 0, 0); } __builtin_amdgcn_s_setprio(0); } while (0)
#define PG8_WAIT_V_(n) asm volatile("s_waitcnt vmcnt(" #n ")" ::: "memory")
#define PG8_WAIT_V(n) PG8_WAIT_V_(n)
#define PG8_WAIT_L(n) asm volatile("s_waitcnt lgkmcnt(" #n ")" ::: "memory")
#define PG8_BAR __builtin_amdgcn_s_barrier()
#define PG8_SCHED __builtin_amdgcn_sched_barrier(0)
#define PG8_PAIR(W1, MMAF) do { \
            PG8_LDB(B0, 0, 0); PG8_LDB(B1, 0, 1); PG8_SCHED; PG8_LDA(At, 0, 0); PG8_STAGE(PG8_SA(1, 1), a1 + hstepA, voffA); \
            PG8_WAIT_V(W1); PG8_WAIT_L(0); PG8_BAR; MMAF(0, 0, At, B0); MMAF(0, 1, At, B1); PG8_BAR; PG8_SCHED; \
            PG8_LDA(At, 0, 1); PG8_STAGE(PG8_SB(0, 0), b2, voffB); PG8_STAGE(PG8_SB(0, 1), b2 + hstep, voffB); PG8_STAGE(PG8_SA(0, 0), a2, voffA); \
            PG8_WAIT_V(W1); PG8_WAIT_L(0); PG8_BAR; MMAF(1, 0, At, B0); MMAF(1, 1, At, B1); PG8_BAR; PG8_SCHED; \
            PG8_LDB(B0, 1, 0); PG8_LDB(B1, 1, 1); PG8_SCHED; PG8_LDA(At, 1, 0); PG8_STAGE(PG8_SA(0, 1), a2 + hstepA, voffA); \
            PG8_WAIT_V(8); PG8_WAIT_L(0); PG8_BAR; PG8_MMA(0, 0, At, B0); PG8_MMA(0, 1, At, B1); PG8_BAR; PG8_SCHED; \
            PG8_LDA(At, 1, 1); PG8_STAGE(PG8_SB(1, 0), b3, voffB); PG8_STAGE(PG8_SB(1, 1), b3 + hstep, voffB); PG8_STAGE(PG8_SA(1, 0), a3, voffA); \
            PG8_WAIT_V(8); PG8_WAIT_L(0); PG8_BAR; PG8_MMA(1, 0, At, B0); PG8_MMA(1, 1, At, B1); PG8_BAR; PG8_SCHED; } while (0)
    Unit cur, nxt; int ui = 0, t0 = 0;
    if (!S.next(0, cur)) return;
    f32x4 acc[2][2][MR][2];
#pragma unroll
    for (int a = 0; a < 2; ++a)
#pragma unroll
        for (int b = 0; b < 2; ++b)
#pragma unroll
            for (int m = 0; m < MR; ++m)
#pragma unroll
                for (int n = 0; n < 2; ++n) acc[a][b][m][n] = (f32x4){0.f, 0.f, 0.f, 0.f};
    bf16x8 At[MR][2], B0[2][2], B1[2][2];
    const char* cA = (const char*)g.A + (size_t)cur.pm * tstepA; const char* cB = (const char*)g.Bt + (size_t)cur.pn * tstep;
    S.a_ready(cur);
    if constexpr (SP2) {
        PG8_STAGE(PG8_SB(0, 0), cB, voffB); PG8_STAGE(PG8_SB(0, 1), cB + hstep, voffB); PG8_STAGE(PG8_SA(0, 0), cA, voffA); PG8_STAGE(PG8_SA(0, 1), cA + hstepA, voffA);
        if (wr == 1) PG8_BAR;
        PG8_WAIT_V(2); PG8_BAR;
        PG8_STAGE(PG8_SB(1, 0), cB + kstep, voffB); PG8_STAGE(PG8_SA(1, 0), cA + kstep, voffA); PG8_STAGE(PG8_SB(1, 1), cB + hstep + kstep, voffB);
        PG8_WAIT_V(6); PG8_BAR;
    } else {
        PG8_STAGE(PG8_SB(0, 0), cB, voffB); PG8_STAGE(PG8_SA(0, 0), cA, voffA); PG8_STAGE(PG8_SB(0, 1), cB + hstep, voffB); PG8_STAGE(PG8_SA(0, 1), cA + hstepA, voffA);
        if (wr == 1) PG8_BAR;
        PG8_WAIT_V(4); PG8_BAR;
        PG8_STAGE(PG8_SB(1, 0), cB + kstep, voffB); PG8_STAGE(PG8_SA(1, 0), cA + kstep, voffA); PG8_STAGE(PG8_SB(1, 1), cB + hstep + kstep, voffB);
        PG8_WAIT_V(6); PG8_BAR;
    }
    for (;;) {
        const bool has_next = S.next(ui + 1, nxt);
        const char* nA = has_next ? (const char*)g.A + (size_t)nxt.pm * tstepA : cA; const char* nB = has_next ? (const char*)g.Bt + (size_t)nxt.pn * tstep : cB;
#ifdef DUP_KLOOP
        constexpr int NDUP = Epi::DUPK ? DUP_KLOOP : 1;
#else
        constexpr int NDUP = 1;
#endif
#pragma unroll 1
        for (int dup = 0; dup < NDUP; ++dup) {
        if (dup > 0) {
#pragma unroll
            for (int a = 0; a < 2; ++a)
#pragma unroll
                for (int b = 0; b < 2; ++b)
#pragma unroll
                    for (int m = 0; m < MR; ++m)
#pragma unroll
                        for (int n = 0; n < 2; ++n) acc[a][b][m][n] = (f32x4){0.f, 0.f, 0.f, 0.f};
        }
        const char* nA2 = dup < NDUP - 1 ? cA : nA; const char* nB2 = dup < NDUP - 1 ? cB : nB;
        for (int t = t0; t < nt; t += 2) {
            const bool last = (t == nt - 2);
            const char* a1 = cA + (size_t)(t + 1) * kstep;
            const char* a2 = last ? nA2 : cA + (size_t)(t + 2) * kstep; const char* b2 = last ? nB2 : cB + (size_t)(t + 2) * kstep;
            const char* a3 = a2 + kstep; const char* b3 = b2 + kstep;
            if (last && has_next) S.a_ready(nxt);
            if constexpr (SP2) {
            PG8_PAIR(8, PG8_MMA);
            } else {
            PG8_LDB(B0, 0, 0); PG8_SCHED; PG8_LDA(At, 0, 0); PG8_STAGE(PG8_SA(1, 1), a1 + hstepA, voffA);
            PG8_WAIT_L(8); PG8_BAR; PG8_WAIT_L(0); PG8_MMA(0, 0, At, B0); PG8_BAR; PG8_SCHED;
            PG8_LDB(B1, 0, 1); PG8_STAGE(PG8_SB(0, 0), b2, voffB);
            PG8_BAR; PG8_WAIT_L(0); PG8_MMA(0, 1, At, B1); PG8_BAR;
            PG8_LDA(At, 0, 1); PG8_STAGE(PG8_SA(0, 0), a2, voffA);
            PG8_BAR; PG8_WAIT_L(0); PG8_MMA(1, 0, At, B0); PG8_BAR; PG8_SCHED;
            PG8_STAGE(PG8_SB(0, 1), b2 + hstep, voffB);
            PG8_WAIT_V(6); PG8_BAR; PG8_MMA(1, 1, At, B1); PG8_BAR;
            PG8_LDB(B0, 1, 0); PG8_SCHED; PG8_LDA(At, 1, 0); PG8_STAGE(PG8_SA(0, 1), a2 + hstepA, voffA);
            PG8_WAIT_L(8); PG8_BAR; PG8_WAIT_L(0); PG8_MMA(0, 0, At, B0); PG8_BAR; PG8_SCHED;
            PG8_LDB(B1, 1, 1); PG8_STAGE(PG8_SB(1, 0), b3, voffB);
            PG8_BAR; PG8_WAIT_L(0); PG8_MMA(0, 1, At, B1); PG8_BAR;
            PG8_LDA(At, 1, 1); PG8_STAGE(PG8_SA(1, 0), a3, voffA);
            PG8_BAR; PG8_WAIT_L(0); PG8_MMA(1, 0, At, B0); PG8_BAR; PG8_SCHED;
            PG8_STAGE(PG8_SB(1, 1), b3 + hstep, voffB);
            PG8_WAIT_V(6); PG8_BAR; PG8_MMA(1, 1, At, B1); PG8_BAR;
            }
        }
        }
        if constexpr (ALIGN_EPI) { if (wr == 0) PG8_BAR; }
        if constexpr (!Epi::AFTER_DRAIN) { E.template operator()<MR>(acc, cur, wr, wc, fr, fq); S.done(cur); }
        if (!has_next) break;
        if constexpr (!(SP2 && MR == 4 && Epi::RELAX)) {
#pragma unroll
        for (int a = 0; a < 2; ++a)
#pragma unroll
            for (int b = 0; b < 2; ++b)
#pragma unroll
                for (int m = 0; m < MR; ++m)
#pragma unroll
                    for (int n = 0; n < 2; ++n) acc[a][b][m][n] = (f32x4){0.f, 0.f, 0.f, 0.f};
        }
        cur = nxt; cA = nA; cB = nB; ++ui;
        if constexpr (ALIGN_EPI) { if (wr == 1) PG8_BAR; }
        if constexpr (SP2 && MR == 4 && Epi::RELAX) {
            const char* a1 = cA + kstep; const char* a2 = cA + 2 * kstep; const char* b2 = cB + 2 * kstep; const char* a3 = a2 + kstep; const char* b3 = b2 + kstep;
            PG8_PAIR(24, PG8_MMA0); t0 = 2;
        }
    }
    PG8_WAIT_V(0);
    if constexpr (!ALIGN_EPI) { if (wr == 0) PG8_BAR; }
    PG8_BAR;
    if constexpr (Epi::AFTER_DRAIN) { E.fused(acc, cur, wr, wc, fr, fq, lds, wid, lane); S.done(cur); }
#undef PG8_SA
#undef PG8_SB
#undef PG8_STAGE
#undef PG8_LDA
#undef PG8_LDB
#undef PG8_MMA
#undef PG8_WAIT_V
#undef PG8_WAIT_L
#undef PG8_BAR
#undef PG8_SCHED
#undef PG8_PAIR
#undef PG8_MMA0
#undef PG8_WAIT_V_
}
}
constexpr int NWAVES = 8, NTHREADS = 512;
constexpr int DM = 1024, T_CTX = 8192, T_LAT = 16384, T_ALL = 24576, LAT_SEQ = 4096, CTX_SEQ = 256;
constexpr int QKV_LD = 2304, DFF = 4096, DRNN = 1280;
#ifndef LDH_PAD
#define LDH_PAD 64
#endif
constexpr int LDH = DFF + LDH_PAD;
constexpr int QA_OFF = 0, KA_OFF = 512, VA_OFF = 640, QB_OFF = 768, KB_OFF = 1280, VB_OFF = 1792;
constexpr float EPSN = 1e-6f;
constexpr float SM_C = 0.125f * 1.4426950408889634f;
constexpr long OUT_AK = 25165824, OUT_AV = 26214400, OUT_BK = 27262976, OUT_BV = 31457280, OUT_SF = 35651584, OUT_SB = 35692544;
constexpr size_t MiB = 1u << 20;
constexpr size_t WS_CTL = 0, CTL_ZERO_BYTES = 64 * 1024;
constexpr size_t WS_MOD = 1 * MiB;
constexpr size_t WS_ROPE = 1 * MiB + 256 * 1024;
constexpr size_t WS_LAM = WS_ROPE + 16 * 1024;
constexpr size_t WS_SP8 = WS_LAM + 1024;
constexpr size_t WS_CAK = 2 * MiB, WS_CAV = WS_CAK + 256 * 1024, WS_CBK = WS_CAV + 256 * 1024, WS_CBV = WS_CBK + 1 * MiB;
constexpr size_t WS_WIN = 5 * MiB;
constexpr size_t WS_WOUT = 10 * MiB;
constexpr size_t WS_W1 = 12 * MiB;
constexpr size_t WS_W2 = 28 * MiB;
constexpr size_t WS_WRIN = 44 * MiB;
constexpr size_t WS_WROUT = 49 * MiB;
constexpr size_t WS_WG = 52 * MiB;
constexpr size_t WS_SUM = 54 * MiB;
constexpr size_t WS_H = 56 * MiB;
constexpr size_t WS_BIG = 104 * MiB;
constexpr size_t WS_END = 256 * MiB;
constexpr size_t WS_XA_BIG = 256 * MiB, WS_END_BIG = WS_XA_BIG + 32 * MiB;
static_assert(WS_BIG + (size_t)T_ALL * QKV_LD * 2 <= WS_END && WS_BIG + (size_t)(T_ALL / 2) * LDH * 2 <= WS_BIG + 120 * MiB && WS_BIG + (size_t)T_ALL * DRNN * 4 <= WS_END, "ws map");
constexpr int LDS_BYTES = 160 * 1024;
constexpr int MISC_OFF = 152 * 1024;

#define GAS __attribute__((address_space(1)))
#define LAS __attribute__((address_space(3)))
typedef unsigned short bf16;
typedef unsigned v4u __attribute__((ext_vector_type(4)));
typedef unsigned v2u __attribute__((ext_vector_type(2)));
typedef float f32x4 __attribute__((ext_vector_type(4)));
typedef float f32x2 __attribute__((ext_vector_type(2)));
typedef float f32x16 __attribute__((ext_vector_type(16)));
typedef short bf16x8 __attribute__((ext_vector_type(8)));
typedef short s16x4 __attribute__((ext_vector_type(4)));
typedef GAS unsigned gu32;
#define RLX_AGENT __ATOMIC_RELAXED, __HIP_MEMORY_SCOPE_AGENT
__device__ __forceinline__ unsigned f2bf(float f) { unsigned u = __builtin_bit_cast(unsigned, f); return (u + 0x7fffu + ((u >> 16) & 1u)) >> 16; }
__device__ __forceinline__ unsigned pk2(float lo, float hi) { return f2bf(lo) | (f2bf(hi) << 16); }
__device__ __forceinline__ float bf2f(unsigned short b) { return __builtin_bit_cast(float, (unsigned)b << 16); }
__device__ __forceinline__ float bflo(unsigned w) { return __builtin_bit_cast(float, w << 16); }
__device__ __forceinline__ float bfhi(unsigned w) { return __builtin_bit_cast(float, w & 0xffff0000u); }

#define XB_TMO      128
#define XB_XCNT(j)  (256  + 64 * (j))
#define XB_XSUB(j)  (1280 + 64 * (j))
#define XB_XGEN(j)  (2304 + 64 * (j))
#define XB_TOP      3328
#define XB_TOPGEN   3392
#define XCD_BAR_WORDS 3456
#define XB_SPIN_CAP (1u << 18)
__device__ __forceinline__ unsigned xb_ld(unsigned* p)              { return __hip_atomic_load(p, __ATOMIC_RELAXED, __HIP_MEMORY_SCOPE_AGENT); }
__device__ __forceinline__ unsigned xb_add(unsigned* p, unsigned v) { return __hip_atomic_fetch_add(p, v, __ATOMIC_RELAXED, __HIP_MEMORY_SCOPE_AGENT); }
__device__ __forceinline__ unsigned xb_xcc_id() { return (unsigned)__builtin_amdgcn_s_getreg((3 << 11) | 20) & 0xFu; }
#define XB_SPIN(cond, bar) do { unsigned _sp = 0; while (cond) { __builtin_amdgcn_s_sleep(1); \
    if ((++_sp & 255u) == 0u) { if (xb_ld(&(bar)[XB_TMO])) break; if (_sp > XB_SPIN_CAP) { atomicAdd(&(bar)[XB_TMO], 1u); break; } } } } while (0)
struct XcdBarrier { unsigned* bar; unsigned x; volatile LAS unsigned* st; int wave; };
__device__ __forceinline__ XcdBarrier xcd_barrier_post(unsigned* bar, volatile LAS unsigned* st, int wave) {
    XcdBarrier b; b.bar = bar; b.x = xb_xcc_id(); b.st = st; b.wave = wave;
    if (wave == 0 && lane_now() == 0) (void)xb_add(&bar[XB_XCNT(b.x)], 1u);
    return b;
}
__device__ __forceinline__ void xcd_barrier_complete(unsigned* bar, unsigned x, unsigned& nloc, unsigned& nx) {
    const unsigned G = gridDim.x * gridDim.y * gridDim.z;
    unsigned sum, cnt, mine, sp = 0u;
    for (;;) {
        sum = 0u; cnt = 0u; mine = 0u;
#pragma unroll
        for (unsigned j = 0; j < 16; ++j) { const unsigned c = xb_ld(&bar[XB_XCNT(j)]); sum += c; cnt += (c > 0u) ? 1u : 0u; mine = (j == x) ? c : mine; }
        if (sum == G) break;
        __builtin_amdgcn_s_sleep(1);
        if ((++sp & 255u) == 0u) { if (xb_ld(&bar[XB_TMO])) break; if (sp > XB_SPIN_CAP) { atomicAdd(&bar[XB_TMO], 1u); break; } }
    }
    nloc = mine > 0u ? mine : 1u; nx = cnt > 0u ? cnt : 1u;
}
__device__ __forceinline__ void xcd_barrier(const XcdBarrier& b) {
    asm volatile("s_waitcnt vmcnt(0)" ::: "memory");
    __syncthreads();
    if (b.wave == 0 && lane_now() == 0) {
        unsigned* bar = b.bar;
        __builtin_amdgcn_s_waitcnt(0);
        unsigned nloc = b.st[0], nx = b.st[1];
        if (nloc == 0u) { xcd_barrier_complete(bar, b.x, nloc, nx); b.st[0] = nloc; b.st[1] = nx; }
        const unsigned old = xb_add(&bar[XB_XSUB(b.x)], 1u);
        const unsigned gen = old / nloc;
        if (old + 1u == (gen + 1u) * nloc) {
            __builtin_amdgcn_fence(__ATOMIC_RELEASE, "agent");
            asm volatile("s_waitcnt vmcnt(0)" ::: "memory");
            const unsigned og = xb_add(&bar[XB_TOP], 1u);
            const unsigned tg = og / nx;
            if (og + 1u == (tg + 1u) * nx) xb_add(&bar[XB_TOPGEN], 1u);
            else XB_SPIN(xb_ld(&bar[XB_TOPGEN]) == tg, bar);
            __builtin_amdgcn_fence(__ATOMIC_ACQUIRE, "agent");
            xb_add(&bar[XB_XGEN(b.x)], 1u);
            asm volatile("s_waitcnt vmcnt(0)" ::: "memory");
        } else {
            XB_SPIN(xb_ld(&bar[XB_XGEN(b.x)]) == gen, bar);
            __builtin_amdgcn_fence(__ATOMIC_ACQUIRE, "agent");
            asm volatile("s_waitcnt vmcnt(0)" ::: "memory");
        }
    }
    __syncthreads();
}

struct Args { const float* in[31]; float* out; unsigned char* ws; int ph_lo, ph_hi; int use_bar, fn_split; unsigned short* xa; };
struct Frame {
    LAS unsigned char* lds;
    int tid, lane, wave, vcu, G;
    const float* const* in; float* out; unsigned char* ws;
};
#define WSP(T, off) ((T*)(F.ws + (off)))
__device__ __forceinline__ Frame fresh(const Frame& F) { Frame P = F; int t = F.wave * 64 + lane_now(); asm volatile("" : "+v"(t)); P.tid = t; P.lane = t & 63; P.wave = __builtin_amdgcn_readfirstlane(t >> 6); return P; }
enum { IN_XP = 0, IN_XS, IN_CAK, IN_CAV, IN_CBK, IN_CBV, IN_SF, IN_SB, IN_C, IN_CCTX, IN_NORM1, IN_NORM2, IN_WADA, IN_BADA, IN_WMLP1, IN_WMLP2, IN_AWIN, IN_AWOUT, IN_SINK, IN_LAMQK, IN_SUBLN,
       IN_RWIN, IN_RCONVW, IN_RCONVB, IN_RWA, IN_RBA, IN_RWX, IN_RBX, IN_RLAM, IN_RWOUT, IN_FNORM };

__device__ __forceinline__ float wave_sum(float v) {
#define WS_DPP(x, ctrl, rmask) __builtin_bit_cast(float, __builtin_amdgcn_update_dpp(0, __builtin_bit_cast(int, x), ctrl, rmask, 0xf, false))
    v += WS_DPP(v, 0xB1, 0xf); v += WS_DPP(v, 0x4E, 0xf); v += WS_DPP(v, 0x141, 0xf); v += WS_DPP(v, 0x140, 0xf);
    v += WS_DPP(v, 0x142, 0xa); v += WS_DPP(v, 0x143, 0xc);
#undef WS_DPP
    return __builtin_bit_cast(float, __builtin_amdgcn_readlane(__builtin_bit_cast(int, v), 63));
}

__device__ __forceinline__ void p0_transpose_item(const float* W, int K, int N, bf16* WT, LAS float* scr, int item, int lane, float wscale = 1.0f) {
    const int nblk = N / 32, kb = item / nblk, nb = item % nblk, k0 = 64 * kb, n0 = 32 * nb;
#pragma unroll 8
    for (int i = 0; i < 32; ++i) { const int kk = 2 * i + (lane >> 5); scr[kk * 33 + (lane & 31)] = W[(size_t)(k0 + kk) * N + n0 + (lane & 31)]; }
    asm volatile("s_waitcnt lgkmcnt(0)" ::: "memory");
    const int c = lane & 7;
#pragma unroll
    for (int j = 0; j < 4; ++j) { const int n = (lane >> 3) + 8 * j; const LAS float* s = scr + (8 * c) * 33 + n;
        v4u o; o.x = pk2(s[0 * 33] * wscale, s[1 * 33] * wscale); o.y = pk2(s[2 * 33] * wscale, s[3 * 33] * wscale); o.z = pk2(s[4 * 33] * wscale, s[5 * 33] * wscale); o.w = pk2(s[6 * 33] * wscale, s[7 * 33] * wscale);
        *(GAS v4u*)(WT + (size_t)(n0 + n) * K + k0 + 8 * c) = o; }
    asm volatile("s_waitcnt lgkmcnt(0)" ::: "memory");
}
__device__ __forceinline__ void p0_prologue(Frame& F) {
    const float* const* in = F.in;
    {
        LAS float* SC = (LAS float*)(F.lds);
        LAS float* RED = (LAS float*)(F.lds + 20480);
        for (int i = F.tid; i < 5 * 1024; i += NTHREADS) { const int v = i >> 10, k = i & 1023; const float c = v < 4 ? in[IN_C][v * 1024 + k] : in[IN_CCTX][k]; SC[i] = c / (1.0f + __expf(-c)); }
        __syncthreads();
        float* MOD = WSP(float, WS_MOD);
        for (int u = blockIdx.x; u < 384; u += F.G) {
            const int l = u / 192, n0 = (u % 192) * 32;
            const float* W = in[IN_WADA] + (size_t)l * 1024 * 6144 + n0 + (F.lane & 31);
            float a[5] = {0.f, 0.f, 0.f, 0.f, 0.f};
            const int kb = F.wave * 128 + (F.lane >> 5);
#pragma unroll 1
            for (int kh = 0; kh < 64; kh += 16) {
                float wv[16];
#pragma unroll
                for (int kk = 0; kk < 16; ++kk) wv[kk] = W[(size_t)(kb + 2 * (kh + kk)) * 6144];
#pragma unroll
                for (int kk = 0; kk < 16; ++kk) { const int k = kb + 2 * (kh + kk);
#pragma unroll
                    for (int v = 0; v < 5; ++v) a[v] += SC[v * 1024 + k] * wv[kk]; }
            }
#pragma unroll
            for (int v = 0; v < 5; ++v) { a[v] += __shfl_xor(a[v], 32); if (F.lane < 32) RED[(F.wave * 5 + v) * 32 + F.lane] = a[v]; }
            __syncthreads();
            if (F.tid < 160) { const int v = F.tid >> 5, c = F.tid & 31; float s = in[IN_BADA][l * 6144 + n0 + c];
#pragma unroll
                for (int w = 0; w < 8; ++w) s += RED[(w * 5 + v) * 32 + c];
                MOD[((size_t)l * 5 + v) * 6144 + n0 + c] = s; }
            __syncthreads();
        }
    }
    {
        LAS float* scr = (LAS float*)(F.lds + 32768 + F.wave * 8704);
        const int gw = F.vcu * NWAVES + F.wave, NGW = F.G * NWAVES;
        constexpr int I_IN = 16 * 72, I_OUT = 16 * 32;
        for (int it = gw; it < I_IN + I_OUT; it += NGW) {
            if (it < I_IN) p0_transpose_item(in[IN_AWIN], 1024, 2304, WSP(bf16, WS_WIN), scr, it, F.lane);
            else p0_transpose_item(in[IN_AWOUT], 1024, 1024, WSP(bf16, WS_WOUT), scr, it - I_IN, F.lane);
        }
    }
    {
        const int gt = F.vcu * NTHREADS + F.tid, NGT = F.G * NTHREADS;
        for (int i = gt; i < 4 * 256 * 128 / 4; i += NGT) {
            const f32x4 a = ((const f32x4*)in[IN_CAK])[i], b = ((const f32x4*)in[IN_CAV])[i];
            v2u o; o.x = pk2(a[0], a[1]); o.y = pk2(a[2], a[3]); WSP(v2u, WS_CAK)[i] = o; o.x = pk2(b[0], b[1]); o.y = pk2(b[2], b[3]); WSP(v2u, WS_CAV)[i] = o; }
        for (int i = gt; i < 4 * 256 * 512 / 4; i += NGT) {
            const f32x4 a = ((const f32x4*)in[IN_CBK])[i], b = ((const f32x4*)in[IN_CBV])[i];
            v2u o; o.x = pk2(a[0], a[1]); o.y = pk2(a[2], a[3]); WSP(v2u, WS_CBK)[i] = o; o.x = pk2(b[0], b[1]); o.y = pk2(b[2], b[3]); WSP(v2u, WS_CBV)[i] = o; }
        if (gt < 1024) { const int pos = gt >> 4, i = gt & 15; const double ang = (double)pos * pow(10000.0, -(double)i / 16.0);
            WSP(f32x2, WS_ROPE)[gt] = (f32x2){(float)cos(ang), (float)sin(ang)}; }
        if (gt == 0) { const float* lq = in[IN_LAMQK]; float s1 = 0.f, s2 = 0.f; for (int i = 0; i < 64; ++i) { s1 += lq[i] * lq[64 + i]; s2 += lq[128 + i] * lq[192 + i]; }
            WSP(float, WS_LAM)[0] = __expf(s1) - __expf(s2) + 0.2f; }
        if (gt >= 1024 && gt < 1024 + 2 * DRNN) { const float lamv = in[IN_RLAM][gt - 1024]; WSP(float, WS_SP8)[gt - 1024] = -8.0f * (lamv > 20.f ? __expf(-lamv) : log1pf(__expf(-lamv))); }
    }
}

__device__ __forceinline__ void p_deferred_transposes(Frame& F, int iw, int nw) {
    const float* const* in = F.in;
    LAS float* scr = (LAS float*)(F.lds + 32768 + F.wave * 8704);
    const int gw = iw * NWAVES + F.wave, NGW = nw * NWAVES;
    constexpr int I_M1 = 16 * 128, I_M2 = 64 * 32, I_RIN = 16 * 80, I_ROUT = 20 * 32, I_G = 8;
    constexpr int NITEMS = 2 * I_M1 + 2 * I_M2 + I_RIN + I_ROUT + 40 * I_G;
    for (int it = gw; it < NITEMS; it += NGW) {
        int r = it;
        if (r < 2 * I_M1) { const int l = r / I_M1; p0_transpose_item(in[IN_WMLP1] + (size_t)l * 1024 * 4096, 1024, 4096, WSP(bf16, WS_W1) + (size_t)l * 4096 * 1024, scr, r % I_M1, F.lane); continue; } r -= 2 * I_M1;
        if (r < 2 * I_M2) { const int l = r / I_M2; p0_transpose_item(in[IN_WMLP2] + (size_t)l * 4096 * 1024, 4096, 1024, WSP(bf16, WS_W2) + (size_t)l * 1024 * 4096, scr, r % I_M2, F.lane); continue; } r -= 2 * I_M2;
        if (r < I_RIN) { p0_transpose_item(in[IN_RWIN], 1024, 2560, WSP(bf16, WS_WRIN), scr, r, F.lane); continue; } r -= I_RIN;
        if (r < I_ROUT) { p0_transpose_item(in[IN_RWOUT], 1280, 1024, WSP(bf16, WS_WROUT), scr, r, F.lane); continue; } r -= I_ROUT;
        { const int mtx = r / I_G, gate = mtx / 20, db = mtx % 20;
          p0_transpose_item(in[gate ? IN_RWX : IN_RWA] + (size_t)db * 16384, 128, 128, WSP(bf16, WS_WG) + (size_t)(gate * 20 + db) * 16384, scr, r % I_G, F.lane, -1.4426950408889634f); }
    }
}

__device__ __forceinline__ void norm_mod_pass(Frame& F, const float* x_ctx, const float* x_lat, const float* g, const float* mod  , int shift_off, int scale_off, bf16* H) {
    const int gw = F.vcu * NWAVES + F.wave, NGW = F.G * NWAVES;
    for (int m = gw; m < T_ALL; m += NGW) {
        const float* xr = m < T_CTX ? x_ctx + (size_t)m * DM : x_lat + (size_t)(m - T_CTX) * DM;
        const int midx = m < T_CTX ? 4 : ((m - T_CTX) >> 12);
        const float* mv = mod + (size_t)midx * 6144;
        f32x4 v[4]; float s = 0.f;
#pragma unroll
        for (int j = 0; j < 4; ++j) { v[j] = ((const f32x4*)xr)[F.lane + 64 * j]; s += (v[j][0] * v[j][0] + v[j][1] * v[j][1]) + (v[j][2] * v[j][2] + v[j][3] * v[j][3]); }
        const float rstd = 1.0f / sqrtf(wave_sum(s) * (1.0f / DM) + EPSN);
#pragma unroll
        for (int j = 0; j < 4; ++j) {
            const int c = 4 * (F.lane + 64 * j);
            const f32x4 gg = *(const f32x4*)(g + c), sc = *(const f32x4*)(mv + scale_off + c), sh = *(const f32x4*)(mv + shift_off + c);
            f32x4 o = (v[j] * rstd) * gg; o = o * (sc + 1.0f) + sh;
            v2u w; w.x = pk2(o[0], o[1]); w.y = pk2(o[2], o[3]);
            *(v2u*)(H + (size_t)m * DM + c) = w;
        }
    }
}
constexpr int X_SPLIT = 16384;
__device__ __forceinline__ const bf16* xrow_bf(const bf16* XA, const bf16* XB, int m) { return m < X_SPLIT ? XA + (size_t)m * DM : XB + (size_t)(m - X_SPLIT) * DM; }
__device__ __forceinline__ void unpack16(const v4u a, const v4u b, float (&v)[16]) {
    const unsigned w[8] = {a.x, a.y, a.z, a.w, b.x, b.y, b.z, b.w};
#pragma unroll
    for (int e = 0; e < 8; ++e) { v[2 * e] = bflo(w[e]); v[2 * e + 1] = bfhi(w[e]); }
}
__device__ __forceinline__ void norm_mod_pass_bf(Frame& F, const bf16* XA, const bf16* XB, const float* g, const float* mod  , int shift_off, int scale_off, bf16* H) {
    const int gw = F.vcu * NWAVES + F.wave, NGW = F.G * NWAVES;
    for (int m = gw; m < T_ALL; m += NGW) {
        const v4u* xp = (const v4u*)(xrow_bf(XA, XB, m) + F.lane * 8);
        const int midx = m < T_CTX ? 4 : ((m - T_CTX) >> 12);
        const float* mv = mod + (size_t)midx * 6144;
        float v[16]; unpack16(xp[0], xp[64], v);
        float s = 0.f;
#pragma unroll
        for (int e = 0; e < 16; ++e) s += v[e] * v[e];
        const float rstd = 1.0f / sqrtf(wave_sum(s) * (1.0f / DM) + EPSN);
        unsigned ow[8];
#pragma unroll
        for (int q = 0; q < 4; ++q) {
            const int c = 8 * F.lane + (q >> 1) * 512 + (q & 1) * 4;
            const f32x4 gg = *(const f32x4*)(g + c), sc = *(const f32x4*)(mv + scale_off + c), sh = *(const f32x4*)(mv + shift_off + c);
            const float o0 = (v[4 * q] * rstd) * gg[0] * (sc[0] + 1.0f) + sh[0], o1 = (v[4 * q + 1] * rstd) * gg[1] * (sc[1] + 1.0f) + sh[1];
            const float o2 = (v[4 * q + 2] * rstd) * gg[2] * (sc[2] + 1.0f) + sh[2], o3 = (v[4 * q + 3] * rstd) * gg[3] * (sc[3] + 1.0f) + sh[3];
            ow[2 * q] = pk2(o0, o1); ow[2 * q + 1] = pk2(o2, o3);
        }
        v4u* hp = (v4u*)(H + (size_t)m * DM + 8 * F.lane);
        v4u a, b2; a.x = ow[0]; a.y = ow[1]; a.z = ow[2]; a.w = ow[3]; b2.x = ow[4]; b2.y = ow[5]; b2.z = ow[6]; b2.w = ow[7];
        hp[0] = a; hp[64] = b2;
    }
}
__device__ __forceinline__ void final_norm_pass(Frame& F, const bf16* XA, const bf16* XB, float* Y, const float* g, int m_lo, int m_hi) {
    const int gw = F.vcu * NWAVES + F.wave, NGW = F.G * NWAVES;
    for (int m = m_lo + gw; m < m_hi; m += NGW) {
        const v4u* xp = (const v4u*)(xrow_bf(XA, XB, m) + F.lane * 8);
        float v[16]; unpack16(xp[0], xp[64], v);
        float s = 0.f;
#pragma unroll
        for (int e = 0; e < 16; ++e) s += v[e] * v[e];
        const float rstd = 1.0f / sqrtf(wave_sum(s) * (1.0f / DM) + EPSN);
#pragma unroll
        for (int q = 0; q < 4; ++q) { const int c = 8 * F.lane + (q >> 1) * 512 + (q & 1) * 4; const f32x4 gg = *(const f32x4*)(g + c);
            f32x4 o; o[0] = v[4 * q] * rstd * gg[0]; o[1] = v[4 * q + 1] * rstd * gg[1]; o[2] = v[4 * q + 2] * rstd * gg[2]; o[3] = v[4 * q + 3] * rstd * gg[3];
            *(f32x4*)(Y + (size_t)m * DM + c) = o; }
    }
}

constexpr float ATT_THR = 8.0f;
constexpr int AT_K0 = 0, AT_K1 = 9216;
constexpr int AT_V0 = 18432, AT_V1 = 38912;
constexpr int AT_WS = 59392;
constexpr int AT_O1 = 61440;
static_assert(AT_O1 + 65536 <= MISC_OFF, "attention LDS map");
__device__ __forceinline__ int crow(int r, int hi) { return (r & 3) + 8 * (r >> 2) + 4 * hi; }
__device__ __forceinline__ unsigned cvtpk_s(float lo, float hi) { typedef __bf16 bf16x2_t __attribute__((ext_vector_type(2))); f32x2 v = {lo, hi}; bf16x2_t b = __builtin_convertvector(v, bf16x2_t); return __builtin_bit_cast(unsigned, b); }
__device__ __forceinline__ s16x4 vtr(const LAS unsigned char* p) { typedef short v4i16_t __attribute__((ext_vector_type(4))); return __builtin_bit_cast(s16x4, __builtin_amdgcn_ds_read_tr16_b64_v4i16((LAS v4i16_t*)p)); }

struct AttnSrc {
    const bf16* K0; const bf16* V0; int ld0, n0;
    const bf16* K1; const bf16* V1; int ld1, t_lo, t_hi;
};
template <int DV, bool WINDOW>
__device__ __forceinline__ void attn_pass(Frame& F, const bf16* Q, int ldq, const AttnSrc& S, int qpos0, float m_init, float l_init, bool start_exact, f32x16 (&o)[DV / 32], float& m_out, float& l_out) {
    constexpr int RSV = DV == 128 ? 320 : 192, NVL = DV / 64;
    LAS unsigned char* lds = F.lds;
    const int tid = F.tid, lane = F.lane, wid = F.wave, r32 = lane & 31, hi = lane >> 5;
    LAS float* wsf = (LAS float*)(lds + AT_WS) + wid * 64;
    bf16x8 qr[4];
    { const bf16* qp = Q + (size_t)(wid * 32 + r32) * ldq + hi * 8;
#pragma unroll
      for (int d0 = 0; d0 < 4; ++d0) qr[d0] = *(const bf16x8*)(qp + d0 * 16); }
#pragma unroll
    for (int d = 0; d < DV / 32; ++d) o[d] = f32x16{};
    float m = m_init, l = l_init;
    f32x16 negm;
#pragma unroll
    for (int r = 0; r < 16; ++r) negm[r] = -m_init;
    const int nt = S.n0 + (S.t_hi - S.t_lo);
    v4u kreg, vreg[NVL];
    const int krow = tid >> 3, kch = tid & 7;
#define AT_ISSUE(it_) do { const int it__ = (it_); const bf16* Kp; const bf16* Vp; int ld; \
        if (it__ < S.n0) { Kp = S.K0 + (size_t)(it__ * 64) * S.ld0; Vp = S.V0 + (size_t)(it__ * 64) * S.ld0; ld = S.ld0; } \
        else { const int t = S.t_lo + it__ - S.n0; Kp = S.K1 + (size_t)(t * 64) * S.ld1; Vp = S.V1 + (size_t)(t * 64) * S.ld1; ld = S.ld1; } \
        kreg = *(const v4u*)(Kp + (size_t)krow * ld + kch * 8); \
        if (DV == 128) { _Pragma("unroll") for (int i = 0; i < NVL; ++i) { const int idx = tid + 512 * i; vreg[i] = *(const v4u*)(Vp + (size_t)(idx >> 4) * ld + (idx & 15) * 8); } } \
        else vreg[0] = *(const v4u*)(Vp + (size_t)krow * ld + kch * 8); } while (0)
#define AT_COMMIT(buf_) do { const int kb_ = (buf_) ? AT_K1 : AT_K0, vb_ = (buf_) ? AT_V1 : AT_V0; \
        *(LAS v4u*)(lds + kb_ + krow * 144 + kch * 16) = kreg; \
        if (DV == 128) { _Pragma("unroll") for (int i = 0; i < NVL; ++i) { const int idx = tid + 512 * i; *(LAS v4u*)(lds + vb_ + (idx >> 4) * RSV + (idx & 15) * 16) = vreg[i]; } } \
        else *(LAS v4u*)(lds + vb_ + krow * RSV + kch * 16) = vreg[0]; } while (0)
    const int koff = r32 * 144 + hi * 16;
    const int voff = (4 * hi + ((lane & 15) >> 2)) * RSV + ((lane >> 4) & 1) * 32 + (lane & 3) * 8;
    const int qw0 = qpos0 + 32 * wid;
    if (wid >= 4) __builtin_amdgcn_s_setprio(1);
    __syncthreads();
    AT_ISSUE(0); AT_COMMIT(0);
    if (nt > 1) AT_ISSUE(1);
#pragma unroll 1
    for (int it = 0; it < nt; ++it) {
        __syncthreads();
        const LAS unsigned char* kbase = lds + ((it & 1) ? AT_K1 : AT_K0) + koff;
        const LAS unsigned char* vbase = lds + ((it & 1) ? AT_V1 : AT_V0) + voff;
        bool skip = false, need_mask = false;
        int kp0 = 0;
        if (WINDOW && it >= S.n0) {
            kp0 = (S.t_lo + it - S.n0) * 64;
            skip = (kp0 + 63 < qw0 - 128 || kp0 > qw0 + 31 + 128);
            need_mask = !(kp0 >= qw0 + 31 - 128 && kp0 + 63 <= qw0 + 128);
        }
        if (!skip) {
            f32x16 p0, p1;
#pragma unroll
            for (int d0 = 0; d0 < 4; ++d0) {
                const bf16x8 k0 = *(const LAS bf16x8*)(kbase + d0 * 32);
                const bf16x8 k1 = *(const LAS bf16x8*)(kbase + 32 * 144 + d0 * 32);
                if (d0 == 0) { p0 = __builtin_amdgcn_mfma_f32_32x32x16_bf16(k0, qr[0], negm, 0, 0, 0); p1 = __builtin_amdgcn_mfma_f32_32x32x16_bf16(k1, qr[0], negm, 0, 0, 0); }
                else { p0 = __builtin_amdgcn_mfma_f32_32x32x16_bf16(k0, qr[d0], p0, 0, 0, 0); p1 = __builtin_amdgcn_mfma_f32_32x32x16_bf16(k1, qr[d0], p1, 0, 0, 0); }
            }
            if (WINDOW && need_mask) {
                const int q = qw0 + r32;
#pragma unroll
                for (int r = 0; r < 16; ++r) { const int kv = kp0 + crow(r, hi); int d0 = q - kv; d0 = d0 < 0 ? -d0 : d0; int d1 = q - kv - 32; d1 = d1 < 0 ? -d1 : d1;
                    if (d0 > 128) p0[r] = -1e30f; if (d1 > 128) p1[r] = -1e30f; }
            }
            float rm = fmaxf(p0[0], p1[0]);
#pragma unroll
            for (int r = 1; r < 16; ++r) rm = fmaxf(fmaxf(rm, p0[r]), p1[r]);
            const bool exact = start_exact && it == 0;
            if (exact || __any(rm > ATT_THR)) {
                rm = fmaxf(rm, __shfl_xor(rm, 32));
                const float dl = exact ? rm : fmaxf(rm, 0.f);
                m += dl;
#pragma unroll
                for (int r = 0; r < 16; ++r) { p0[r] -= dl; p1[r] -= dl; negm[r] = -m; }
                const float alpha = exact ? 1.0f : __builtin_amdgcn_exp2f(-dl);
                l *= alpha;
                if (hi == 0) wsf[r32] = alpha;
                asm volatile("s_waitcnt lgkmcnt(0)" ::: "memory");
#pragma unroll
                for (int r = 0; r < 16; ++r) { const float a = wsf[crow(r, hi)];
#pragma unroll
                    for (int d = 0; d < DV / 32; ++d) o[d][r] *= a; }
            }
            float ps = 0.f;
            bf16x8 pa[4];
#define AT_ECHUNK(P_, B_, c_) do { v4u w_; \
                _Pragma("unroll") for (int j = 0; j < 4; ++j) { const float e0 = __builtin_amdgcn_exp2f(P_[(B_) + 2 * j]), e1 = __builtin_amdgcn_exp2f(P_[(B_) + 2 * j + 1]); \
                    ps += e0 + e1; w_[j] = cvtpk_s(e0, e1); } \
                pa[c_] = __builtin_bit_cast(bf16x8, w_); } while (0)
#define AT_PVSTEP(s_) do { _Pragma("unroll") for (int d = 0; d < DV / 32; ++d) { \
                const s16x4 lo = vtr(vbase + (16 * (s_)) * RSV + d * 64); const s16x4 hh = vtr(vbase + (16 * (s_) + 8) * RSV + d * 64); \
                const bf16x8 vf = (bf16x8){lo[0], lo[1], lo[2], lo[3], hh[0], hh[1], hh[2], hh[3]}; \
                o[d] = __builtin_amdgcn_mfma_f32_32x32x16_bf16(pa[s_], vf, o[d], 0, 0, 0); } } while (0)
            AT_ECHUNK(p0, 0, 0);
            AT_ECHUNK(p0, 8, 1); AT_PVSTEP(0);
            AT_ECHUNK(p1, 0, 2); AT_PVSTEP(1);
            AT_ECHUNK(p1, 8, 3); AT_PVSTEP(2);
            AT_PVSTEP(3);
            l += ps;
#undef AT_ECHUNK
#undef AT_PVSTEP
        }
        if (it + 1 < nt) { AT_COMMIT((it + 1) & 1); if (it + 2 < nt) AT_ISSUE(it + 2); }
    }
#undef AT_ISSUE
#undef AT_COMMIT
    __builtin_amdgcn_s_setprio(0);
    m_out = m; l_out = l;
}
__device__ __forceinline__ void row_recip(Frame& F, float l, float (&rli)[16]) {
    LAS float* wsf = (LAS float*)(F.lds + AT_WS) + F.wave * 64;
    const int r32 = F.lane & 31, hi = F.lane >> 5;
    l += __shfl_xor(l, 32);
    asm volatile("s_waitcnt lgkmcnt(0)" ::: "memory");
    if (hi == 0) wsf[r32] = 1.0f / l;
    asm volatile("s_waitcnt lgkmcnt(0)" ::: "memory");
#pragma unroll
    for (int r = 0; r < 16; ++r) rli[r] = wsf[crow(r, hi)];
    asm volatile("s_waitcnt lgkmcnt(0)" ::: "memory");
}
template <bool WINDOW>
__device__ __forceinline__ void attn_a_unit(Frame& F, const bf16* QKV, size_t row0, int h, const AttnSrc& S, int qpos0, float sink, bf16* OM) {
    f32x16 o[2]; float m, l;
    attn_pass<64, WINDOW>(F, QKV + row0 * QKV_LD + QA_OFF + h * 64, QKV_LD, S, qpos0, sink * 1.4426950408889634f, (F.lane >> 5) == 0 ? 1.0f : 0.0f, false, o, m, l);
    float rli[16]; row_recip(F, l, rli);
    const int r32 = F.lane & 31, hi = F.lane >> 5;
    bf16* op = OM + (row0 + F.wave * 32) * DM + h * 64 + r32;
#pragma unroll
    for (int r = 0; r < 16; ++r)
#pragma unroll
        for (int d = 0; d < 2; ++d) op[(size_t)crow(r, hi) * DM + d * 32] = (bf16)f2bf(o[d][r] * rli[r]);
}
__device__ __forceinline__ void attn_b_unit(Frame& F, const bf16* QKV, size_t row0, int h, AttnSrc S, float lam, const float* subln, bf16* OM) {
    f32x16 o[4]; float m, l; float rli[16];
    const bf16* K0 = S.K0; const bf16* K1 = S.K1;
    const int r32 = F.lane & 31, hi = F.lane >> 5;
    LAS unsigned* o1s = (LAS unsigned*)(F.lds + AT_O1) + F.wave * 2048 + F.lane;
    attn_pass<128, false>(F, QKV + row0 * QKV_LD + QB_OFF + h * 128, QKV_LD, S, 0, 0.f, 0.f, true, o, m, l);
    row_recip(F, l, rli);
#pragma unroll
    for (int d = 0; d < 4; ++d)
#pragma unroll
        for (int r = 0; r < 8; ++r) o1s[(d * 8 + r) * 64] = cvtpk_s(o[d][2 * r] * rli[2 * r], o[d][2 * r + 1] * rli[2 * r + 1]);
    S.K0 = K0 + 64; S.K1 = K1 + 64;
    attn_pass<128, false>(F, QKV + row0 * QKV_LD + QB_OFF + h * 128 + 64, QKV_LD, S, 0, 0.f, 0.f, true, o, m, l);
    row_recip(F, l, rli);
    float ss[16];
#pragma unroll
    for (int r = 0; r < 16; ++r) { float s = 0.f;
#pragma unroll
        for (int d = 0; d < 4; ++d) { const unsigned w = o1s[(d * 8 + (r >> 1)) * 64]; const float o1 = (r & 1) ? bfhi(w) : bflo(w); const float v = o1 - lam * (o[d][r] * rli[r]); o[d][r] = v; s += v * v; }
        ss[r] = s; }
#pragma unroll
    for (int r = 0; r < 16; ++r) { float s = ss[r];
#pragma unroll
        for (int x = 1; x < 32; x <<= 1) s += __shfl_xor(s, x);
        ss[r] = 0.8f / sqrtf(s * (1.0f / 128.0f) + EPSN); }
    float gs[4];
#pragma unroll
    for (int d = 0; d < 4; ++d) gs[d] = subln[d * 32 + r32];
    bf16* op = OM + (row0 + F.wave * 32) * DM + 512 + h * 128 + r32;
#pragma unroll
    for (int r = 0; r < 16; ++r)
#pragma unroll
        for (int d = 0; d < 4; ++d) op[(size_t)crow(r, hi) * DM + d * 32] = (bf16)f2bf(o[d][r] * ss[r] * gs[d]);
}
__device__ __forceinline__ void attention_phase(Frame& F) {
    const bf16* QKV = WSP(bf16, WS_BIG); bf16* OM = WSP(bf16, WS_H);
    const float lam = WSP(float, WS_LAM)[0];
    const float* sinkp = F.in[IN_SINK]; const float* subln = F.in[IN_SUBLN];
    for (int u = F.vcu; u < 256; u += F.G) {
        const int b = u >> 6, h = (u >> 4) & 3, qb = u & 15;
        const size_t seq0 = T_CTX + (size_t)b * LAT_SEQ;
        AttnSrc S; S.K0 = WSP(bf16, WS_CBK) + (size_t)b * 256 * 512 + h * 128; S.V0 = WSP(bf16, WS_CBV) + (size_t)b * 256 * 512 + h * 128; S.ld0 = 512; S.n0 = 4;
        S.K1 = QKV + seq0 * QKV_LD + KB_OFF + h * 128; S.V1 = QKV + seq0 * QKV_LD + VB_OFF + h * 128; S.ld1 = QKV_LD; S.t_lo = 0; S.t_hi = 64;
        attn_b_unit(F, QKV, seq0 + qb * 256, h, S, lam, subln, OM);
    }
    for (int u = F.vcu; u < 512; u += F.G) {
        const int b = u >> 7, h = (u >> 4) & 7, qb = u & 15, kvh = h >> 2;
        const size_t seq0 = T_CTX + (size_t)b * LAT_SEQ;
        AttnSrc S; S.K0 = WSP(bf16, WS_CAK) + (size_t)b * 256 * 128 + kvh * 64; S.V0 = WSP(bf16, WS_CAV) + (size_t)b * 256 * 128 + kvh * 64; S.ld0 = 128; S.n0 = 4;
        S.K1 = QKV + seq0 * QKV_LD + KA_OFF + kvh * 64; S.V1 = QKV + seq0 * QKV_LD + VA_OFF + kvh * 64; S.ld1 = QKV_LD;
        S.t_lo = 4 * qb - 2 < 0 ? 0 : 4 * qb - 2; S.t_hi = 4 * qb + 6 > 64 ? 64 : 4 * qb + 6;
        attn_a_unit<true>(F, QKV, seq0 + qb * 256, h, S, qb * 256, sinkp[h], OM);
    }
    for (int u = (F.G == 256 ? (F.vcu >= 128 ? F.vcu - 128 : 256) : F.vcu); u < 256; u += (F.G == 256 ? 128 : F.G)) {
        const int b = u >> 3, h = u & 7, kvh = h >> 2;
        const size_t seq0 = (size_t)b * CTX_SEQ;
        AttnSrc S; S.K0 = nullptr; S.V0 = nullptr; S.ld0 = 0; S.n0 = 0;
        S.K1 = QKV + seq0 * QKV_LD + KA_OFF + kvh * 64; S.V1 = QKV + seq0 * QKV_LD + VA_OFF + kvh * 64; S.ld1 = QKV_LD; S.t_lo = 0; S.t_hi = 4;
        attn_a_unit<false>(F, QKV, seq0, h, S, 0, sinkp[h], OM);
    }
    for (int u = F.vcu; u < 128; u += F.G) {
        const int b = u >> 2, h = u & 3;
        const size_t seq0 = (size_t)b * CTX_SEQ;
        AttnSrc S; S.K0 = nullptr; S.V0 = nullptr; S.ld0 = 0; S.n0 = 0;
        S.K1 = QKV + seq0 * QKV_LD + KB_OFF + h * 128; S.V1 = QKV + seq0 * QKV_LD + VB_OFF + h * 128; S.ld1 = QKV_LD; S.t_lo = 0; S.t_hi = 4;
        attn_b_unit(F, QKV, seq0, h, S, lam, subln, OM);
    }
}

constexpr int SC_XC = 0;
constexpr int SC_AUF = 17408;
constexpr int SC_AUB = 17408 + 65536;
constexpr int SC_CW = 17408 + 131072;
static_assert(SC_CW + 2560 <= MISC_OFF, "scan LDS map");
#ifndef DUP_EPI
#define DUP_EPI 1
#endif
#ifndef DUP_SCAN
#define DUP_SCAN 1
#endif
#ifndef DUP_CONV
#define DUP_CONV 1
#endif
constexpr int SCAN_UNITS = 3840;
__device__ __forceinline__ void scan_pass(Frame& F) {
    LAS unsigned char* lds = F.lds;
    const int tid = F.tid, lane = F.lane, wid = F.wave, r32 = lane & 31, hi = lane >> 5;
    bf16* XR = WSP(bf16, WS_BIG) + (size_t)T_ALL * DRNN; bf16* GG = WSP(bf16, WS_BIG); bf16* ABG = (bf16*)F.out;
    const bf16* HALO = WSP(bf16, WS_BIG + 136 * MiB);
    f32x2* SUM = WSP(f32x2, WS_H);
    const int wdir = wid >> 2, cb = wid & 3, chl = cb * 32 + r32;
    const int tk = tid >> 3, cg = tid & 7;
    LAS float* CW = (LAS float*)(lds + SC_CW);
    const int per = (SCAN_UNITS + F.G - 1) / F.G, u_lo = F.vcu * per, u_hi = (u_lo + per) < SCAN_UNITS ? (u_lo + per) : SCAN_UNITS;
    int n_cur = -1;
    v4u xr[8];
    bf16x8 wa[8], wx[8]; float ba = 0.f, bx = 0.f, sp8 = 0.f;
#define SC_DECODE(u_) const int n = (u_) / 384, cidx = (u_) % 384; const bool isctx = cidx < 128; const int b = isctx ? (cidx >> 2) : ((cidx - 128) >> 6); const int c = isctx ? (cidx & 3) : ((cidx - 128) & 63); \
        const size_t seq0 = isctx ? (size_t)b * CTX_SEQ : (size_t)T_CTX + (size_t)b * LAT_SEQ; const int seq_len = isctx ? CTX_SEQ : LAT_SEQ, t0 = c * 64;
#define SC_LOADX(u_) do { SC_DECODE(u_) (void)b; (void)seq_len; \
        _Pragma("unroll") for (int j = 0; j < 4; ++j) { const int tl = tk - 1 + j; \
            const bf16* src = tl < 0 ? HALO + (size_t)((cidx > 0 ? cidx - 1 : 0) * 3 + 0) * DRNN : (tl >= 64 ? HALO + (size_t)((cidx < 383 ? cidx + 1 : 383) * 3 + 1 + (tl - 64)) * DRNN : XR + (seq0 + t0 + tl) * DRNN); \
            const v4u* p = (const v4u*)(src + n * 128 + cg * 8); xr[2 * j] = p[0]; xr[2 * j + 1] = p[8]; } } while (0)
    if (wid >= 4) __builtin_amdgcn_s_setprio(1);
    if (u_lo < u_hi) SC_LOADX(u_lo);
#pragma unroll 1
    for (int u = u_lo; u < u_hi; ++u) {
        SC_DECODE(u)
        (void)b;
        if (n != n_cur) {
            __syncthreads();
            for (int i = tid; i < 640; i += NTHREADS) CW[i] = i < 512 ? F.in[IN_RCONVW][(i >> 7) * DRNN + n * 128 + (i & 127)] : F.in[IN_RCONVB][n * 128 + (i & 127)];
            n_cur = n;
            { const bf16* wap = WSP(bf16, WS_WG) + (size_t)((0 * 2 + wdir) * 10 + n) * 16384 + (size_t)chl * 128 + hi * 8;
              const bf16* wxp = WSP(bf16, WS_WG) + (size_t)((1 * 2 + wdir) * 10 + n) * 16384 + (size_t)chl * 128 + hi * 8;
#pragma unroll
              for (int ks = 0; ks < 8; ++ks) { wa[ks] = *(const bf16x8*)(wap + ks * 16); wx[ks] = *(const bf16x8*)(wxp + ks * 16); } }
            ba = F.in[IN_RBA][wdir * DRNN + n * 128 + chl] * -1.4426950408889634f; bx = F.in[IN_RBX][wdir * DRNN + n * 128 + chl] * -1.4426950408889634f;
            sp8 = WSP(float, WS_SP8)[wdir * DRNN + n * 128 + chl];
            __syncthreads();
        }
        { float a[16];
#pragma unroll
          for (int e = 0; e < 16; ++e) a[e] = CW[512 + (e >> 3) * 64 + cg * 8 + (e & 7)];
#pragma unroll
          for (int j = 0; j < 4; ++j) { const int t = t0 + tk - 1 + j; const float msk = (t >= 0 && t < seq_len) ? 1.0f : 0.0f;
              const unsigned w[8] = {xr[2 * j].x, xr[2 * j].y, xr[2 * j].z, xr[2 * j].w, xr[2 * j + 1].x, xr[2 * j + 1].y, xr[2 * j + 1].z, xr[2 * j + 1].w};
#pragma unroll
              for (int e = 0; e < 8; ++e) { const int c0 = (e >> 2) * 64 + cg * 8 + 2 * (e & 3); a[2 * e] += (CW[j * 128 + c0] * msk) * bflo(w[e]); a[2 * e + 1] += (CW[j * 128 + c0 + 1] * msk) * bfhi(w[e]); } }
          v4u o0, o1; o0.x = pk2(a[0], a[1]); o0.y = pk2(a[2], a[3]); o0.z = pk2(a[4], a[5]); o0.w = pk2(a[6], a[7]); o1.x = pk2(a[8], a[9]); o1.y = pk2(a[10], a[11]); o1.z = pk2(a[12], a[13]); o1.w = pk2(a[14], a[15]);
          LAS v4u* xp = (LAS v4u*)(lds + SC_XC + tk * 272 + cg * 16); xp[0] = o0; xp[8] = o1; }
        __syncthreads();
        if (u + 1 < u_hi) SC_LOADX(u + 1);
        { LAS f32x2* AU = (LAS f32x2*)(lds + (wdir ? SC_AUB : SC_AUF));
#pragma unroll 1
          for (int rb = 0; rb < 2; ++rb) {
            f32x16 ra, ia;
#pragma unroll
            for (int r = 0; r < 16; ++r) { ra[r] = ba; ia[r] = bx; }
            { const LAS unsigned char* ap = lds + SC_XC + (rb * 32 + r32) * 272 + hi * 16;
#pragma unroll
              for (int ks = 0; ks < 8; ++ks) { const bf16x8 af = *(const LAS bf16x8*)(ap + ks * 32);
                  ra = __builtin_amdgcn_mfma_f32_32x32x16_bf16(af, wa[ks], ra, 0, 0, 0);
                  ia = __builtin_amdgcn_mfma_f32_32x32x16_bf16(af, wx[ks], ia, 0, 0, 0); } }
#pragma unroll
            for (int r = 0; r < 16; ++r) {
                const int row = rb * 32 + crow(r, hi);
                const float rr = __builtin_amdgcn_rcpf(1.0f + __builtin_amdgcn_exp2f(ra[r]));
                const float ii = __builtin_amdgcn_rcpf(1.0f + __builtin_amdgcn_exp2f(ia[r]));
                const float x = sp8 * rr;
                const float em = -x * (1.0f + x * (0.5f + x * (0.16666667f + x * (0.041666668f + x * 0.0083333338f))));
                const float av = 1.0f - em;
                const float om = __builtin_fmaf(em, av, em);
                const float xv = bf2f(*(const LAS unsigned short*)(lds + SC_XC + row * 272 + chl * 2));
                AU[row * 128 + chl] = (f32x2){av, __builtin_amdgcn_sqrtf(om) * ii * xv};
            }
          } }
        __syncthreads();
        if (tid >= 256) {
            const int sch = tid & 127, sd = (tid >> 7) & 1;
            LAS f32x2* AU = (LAS f32x2*)(lds + (sd ? SC_AUB : SC_AUF)) + sch;
            float h = 0.f, pprod = 1.0f;
            f32x2 auA[8], auB[8];
#define SC_LD(dst, s0_) do { _Pragma("unroll") for (int j = 0; j < 8; ++j) { const int row = sd == 0 ? (s0_) + j : 63 - (s0_) - j; dst[j] = AU[row * 128]; } } while (0)
#define SC_RUN(src, s0_) do { _Pragma("unroll") for (int j = 0; j < 8; ++j) { const int row = sd == 0 ? (s0_) + j : 63 - (s0_) - j; h = src[j].x * h + src[j].y; pprod *= src[j].x; AU[row * 128] = (f32x2){h, pprod}; } } while (0)
            SC_LD(auA, 0);
#pragma unroll 1
            for (int s0 = 0; s0 < 64; s0 += 16) {
                SC_LD(auB, s0 + 8);
                SC_RUN(auA, s0);
                if (s0 + 16 < 64) SC_LD(auA, s0 + 16);
                SC_RUN(auB, s0 + 8);
            }
#undef SC_LD
#undef SC_RUN
            SUM[(size_t)cidx * 2 * DRNN + sd * DRNN + n * 128 + sch] = (f32x2){pprod, h};
        }
        __syncthreads();
        {
            const LAS f32x4* hfp = (const LAS f32x4*)(lds + SC_AUF) + lane; const LAS f32x4* hbp = (const LAS f32x4*)(lds + SC_AUB) + lane;
            const size_t eoff = (seq0 + t0 + wid * 8) * DRNN + n * 128;
            unsigned* gp = (unsigned*)(GG + eoff) + lane; unsigned* fp = (unsigned*)(XR + eoff) + lane; unsigned* bp = (unsigned*)(ABG + eoff) + lane;
            unsigned gw[8];
#pragma unroll
            for (int i = 0; i < 8; ++i) gw[i] = gp[(size_t)i * (DRNN / 2)];
#pragma unroll
            for (int i = 0; i < 8; ++i) {
                const f32x4 hf = hfp[(wid * 8 + i) * 64], hb = hbp[(wid * 8 + i) * 64];
                const float g0 = bflo(gw[i]), g1 = bfhi(gw[i]);
                gp[(size_t)i * (DRNN / 2)] = pk2((hf[0] + hb[0]) * g0, (hf[2] + hb[2]) * g1);
                fp[(size_t)i * (DRNN / 2)] = pk2(hf[1] * g0, hf[3] * g1);
                bp[(size_t)i * (DRNN / 2)] = pk2(hb[1] * g0, hb[3] * g1);
            }
        }
        __syncthreads();
    }
    __builtin_amdgcn_s_setprio(0);
#undef SC_DECODE
#undef SC_LOADX
}
__device__ __forceinline__ void scan_correct_phase(Frame& F) {
    bf16* GG = WSP(bf16, WS_BIG); const bf16* XR = WSP(bf16, WS_BIG) + (size_t)T_ALL * DRNN; const bf16* ABG = (const bf16*)F.out;
    const float* CAR = WSP(float, WS_H + 8 * MiB);
    const int gt = F.vcu * NTHREADS + F.tid, NGT = F.G * NTHREADS;
    for (int i = gt; i < T_ALL * (DRNN / 8); i += NGT) {
        const int row = i / (DRNN / 8), c8 = (i % (DRNN / 8)) * 8;
        const size_t off = (size_t)row * DRNN + c8;
        const v4u yl = *(const v4u*)(GG + off), af = *(const v4u*)(XR + off), ab = *(const v4u*)(ABG + off);
        const float* cf = CAR + (size_t)(row >> 6) * 2 * DRNN + c8; const float* cbp = cf + DRNN;
        const f32x4 f0 = *(const f32x4*)cf, f1 = *(const f32x4*)(cf + 4), b0 = *(const f32x4*)cbp, b1 = *(const f32x4*)(cbp + 4);
        const unsigned wy[4] = {yl.x, yl.y, yl.z, yl.w}, wf[4] = {af.x, af.y, af.z, af.w}, wb[4] = {ab.x, ab.y, ab.z, ab.w};
        const float cfv[8] = {f0[0], f0[1], f0[2], f0[3], f1[0], f1[1], f1[2], f1[3]}, cbv[8] = {b0[0], b0[1], b0[2], b0[3], b1[0], b1[1], b1[2], b1[3]};
        unsigned o[4];
#pragma unroll
        for (int e = 0; e < 4; ++e) o[e] = pk2(bflo(wy[e]) + bflo(wf[e]) * cfv[2 * e] + bflo(wb[e]) * cbv[2 * e], bfhi(wy[e]) + bfhi(wf[e]) * cfv[2 * e + 1] + bfhi(wb[e]) * cbv[2 * e + 1]);
        v4u ov; ov.x = o[0]; ov.y = o[1]; ov.z = o[2]; ov.w = o[3];
        *(v4u*)(GG + off) = ov;
    }
}

__device__ __forceinline__ void scan_carry_phase(Frame& F) {
    const f32x2* SUM = WSP(f32x2, WS_H); float* CAR = WSP(float, WS_H + 8 * MiB);
    const int gt = F.vcu * NTHREADS + F.tid, NGT = F.G * NTHREADS;
    for (int i = gt; i < 10240 + 81920; i += NGT) {
        const bool lat = i < 10240; const int j = lat ? i : i - 10240;
        const int ch = j % DRNN, sd = (j / DRNN) & 1, b = j / (2 * DRNN);
        const int nch = lat ? 64 : 4, cfirst = lat ? 128 + b * 64 : b * 4;
        float h = lat ? F.in[sd ? IN_SB : IN_SF][b * DRNN + ch] : 0.f;
        const f32x2* sp = SUM + (size_t)cfirst * 2 * DRNN + sd * DRNN + ch; float* cp = CAR + (size_t)cfirst * 2 * DRNN + sd * DRNN + ch;
        if (lat) {
            for (int k0 = 0; k0 < 64; k0 += 16) {
                f32x2 s[16];
#pragma unroll
                for (int q = 0; q < 16; ++q) { const int c = sd == 0 ? k0 + q : 63 - k0 - q; s[q] = sp[(size_t)c * 2 * DRNN]; }
#pragma unroll
                for (int q = 0; q < 16; ++q) { const int c = sd == 0 ? k0 + q : 63 - k0 - q; cp[(size_t)c * 2 * DRNN] = h; h = s[q].x * h + s[q].y; }
            }
        } else {
            f32x2 s[4];
#pragma unroll
            for (int q = 0; q < 4; ++q) { const int c = sd == 0 ? q : 3 - q; s[q] = sp[(size_t)c * 2 * DRNN]; }
#pragma unroll
            for (int q = 0; q < 4; ++q) { const int c = sd == 0 ? q : 3 - q; cp[(size_t)c * 2 * DRNN] = h; h = s[q].x * h + s[q].y; }
        }
        if (!lat) F.out[(sd ? OUT_SB : OUT_SF) + b * DRNN + ch] = h;
    }
}

constexpr int N_PHASES = 23;
__global__ void __launch_bounds__(NTHREADS, 2) fwd_kernel(Args args) {
    extern __shared__ __attribute__((aligned(16))) unsigned char lds_raw[];
    Frame F;
    F.lds = (LAS unsigned char*)lds_raw;
    F.tid = threadIdx.x; F.lane = F.tid & 63; F.wave = __builtin_amdgcn_readfirstlane(F.tid >> 6);
    F.G = gridDim.x; { const int bx = blockIdx.x; F.vcu = (F.G % 8 == 0) ? (bx % 8) * (F.G / 8) + bx / 8 : bx; }
    F.in = args.in; F.out = args.out; F.ws = args.ws;
    volatile LAS unsigned* MISC = (volatile LAS unsigned*)(F.lds + MISC_OFF);
    if (F.tid < 32) MISC[F.tid] = 0u;
    __syncthreads();
    XcdBarrier bar; bar.bar = (unsigned*)(args.ws + WS_CTL) + 1024; bar.x = 0; bar.st = nullptr; bar.wave = F.wave;
    if (args.use_bar) bar = xcd_barrier_post((unsigned*)(args.ws + WS_CTL) + 1024, MISC + 8, F.wave);
    const int lo = args.ph_lo, hi = args.ph_hi;
#ifndef PHMASK
#define PHMASK 0x7fffff
#endif
#ifndef REP_PHASE
#define REP_PHASE -1
#endif
#ifndef REP_N
#define REP_N 1
#endif
#define IN(k) (((PHMASK >> (k)) & 1) && lo <= (k) && (k) < hi)
#define REPS(k) for (int rep_ = 0; rep_ < (((k) == REP_PHASE) ? REP_N : 1); ++rep_)
#ifdef AMP_PHASE
    unsigned long long tph = __builtin_amdgcn_s_memrealtime();
#define SEAM(k) do { if ((k) == AMP_PHASE) { asm volatile("s_waitcnt vmcnt(0)" ::: "memory"); const unsigned long long t1_ = __builtin_amdgcn_s_memrealtime(), d_ = (t1_ - tph) * AMP_N; \
        while (__builtin_amdgcn_s_memrealtime() - t1_ < d_) __builtin_amdgcn_s_sleep(4); } if (IN(k) && IN((k) + 1)) xcd_barrier(bar); tph = __builtin_amdgcn_s_memrealtime(); } while (0)
#else
#define SEAM(k) do { if (IN(k) && IN((k) + 1)) xcd_barrier(bar); } while (0)
#endif
    bf16* XA = args.xa;
    bf16* XB = WSP(bf16, WS_BIG + 120 * MiB);
    const float* MOD = WSP(float, WS_MOD);
    bf16* H = WSP(bf16, WS_H);
    PG8_LAS unsigned char* ring = (PG8_LAS unsigned char*)lds_raw;

    if (IN(0)) REPS(0) { Frame P = fresh(F); p0_prologue(P); } SEAM(0);
    if (IN(1)) REPS(1) { Frame P = fresh(F); norm_mod_pass(P, F.in[IN_XP], F.in[IN_XS], F.in[IN_NORM1], MOD, 0, 1024, H); } SEAM(1);
    if (IN(2)) REPS(2) {
        pg8::Gemm g{H, WSP(bf16, WS_WIN), T_ALL, QKV_LD, DM, DM}; pg8::StaticOrder S; S.init(T_ALL, QKV_LD, F.G, (int)blockIdx.x);
        pg8::EpiInProj E{WSP(bf16, WS_BIG), F.out, WSP(pg8::f32x2, WS_ROPE)};
        pg8::gemm_phase<pg8::EpiInProj, pg8::StaticOrder, true, true>(ring, g, S, E, F.wave);
        { const int nfull = (T_ALL / 256) * (QKV_LD / 256) % F.G; Frame P = fresh(F);
          if (nfull == 0) p_deferred_transposes(P, (int)blockIdx.x, F.G); else if ((int)blockIdx.x >= nfull) p_deferred_transposes(P, (int)blockIdx.x - nfull, F.G - nfull); }
    } SEAM(2);
    if (IN(3)) REPS(3) { Frame P = fresh(F); attention_phase(P); } SEAM(3);
    if (IN(4)) REPS(4) {
        pg8::Gemm g{H, WSP(bf16, WS_WOUT), T_ALL, DM, DM, DM}; pg8::StaticOrder S; S.init(T_ALL, DM, F.G, (int)blockIdx.x, 192);
        pg8::EpiRes<true> E{F.in[IN_XP], F.in[IN_XS], XA, XB, MOD + 2048, 0};
        pg8::gemm_phase<pg8::EpiRes<true>, pg8::StaticOrder, true, true, 96>(ring, g, S, E, F.wave);
    } SEAM(4);
#pragma unroll 1
    for (int layer = 0; layer < 2; ++layer) {
        const int pb = layer == 0 ? 5 : 16;
        const float* MODL = MOD + (size_t)layer * 5 * 6144;
        if (IN(pb)) REPS(pb) { Frame P = fresh(F); norm_mod_pass_bf(P, XA, XB, F.in[IN_NORM2] + layer * DM, MODL, 3072, 4096, H); } SEAM(pb);
#pragma unroll 1
        for (int half = 0; half < 2; ++half) {
            const int row0 = half * (T_ALL / 2);
            if (IN(pb + 1 + 2 * half)) REPS(pb + 1 + 2 * half) {
                pg8::Gemm g{H + (size_t)row0 * DM, WSP(bf16, WS_W1) + (size_t)layer * DFF * DM, T_ALL / 2, DFF, DM, DM}; pg8::StaticOrder S; S.init(T_ALL / 2, DFF, F.G, (int)blockIdx.x);
                pg8::EpiSqRelu E{WSP(bf16, WS_BIG), LDH};
#ifdef STAGGER_TICKS
                if ((blockIdx.x >> 3) & 1) { const unsigned long long t0 = __builtin_amdgcn_s_memrealtime(); while (__builtin_amdgcn_s_memrealtime() - t0 < STAGGER_TICKS) __builtin_amdgcn_s_sleep(8); }
#endif
                pg8::gemm_phase<pg8::EpiSqRelu, pg8::StaticOrder, true, true>(ring, g, S, E, F.wave);
            } SEAM(pb + 1 + 2 * half);
            if (IN(pb + 2 + 2 * half)) REPS(pb + 2 + 2 * half) {
                pg8::Gemm g{WSP(bf16, WS_BIG), WSP(bf16, WS_W2) + (size_t)layer * DM * DFF, T_ALL / 2, DM, DFF, LDH}; pg8::StaticOrder S; S.init(T_ALL / 2, DM, F.G, (int)blockIdx.x, 192);
                pg8::EpiRes<false> E{nullptr, nullptr, XA, XB, MODL + 5120, row0};
                pg8::gemm_phase<pg8::EpiRes<false>, pg8::StaticOrder, true, true, 96>(ring, g, S, E, F.wave);
            } SEAM(pb + 2 + 2 * half);
        }
        if (layer == 0) {
            const float* MOD1 = MOD + 5 * 6144;
            if (IN(10)) REPS(10) { Frame P = fresh(F); norm_mod_pass_bf(P, XA, XB, F.in[IN_NORM1] + DM, MOD1, 0, 1024, H); } SEAM(10);
            if (IN(11)) REPS(11) {
                pg8::Gemm g{H, WSP(bf16, WS_WRIN), T_ALL, 2 * DRNN, DM, DM}; pg8::StaticOrder S; S.init(T_ALL, 2 * DRNN, F.G, (int)blockIdx.x);
                pg8::EpiRecIn E{WSP(bf16, WS_BIG), WSP(bf16, WS_BIG) + (size_t)T_ALL * DRNN, WSP(bf16, WS_BIG + 136 * MiB)};
                pg8::gemm_phase<pg8::EpiRecIn, pg8::StaticOrder, true, true>(ring, g, S, E, F.wave);
            } SEAM(11);
            if (IN(12)) REPS(12) { Frame P = fresh(F); scan_pass(P); } SEAM(12);
            if (IN(13)) REPS(13) { Frame P = fresh(F); scan_carry_phase(P); } SEAM(13);
            if (IN(14)) REPS(14) { Frame P = fresh(F); scan_correct_phase(P); } SEAM(14);
            if (IN(15)) REPS(15) {
                pg8::Gemm g{WSP(bf16, WS_BIG), WSP(bf16, WS_WROUT), T_ALL, DM, DRNN, DRNN}; pg8::StaticOrder S; S.init(T_ALL, DM, F.G, (int)blockIdx.x, 192);
                pg8::EpiRes<false> E{nullptr, nullptr, XA, XB, MOD1 + 2048, 0};
                pg8::gemm_phase<pg8::EpiRes<false>, pg8::StaticOrder, true, true, 96>(ring, g, S, E, F.wave);
            } SEAM(15);
        }
    }
    if (IN(21)) REPS(21) { Frame P = fresh(F); final_norm_pass(P, XA, XB, F.out, F.in[IN_FNORM], 0, args.fn_split); }
    if (args.fn_split < T_ALL) { SEAM(21);
    if (IN(22)) REPS(22) { Frame P = fresh(F); final_norm_pass(P, XA, XB, F.out, F.in[IN_FNORM], args.fn_split, T_ALL); } }
#undef IN
#undef SEAM
}

#ifndef MK_ONE_LAUNCH
#define MK_ONE_LAUNCH 1
#endif
extern "C" void kernel_launch(void* const* d_in, const int* in_sizes, int n_in, void* d_out, int out_size, void* d_ws, size_t ws_size, hipStream_t stream) {
    static int grid = 0;
    if (grid == 0) {
        if (n_in != 31 || ws_size < WS_END) { fprintf(stderr, "kernel_launch: unexpected n_in %d / ws_size %zu\n", n_in, ws_size); grid = -1; return; }
        int dev = 0, cus = 0, per_cu = 0;
        if (hipGetDevice(&dev) != hipSuccess || hipDeviceGetAttribute(&cus, hipDeviceAttributeMultiprocessorCount, dev) != hipSuccess) { grid = -1; return; }
        if (hipFuncSetAttribute((const void*)fwd_kernel, hipFuncAttributeMaxDynamicSharedMemorySize, LDS_BYTES) != hipSuccess) { fprintf(stderr, "kernel_launch: hipFuncSetAttribute failed\n"); grid = -1; return; }
        if (hipOccupancyMaxActiveBlocksPerMultiprocessor(&per_cu, (const void*)fwd_kernel, NTHREADS, LDS_BYTES) != hipSuccess || per_cu < 1) { fprintf(stderr, "kernel_launch: occupancy query says %d\n", per_cu); (void)hipGetLastError(); grid = -1; return; }
        grid = cus;
    }
    if (grid < 0) return;
    (void)hipMemsetAsync((char*)d_ws + WS_CTL, 0, CTL_ZERO_BYTES, stream);
#ifdef WS_PROBE
    if (ws_size >= (size_t)WS_PROBE * MiB) (void)hipMemsetAsync((char*)d_ws + 128 * MiB, 0, 100 * MiB, stream);
#endif
    Args a{};
    for (int i = 0; i < 31; ++i) a.in[i] = (const float*)d_in[i];
    a.out = (float*)d_out; a.ws = (unsigned char*)d_ws; { const bool big = ws_size >= WS_END_BIG; a.xa = big ? (unsigned short*)((unsigned char*)d_ws + WS_XA_BIG) : (unsigned short*)((unsigned char*)d_out + 64 * MiB); a.fn_split = big ? T_ALL : pg8::X_SPLIT; }
#if MK_ONE_LAUNCH
    a.ph_lo = 0; a.ph_hi = N_PHASES; a.use_bar = 1;
    hipLaunchKernelGGL(fwd_kernel, dim3(grid), dim3(NTHREADS), LDS_BYTES, stream, a);
#else
    for (int p = 0; p < N_PHASES; ++p) { a.ph_lo = p; a.ph_hi = p + 1; a.use_bar = 0; hipLaunchKernelGGL(fwd_kernel, dim3(grid), dim3(NTHREADS), LDS_BYTES, stream, a); }
#endif
}
```
